# Optimizing an MI355X kernel written in HIP

```python
import jax, jax.numpy as jnp
from jax import lax
import numpy as np

D_MODEL = 2048
BATCH = 4
SEQ = 4096
DEPTH = 1

PLE_DIM = 256
ATTN_HEADS = 8
ATTN_HEAD_DIM = 128
ATTN_BLOCK = 128
MLSTM_HEADS = 4
MLSTM_QK_DIM = 128
MLSTM_V_DIM = 256
MLSTM_CHUNK = 64
CONV_WIDTH = 4
ATTN_WIDTH = ATTN_HEADS * ATTN_HEAD_DIM
MLSTM_QK_WIDTH = MLSTM_HEADS * MLSTM_QK_DIM
MLSTM_WIDTH = MLSTM_HEADS * MLSTM_V_DIM
MIX_WIDTH = ATTN_WIDTH + MLSTM_WIDTH
D_FF = -(-8 * D_MODEL // (3 * 256)) * 256
IN_WIDTHS = (ATTN_WIDTH, ATTN_WIDTH, ATTN_WIDTH, ATTN_HEADS,
             MLSTM_QK_WIDTH, MLSTM_QK_WIDTH, MLSTM_WIDTH, MLSTM_HEADS, MLSTM_HEADS, MLSTM_WIDTH)
IN_COLS = sum(IN_WIDTHS)
EPS = 1e-6

kernel_name = 'fox_mlstm_parallel_hybrid_block'


def rms_norm(u, w):
    uf = u.astype(jnp.float32)
    y = uf * lax.rsqrt(jnp.mean(uf * uf, axis=-1, keepdims=True) + EPS)
    return y.astype(u.dtype) * w


def causal_dwconv(u, w, b):
    K, C = w.shape
    out = lax.conv_general_dilated(u, w[:, None, :], window_strides=(1,), padding=[(K - 1, 0)],
                                   dimension_numbers=('NWC', 'WIO', 'NWC'), feature_group_count=C)
    return out + b


def forgetting_attention(q, k, v, logf):
    B, S, H, d = q.shape
    q = q.transpose(0, 2, 1, 3)
    k = k.transpose(0, 2, 1, 3)
    v = v.transpose(0, 2, 1, 3)
    c = jnp.cumsum(logf, axis=1).transpose(0, 2, 1)
    kpos = jnp.arange(S)
    scale = d ** -0.5

    def block(bi):
        start = bi * ATTN_BLOCK
        qb = lax.dynamic_slice_in_dim(q, start, ATTN_BLOCK, axis=2)
        cb = lax.dynamic_slice_in_dim(c, start, ATTN_BLOCK, axis=2)
        s = jnp.einsum('bhqd,bhkd->bhqk', qb, k).astype(jnp.float32) * scale
        s = s + cb[..., :, None] - c[..., None, :]
        qpos = start + jnp.arange(ATTN_BLOCK)
        s = jnp.where(kpos[None, :] <= qpos[:, None], s, -jnp.inf)
        pr = jax.nn.softmax(s, axis=-1).astype(v.dtype)
        return jnp.einsum('bhqk,bhkd->bhqd', pr, v)

    o = lax.map(block, jnp.arange(S // ATTN_BLOCK))
    return o.transpose(1, 0, 3, 2, 4).reshape(B, S, H * d)


def mlstm_chunkwise(q, k, v, i_pre, logf):
    B, H, S, dk = q.shape
    dv = v.shape[-1]
    L = MLSTM_CHUNK
    NC = S // L
    qc = jnp.moveaxis(q.reshape(B, H, NC, L, dk), 2, 0)
    kc = jnp.moveaxis(k.reshape(B, H, NC, L, dk), 2, 0)
    vc = jnp.moveaxis(v.reshape(B, H, NC, L, dv), 2, 0)
    ic = jnp.moveaxis(i_pre.reshape(B, H, NC, L), 2, 0)
    fc = jnp.moveaxis(logf.reshape(B, H, NC, L), 2, 0)
    causal = jnp.tril(jnp.ones((L, L), dtype=bool))

    def step(carry, xs):
        C, n, m = carry
        qt, kt, vt, it, ft = xs
        b = jnp.cumsum(ft, axis=-1)
        D = b[..., :, None] - b[..., None, :] + it[..., None, :]
        D = jnp.where(causal, D, -jnp.inf)
        inter = b + m[..., None]
        m_t = jnp.maximum(inter, jnp.max(D, axis=-1))
        w_intra = jnp.exp(D - m_t[..., None])
        w_inter = jnp.exp(inter - m_t)
        s_qk = jnp.einsum('bhtd,bhsd->bhts', qt, kt) * w_intra
        num = jnp.einsum('bhts,bhsv->bhtv', s_qk, vt) + w_inter[..., None] * jnp.einsum('bhvd,bhtd->bhtv', C, qt)
        den = jnp.sum(s_qk, axis=-1) + w_inter * jnp.einsum('bhd,bhtd->bht', n, qt)
        h = num / jnp.maximum(jnp.abs(den), jnp.exp(-m_t))[..., None]
        bL = b[..., -1]
        g = bL[..., None] - b + it
        m_new = jnp.maximum(bL + m, jnp.max(g, axis=-1))
        ws = jnp.exp(g - m_new[..., None])
        wc = jnp.exp(bL + m - m_new)
        C_new = wc[..., None, None] * C + jnp.einsum('bhs,bhsv,bhsd->bhvd', ws, vt, kt)
        n_new = wc[..., None] * n + jnp.einsum('bhs,bhsd->bhd', ws, kt)
        return (C_new, n_new, m_new), h

    init = (jnp.zeros((B, H, dv, dk), jnp.float32), jnp.zeros((B, H, dk), jnp.float32), jnp.zeros((B, H), jnp.float32))
    _, hs = lax.scan(step, init, (qc, kc, vc, ic, fc))
    return jnp.moveaxis(hs, 0, 2).reshape(B, H, S, dv)


def setup_inputs(seed: int = 0) -> dict:
    key = jax.random.key(seed)
    ks = jax.random.split(key, 24)
    f32 = jnp.float32

    def nrm(k, shape, scale):
        return jax.random.normal(k, shape, f32) * scale

    def gain(k, shape):
        return 1.0 + 0.01 * jax.random.normal(k, shape, f32)

    return {
        'x': nrm(ks[0], (BATCH, SEQ, D_MODEL), 1.0),
        'p': nrm(ks[1], (DEPTH, BATCH, SEQ, PLE_DIM), 1.0),
        'w_norm_mix': gain(ks[2], (DEPTH, D_MODEL)),
        'w_in': nrm(ks[3], (DEPTH, D_MODEL, IN_COLS), D_MODEL ** -0.5),
        'fox_f_bias': jnp.linspace(1.0, 5.0, ATTN_HEADS, dtype=f32)[None, :] + nrm(ks[4], (DEPTH, ATTN_HEADS), 0.1),
        'q_norm_w': gain(ks[5], (DEPTH, ATTN_HEAD_DIM)),
        'k_norm_w': gain(ks[6], (DEPTH, ATTN_HEAD_DIM)),
        'mlstm_conv_w': nrm(ks[7], (DEPTH, CONV_WIDTH, 2 * MLSTM_QK_WIDTH), CONV_WIDTH ** -0.5),
        'mlstm_conv_b': nrm(ks[8], (DEPTH, 2 * MLSTM_QK_WIDTH), 0.01),
        'mlstm_i_bias': nrm(ks[9], (DEPTH, MLSTM_HEADS), 0.1),
        'mlstm_f_bias': jnp.linspace(3.0, 6.0, MLSTM_HEADS, dtype=f32)[None, :] + nrm(ks[10], (DEPTH, MLSTM_HEADS), 0.1),
        'mlstm_out_norm_w': gain(ks[11], (DEPTH, MLSTM_WIDTH)),
        'w_out': nrm(ks[12], (DEPTH, MIX_WIDTH, D_MODEL), MIX_WIDTH ** -0.5),
        'w_norm_ffn': gain(ks[13], (DEPTH, D_MODEL)),
        'w_ffn_gate': nrm(ks[14], (DEPTH, D_MODEL, D_FF), D_MODEL ** -0.5),
        'w_ffn_up': nrm(ks[15], (DEPTH, D_MODEL, D_FF), D_MODEL ** -0.5),
        'w_ffn_down': nrm(ks[16], (DEPTH, D_FF, D_MODEL), D_FF ** -0.5),
        'w_norm_ple': gain(ks[17], (DEPTH, D_MODEL)),
        'w_ple_gate': nrm(ks[18], (DEPTH, D_MODEL, D_MODEL), D_MODEL ** -0.5),
        'w_ple_proj': nrm(ks[19], (DEPTH, PLE_DIM, D_MODEL), PLE_DIM ** -0.5),
        'w_ple_post_norm': gain(ks[20], (DEPTH, D_MODEL)),
    }


def reference(x, p, w_norm_mix, w_in, fox_f_bias, q_norm_w, k_norm_w, mlstm_conv_w, mlstm_conv_b,
              mlstm_i_bias, mlstm_f_bias, mlstm_out_norm_w, w_out, w_norm_ffn, w_ffn_gate, w_ffn_up,
              w_ffn_down, w_norm_ple, w_ple_gate, w_ple_proj, w_ple_post_norm):
    B, S, _ = x.shape
    f32 = jnp.float32
    split_points = np.cumsum(IN_WIDTHS)[:-1].tolist()
    for i in range(DEPTH):
        h = rms_norm(x, w_norm_mix[i])
        proj = h @ w_in[i]
        aq, ak, av, af, mq, mk, mv, mi, mf, mo = jnp.split(proj, split_points, axis=-1)

        aq = rms_norm(aq.reshape(B, S, ATTN_HEADS, ATTN_HEAD_DIM), q_norm_w[i])
        ak = rms_norm(ak.reshape(B, S, ATTN_HEADS, ATTN_HEAD_DIM), k_norm_w[i])
        av = av.reshape(B, S, ATTN_HEADS, ATTN_HEAD_DIM)
        a_logf = jax.nn.log_sigmoid(af.astype(f32) + fox_f_bias[i].astype(f32))
        attn_out = forgetting_attention(aq, ak, av, a_logf)

        mqk = jax.nn.silu(causal_dwconv(jnp.concatenate([mq, mk], axis=-1), mlstm_conv_w[i], mlstm_conv_b[i]))
        mq, mk = jnp.split(mqk, 2, axis=-1)
        mq = mq.reshape(B, S, MLSTM_HEADS, MLSTM_QK_DIM).transpose(0, 2, 1, 3).astype(f32) * (MLSTM_QK_DIM ** -0.5)
        mk = mk.reshape(B, S, MLSTM_HEADS, MLSTM_QK_DIM).transpose(0, 2, 1, 3).astype(f32)
        mv = mv.reshape(B, S, MLSTM_HEADS, MLSTM_V_DIM).transpose(0, 2, 1, 3).astype(f32)
        m_i = (mi.astype(f32) + mlstm_i_bias[i].astype(f32)).transpose(0, 2, 1)
        m_logf = jax.nn.log_sigmoid(mf.astype(f32) + mlstm_f_bias[i].astype(f32)).transpose(0, 2, 1)
        ht = mlstm_chunkwise(mq, mk, mv, m_i, m_logf)
        ht = rms_norm(ht.transpose(0, 2, 1, 3), jnp.ones((), f32)).reshape(B, S, MLSTM_WIDTH)
        mlstm_out = (ht.astype(x.dtype) * mlstm_out_norm_w[i]) * jax.nn.sigmoid(mo)

        x = x + jnp.concatenate([attn_out, mlstm_out], axis=-1) @ w_out[i]

        h2 = rms_norm(x, w_norm_ffn[i])
        x = x + (jax.nn.silu(h2 @ w_ffn_gate[i]) * (h2 @ w_ffn_up[i])) @ w_ffn_down[i]

        gate = jax.nn.sigmoid(rms_norm(x, w_norm_ple[i]) @ w_ple_gate[i])
        e = rms_norm(p[i] @ w_ple_proj[i], w_ple_post_norm[i])
        x = x + gate * e
    return x
```

```cpp
#include <hip/hip_runtime.h>
#include <hip/hip_cooperative_groups.h>
#include <hip/hip_bf16.h>
#include <cstdio>
#include <cstdint>
namespace cg = cooperative_groups;

constexpr int NB = 4, SEQ = 4096, DM = 2048, MROWS = NB * SEQ;
constexpr int PLE = 256, AH = 8, MH = 4, DFF = 5632, INC = 6160;
constexpr int PROJ_LD = 6144, NIN = 6400;
constexpr int PC_AQ = 0, PC_AK = 1024, PC_AV = 2048, PC_MQ = 3072, PC_MK = 3584, PC_MV = 4096, PC_MO = 5120;
constexpr float EPS = 1e-6f;
constexpr float LOG2E = 1.4426950408889634f;

typedef unsigned short bf16_t;
typedef float f32x4 __attribute__((ext_vector_type(4)));
typedef float f32x2 __attribute__((ext_vector_type(2)));
typedef unsigned u32x4 __attribute__((ext_vector_type(4)));
typedef unsigned u32x2 __attribute__((ext_vector_type(2)));
typedef __bf16 bf16x2_t __attribute__((ext_vector_type(2)));
__device__ __forceinline__ unsigned cvtpk2(float lo, float hi) { f32x2 v = {lo, hi}; bf16x2_t b = __builtin_convertvector(v, bf16x2_t); return __builtin_bit_cast(unsigned, b); }
__device__ __forceinline__ float bflo(unsigned w) { return __uint_as_float(w << 16); }
__device__ __forceinline__ float bfhi(unsigned w) { return __uint_as_float(w & 0xffff0000u); }
__device__ __forceinline__ float sigmoidf_(float x) { return __builtin_amdgcn_rcpf(1.f + __expf(-x)); }
namespace pg8 {
#define PG8_LAS __attribute__((address_space(3)))
typedef unsigned short bf16_t;
typedef short bf16x8 __attribute__((ext_vector_type(8)));
typedef float f32x4 __attribute__((ext_vector_type(4)));
typedef unsigned u32x4 __attribute__((ext_vector_type(4)));
constexpr int BM = 256, BK = 64, HALF = 128, HTB = HALF * BK * 2  , STAGE_BYTES = 8 * HTB, NXCD = 8, WGM = 8;

__host__ __device__ __forceinline__ int lds_byte(int r, int c) { const int st = (r >> 4) * 2 + (c >> 5), rr = r & 15, cc = c & 31, ob = rr * 64 + cc * 2; return st * 1024 + (ob ^ (((ob >> 9) & 1) << 5)); }
__host__ __device__ __forceinline__ void stage_rc(int b, int& R, int& C) { const int st = b / 1024, sb = b % 1024, swz = sb ^ (((sb >> 9) & 1) << 5); R = (st >> 1) * 16 + swz / 64; C = (st & 1) * 32 + (swz % 64) / 2; }
__host__ __device__ __forceinline__ int perm32(int rho) { const int n = rho >> 4, i = rho & 15; return 8 * (i >> 2) + 4 * n + (i & 3); }

struct Unit { int pm, pn; };
struct Gemm { const bf16_t* A; const bf16_t* Bt; int M, N, K; };

struct StaticOrder {
    int nM, nN, nwg, G, c;
    __host__ __device__ void init(int M, int N, int G_, int c_) { nM = M / BM; nN = N / BM; nwg = nM * nN; G = G_; c = c_; }
    __host__ __device__ bool next(int i, Unit& u) const {
        const long L = (long)i * G + c; if (L >= nwg) return false;
        int wgid = (int)L; { const int q = nwg / NXCD, r = nwg % NXCD, xcd = wgid % NXCD, off = wgid / NXCD; wgid = (xcd < r ? xcd * (q + 1) : r * (q + 1) + (xcd - r) * q) + off; }
        const int nig = WGM * nN, gid = wgid / nig, fm = gid * WGM, gsz = (nM - fm) < WGM ? (nM - fm) : WGM;
        u.pm = fm + ((wgid % nig) % gsz); u.pn = (wgid % nig) / gsz; return true;
    }
    __device__ __forceinline__ void a_ready(const Unit&) const {}
    __device__ __forceinline__ void done(const Unit&) const {}
};
__device__ __forceinline__ unsigned cvt_pk_bf16(float lo, float hi) { return ::cvtpk2(lo, hi); }
__device__ __forceinline__ float sumsq4(f32x4 v) { return (v[0] * v[0] + v[1] * v[1]) + (v[2] * v[2] + v[3] * v[3]); }
__device__ __forceinline__ void atomic_add_f32(float* p, float v) { __hip_atomic_fetch_add(p, v, __ATOMIC_RELAXED, __HIP_MEMORY_SCOPE_AGENT); }

struct EpiProj {
    static constexpr bool PERM = true, AFTER_DRAIN = false;
    bf16_t* O; float* G;
    __device__ __forceinline__ void operator()(const f32x4 (&acc)[2][2][4][2], const Unit& u, int wr, int wc, int fr, int fq) const {
        const int row0 = u.pm * BM + wr * 64 + fr;
        if (u.pn < 24) {
            const int col0 = u.pn * BM + wc * 32 + 8 * fq;
#pragma unroll
            for (int ai = 0; ai < 2; ++ai)
#pragma unroll
                for (int m = 0; m < 4; ++m) { bf16_t* rowp = O + (size_t)(row0 + ai * HALF + m * 16) * 6144 + col0;
#pragma unroll
                    for (int bj = 0; bj < 2; ++bj) { const f32x4 v0 = acc[ai][bj][m][0], v1 = acc[ai][bj][m][1];
                        u32x4 w; w.x = cvt_pk_bf16(v0[0], v0[1]); w.y = cvt_pk_bf16(v0[2], v0[3]); w.z = cvt_pk_bf16(v1[0], v1[1]); w.w = cvt_pk_bf16(v1[2], v1[3]);
                        *(u32x4*)(rowp + bj * HALF) = w; } }
        } else if (wc == 0) {
            if (fq < 2) {
#pragma unroll
                for (int ai = 0; ai < 2; ++ai)
#pragma unroll
                    for (int m = 0; m < 4; ++m) { float* gp = G + (size_t)(row0 + ai * HALF + m * 16) * 16 + 8 * fq;
                        *(f32x4*)(gp) = acc[ai][0][m][0]; *(f32x4*)(gp + 4) = acc[ai][0][m][1]; }
            }
        }
    }
};
struct EpiE {
    static constexpr bool PERM = true, AFTER_DRAIN = false;
    bf16_t* O; float* ss;
    __device__ __forceinline__ void operator()(const f32x4 (&acc)[2][2][4][2], const Unit& u, int wr, int wc, int fr, int fq) const {
        const int row0 = u.pm * BM + wr * 64 + fr, col0 = u.pn * BM + wc * 32 + 8 * fq;
#pragma unroll
        for (int ai = 0; ai < 2; ++ai)
#pragma unroll
            for (int m = 0; m < 4; ++m) { const int row = row0 + ai * HALF + m * 16; bf16_t* rowp = O + (size_t)row * 2048 + col0; float s = 0.f;
#pragma unroll
                for (int bj = 0; bj < 2; ++bj) { const f32x4 v0 = acc[ai][bj][m][0], v1 = acc[ai][bj][m][1]; s += sumsq4(v0) + sumsq4(v1);
                    u32x4 w; w.x = cvt_pk_bf16(v0[0], v0[1]); w.y = cvt_pk_bf16(v0[2], v0[3]); w.z = cvt_pk_bf16(v1[0], v1[1]); w.w = cvt_pk_bf16(v1[2], v1[3]);
                    *(u32x4*)(rowp + bj * HALF) = w; }
                s += __shfl_xor(s, 16); s += __shfl_xor(s, 32);
                if (fq == 0) atomic_add_f32(ss + row, s); }
    }
};
struct EpiRes {
    static constexpr bool PERM = false, AFTER_DRAIN = false;
    const float* xin; float* xout; bf16_t* xn; const float* wn; float* ss;
    __device__ __forceinline__ void operator()(const f32x4 (&acc)[2][2][4][2], const Unit& u, int wr, int wc, int fr, int fq) const {
        const int row0 = u.pm * BM + wr * 64 + fr, col0 = u.pn * BM + wc * 32 + 4 * fq;
        f32x4 wv[2][2];
#pragma unroll
        for (int bj = 0; bj < 2; ++bj)
#pragma unroll
            for (int n = 0; n < 2; ++n) wv[bj][n] = *(const f32x4*)(wn + col0 + bj * HALF + n * 16);
#pragma unroll
        for (int ai = 0; ai < 2; ++ai)
#pragma unroll
            for (int m = 0; m < 4; ++m) { const int row = row0 + ai * HALF + m * 16; const size_t off = (size_t)row * 2048 + col0; float s = 0.f;
#pragma unroll
                for (int bj = 0; bj < 2; ++bj)
#pragma unroll
                    for (int n = 0; n < 2; ++n) { const size_t o2 = off + bj * HALF + n * 16; const f32x4 v = *(const f32x4*)(xin + o2) + acc[ai][bj][m][n];
                        *(f32x4*)(xout + o2) = v; s += sumsq4(v); const f32x4 y = v * wv[bj][n];
                        u32x2 w; w.x = cvt_pk_bf16(y[0], y[1]); w.y = cvt_pk_bf16(y[2], y[3]); *(u32x2*)(xn + o2) = w; }
                s += __shfl_xor(s, 16); s += __shfl_xor(s, 32);
                if (fq == 0) atomic_add_f32(ss + row, s); }
    }
};
struct EpiSwiGLU {
    static constexpr bool PERM = true, AFTER_DRAIN = false;
    bf16_t* O; const float* ss;
    __device__ __forceinline__ void operator()(const f32x4 (&acc)[2][2][4][2], const Unit& u, int wr, int wc, int fr, int fq) const {
        const int row0 = u.pm * BM + wr * 64 + fr, col0 = u.pn * HALF + wc * 32 + 8 * fq;
#pragma unroll
        for (int ai = 0; ai < 2; ++ai)
#pragma unroll
            for (int m = 0; m < 4; ++m) { const int row = row0 + ai * HALF + m * 16; const float rs = __builtin_amdgcn_rsqf(ss[row] * (1.f / 2048.f) + 1e-6f);
                float r[8];
#pragma unroll
                for (int n = 0; n < 2; ++n)
#pragma unroll
                    for (int e = 0; e < 4; ++e) { const float g = acc[ai][0][m][n][e] * rs, up = acc[ai][1][m][n][e] * rs; r[n * 4 + e] = g * __builtin_amdgcn_rcpf(1.f + __expf(-g)) * up; }
                u32x4 w; w.x = cvt_pk_bf16(r[0], r[1]); w.y = cvt_pk_bf16(r[2], r[3]); w.z = cvt_pk_bf16(r[4], r[5]); w.w = cvt_pk_bf16(r[6], r[7]);
                *(u32x4*)(O + (size_t)row * 5632 + col0) = w; }
    }
};
struct EpiFinal {
    static constexpr bool PERM = false, AFTER_DRAIN = false;
    float* out; const bf16_t* eraw; const float* wpost; const float* ss3; const float* ssE;
    __device__ __forceinline__ void operator()(const f32x4 (&acc)[2][2][4][2], const Unit& u, int wr, int wc, int fr, int fq) const {
        const int row0 = u.pm * BM + wr * 64 + fr, col0 = u.pn * BM + wc * 32 + 4 * fq;
        f32x4 wv[2][2];
#pragma unroll
        for (int bj = 0; bj < 2; ++bj)
#pragma unroll
            for (int n = 0; n < 2; ++n) wv[bj][n] = *(const f32x4*)(wpost + col0 + bj * HALF + n * 16);
#pragma unroll
        for (int ai = 0; ai < 2; ++ai)
#pragma unroll
            for (int m = 0; m < 4; ++m) { const int row = row0 + ai * HALF + m * 16; const size_t off = (size_t)row * 2048 + col0;
                const float rs = __builtin_amdgcn_rsqf(ss3[row] * (1.f / 2048.f) + 1e-6f), re = __builtin_amdgcn_rsqf(ssE[row] * (1.f / 2048.f) + 1e-6f);
#pragma unroll
                for (int bj = 0; bj < 2; ++bj)
#pragma unroll
                    for (int n = 0; n < 2; ++n) { const size_t o2 = off + bj * HALF + n * 16; const f32x4 x2 = *(const f32x4*)(out + o2); const u32x2 ew = *(const u32x2*)(eraw + o2);
                        const f32x4 a = acc[ai][bj][m][n] * rs; f32x4 e = {::bflo(ew.x), ::bfhi(ew.x), ::bflo(ew.y), ::bfhi(ew.y)}; e = e * re * wv[bj][n];
                        f32x4 o; o[0] = x2[0] + ::sigmoidf_(a[0]) * e[0]; o[1] = x2[1] + ::sigmoidf_(a[1]) * e[1]; o[2] = x2[2] + ::sigmoidf_(a[2]) * e[2]; o[3] = x2[3] + ::sigmoidf_(a[3]) * e[3];
                        *(f32x4*)(out + o2) = o; } }
    }
};
template <class Epi, class Sched, bool ALIGN_EPI = false, bool SP2 = false>
__device__ __forceinline__ void gemm_phase(PG8_LAS unsigned char* lds, const Gemm g, const Sched& S, const Epi& E) {
    int tid0_ = threadIdx.x; asm volatile("" : "+v"(tid0_));
    const int tid = tid0_, wid = __builtin_amdgcn_readfirstlane(tid >> 6), lane = tid & 63, wr = wid >> 2, wc = wid & 3, fr = lane & 15, fq = lane >> 4;
    int K0_ = g.K; asm volatile("" : "+s"(K0_));
    const int K = K0_, nt = K / BK;
    unsigned voffA[2], voffB[2];
#pragma unroll
    for (int i = 0; i < 2; ++i) { int R, C; stage_rc(tid * 16 + i * 8192, R, C); const int Rb = Epi::PERM ? ((R & ~31) + perm32(R & 31)) : R;
        voffA[i] = (unsigned)(R * K + C) * 2u; voffB[i] = (unsigned)(Rb * K + C) * 2u; }
    const size_t kstep = (size_t)(BK * 2);
    const size_t hstep = (size_t)HALF * K * 2;
    const size_t tstep = 2 * hstep;
    const unsigned ldsw = (unsigned)wid * 1024u;
    const int aoff = lds_byte(wr * 64 + fr, fq * 8), boff = lds_byte(wc * 32 + fr, fq * 8);
#define PG8_SA(b, h) (((b) * 2 + (h)) * HTB)
#define PG8_SB(b, h) ((4 + (b) * 2 + (h)) * HTB)
#define PG8_STAGE(bufoff, gbase, voff) do { _Pragma("unroll") for (int _i = 0; _i < 2; ++_i) \
        __builtin_amdgcn_global_load_lds((const unsigned*)((const char*)(gbase) + (voff)[_i]), (PG8_LAS unsigned*)(lds + (bufoff) + ldsw + _i * 8192), 16, 0, 0); } while (0)
#define PG8_LDA(dst, b, h) do { _Pragma("unroll") for (int m = 0; m < 4; ++m) _Pragma("unroll") for (int k = 0; k < 2; ++k) dst[m][k] = *(const PG8_LAS bf16x8*)(lds + PG8_SA(b, h) + aoff + m * 2048 + k * 1024); } while (0)
#define PG8_LDB(dst, b, h) do { _Pragma("unroll") for (int n = 0; n < 2; ++n) _Pragma("unroll") for (int k = 0; k < 2; ++k) dst[n][k] = *(const PG8_LAS bf16x8*)(lds + PG8_SB(b, h) + boff + n * 2048 + k * 1024); } while (0)
#define PG8_MMA(ai, bj, At, Bt) do { __builtin_amdgcn_s_setprio(1); _Pragma("unroll") for (int m = 0; m < 4; ++m) _Pragma("unroll") for (int n = 0; n < 2; ++n) _Pragma("unroll") for (int k = 0; k < 2; ++k) \
        acc[ai][bj][m][n] = __builtin_amdgcn_mfma_f32_16x16x32_bf16(Bt[n][k], At[m][k], acc[ai][bj][m][n], 0, 0, 0); __builtin_amdgcn_s_setprio(0); } while (0)
#define PG8_WAIT_V(n) asm volatile("s_waitcnt vmcnt(" #n ")" ::: "memory")
#define PG8_WAIT_L(n) asm volatile("s_waitcnt lgkmcnt(" #n ")" ::: "memory")
#define PG8_BAR __builtin_amdgcn_s_barrier()
#define PG8_SCHED __builtin_amdgcn_sched_barrier(0)
    Unit cur, nxt; int ui = 0;
    if (!S.next(0, cur)) return;
    f32x4 acc[2][2][4][2];
#pragma unroll
    for (int a = 0; a < 2; ++a)
#pragma unroll
        for (int b = 0; b < 2; ++b)
#pragma unroll
            for (int m = 0; m < 4; ++m)
#pragma unroll
                for (int n = 0; n < 2; ++n) acc[a][b][m][n] = (f32x4){0.f, 0.f, 0.f, 0.f};
    bf16x8 At[4][2], B0[2][2], B1[2][2];
    const char* cA = (const char*)g.A + (size_t)cur.pm * tstep; const char* cB = (const char*)g.Bt + (size_t)cur.pn * tstep;
    S.a_ready(cur);
    if constexpr (SP2) {
        PG8_STAGE(PG8_SB(0, 0), cB, voffB); PG8_STAGE(PG8_SB(0, 1), cB + hstep, voffB); PG8_STAGE(PG8_SA(0, 0), cA, voffA); PG8_STAGE(PG8_SA(0, 1), cA + hstep, voffA);
        if (wr == 1) PG8_BAR;
        PG8_WAIT_V(2); PG8_BAR;
        PG8_STAGE(PG8_SB(1, 0), cB + kstep, voffB); PG8_STAGE(PG8_SA(1, 0), cA + kstep, voffA); PG8_STAGE(PG8_SB(1, 1), cB + hstep + kstep, voffB);
        PG8_WAIT_V(6); PG8_BAR;
    } else {
        PG8_STAGE(PG8_SB(0, 0), cB, voffB); PG8_STAGE(PG8_SA(0, 0), cA, voffA); PG8_STAGE(PG8_SB(0, 1), cB + hstep, voffB); PG8_STAGE(PG8_SA(0, 1), cA + hstep, voffA);
        if (wr == 1) PG8_BAR;
        PG8_WAIT_V(4); PG8_BAR;
        PG8_STAGE(PG8_SB(1, 0), cB + kstep, voffB); PG8_STAGE(PG8_SA(1, 0), cA + kstep, voffA); PG8_STAGE(PG8_SB(1, 1), cB + hstep + kstep, voffB);
        PG8_WAIT_V(6); PG8_BAR;
    }
    for (;;) {
        const bool has_next = S.next(ui + 1, nxt);
        const char* nA = has_next ? (const char*)g.A + (size_t)nxt.pm * tstep : cA; const char* nB = has_next ? (const char*)g.Bt + (size_t)nxt.pn * tstep : cB;
        for (int t = 0; t < nt; t += 2) {
            const bool last = (t == nt - 2);
            const char* a1 = cA + (size_t)(t + 1) * kstep;
            const char* a2 = last ? nA : cA + (size_t)(t + 2) * kstep; const char* b2 = last ? nB : cB + (size_t)(t + 2) * kstep;
            const char* a3 = a2 + kstep; const char* b3 = b2 + kstep;
            if (last && has_next) S.a_ready(nxt);
            if constexpr (SP2) {
            PG8_LDB(B0, 0, 0); PG8_LDB(B1, 0, 1); PG8_SCHED; PG8_LDA(At, 0, 0); PG8_STAGE(PG8_SA(1, 1), a1 + hstep, voffA);
            PG8_WAIT_V(8); PG8_WAIT_L(0); PG8_BAR; PG8_MMA(0, 0, At, B0); PG8_MMA(0, 1, At, B1); PG8_BAR; PG8_SCHED;
            PG8_LDA(At, 0, 1); PG8_STAGE(PG8_SB(0, 0), b2, voffB); PG8_STAGE(PG8_SB(0, 1), b2 + hstep, voffB); PG8_STAGE(PG8_SA(0, 0), a2, voffA);
            PG8_WAIT_V(8); PG8_WAIT_L(0); PG8_BAR; PG8_MMA(1, 0, At, B0); PG8_MMA(1, 1, At, B1); PG8_BAR; PG8_SCHED;
            PG8_LDB(B0, 1, 0); PG8_LDB(B1, 1, 1); PG8_SCHED; PG8_LDA(At, 1, 0); PG8_STAGE(PG8_SA(0, 1), a2 + hstep, voffA);
            PG8_WAIT_V(8); PG8_WAIT_L(0); PG8_BAR; PG8_MMA(0, 0, At, B0); PG8_MMA(0, 1, At, B1); PG8_BAR; PG8_SCHED;
            PG8_LDA(At, 1, 1); PG8_STAGE(PG8_SB(1, 0), b3, voffB); PG8_STAGE(PG8_SB(1, 1), b3 + hstep, voffB); PG8_STAGE(PG8_SA(1, 0), a3, voffA);
            PG8_WAIT_V(8); PG8_WAIT_L(0); PG8_BAR; PG8_MMA(1, 0, At, B0); PG8_MMA(1, 1, At, B1); PG8_BAR; PG8_SCHED;
            } else {
            PG8_LDB(B0, 0, 0); PG8_SCHED; PG8_LDA(At, 0, 0); PG8_STAGE(PG8_SA(1, 1), a1 + hstep, voffA);
            PG8_WAIT_L(8); PG8_BAR; PG8_WAIT_L(0); PG8_MMA(0, 0, At, B0); PG8_BAR; PG8_SCHED;
            PG8_LDB(B1, 0, 1); PG8_STAGE(PG8_SB(0, 0), b2, voffB);
            PG8_BAR; PG8_WAIT_L(0); PG8_MMA(0, 1, At, B1); PG8_BAR;
            PG8_LDA(At, 0, 1); PG8_STAGE(PG8_SA(0, 0), a2, voffA);
            PG8_BAR; PG8_WAIT_L(0); PG8_MMA(1, 0, At, B0); PG8_BAR; PG8_SCHED;
            PG8_STAGE(PG8_SB(0, 1), b2 + hstep, voffB);
            PG8_WAIT_V(6); PG8_BAR; PG8_MMA(1, 1, At, B1); PG8_BAR;
            PG8_LDB(B0, 1, 0); PG8_SCHED; PG8_LDA(At, 1, 0); PG8_STAGE(PG8_SA(0, 1), a2 + hstep, voffA);
            PG8_WAIT_L(8); PG8_BAR; PG8_WAIT_L(0); PG8_MMA(0, 0, At, B0); PG8_BAR; PG8_SCHED;
            PG8_LDB(B1, 1, 1); PG8_STAGE(PG8_SB(1, 0), b3, voffB);
            PG8_BAR; PG8_WAIT_L(0); PG8_MMA(0, 1, At, B1); PG8_BAR;
            PG8_LDA(At, 1, 1); PG8_STAGE(PG8_SA(1, 0), a3, voffA);
            PG8_BAR; PG8_WAIT_L(0); PG8_MMA(1, 0, At, B0); PG8_BAR; PG8_SCHED;
            PG8_STAGE(PG8_SB(1, 1), b3 + hstep, voffB);
            PG8_WAIT_V(6); PG8_BAR; PG8_MMA(1, 1, At, B1); PG8_BAR;
            }
        }
        if constexpr (ALIGN_EPI) { if (wr == 0) PG8_BAR; }
        if constexpr (!Epi::AFTER_DRAIN) { E(acc, cur, wr, wc, fr, fq); S.done(cur); }
        if (!has_next) break;
#pragma unroll
        for (int a = 0; a < 2; ++a)
#pragma unroll
            for (int b = 0; b < 2; ++b)
#pragma unroll
                for (int m = 0; m < 4; ++m)
#pragma unroll
                    for (int n = 0; n < 2; ++n) acc[a][b][m][n] = (f32x4){0.f, 0.f, 0.f, 0.f};
        cur = nxt; cA = nA; cB = nB; ++ui;
        if constexpr (ALIGN_EPI) { if (wr == 1) PG8_BAR; }
    }
    PG8_WAIT_V(0);
    if constexpr (!ALIGN_EPI) { if (wr == 0) PG8_BAR; }
    PG8_BAR;
    if constexpr (Epi::AFTER_DRAIN) { E.fused(acc, cur, wr, wc, fr, fq, lds, wid, lane); S.done(cur); }
#undef PG8_SA
#undef PG8_SB
#undef PG8_STAGE
#undef PG8_LDA
#undef PG8_LDB
#undef PG8_MMA
#undef PG8_WAIT_V
#undef PG8_WAIT_L
#undef PG8_BAR
#undef PG8_SCHED
}
}
namespace fa {
using bf16 = __hip_bfloat16;
typedef short bf16x8 __attribute__((ext_vector_type(8)));
typedef short s16x4 __attribute__((ext_vector_type(4)));
typedef float f32x16 __attribute__((ext_vector_type(16)));
constexpr int D = 128, NW = 8, QBLK = 32, KVBLK = 64, QB = NW * QBLK;
constexpr int SHM_V = KVBLK * D * 2, SHM_K = KVBLK * D * 2;
constexpr int OFF_WS = 2 * SHM_V + 2 * SHM_K, OFF_CK = OFF_WS + NW * 64 * 4, LDS_BYTES = OFF_CK + 2 * 64 * 4;
constexpr float SCALE = 0.08838834764831845f;
constexpr float THR = 8.f;

#define KSWZ(row, colB) ((row) * 256 + ((colB) ^ (((row) & 7) << 4)))
#define SBAR() __builtin_amdgcn_sched_barrier(0)
__device__ __forceinline__ int v_st(int k, int c) { const int kk = (k & ~0xC) | ((k & 4) << 1) | ((k & 8) >> 1); return ((kk >> 3) * 4 + (c >> 5)) * 512 + ((kk & 7) * 32 + (c & 31)) * 2; }
__device__ __forceinline__ int v_rd_base(int lane) { return ((lane & 3) << 3) | (((lane >> 2) & 3) << 6) | (((lane >> 4) & 1) << 5) | (((lane >> 5) & 1) << 8); }
constexpr int v_rd_off(int d0, int ks, int half) { return d0 * 512 + ks * 4096 + half * 2048; }
__device__ __forceinline__ int crow(int r, int hi) { return (r & 3) + 8 * (r >> 2) + 4 * hi; }
__device__ __forceinline__ unsigned cvtpk(float lo, float hi) { return ::cvtpk2(lo, hi); }
__device__ __forceinline__ bf16x8 load8(const bf16* p) { return *reinterpret_cast<const bf16x8*>(p); }
template <int MODE> __device__ __forceinline__ void mask_tile(f32x16& p0, f32x16& p1, int dq) {
    const float NEG = MODE == 0 ? -__builtin_inff() : 0.f;
#pragma unroll
    for (int r = 0; r < 16; ++r) {
        const int c = (r & 3) + 8 * (r >> 2);
        if (dq - c < 0) p0[r] = NEG;
        if (dq - c - 32 < 0) p1[r] = NEG;
    }
}
__device__ __forceinline__ void partialSM(f32x16& p0, f32x16& p1, float& m_reg, float& mn, float& alpha) {
    float pmax = p0[0]; for (int r = 1; r < 16; ++r) pmax = fmaxf(pmax, p0[r]); for (int r = 0; r < 16; ++r) pmax = fmaxf(pmax, p1[r]);
    { auto rr = __builtin_amdgcn_permlane32_swap(__float_as_uint(pmax), __float_as_uint(pmax), false, false);
      pmax = fmaxf(__uint_as_float(rr[0]), __uint_as_float(rr[1])); }
    constexpr float C2 = 1.4426950408889634f * SCALE;
    if (__builtin_expect(__all((pmax - m_reg) * SCALE <= THR), 1)) { mn = m_reg; alpha = 1.f; }
    else { mn = fmaxf(m_reg, pmax); alpha = __builtin_amdgcn_exp2f((m_reg - mn) * C2); m_reg = mn; }
    const float mnL = -mn * C2;
    for (int r = 0; r < 16; ++r) p0[r] = fmaf(p0[r], C2, mnL); for (int r = 0; r < 16; ++r) p1[r] = fmaf(p1[r], C2, mnL);
    for (int r = 0; r < 16; ++r) p0[r] = __builtin_amdgcn_exp2f(p0[r]);
}
#define PK4(P, B_, OUT) do { unsigned a0 = cvtpk(P[B_+0], P[B_+1]), a1 = cvtpk(P[B_+2], P[B_+3]);                          \
        unsigned b0 = cvtpk(P[B_+4], P[B_+5]), b1 = cvtpk(P[B_+6], P[B_+7]);                                             \
        auto r0 = __builtin_amdgcn_permlane32_swap(a0, b0, false, false); auto r1 = __builtin_amdgcn_permlane32_swap(a1, b1, false, false); \
        u32x4 w = {r0[0], r1[0], r0[1], r1[1]}; OUT = *reinterpret_cast<bf16x8*>(&w); } while (0)
__device__ __forceinline__ void finishSM(f32x16& p0, f32x16& p1, float alpha, float& l_reg, bf16x8& pa0, bf16x8& pa1, bf16x8& pa2, bf16x8& pa3) {
    for (int r = 0; r < 16; ++r) p1[r] = __builtin_amdgcn_exp2f(p1[r]);
    float ps = 0; for (int r = 0; r < 16; ++r) ps += p0[r]; for (int r = 0; r < 16; ++r) ps += p1[r];
    { auto rr = __builtin_amdgcn_permlane32_swap(__float_as_uint(ps), __float_as_uint(ps), false, false);
      ps = __uint_as_float(rr[0]) + __uint_as_float(rr[1]); }
    l_reg = l_reg * alpha + ps;
    PK4(p0, 0, pa0); PK4(p0, 8, pa1); PK4(p1, 0, pa2); PK4(p1, 8, pa3);
}
__device__ __forceinline__ void linScale(f32x16& p0, f32x16& p1, float fr) {
    for (int r = 0; r < 16; ++r) p0[r] *= fr; for (int r = 0; r < 16; ++r) p1[r] *= fr;
}
__device__ __forceinline__ void linFinish(f32x16& p0, f32x16& p1, float& l_reg, bf16x8& pa0, bf16x8& pa1, bf16x8& pa2, bf16x8& pa3) {
    float ps = 0; for (int r = 0; r < 16; ++r) ps += p0[r]; for (int r = 0; r < 16; ++r) ps += p1[r];
    { auto rr = __builtin_amdgcn_permlane32_swap(__float_as_uint(ps), __float_as_uint(ps), false, false);
      ps = __uint_as_float(rr[0]) + __uint_as_float(rr[1]); }
    l_reg += ps;
    PK4(p0, 0, pa0); PK4(p0, 8, pa1); PK4(p1, 0, pa2); PK4(p1, 8, pa3);
}
#undef PK4
template <int KB, int MODE>
__device__ __forceinline__ void qkt(f32x16& p0, f32x16& p1, const char* K_lds, const float* ckl, int r32, int hi, const bf16x8* qr) {
    if constexpr (MODE == 0) {
        const float* c = ckl + KB * 64 + 4 * hi;
#pragma unroll
        for (int g = 0; g < 4; ++g) { const f32x4 a = *(const f32x4*)(c + 8 * g), b = *(const f32x4*)(c + 32 + 8 * g);
            p0[4 * g + 0] = a[0]; p0[4 * g + 1] = a[1]; p0[4 * g + 2] = a[2]; p0[4 * g + 3] = a[3];
            p1[4 * g + 0] = b[0]; p1[4 * g + 1] = b[1]; p1[4 * g + 2] = b[2]; p1[4 * g + 3] = b[3]; }
    } else { p0 = f32x16{}; p1 = f32x16{}; }
    const char* kb[4];
#pragma unroll
    for (int dd = 0; dd < 4; ++dd) kb[dd] = K_lds + KB * SHM_K + KSWZ(r32, (dd * 16 + hi * 8) * 2);
#pragma unroll
    for (int d0 = 0; d0 < 8; ++d0) { const char* a = kb[d0 & 3] + (d0 >> 2) * 128;
        bf16x8 b0 = *reinterpret_cast<const bf16x8*>(a);
        bf16x8 b1 = *reinterpret_cast<const bf16x8*>(a + 32 * 256);
        p0 = __builtin_amdgcn_mfma_f32_32x32x16_bf16(b0, qr[d0], p0, 0, 0, 0);
        p1 = __builtin_amdgcn_mfma_f32_32x32x16_bf16(b1, qr[d0], p1, 0, 0, 0); }
}
template <int VB>
__device__ __forceinline__ void pv_tile(f32x16* o, int vb0, bf16x8 pa0, bf16x8 pa1, bf16x8 pa2, bf16x8 pa3) {
#define TRRD(dst, off) asm volatile("ds_read_b64_tr_b16 %0, %1 offset:%2" : "=&v"(dst) : "v"(vb0), "i"(off) : "memory")
#define PV_D0(d0) do { s16x4 l0, l1, l2, l3, h0, h1, h2, h3; constexpr int b_ = VB * SHM_V + v_rd_off(d0, 0, 0);     \
        TRRD(l0, b_); TRRD(h0, b_ + 2048); TRRD(l1, b_ + 4096); TRRD(h1, b_ + 6144); TRRD(l2, b_ + 8192); TRRD(h2, b_ + 10240); TRRD(l3, b_ + 12288); TRRD(h3, b_ + 14336); \
        asm volatile("s_waitcnt lgkmcnt(0)" ::: "memory"); SBAR();                 \
        o[d0] = __builtin_amdgcn_mfma_f32_32x32x16_bf16(pa0, (bf16x8){l0[0], l0[1], l0[2], l0[3], h0[0], h0[1], h0[2], h0[3]}, o[d0], 0, 0, 0);   \
        o[d0] = __builtin_amdgcn_mfma_f32_32x32x16_bf16(pa1, (bf16x8){l1[0], l1[1], l1[2], l1[3], h1[0], h1[1], h1[2], h1[3]}, o[d0], 0, 0, 0);   \
        o[d0] = __builtin_amdgcn_mfma_f32_32x32x16_bf16(pa2, (bf16x8){l2[0], l2[1], l2[2], l2[3], h2[0], h2[1], h2[2], h2[3]}, o[d0], 0, 0, 0);   \
        o[d0] = __builtin_amdgcn_mfma_f32_32x32x16_bf16(pa3, (bf16x8){l3[0], l3[1], l3[2], l3[3], h3[0], h3[1], h3[2], h3[3]}, o[d0], 0, 0, 0); } while (0)
    PV_D0(0); PV_D0(1); PV_D0(2); PV_D0(3);
#undef PV_D0
#undef TRRD
}

struct BlockRef { const bf16* Q; const bf16* K; const bf16* V; bf16* O; const float* aux; int P0; };
constexpr int AUX_MEXP = 65536, AUX_AREF = 131072;
template <int MODE> struct Pitch { static constexpr int qp = MODE ? 512 : 6144, kp = MODE ? 512 : 6144, vp = 6144, op = MODE ? 1024 : 2048; };
struct Seam { bf16x8 qr[8]; bf16x8 st_v0, st_v1, st_k0, st_k1; float st_c; };
#define ROWK(R, PM, k0, rr) ((R).K + (size_t)(k0) * Pitch<PM>::kp + (unsigned)(((rr) * Pitch<PM>::kp) + sc))
#define ROWV(R, PM, k0, rr) ((R).V + (size_t)(k0) * Pitch<PM>::vp + (unsigned)(((rr) * Pitch<PM>::vp) + sc))
#define VMW() asm volatile("s_waitcnt vmcnt(0)" ::: "memory")
#define VMWN(n) asm volatile("s_waitcnt vmcnt(%0)" :: "i"(n) : "memory")
#define SLOAD_H(R, PM, k0) do { S.st_v0 = load8(ROWV(R, PM, k0, sr)); S.st_v1 = load8(ROWV(R, PM, k0, 32 + sr));              \
                         S.st_k0 = load8(ROWK(R, PM, k0, sr)); S.st_k1 = load8(ROWK(R, PM, k0, 32 + sr));                \
                         if constexpr (PM == 0) S.st_c = (R).aux[(k0) + (tid & 63)]; } while (0)
#define SWRITE_HK(bf) do { *(bf16x8*)(K_lds + (bf) * SHM_K + kws) = S.st_k0; *(bf16x8*)(K_lds + (bf) * SHM_K + kws + 32 * 256) = S.st_k1; \
                           if constexpr (MODE == 0) { if (tid < 64) ckl[(bf) * 64 + tid] = S.st_c; } } while (0)
#define SWRITE_HV(bf) do { *(bf16x8*)(V_lds + (bf) * SHM_V + vst0) = S.st_v0; *(bf16x8*)(V_lds + (bf) * SHM_V + vst1) = S.st_v1; } while (0)
#define SWRITE_H(bf) do { SWRITE_HV(bf); SWRITE_HK(bf); } while (0)
template <int MODE>
__device__ __forceinline__ void attn_prime(const BlockRef& cur, char* lds, Seam& S) {
    const int tid = threadIdx.x, wid = __builtin_amdgcn_readfirstlane(tid >> 6), lane = tid & 63, r32 = lane & 31, hi = lane >> 5;
    const int sr = tid >> 4, sc = (tid & 15) * 8, kws = KSWZ(sr, sc * 2), vst0 = v_st(sr, sc), vst1 = v_st(32 + sr, sc); char* V_lds = lds; char* K_lds = lds + 2 * SHM_V; float* ckl = (float*)(lds + OFF_CK);
#pragma unroll
    for (int d0 = 0; d0 < 8; ++d0) S.qr[d0] = load8(cur.Q + (size_t)(cur.P0 + wid * QBLK) * Pitch<MODE>::qp + (unsigned)(r32 * Pitch<MODE>::qp + d0 * 16 + hi * 8));
    SLOAD_H(cur, MODE, 0); VMW(); SWRITE_H(0);
    __syncthreads();
}
template <int MODE>
__device__ __forceinline__ void attn_block(const BlockRef& cur, const BlockRef& nxt, char* lds, Seam& S) {
    int tid0_ = threadIdx.x; asm volatile("" : "+v"(tid0_));
    const int tid = tid0_, wid = __builtin_amdgcn_readfirstlane(tid >> 6), lane = tid & 63, r32 = lane & 31, hi = lane >> 5;
    const int NT = cur.P0 / KVBLK + 4;
    const int qlo = cur.P0 + wid * QBLK, qm = qlo + r32 - 4 * hi;
    char* V_lds = lds; char* K_lds = lds + 2 * SHM_V;
    float* ws = (float*)(lds + OFF_WS) + wid * 64; float* li_l = ws, * al_l = ws + 32; float* ckl = (float*)(lds + OFF_CK);
    float m_reg = -1e30f, l_reg = 0; f32x16 o[4] = {};
    const int sr = tid >> 4, sc = (tid & 15) * 8, vst0 = v_st(sr, sc), vst1 = v_st(32 + sr, sc), kws = KSWZ(sr, sc * 2);
    const int vb0 = (int)(uintptr_t)V_lds + v_rd_base(lane);
    float m2row = 0.f; if constexpr (MODE == 1) m2row = cur.aux[qlo + r32];
#define RESC(a) do { if constexpr (MODE == 0) { if (__any((a) < 1.f)) { if (hi == 0) al_l[r32] = (a); asm volatile("s_waitcnt lgkmcnt(0)" ::: "memory");              \
                     for (int d_ = 0; d_ < 4; ++d_) for (int r = 0; r < 16; ++r) o[d_][r] *= al_l[crow(r, hi)]; } } } while (0)
#define KBASE(t) ((t) * KVBLK)
    f32x16 p0, p1; float mn, al; bf16x8 pa0, pa1, pa2, pa3;
#define STEP(t, BUF, LASTCHK) do {                                                                                               \
        float ar = 0.f; if constexpr (MODE == 1) ar = cur.aux[AUX_AREF + (t)];                                                    \
        const bool last_ = LASTCHK && ((t) + 1 >= NT);                                                                            \
        if (last_) { SLOAD_H(nxt, MODE, 0); } else { SLOAD_H(cur, MODE, KBASE((t) + 1)); }                                         \
        SBAR(); qkt<BUF, MODE>(p0, p1, K_lds, ckl, r32, hi, S.qr); SBAR();                                                          \
        if (last_) { _Pragma("unroll") for (int d0 = 0; d0 < 8; ++d0) S.qr[d0] = load8(nxt.Q + (size_t)(nxt.P0 + wid * QBLK) * Pitch<MODE>::qp + (unsigned)(r32 * Pitch<MODE>::qp + d0 * 16 + hi * 8)); SBAR(); } \
        { const int kb_ = KBASE(t); if (kb_ + KVBLK - 1 > qlo) mask_tile<MODE>(p0, p1, qm - kb_); }                               \
        if constexpr (MODE == 0) { partialSM(p0, p1, m_reg, mn, al); RESC(al); finishSM(p0, p1, al, l_reg, pa0, pa1, pa2, pa3); }    \
        else { linScale(p0, p1, __builtin_amdgcn_exp2f(ar - m2row)); linFinish(p0, p1, l_reg, pa0, pa1, pa2, pa3); }               \
        SBAR(); pv_tile<BUF>(o, vb0, pa0, pa1, pa2, pa3); SBAR();                                                                 \
        VMW(); SWRITE_H((BUF) ^ 1);                                                                                               \
        __syncthreads(); } while (0)
    for (int t = 0; t < NT; t += 2) { STEP(t, 0, false); STEP(t + 1, 1, true); }
    { float lv = l_reg; if constexpr (MODE == 1) lv = fmaxf(fabsf(l_reg), cur.aux[AUX_MEXP + qlo + r32]);
      if (hi == 0) li_l[r32] = lv; }
    asm volatile("s_waitcnt lgkmcnt(0)" ::: "memory");
    float rli[16];
#pragma unroll
    for (int r = 0; r < 16; ++r) rli[r] = __builtin_amdgcn_rcpf(li_l[crow(r, hi)]);
    bf16* Ow = cur.O + (size_t)(qlo) * Pitch<MODE>::op;
#pragma unroll
    for (int r = 0; r < 16; ++r) { const int orow = crow(r, hi);
#pragma unroll
        for (int d0 = 0; d0 < 4; ++d0) { const float v = o[d0][r] * rli[r];
            const float vn = __shfl_xor(v, 1);
            if ((r32 & 1) == 0) *(unsigned*)(Ow + (unsigned)(orow * Pitch<MODE>::op + d0 * 32 + r32)) = cvtpk(v, vn); } }
    asm volatile("s_waitcnt lgkmcnt(0)" ::: "memory");
#undef RESC
#undef KBASE
#undef STEP
}
#undef ROWK
#undef ROWV
#undef VMW
#undef VMWN
#undef SLOAD_H
#undef SWRITE_HK
#undef SWRITE_HV
#undef SWRITE_H
#undef SBAR
#undef KSWZ
}
#define LAS __attribute__((address_space(3)))
constexpr int NWAVES = 8, NTHREADS = NWAVES * 64;
constexpr int LDS_BYTES = 131072 + 4096;
static_assert(fa::LDS_BYTES <= 131072, "attention scratch fits the ring region");
constexpr size_t MiB = 1u << 20;
constexpr size_t WS_SS = 0;
constexpr size_t WS_G = 1 * MiB;
constexpr size_t WS_CK = 2 * MiB;
constexpr size_t WS_A2 = 2 * MiB + 512 * 1024, WS_M2 = WS_A2 + 256 * 1024, WS_MEXP = WS_M2 + 256 * 1024, WS_AREF = WS_MEXP + 256 * 1024;
static_assert((WS_MEXP - WS_M2) / 4 == fa::AUX_MEXP && (WS_AREF - WS_M2) / 4 == fa::AUX_AREF, "aux offsets");
constexpr size_t WS_WIN = 4 * MiB, WS_WO = 29 * MiB, WS_WGU = 37 * MiB, WS_WD = 81 * MiB, WS_WPG = 103 * MiB, WS_WPP = 111 * MiB;
constexpr size_t WS_R1 = 112 * MiB;
constexpr size_t WS_R2 = 304 * MiB;
constexpr size_t WS_R3 = 368 * MiB;
constexpr size_t WS_HB = WS_R3, WS_MQ = WS_R3 + 32 * MiB, WS_MK = WS_R3 + 48 * MiB;
constexpr size_t WS_ERAW = 432 * MiB, WS_END = 496 * MiB;

struct Args {
    const float *x, *p, *w_norm_mix, *w_in, *fox_f_bias, *q_norm_w, *k_norm_w, *conv_w, *conv_b, *mi_bias, *mf_bias, *out_norm_w, *w_out, *w_norm_ffn,
                *w_gate, *w_up, *w_down, *w_norm_ple, *w_ple_gate, *w_ple_proj, *w_ple_post;
    float* out; unsigned char* ws;
};

__device__ __forceinline__ float wave_sum(float v) {
#pragma unroll
    for (int o = 1; o < 64; o <<= 1) v += __shfl_xor(v, o);
    return v;
}
__device__ __forceinline__ int win_src_col(int d) {
    if (d < 3072) return d;
    if (d < 5120) return d + 8;
    if (d < 6144) return d + 16;
    if (d < 6152) return 3072 + (d - 6144);
    if (d < 6160) return 5128 + (d - 6152);
    return -1;
}
__device__ __forceinline__ void p0_transpose_item(const float* src, int ld, int k0, bf16_t* WT, int K, int d0, LAS float* scr, int lane) {
#pragma unroll 8
    for (int i = 0; i < 32; ++i) { const int kk = 2 * i + (lane >> 5); scr[kk * 33 + (lane & 31)] = src ? src[(size_t)(k0 + kk) * ld] : 0.f; }
    asm volatile("s_waitcnt lgkmcnt(0)" ::: "memory");
    const int c = lane & 7;
#pragma unroll
    for (int j = 0; j < 4; ++j) { const int n = (lane >> 3) + 8 * j; const LAS float* s = scr + (8 * c) * 33 + n;
        u32x4 o; o.x = cvtpk2(s[0 * 33], s[1 * 33]); o.y = cvtpk2(s[2 * 33], s[3 * 33]); o.z = cvtpk2(s[4 * 33], s[5 * 33]); o.w = cvtpk2(s[6 * 33], s[7 * 33]);
        *(u32x4*)(WT + (size_t)(d0 + n) * K + k0 + 8 * c) = o; }
    asm volatile("s_waitcnt lgkmcnt(0)" ::: "memory");
}
__device__ __forceinline__ void p0_prologue(const Args& A, LAS unsigned char* lds, int gw, int NGW, int lane, int wave) {
    LAS float* scr = (LAS float*)(lds + wave * 16384);
    unsigned char* ws = A.ws;
    bf16_t* WinT = (bf16_t*)(ws + WS_WIN); bf16_t* WoT = (bf16_t*)(ws + WS_WO); bf16_t* WguT = (bf16_t*)(ws + WS_WGU);
    bf16_t* WdT = (bf16_t*)(ws + WS_WD); bf16_t* WpgT = (bf16_t*)(ws + WS_WPG); bf16_t* WppT = (bf16_t*)(ws + WS_WPP);
    constexpr int I_IN = (DM / 64) * (NIN / 32), I_O = (DM / 64) * (DM / 32), I_GU = (DM / 64) * (2 * DFF / 32), I_D = (DFF / 64) * (DM / 32), I_PG = I_O, I_PP = (PLE / 64) * (DM / 32);
    constexpr int NITEMS = I_IN + I_O + I_GU + I_D + I_PG + I_PP;
    const int l31 = lane & 31;
    for (int it = gw; it < NITEMS; it += NGW) {
        int r = it;
        if (r < I_IN) { const int nblk = NIN / 32, kb = r / nblk, nb = r % nblk; const int sc = win_src_col(nb * 32 + l31);
            p0_transpose_item(sc >= 0 ? A.w_in + sc : nullptr, INC, kb * 64, WinT, DM, nb * 32, scr, lane); continue; } r -= I_IN;
        if (r < I_O) { const int nblk = DM / 32, kb = r / nblk, nb = r % nblk; p0_transpose_item(A.w_out + nb * 32 + l31, DM, kb * 64, WoT, DM, nb * 32, scr, lane); continue; } r -= I_O;
        if (r < I_GU) { const int nblk = 2 * DFF / 32, kb = r / nblk, nb = r % nblk; const int d = nb * 32, pn = d >> 8, j = d & 255;
            const float* s = (j < 128) ? A.w_gate + 128 * pn + j + l31 : A.w_up + 128 * pn + (j - 128) + l31;
            p0_transpose_item(s, DFF, kb * 64, WguT, DM, d, scr, lane); continue; } r -= I_GU;
        if (r < I_D) { const int nblk = DM / 32, kb = r / nblk, nb = r % nblk; p0_transpose_item(A.w_down + nb * 32 + l31, DM, kb * 64, WdT, DFF, nb * 32, scr, lane); continue; } r -= I_D;
        if (r < I_PG) { const int nblk = DM / 32, kb = r / nblk, nb = r % nblk; p0_transpose_item(A.w_ple_gate + nb * 32 + l31, DM, kb * 64, WpgT, DM, nb * 32, scr, lane); continue; } r -= I_PG;
        { const int nblk = DM / 32, kb = r / nblk, nb = r % nblk; p0_transpose_item(A.w_ple_proj + nb * 32 + l31, DM, kb * 64, WppT, PLE, nb * 32, scr, lane); }
    }
    bf16_t* XN = (bf16_t*)(ws + WS_R2);
    f32x4 wv[8];
#pragma unroll
    for (int j = 0; j < 8; ++j) wv[j] = ((const f32x4*)A.w_norm_mix)[64 * j + lane];
    for (int m = gw; m < MROWS; m += NGW) {
        const f32x4* xr = (const f32x4*)(A.x + (size_t)m * DM) + lane;
        f32x4 v[8]; float s = 0.f;
#pragma unroll
        for (int j = 0; j < 8; ++j) { v[j] = xr[64 * j]; s += (v[j].x * v[j].x + v[j].y * v[j].y) + (v[j].z * v[j].z + v[j].w * v[j].w); }
        const float rs = 1.f / sqrtf(wave_sum(s) * (1.f / DM) + EPS);
        u32x2* o8 = (u32x2*)(XN + (size_t)m * DM) + lane;
#pragma unroll
        for (int j = 0; j < 8; ++j) { const f32x4 y = v[j] * rs * wv[j]; u32x2 w; w.x = cvtpk2(y.x, y.y); w.y = cvtpk2(y.z, y.w); o8[64 * j] = w; }
    }
    bf16_t* PB = (bf16_t*)(ws + WS_R3);
    for (int m = gw; m < MROWS; m += NGW) { const f32x4 v = ((const f32x4*)(A.p + (size_t)m * PLE))[lane]; u32x2 w; w.x = cvtpk2(v.x, v.y); w.y = cvtpk2(v.z, v.w); ((u32x2*)(PB + (size_t)m * PLE))[lane] = w; }
    float* ss = (float*)(ws + WS_SS);
    for (int i = gw * 64 + lane; i < 3 * MROWS; i += NGW * 64) ss[i] = 0.f;
}
__device__ __forceinline__ float logsigf(float x) { return fminf(x, 0.f) - log1pf(expf(-fabsf(x))); }
__device__ __forceinline__ void scan_sequence(const Args& A, int v, LAS float* red) {
    const int tid = threadIdx.x, lane = tid & 63, wid = tid >> 6;
    const bool fox = v < NB * AH; int b, h;
    if (fox) { b = v / AH; h = v % AH; } else { const int u = v - NB * AH; b = u / MH; h = u % MH; }
    const float* Gp = (const float*)(A.ws + WS_G) + (size_t)(b * SEQ + 8 * tid) * 16;
    const int fcol = fox ? h : 12 + h; const float fb = fox ? A.fox_f_bias[h] : A.mf_bias[h];
    float lf[8]; float run = 0.f;
#pragma unroll
    for (int i = 0; i < 8; ++i) { run += logsigf(Gp[i * 16 + fcol] + fb); lf[i] = run; }
    float incl = run;
#pragma unroll
    for (int o = 1; o < 64; o <<= 1) { const float t = __shfl_up(incl, o); if (lane >= o) incl += t; }
    if (lane == 63) red[wid] = incl;
    __syncthreads();
    float base = incl - run;
    for (int w = 0; w < wid; ++w) base += red[w];
    if (fox) {
        float* CK = (float*)(A.ws + WS_CK) + (size_t)(b * AH + h) * SEQ + 8 * tid;
#pragma unroll
        for (int i = 0; i < 8; ++i) CK[i] = -(base + lf[i]) * 11.313708498984761f;
    } else {
        const float ib = A.mi_bias[h];
        float a[8], lm[8]; float rm = -__builtin_inff();
#pragma unroll
        for (int i = 0; i < 8; ++i) { a[i] = (Gp[i * 16 + 8 + h] + ib) - (base + lf[i]); rm = fmaxf(rm, a[i]); lm[i] = rm; }
        float im = rm;
#pragma unroll
        for (int o = 1; o < 64; o <<= 1) { const float t = __shfl_up(im, o); if (lane >= o) im = fmaxf(im, t); }
        if (lane == 63) red[8 + wid] = im;
        __syncthreads();
        float ex = __shfl_up(im, 1); if (lane == 0) ex = -__builtin_inff();
        for (int w = 0; w < wid; ++w) ex = fmaxf(ex, red[8 + w]);
        const size_t o0 = (size_t)(b * MH + h) * SEQ + 8 * tid;
        float* A2 = (float*)(A.ws + WS_A2) + o0; float* M2 = (float*)(A.ws + WS_M2) + o0; float* ME = (float*)(A.ws + WS_MEXP) + o0;
#pragma unroll
        for (int i = 0; i < 8; ++i) { const float Mt = fmaxf(0.f, fmaxf(ex, lm[i])); A2[i] = a[i] * LOG2E; M2[i] = Mt * LOG2E; ME[i] = expf(-((base + lf[i]) + Mt)); }
        float tm = rm; tm = fmaxf(tm, __shfl_xor(tm, 1)); tm = fmaxf(tm, __shfl_xor(tm, 2)); tm = fmaxf(tm, __shfl_xor(tm, 4));
        if ((lane & 7) == 0) ((float*)(A.ws + WS_AREF))[(b * MH + h) * SEQ + (tid >> 3)] = tm * LOG2E;
    }
}
__device__ __forceinline__ void unpack8(const u32x4 w, float (&f)[8]) { f[0] = bflo(w.x); f[1] = bfhi(w.x); f[2] = bflo(w.y); f[3] = bfhi(w.y); f[4] = bflo(w.z); f[5] = bfhi(w.z); f[6] = bflo(w.w); f[7] = bfhi(w.w); }
__device__ __forceinline__ u32x4 pack8f(const float (&f)[8]) { u32x4 w; w.x = cvtpk2(f[0], f[1]); w.y = cvtpk2(f[2], f[3]); w.z = cvtpk2(f[4], f[5]); w.w = cvtpk2(f[6], f[7]); return w; }
__device__ __forceinline__ void qk_norm_rows(const Args& A, int gw, int NGW, int lane) {
    bf16_t* PROJ = (bf16_t*)(A.ws + WS_R1);
    const int d0 = (8 * lane) & 127;
    float qw[8], kw[8];
#pragma unroll
    for (int i = 0; i < 8; ++i) { qw[i] = A.q_norm_w[d0 + i]; kw[i] = A.k_norm_w[d0 + i]; }
    for (int m = gw; m < MROWS; m += NGW) {
        bf16_t* p = PROJ + (size_t)m * PROJ_LD + 8 * lane;
        u32x4 raw[4];
#pragma unroll
        for (int j = 0; j < 4; ++j) raw[j] = *(const u32x4*)(p + 512 * j);
#pragma unroll
        for (int j = 0; j < 4; ++j) { float f[8]; unpack8(raw[j], f); float s = 0.f;
#pragma unroll
            for (int i = 0; i < 8; ++i) s += f[i] * f[i];
            s += __shfl_xor(s, 1); s += __shfl_xor(s, 2); s += __shfl_xor(s, 4); s += __shfl_xor(s, 8);
            const float rs = 1.f / sqrtf(s * (1.f / 128.f) + EPS);
#pragma unroll
            for (int i = 0; i < 8; ++i) f[i] = f[i] * rs * (j < 2 ? qw[i] : kw[i]);
            *(u32x4*)(p + 512 * j) = pack8f(f); }
    }
}
template <int KPART> __device__ __forceinline__ void mconv_rows(const Args& A, int gw, int NGW, int lane) {
    const bf16_t* PROJ = (const bf16_t*)(A.ws + WS_R1) + (KPART ? PC_MK : PC_MQ) + 8 * lane;
    bf16_t* OUT = (bf16_t*)(A.ws + (KPART ? WS_MK : WS_MQ)) + 8 * lane;
    const int c0 = KPART * 512 + 8 * lane, hh = lane >> 4;
    float w[4][8], bb[8];
#pragma unroll
    for (int j = 0; j < 4; ++j)
#pragma unroll
        for (int i = 0; i < 8; ++i) w[j][i] = A.conv_w[j * 1024 + c0 + i];
#pragma unroll
    for (int i = 0; i < 8; ++i) bb[i] = A.conv_b[c0 + i];
    for (int m = gw; m < MROWS; m += NGW) {
        const int t = m & (SEQ - 1), b = m / SEQ;
        float acc[8];
#pragma unroll
        for (int i = 0; i < 8; ++i) acc[i] = bb[i];
#pragma unroll
        for (int j = 0; j < 4; ++j) { if (t - 3 + j >= 0) { float f[8]; unpack8(*(const u32x4*)(PROJ + (size_t)(m - 3 + j) * PROJ_LD), f);
#pragma unroll
                for (int i = 0; i < 8; ++i) acc[i] = fmaf(w[j][i], f[i], acc[i]); } }
        float sc;
        if (KPART) { const int bh = b * MH + hh; sc = exp2f(((const float*)(A.ws + WS_A2))[(size_t)bh * SEQ + t] - ((const float*)(A.ws + WS_AREF))[bh * SEQ + (t >> 6)]); }
        else sc = 0.08838834764831845f;
#pragma unroll
        for (int i = 0; i < 8; ++i) acc[i] = acc[i] * sigmoidf_(acc[i]) * sc;
        *(u32x4*)(OUT + (size_t)m * 512) = pack8f(acc);
    }
}
__device__ __forceinline__ void mlstm_out_rows(const Args& A, int gw, int NGW, int lane) {
    const bf16_t* HB = (const bf16_t*)(A.ws + WS_HB) + 16 * lane;
    const bf16_t* MO = (const bf16_t*)(A.ws + WS_R1) + PC_MO + 16 * lane;
    bf16_t* MIX = (bf16_t*)(A.ws + WS_R2) + 1024 + 16 * lane;
    float ow[16];
#pragma unroll
    for (int i = 0; i < 16; ++i) ow[i] = A.out_norm_w[16 * lane + i];
    for (int m = gw; m < MROWS; m += NGW) {
        float h[16], g[16];
        { float f[8]; unpack8(*(const u32x4*)(HB + (size_t)m * 1024), f);
#pragma unroll
          for (int i = 0; i < 8; ++i) h[i] = f[i];
          unpack8(*(const u32x4*)(HB + (size_t)m * 1024 + 8), f);
#pragma unroll
          for (int i = 0; i < 8; ++i) h[8 + i] = f[i];
          unpack8(*(const u32x4*)(MO + (size_t)m * PROJ_LD), f);
#pragma unroll
          for (int i = 0; i < 8; ++i) g[i] = f[i];
          unpack8(*(const u32x4*)(MO + (size_t)m * PROJ_LD + 8), f);
#pragma unroll
          for (int i = 0; i < 8; ++i) g[8 + i] = f[i]; }
        float s = 0.f;
#pragma unroll
        for (int i = 0; i < 16; ++i) s += h[i] * h[i];
        s += __shfl_xor(s, 1); s += __shfl_xor(s, 2); s += __shfl_xor(s, 4); s += __shfl_xor(s, 8);
        const float rs = 1.f / sqrtf(s * (1.f / 256.f) + EPS);
        float o[8];
#pragma unroll
        for (int i = 0; i < 8; ++i) o[i] = h[i] * rs * ow[i] * sigmoidf_(g[i]);
        *(u32x4*)(MIX + (size_t)m * DM) = pack8f(o);
#pragma unroll
        for (int i = 0; i < 8; ++i) o[i] = h[8 + i] * rs * ow[8 + i] * sigmoidf_(g[8 + i]);
        *(u32x4*)(MIX + (size_t)m * DM + 8) = pack8f(o);
    }
}
__device__ __forceinline__ fa::BlockRef p3_mblock(const Args& A, int w, int i) {
    const int x = w & 15, g = w >> 4; fa::BlockRef r; const int b = g / MH, h = g % MH; const size_t row0 = (size_t)b * SEQ;
    r.Q = (const fa::bf16*)(A.ws + WS_MQ) + row0 * 512 + h * 128; r.K = (const fa::bf16*)(A.ws + WS_MK) + row0 * 512 + h * 128;
    r.V = (const fa::bf16*)(A.ws + WS_R1) + row0 * PROJ_LD + PC_MV + h * 256 + i * 128; r.O = (fa::bf16*)(A.ws + WS_HB) + row0 * 1024 + h * 256 + i * 128;
    r.aux = (const float*)(A.ws + WS_M2) + (size_t)g * SEQ; r.P0 = x * 256; return r;
}
__device__ __forceinline__ fa::BlockRef p3_fblock(const Args& A, int w, int i) {
    const int x = w & 15, g = w >> 4; fa::BlockRef r; const int bh = 2 * g + i, b = bh / AH, h = bh % AH; const size_t row0 = (size_t)b * SEQ;
    const fa::bf16* PROJ = (const fa::bf16*)(A.ws + WS_R1) + row0 * PROJ_LD + h * 128;
    r.Q = PROJ + PC_AQ; r.K = PROJ + PC_AK; r.V = PROJ + PC_AV; r.O = (fa::bf16*)(A.ws + WS_R2) + row0 * DM + h * 128;
    r.aux = (const float*)(A.ws + WS_CK) + (size_t)bh * SEQ; r.P0 = (15 - x) * 256; return r;
}

#ifndef ONLY
#define ONLY -1
#endif
#ifndef SKIPMASK
#define SKIPMASK 0
#endif
#define PH(k) if constexpr (ONLY < 0 ? !((SKIPMASK >> (k)) & 1) : ONLY == (k))
template <class T> __device__ __forceinline__ T* as_global(T* p) { return (T*)(__attribute__((address_space(1))) T*)p; }
__device__ __forceinline__ Args load_args() {
#if defined(__HIP_DEVICE_COMPILE__)
    const __attribute__((address_space(4))) Args* ap = (const __attribute__((address_space(4))) Args*)__builtin_amdgcn_kernarg_segment_ptr();
    asm volatile("" : "+s"(ap));
    Args a = *ap;
#define FX(f) a.f = as_global(a.f)
    FX(x); FX(p); FX(w_norm_mix); FX(w_in); FX(fox_f_bias); FX(q_norm_w); FX(k_norm_w); FX(conv_w); FX(conv_b); FX(mi_bias); FX(mf_bias); FX(out_norm_w); FX(w_out); FX(w_norm_ffn);
    FX(w_gate); FX(w_up); FX(w_down); FX(w_norm_ple); FX(w_ple_gate); FX(w_ple_proj); FX(w_ple_post); FX(out); FX(ws);
#undef FX
    return a;
#else
    return Args{};
#endif
}
#define ARGS() load_args()
__global__ void __launch_bounds__(NTHREADS, 2) fwd_megakernel(Args Aunused) {
    extern __shared__ __attribute__((aligned(16))) unsigned char lds[];
    cg::grid_group grid = cg::this_grid();
    LAS unsigned char* ldsl = (LAS unsigned char*)lds;
    const int G = gridDim.x, bx = blockIdx.x, NGW = G * NWAVES;
#define LANEVARS() int tid_ = threadIdx.x; asm volatile("" : "+v"(tid_)); const int lane = tid_ & 63, wave = __builtin_amdgcn_readfirstlane(tid_ >> 6), gw = bx * NWAVES + wave; (void)lane; (void)gw

    PH(0) { const Args A = ARGS(); LANEVARS(); p0_prologue(A, ldsl, gw, NGW, lane, wave); }
    grid.sync();
    PH(1) { const Args A = ARGS(); unsigned char* ws = A.ws;
        pg8::Gemm g{(const bf16_t*)(ws + WS_R2), (const bf16_t*)(ws + WS_WIN), MROWS, NIN, DM}; pg8::StaticOrder S; S.init(MROWS, NIN, G, bx);
        pg8::EpiProj E{(bf16_t*)(ws + WS_R1), (float*)(ws + WS_G)};
        pg8::gemm_phase<pg8::EpiProj, pg8::StaticOrder, true, true>(ldsl, g, S, E);
    }
    PH(10) { const Args A = ARGS(); unsigned char* ws = A.ws; float* SS = (float*)(ws + WS_SS);
        pg8::Gemm g{(const bf16_t*)(ws + WS_R3), (const bf16_t*)(ws + WS_WPP), MROWS, DM, PLE}; pg8::StaticOrder S; S.init(MROWS, DM, G, bx);
        pg8::EpiE E{(bf16_t*)(ws + WS_ERAW), SS};
        pg8::gemm_phase<pg8::EpiE, pg8::StaticOrder, true, true>(ldsl, g, S, E);
    }
    grid.sync();
    PH(2) { const Args A = ARGS(); for (int v = bx; v < NB * AH + NB * MH; v += G) { scan_sequence(A, v, (LAS float*)ldsl); __syncthreads(); } }
    PH(2) { const Args A = ARGS(); LANEVARS(); qk_norm_rows(A, gw, NGW, lane); }
    PH(2) { const Args A = ARGS(); LANEVARS(); mconv_rows<0>(A, gw, NGW, lane); }
    grid.sync();
    PH(2) { const Args A = ARGS(); LANEVARS(); mconv_rows<1>(A, gw, NGW, lane); }
    grid.sync();
    PH(3) for (int w = bx; w < 256; w += G) { const Args A = ARGS();
        fa::Seam S;
#ifndef NO_M1
        { fa::BlockRef c = p3_mblock(A, w, 0); fa::attn_prime<1>(c, (char*)lds, S);
#pragma nounroll
          for (int i = 0; i < 2; ++i) { const fa::BlockRef n = p3_mblock(A, w, 1); fa::attn_block<1>(c, n, (char*)lds, S); c = n; } }
        asm volatile("s_waitcnt vmcnt(0)" ::: "memory"); __syncthreads();
#endif
#ifndef NO_M0
        { fa::BlockRef c = p3_fblock(A, w, 0); fa::attn_prime<0>(c, (char*)lds, S);
#pragma nounroll
          for (int i = 0; i < 2; ++i) { const fa::BlockRef n = p3_fblock(A, w, 1); fa::attn_block<0>(c, n, (char*)lds, S); c = n; } }
#endif
        asm volatile("s_waitcnt vmcnt(0)" ::: "memory");
        __syncthreads();
    }
    grid.sync();
    PH(4) { const Args A = ARGS(); LANEVARS(); mlstm_out_rows(A, gw, NGW, lane); }
    grid.sync();
    PH(5) { const Args A = ARGS(); unsigned char* ws = A.ws; float* SS = (float*)(ws + WS_SS);
        pg8::Gemm g{(const bf16_t*)(ws + WS_R2), (const bf16_t*)(ws + WS_WO), MROWS, DM, DM}; pg8::StaticOrder S; S.init(MROWS, DM, G, bx);
        pg8::EpiRes E{A.x, A.out, (bf16_t*)(ws + WS_R3), A.w_norm_ffn, SS + MROWS};
        pg8::gemm_phase<pg8::EpiRes, pg8::StaticOrder, true, true>(ldsl, g, S, E);
    }
    grid.sync();
    PH(6) { const Args A = ARGS(); unsigned char* ws = A.ws; float* SS = (float*)(ws + WS_SS);
        pg8::Gemm g{(const bf16_t*)(ws + WS_R3), (const bf16_t*)(ws + WS_WGU), MROWS, 2 * DFF, DM}; pg8::StaticOrder S; S.init(MROWS, 2 * DFF, G, bx);
        pg8::EpiSwiGLU E{(bf16_t*)(ws + WS_R1), SS + MROWS};
        pg8::gemm_phase<pg8::EpiSwiGLU, pg8::StaticOrder, true, true>(ldsl, g, S, E);
    }
    grid.sync();
    PH(7) { const Args A = ARGS(); unsigned char* ws = A.ws; float* SS = (float*)(ws + WS_SS);
        pg8::Gemm g{(const bf16_t*)(ws + WS_R1), (const bf16_t*)(ws + WS_WD), MROWS, DM, DFF}; pg8::StaticOrder S; S.init(MROWS, DM, G, bx);
        pg8::EpiRes E{A.out, A.out, (bf16_t*)(ws + WS_R2), A.w_norm_ple, SS + 2 * MROWS};
        pg8::gemm_phase<pg8::EpiRes, pg8::StaticOrder, true, true>(ldsl, g, S, E);
    }
    grid.sync();
    PH(8) { const Args A = ARGS(); unsigned char* ws = A.ws; float* SS = (float*)(ws + WS_SS);
        pg8::Gemm g{(const bf16_t*)(ws + WS_R2), (const bf16_t*)(ws + WS_WPG), MROWS, DM, DM}; pg8::StaticOrder S; S.init(MROWS, DM, G, bx);
        pg8::EpiFinal E{A.out, (const bf16_t*)(ws + WS_ERAW), A.w_ple_post, SS + 2 * MROWS, SS};
        pg8::gemm_phase<pg8::EpiFinal, pg8::StaticOrder, true, true>(ldsl, g, S, E);
    }
}

extern "C" void kernel_launch(void* const* d_in, const int* in_sizes, int n_in, void* d_out, int out_size, void* d_ws, size_t ws_size, hipStream_t stream) {
    static int grid = 0;
    if (grid == 0) {
        if (n_in != 21 || in_sizes[0] != MROWS * DM || out_size != MROWS * DM || ws_size < WS_END) {
            fprintf(stderr, "kernel_launch: unexpected shapes (n_in %d, in0 %d, out %d, ws %zu; need ws >= %zu)\n", n_in, n_in > 0 ? in_sizes[0] : -1, out_size, ws_size, (size_t)WS_END); grid = -1; return; }
        int dev = 0, cus = 0, per_cu = 0;
        (void)hipGetDevice(&dev); (void)hipDeviceGetAttribute(&cus, hipDeviceAttributeMultiprocessorCount, dev);
        if (hipFuncSetAttribute((const void*)fwd_megakernel, hipFuncAttributeMaxDynamicSharedMemorySize, LDS_BYTES) != hipSuccess) { fprintf(stderr, "kernel_launch: hipFuncSetAttribute failed\n"); grid = -1; return; }
        if (hipOccupancyMaxActiveBlocksPerMultiprocessor(&per_cu, (const void*)fwd_megakernel, NTHREADS, LDS_BYTES) != hipSuccess || per_cu < 1) { fprintf(stderr, "kernel_launch: occupancy query says %d blocks per CU\n", per_cu); per_cu = 1; }
        (void)hipGetLastError();
        if (per_cu > 1) per_cu = 1;
        grid = cus * per_cu;
    }
    if (grid < 0) return;
    Args a{};
    a.x = (const float*)d_in[0]; a.p = (const float*)d_in[1]; a.w_norm_mix = (const float*)d_in[2]; a.w_in = (const float*)d_in[3]; a.fox_f_bias = (const float*)d_in[4];
    a.q_norm_w = (const float*)d_in[5]; a.k_norm_w = (const float*)d_in[6]; a.conv_w = (const float*)d_in[7]; a.conv_b = (const float*)d_in[8]; a.mi_bias = (const float*)d_in[9];
    a.mf_bias = (const float*)d_in[10]; a.out_norm_w = (const float*)d_in[11]; a.w_out = (const float*)d_in[12]; a.w_norm_ffn = (const float*)d_in[13]; a.w_gate = (const float*)d_in[14];
    a.w_up = (const float*)d_in[15]; a.w_down = (const float*)d_in[16]; a.w_norm_ple = (const float*)d_in[17]; a.w_ple_gate = (const float*)d_in[18]; a.w_ple_proj = (const float*)d_in[19];
    a.w_ple_post = (const float*)d_in[20];
    a.out = (float*)d_out; a.ws = (unsigned char*)d_ws;
    void* args[] = {&a};
    hipError_t e = hipLaunchCooperativeKernel((const void*)fwd_megakernel, dim3(grid), dim3(NTHREADS), args, LDS_BYTES, stream);
    if (e != hipSuccess) fprintf(stderr, "kernel_launch: cooperative launch failed: %s (grid %d)\n", hipGetErrorString(e), grid);
}
```

```cpp
#include <hip/hip_runtime.h>
#include <hip/hip_cooperative_groups.h>
#include <hip/hip_bf16.h>
#include <cstdio>
#include <cstdint>
namespace cg = cooperative_groups;

constexpr int NB = 4, SEQ = 4096, DM = 2048, MROWS = NB * SEQ;
constexpr int PLE = 256, AH = 8, MH = 4, DFF = 5632, INC = 6160;
constexpr int PROJ_LD = 6144, NIN = 6400;
constexpr int PC_AQ = 0, PC_AK = 1024, PC_AV = 2048, PC_MQ = 3072, PC_MK = 3584, PC_MV = 4096, PC_MO = 5120;
constexpr float EPS = 1e-6f;
constexpr float LOG2E = 1.4426950408889634f;

typedef unsigned short bf16_t;
typedef float f32x4 __attribute__((ext_vector_type(4)));
typedef float f32x2 __attribute__((ext_vector_type(2)));
typedef unsigned u32x4 __attribute__((ext_vector_type(4)));
typedef unsigned u32x2 __attribute__((ext_vector_type(2)));
typedef __bf16 bf16x2_t __attribute__((ext_vector_type(2)));
__device__ __forceinline__ unsigned cvtpk2(float lo, float hi) { f32x2 v = {lo, hi}; bf16x2_t b = __builtin_convertvector(v, bf16x2_t); return __builtin_bit_cast(unsigned, b); }
__device__ __forceinline__ float bflo(unsigned w) { return __uint_as_float(w << 16); }
__device__ __forceinline__ float bfhi(unsigned w) { return __uint_as_float(w & 0xffff0000u); }
__device__ __forceinline__ float sigmoidf_(float x) { return __builtin_amdgcn_rcpf(1.f + __expf(-x)); }
namespace pg8 {
#define PG8_LAS __attribute__((address_space(3)))
typedef unsigned short bf16_t;
typedef short bf16x8 __attribute__((ext_vector_type(8)));
typedef float f32x4 __attribute__((ext_vector_type(4)));
typedef unsigned u32x4 __attribute__((ext_vector_type(4)));
constexpr int BM = 256, BK = 64, HALF = 128, HTB = HALF * BK * 2  , STAGE_BYTES = 8 * HTB, NXCD = 8, WGM = 8;

__host__ __device__ __forceinline__ int lds_byte(int r, int c) { const int st = (r >> 4) * 2 + (c >> 5), rr = r & 15, cc = c & 31, ob = rr * 64 + cc * 2; return st * 1024 + (ob ^ (((ob >> 9) & 1) << 5)); }
__host__ __device__ __forceinline__ void stage_rc(int b, int& R, int& C) { const int st = b / 1024, sb = b % 1024, swz = sb ^ (((sb >> 9) & 1) << 5); R = (st >> 1) * 16 + swz / 64; C = (st & 1) * 32 + (swz % 64) / 2; }
__host__ __device__ __forceinline__ int perm32(int rho) { const int n = rho >> 4, i = rho & 15; return 8 * (i >> 2) + 4 * n + (i & 3); }

struct Unit { int pm, pn; };
struct Gemm { const bf16_t* A; const bf16_t* Bt; int M, N, K; };

struct StaticOrder {
    int nM, nN, nwg, G, c;
    __host__ __device__ void init(int M, int N, int G_, int c_) { nM = M / BM; nN = N / BM; nwg = nM * nN; G = G_; c = c_; }
    __host__ __device__ bool next(int i, Unit& u) const {
        const long L = (long)i * G + c; if (L >= nwg) return false;
        int wgid = (int)L; { const int q = nwg / NXCD, r = nwg % NXCD, xcd = wgid % NXCD, off = wgid / NXCD; wgid = (xcd < r ? xcd * (q + 1) : r * (q + 1) + (xcd - r) * q) + off; }
        const int nig = WGM * nN, gid = wgid / nig, fm = gid * WGM, gsz = (nM - fm) < WGM ? (nM - fm) : WGM;
        u.pm = fm + ((wgid % nig) % gsz); u.pn = (wgid % nig) / gsz; return true;
    }
    __device__ __forceinline__ void a_ready(const Unit&) const {}
    __device__ __forceinline__ void done(const Unit&) const {}
};
__device__ __forceinline__ unsigned cvt_pk_bf16(float lo, float hi) { return ::cvtpk2(lo, hi); }
__device__ __forceinline__ float sumsq4(f32x4 v) { return (v[0] * v[0] + v[1] * v[1]) + (v[2] * v[2] + v[3] * v[3]); }
__device__ __forceinline__ void atomic_add_f32(float* p, float v) { __hip_atomic_fetch_add(p, v, __ATOMIC_RELAXED, __HIP_MEMORY_SCOPE_AGENT); }

struct EpiProj {
    static constexpr bool PERM = true, AFTER_DRAIN = false;
    bf16_t* O; float* G;
    __device__ __forceinline__ void operator()(const f32x4 (&acc)[2][2][4][2], const Unit& u, int wr, int wc, int fr, int fq) const {
        const int row0 = u.pm * BM + wr * 64 + fr;
        if (u.pn < 24) {
            const int col0 = u.pn * BM + wc * 32 + 8 * fq;
#pragma unroll
            for (int ai = 0; ai < 2; ++ai)
#pragma unroll
                for (int m = 0; m < 4; ++m) { bf16_t* rowp = O + (size_t)(row0 + ai * HALF + m * 16) * 6144 + col0;
#pragma unroll
                    for (int bj = 0; bj < 2; ++bj) { const f32x4 v0 = acc[ai][bj][m][0], v1 = acc[ai][bj][m][1];
                        u32x4 w; w.x = cvt_pk_bf16(v0[0], v0[1]); w.y = cvt_pk_bf16(v0[2], v0[3]); w.z = cvt_pk_bf16(v1[0], v1[1]); w.w = cvt_pk_bf16(v1[2], v1[3]);
                        *(u32x4*)(rowp + bj * HALF) = w; } }
        } else if (wc == 0) {
            if (fq < 2) {
#pragma unroll
                for (int ai = 0; ai < 2; ++ai)
#pragma unroll
                    for (int m = 0; m < 4; ++m) { float* gp = G + (size_t)(row0 + ai * HALF + m * 16) * 16 + 8 * fq;
                        *(f32x4*)(gp) = acc[ai][0][m][0]; *(f32x4*)(gp + 4) = acc[ai][0][m][1]; }
            }
        }
    }
};
struct EpiE {
    static constexpr bool PERM = true, AFTER_DRAIN = false;
    bf16_t* O; float* ss;
    __device__ __forceinline__ void operator()(const f32x4 (&acc)[2][2][4][2], const Unit& u, int wr, int wc, int fr, int fq) const {
        const int row0 = u.pm * BM + wr * 64 + fr, col0 = u.pn * BM + wc * 32 + 8 * fq;
#pragma unroll
        for (int ai = 0; ai < 2; ++ai)
#pragma unroll
            for (int m = 0; m < 4; ++m) { const int row = row0 + ai * HALF + m * 16; bf16_t* rowp = O + (size_t)row * 2048 + col0; float s = 0.f;
#pragma unroll
                for (int bj = 0; bj < 2; ++bj) { const f32x4 v0 = acc[ai][bj][m][0], v1 = acc[ai][bj][m][1]; s += sumsq4(v0) + sumsq4(v1);
                    u32x4 w; w.x = cvt_pk_bf16(v0[0], v0[1]); w.y = cvt_pk_bf16(v0[2], v0[3]); w.z = cvt_pk_bf16(v1[0], v1[1]); w.w = cvt_pk_bf16(v1[2], v1[3]);
                    *(u32x4*)(rowp + bj * HALF) = w; }
                s += __shfl_xor(s, 16); s += __shfl_xor(s, 32);
                if (fq == 0) atomic_add_f32(ss + row, s); }
    }
};
struct EpiRes {
    static constexpr bool PERM = false, AFTER_DRAIN = false;
    const float* xin; float* xout; bf16_t* xn; const float* wn; float* ss;
    __device__ __forceinline__ void operator()(const f32x4 (&acc)[2][2][4][2], const Unit& u, int wr, int wc, int fr, int fq) const {
        const int row0 = u.pm * BM + wr * 64 + fr, col0 = u.pn * BM + wc * 32 + 4 * fq;
        f32x4 wv[2][2];
#pragma unroll
        for (int bj = 0; bj < 2; ++bj)
#pragma unroll
            for (int n = 0; n < 2; ++n) wv[bj][n] = *(const f32x4*)(wn + col0 + bj * HALF + n * 16);
#pragma unroll
        for (int ai = 0; ai < 2; ++ai)
#pragma unroll
            for (int m = 0; m < 4; ++m) { const int row = row0 + ai * HALF + m * 16; const size_t off = (size_t)row * 2048 + col0; float s = 0.f;
#pragma unroll
                for (int bj = 0; bj < 2; ++bj)
#pragma unroll
                    for (int n = 0; n < 2; ++n) { const size_t o2 = off + bj * HALF + n * 16; const f32x4 v = *(const f32x4*)(xin + o2) + acc[ai][bj][m][n];
                        *(f32x4*)(xout + o2) = v; s += sumsq4(v); const f32x4 y = v * wv[bj][n];
                        u32x2 w; w.x = cvt_pk_bf16(y[0], y[1]); w.y = cvt_pk_bf16(y[2], y[3]); *(u32x2*)(xn + o2) = w; }
                s += __shfl_xor(s, 16); s += __shfl_xor(s, 32);
                if (fq == 0) atomic_add_f32(ss + row, s); }
    }
};
struct EpiSwiGLU {
    static constexpr bool PERM = true, AFTER_DRAIN = false;
    bf16_t* O; const float* ss;
    __device__ __forceinline__ void operator()(const f32x4 (&acc)[2][2][4][2], const Unit& u, int wr, int wc, int fr, int fq) const {
        const int row0 = u.pm * BM + wr * 64 + fr, col0 = u.pn * HALF + wc * 32 + 8 * fq;
#pragma unroll
        for (int ai = 0; ai < 2; ++ai)
#pragma unroll
            for (int m = 0; m < 4; ++m) { const int row = row0 + ai * HALF + m * 16; const float rs = __builtin_amdgcn_rsqf(ss[row] * (1.f / 2048.f) + 1e-6f);
                float r[8];
#pragma unroll
                for (int n = 0; n < 2; ++n)
#pragma unroll
                    for (int e = 0; e < 4; ++e) { const float g = acc[ai][0][m][n][e] * rs, up = acc[ai][1][m][n][e] * rs; r[n * 4 + e] = g * __builtin_amdgcn_rcpf(1.f + __expf(-g)) * up; }
                u32x4 w; w.x = cvt_pk_bf16(r[0], r[1]); w.y = cvt_pk_bf16(r[2], r[3]); w.z = cvt_pk_bf16(r[4], r[5]); w.w = cvt_pk_bf16(r[6], r[7]);
                *(u32x4*)(O + (size_t)row * 5632 + col0) = w; }
    }
};
struct EpiFinal {
    static constexpr bool PERM = false, AFTER_DRAIN = false;
    float* out; const bf16_t* eraw; const float* wpost; const float* ss3; const float* ssE;
    __device__ __forceinline__ void operator()(const f32x4 (&acc)[2][2][4][2], const Unit& u, int wr, int wc, int fr, int fq) const {
        const int row0 = u.pm * BM + wr * 64 + fr, col0 = u.pn * BM + wc * 32 + 4 * fq;
        f32x4 wv[2][2];
#pragma unroll
        for (int bj = 0; bj < 2; ++bj)
#pragma unroll
            for (int n = 0; n < 2; ++n) wv[bj][n] = *(const f32x4*)(wpost + col0 + bj * HALF + n * 16);
#pragma unroll
        for (int ai = 0; ai < 2; ++ai)
#pragma unroll
            for (int m = 0; m < 4; ++m) { const int row = row0 + ai * HALF + m * 16; const size_t off = (size_t)row * 2048 + col0;
                const float rs = __builtin_amdgcn_rsqf(ss3[row] * (1.f / 2048.f) + 1e-6f), re = __builtin_amdgcn_rsqf(ssE[row] * (1.f / 2048.f) + 1e-6f);
#pragma unroll
                for (int bj = 0; bj < 2; ++bj)
#pragma unroll
                    for (int n = 0; n < 2; ++n) { const size_t o2 = off + bj * HALF + n * 16; const f32x4 x2 = *(const f32x4*)(out + o2); const u32x2 ew = *(const u32x2*)(eraw + o2);
                        const f32x4 a = acc[ai][bj][m][n] * rs; f32x4 e = {::bflo(ew.x), ::bfhi(ew.x), ::bflo(ew.y), ::bfhi(ew.y)}; e = e * re * wv[bj][n];
                        f32x4 o; o[0] = x2[0] + ::sigmoidf_(a[0]) * e[0]; o[1] = x2[1] + ::sigmoidf_(a[1]) * e[1]; o[2] = x2[2] + ::sigmoidf_(a[2]) * e[2]; o[3] = x2[3] + ::sigmoidf_(a[3]) * e[3];
                        *(f32x4*)(out + o2) = o; } }
    }
};
template <class Epi, class Sched, bool ALIGN_EPI = false, bool SP2 = false>
__device__ __forceinline__ void gemm_phase(PG8_LAS unsigned char* lds, const Gemm g, const Sched& S, const Epi& E) {
    int tid0_ = threadIdx.x; asm volatile("" : "+v"(tid0_));
    const int tid = tid0_, wid = __builtin_amdgcn_readfirstlane(tid >> 6), lane = tid & 63, wr = wid >> 2, wc = wid & 3, fr = lane & 15, fq = lane >> 4;
    int K0_ = g.K; asm volatile("" : "+s"(K0_));
    const int K = K0_, nt = K / BK;
    unsigned voffA[2], voffB[2];
#pragma unroll
    for (int i = 0; i < 2; ++i) { int R, C; stage_rc(tid * 16 + i * 8192, R, C); const int Rb = Epi::PERM ? ((R & ~31) + perm32(R & 31)) : R;
        voffA[i] = (unsigned)(R * K + C) * 2u; voffB[i] = (unsigned)(Rb * K + C) * 2u; }
    const size_t kstep = (size_t)(BK * 2);
    const size_t hstep = (size_t)HALF * K * 2;
    const size_t tstep = 2 * hstep;
    const unsigned ldsw = (unsigned)wid * 1024u;
    const int aoff = lds_byte(wr * 64 + fr, fq * 8), boff = lds_byte(wc * 32 + fr, fq * 8);
#define PG8_SA(b, h) (((b) * 2 + (h)) * HTB)
#define PG8_SB(b, h) ((4 + (b) * 2 + (h)) * HTB)
#define PG8_STAGE(bufoff, gbase, voff) do { _Pragma("unroll") for (int _i = 0; _i < 2; ++_i) \
        __builtin_amdgcn_global_load_lds((const unsigned*)((const char*)(gbase) + (voff)[_i]), (PG8_LAS unsigned*)(lds + (bufoff) + ldsw + _i * 8192), 16, 0, 0); } while (0)
#define PG8_LDA(dst, b, h) do { _Pragma("unroll") for (int m = 0; m < 4; ++m) _Pragma("unroll") for (int k = 0; k < 2; ++k) dst[m][k] = *(const PG8_LAS bf16x8*)(lds + PG8_SA(b, h) + aoff + m * 2048 + k * 1024); } while (0)
#define PG8_LDB(dst, b, h) do { _Pragma("unroll") for (int n = 0; n < 2; ++n) _Pragma("unroll") for (int k = 0; k < 2; ++k) dst[n][k] = *(const PG8_LAS bf16x8*)(lds + PG8_SB(b, h) + boff + n * 2048 + k * 1024); } while (0)
#define PG8_MMA(ai, bj, At, Bt) do { __builtin_amdgcn_s_setprio(1); _Pragma("unroll") for (int m = 0; m < 4; ++m) _Pragma("unroll") for (int n = 0; n < 2; ++n) _Pragma("unroll") for (int k = 0; k < 2; ++k) \
        acc[ai][bj][m][n] = __builtin_amdgcn_mfma_f32_16x16x32_bf16(Bt[n][k], At[m][k], acc[ai][bj][m][n], 0, 0, 0); __builtin_amdgcn_s_setprio(0); } while (0)
#define PG8_WAIT_V(n) asm volatile("s_waitcnt vmcnt(" #n ")" ::: "memory")
#define PG8_WAIT_L(n) asm volatile("s_waitcnt lgkmcnt(" #n ")" ::: "memory")
#define PG8_BAR __builtin_amdgcn_s_barrier()
#define PG8_SCHED __builtin_amdgcn_sched_barrier(0)
    Unit cur, nxt; int ui = 0;
    if (!S.next(0, cur)) return;
    f32x4 acc[2][2][4][2];
#pragma unroll
    for (int a = 0; a < 2; ++a)
#pragma unroll
        for (int b = 0; b < 2; ++b)
#pragma unroll
            for (int m = 0; m < 4; ++m)
#pragma unroll
                for (int n = 0; n < 2; ++n) acc[a][b][m][n] = (f32x4){0.f, 0.f, 0.f, 0.f};
    bf16x8 At[4][2], B0[2][2], B1[2][2];
    const char* cA = (const char*)g.A + (size_t)cur.pm * tstep; const char* cB = (const char*)g.Bt + (size_t)cur.pn * tstep;
    S.a_ready(cur);
    if constexpr (SP2) {
        PG8_STAGE(PG8_SB(0, 0), cB, voffB); PG8_STAGE(PG8_SB(0, 1), cB + hstep, voffB); PG8_STAGE(PG8_SA(0, 0), cA, voffA); PG8_STAGE(PG8_SA(0, 1), cA + hstep, voffA);
        if (wr == 1) PG8_BAR;
        PG8_WAIT_V(2); PG8_BAR;
        PG8_STAGE(PG8_SB(1, 0), cB + kstep, voffB); PG8_STAGE(PG8_SA(1, 0), cA + kstep, voffA); PG8_STAGE(PG8_SB(1, 1), cB + hstep + kstep, voffB);
        PG8_WAIT_V(6); PG8_BAR;
    } else {
        PG8_STAGE(PG8_SB(0, 0), cB, voffB); PG8_STAGE(PG8_SA(0, 0), cA, voffA); PG8_STAGE(PG8_SB(0, 1), cB + hstep, voffB); PG8_STAGE(PG8_SA(0, 1), cA + hstep, voffA);
        if (wr == 1) PG8_BAR;
        PG8_WAIT_V(4); PG8_BAR;
        PG8_STAGE(PG8_SB(1, 0), cB + kstep, voffB); PG8_STAGE(PG8_SA(1, 0), cA + kstep, voffA); PG8_STAGE(PG8_SB(1, 1), cB + hstep + kstep, voffB);
        PG8_WAIT_V(6); PG8_BAR;
    }
    for (;;) {
        const bool has_next = S.next(ui + 1, nxt);
        const char* nA = has_next ? (const char*)g.A + (size_t)nxt.pm * tstep : cA; const char* nB = has_next ? (const char*)g.Bt + (size_t)nxt.pn * tstep : cB;
        for (int t = 0; t < nt; t += 2) {
            const bool last = (t == nt - 2);
            const char* a1 = cA + (size_t)(t + 1) * kstep;
            const char* a2 = last ? nA : cA + (size_t)(t + 2) * kstep; const char* b2 = last ? nB : cB + (size_t)(t + 2) * kstep;
            const char* a3 = a2 + kstep; const char* b3 = b2 + kstep;
            if (last && has_next) S.a_ready(nxt);
            if constexpr (SP2) {
            PG8_LDB(B0, 0, 0); PG8_LDB(B1, 0, 1); PG8_SCHED; PG8_LDA(At, 0, 0); PG8_STAGE(PG8_SA(1, 1), a1 + hstep, voffA);
            PG8_WAIT_V(8); PG8_WAIT_L(0); PG8_BAR; PG8_MMA(0, 0, At, B0); PG8_MMA(0, 1, At, B1); PG8_BAR; PG8_SCHED;
            PG8_LDA(At, 0, 1); PG8_STAGE(PG8_SB(0, 0), b2, voffB); PG8_STAGE(PG8_SB(0, 1), b2 + hstep, voffB); PG8_STAGE(PG8_SA(0, 0), a2, voffA);
            PG8_WAIT_V(8); PG8_WAIT_L(0); PG8_BAR; PG8_MMA(1, 0, At, B0); PG8_MMA(1, 1, At, B1); PG8_BAR; PG8_SCHED;
            PG8_LDB(B0, 1, 0); PG8_LDB(B1, 1, 1); PG8_SCHED; PG8_LDA(At, 1, 0); PG8_STAGE(PG8_SA(0, 1), a2 + hstep, voffA);
            PG8_WAIT_V(8); PG8_WAIT_L(0); PG8_BAR; PG8_MMA(0, 0, At, B0); PG8_MMA(0, 1, At, B1); PG8_BAR; PG8_SCHED;
            PG8_LDA(At, 1, 1); PG8_STAGE(PG8_SB(1, 0), b3, voffB); PG8_STAGE(PG8_SB(1, 1), b3 + hstep, voffB); PG8_STAGE(PG8_SA(1, 0), a3, voffA);
            PG8_WAIT_V(8); PG8_WAIT_L(0); PG8_BAR; PG8_MMA(1, 0, At, B0); PG8_MMA(1, 1, At, B1); PG8_BAR; PG8_SCHED;
            } else {
            PG8_LDB(B0, 0, 0); PG8_SCHED; PG8_LDA(At, 0, 0); PG8_STAGE(PG8_SA(1, 1), a1 + hstep, voffA);
            PG8_WAIT_L(8); PG8_BAR; PG8_WAIT_L(0); PG8_MMA(0, 0, At, B0); PG8_BAR; PG8_SCHED;
            PG8_LDB(B1, 0, 1); PG8_STAGE(PG8_SB(0, 0), b2, voffB);
            PG8_BAR; PG8_WAIT_L(0); PG8_MMA(0, 1, At, B1); PG8_BAR;
            PG8_LDA(At, 0, 1); PG8_STAGE(PG8_SA(0, 0), a2, voffA);
            PG8_BAR; PG8_WAIT_L(0); PG8_MMA(1, 0, At, B0); PG8_BAR; PG8_SCHED;
            PG8_STAGE(PG8_SB(0, 1), b2 + hstep, voffB);
            PG8_WAIT_V(6); PG8_BAR; PG8_MMA(1, 1, At, B1); PG8_BAR;
            PG8_LDB(B0, 1, 0); PG8_SCHED; PG8_LDA(At, 1, 0); PG8_STAGE(PG8_SA(0, 1), a2 + hstep, voffA);
            PG8_WAIT_L(8); PG8_BAR; PG8_WAIT_L(0); PG8_MMA(0, 0, At, B0); PG8_BAR; PG8_SCHED;
            PG8_LDB(B1, 1, 1); PG8_STAGE(PG8_SB(1, 0), b3, voffB);
            PG8_BAR; PG8_WAIT_L(0); PG8_MMA(0, 1, At, B1); PG8_BAR;
            PG8_LDA(At, 1, 1); PG8_STAGE(PG8_SA(1, 0), a3, voffA);
            PG8_BAR; PG8_WAIT_L(0); PG8_MMA(1, 0, At, B0); PG8_BAR; PG8_SCHED;
            PG8_STAGE(PG8_SB(1, 1), b3 + hstep, voffB);
            PG8_WAIT_V(6); PG8_BAR; PG8_MMA(1, 1, At, B1); PG8_BAR;
            }
        }
        if constexpr (ALIGN_EPI) { if (wr == 0) PG8_BAR; }
        if constexpr (!Epi::AFTER_DRAIN) { E(acc, cur, wr, wc, fr, fq); S.done(cur); }
        if (!has_next) break;
#pragma unroll
        for (int a = 0; a < 2; ++a)
#pragma unroll
            for (int b = 0; b < 2; ++b)
#pragma unroll
                for (int m = 0; m < 4; ++m)
#pragma unroll
                    for (int n = 0; n < 2; ++n) acc[a][b][m][n] = (f32x4){0.f, 0.f, 0.f, 0.f};
        cur = nxt; cA = nA; cB = nB; ++ui;
        if constexpr (ALIGN_EPI) { if (wr == 1) PG8_BAR; }
    }
    PG8_WAIT_V(0);
    if constexpr (!ALIGN_EPI) { if (wr == 0) PG8_BAR; }
    PG8_BAR;
    if constexpr (Epi::AFTER_DRAIN) { E.fused(acc, cur, wr, wc, fr, fq, lds, wid, lane); S.done(cur); }
#undef PG8_SA
#undef PG8_SB
#undef PG8_STAGE
#undef PG8_LDA
#undef PG8_LDB
#undef PG8_MMA
#undef PG8_WAIT_V
#undef PG8_WAIT_L
#undef PG8_BAR
#undef PG8_SCHED
}
}
namespace fa {
using bf16 = __hip_bfloat16;
typedef short bf16x8 __attribute__((ext_vector_type(8)));
typedef short s16x4 __attribute__((ext_vector_type(4)));
typedef float f32x16 __attribute__((ext_vector_type(16)));
constexpr int D = 128, NW = 8, QBLK = 32, KVBLK = 64, QB = NW * QBLK;
constexpr int SHM_V = KVBLK * D * 2, SHM_K = KVBLK * D * 2;
constexpr int OFF_WS = 2 * SHM_V + 2 * SHM_K, OFF_CK = OFF_WS + NW * 64 * 4, LDS_BYTES = OFF_CK + 2 * 64 * 4;
constexpr float SCALE = 0.08838834764831845f;
constexpr float THR = 8.f;

#define KSWZ(row, colB) ((row) * 256 + ((colB) ^ (((row) & 7) << 4)))
#define SBAR() __builtin_amdgcn_sched_barrier(0)
__device__ __forceinline__ int v_st(int k, int c) { const int kk = (k & ~0xC) | ((k & 4) << 1) | ((k & 8) >> 1); return ((kk >> 3) * 4 + (c >> 5)) * 512 + ((kk & 7) * 32 + (c & 31)) * 2; }
__device__ __forceinline__ int v_rd_base(int lane) { return ((lane & 3) << 3) | (((lane >> 2) & 3) << 6) | (((lane >> 4) & 1) << 5) | (((lane >> 5) & 1) << 8); }
constexpr int v_rd_off(int d0, int ks, int half) { return d0 * 512 + ks * 4096 + half * 2048; }
__device__ __forceinline__ int crow(int r, int hi) { return (r & 3) + 8 * (r >> 2) + 4 * hi; }
__device__ __forceinline__ unsigned cvtpk(float lo, float hi) { return ::cvtpk2(lo, hi); }
__device__ __forceinline__ bf16x8 load8(const bf16* p) { return *reinterpret_cast<const bf16x8*>(p); }
template <int MODE> __device__ __forceinline__ void mask_tile(f32x16& p0, f32x16& p1, int dq) {
    const float NEG = MODE == 0 ? -__builtin_inff() : 0.f;
#pragma unroll
    for (int r = 0; r < 16; ++r) {
        const int c = (r & 3) + 8 * (r >> 2);
        if (dq - c < 0) p0[r] = NEG;
        if (dq - c - 32 < 0) p1[r] = NEG;
    }
}
__device__ __forceinline__ void partialSM(f32x16& p0, f32x16& p1, float& m_reg, float& mn, float& alpha) {
    float pmax = p0[0]; for (int r = 1; r < 16; ++r) pmax = fmaxf(pmax, p0[r]); for (int r = 0; r < 16; ++r) pmax = fmaxf(pmax, p1[r]);
    { auto rr = __builtin_amdgcn_permlane32_swap(__float_as_uint(pmax), __float_as_uint(pmax), false, false);
      pmax = fmaxf(__uint_as_float(rr[0]), __uint_as_float(rr[1])); }
    constexpr float C2 = 1.4426950408889634f * SCALE;
    if (__builtin_expect(__all((pmax - m_reg) * SCALE <= THR), 1)) { mn = m_reg; alpha = 1.f; }
    else { mn = fmaxf(m_reg, pmax); alpha = __builtin_amdgcn_exp2f((m_reg - mn) * C2); m_reg = mn; }
    const float mnL = -mn * C2;
    for (int r = 0; r < 16; ++r) p0[r] = fmaf(p0[r], C2, mnL); for (int r = 0; r < 16; ++r) p1[r] = fmaf(p1[r], C2, mnL);
    for (int r = 0; r < 16; ++r) p0[r] = __builtin_amdgcn_exp2f(p0[r]);
}
#define PK4(P, B_, OUT) do { unsigned a0 = cvtpk(P[B_+0], P[B_+1]), a1 = cvtpk(P[B_+2], P[B_+3]);                          \
        unsigned b0 = cvtpk(P[B_+4], P[B_+5]), b1 = cvtpk(P[B_+6], P[B_+7]);                                             \
        auto r0 = __builtin_amdgcn_permlane32_swap(a0, b0, false, false); auto r1 = __builtin_amdgcn_permlane32_swap(a1, b1, false, false); \
        u32x4 w = {r0[0], r1[0], r0[1], r1[1]}; OUT = *reinterpret_cast<bf16x8*>(&w); } while (0)
__device__ __forceinline__ void finishSM(f32x16& p0, f32x16& p1, float alpha, float& l_reg, bf16x8& pa0, bf16x8& pa1, bf16x8& pa2, bf16x8& pa3) {
    for (int r = 0; r < 16; ++r) p1[r] = __builtin_amdgcn_exp2f(p1[r]);
    float ps = 0; for (int r = 0; r < 16; ++r) ps += p0[r]; for (int r = 0; r < 16; ++r) ps += p1[r];
    { auto rr = __builtin_amdgcn_permlane32_swap(__float_as_uint(ps), __float_as_uint(ps), false, false);
      ps = __uint_as_float(rr[0]) + __uint_as_float(rr[1]); }
    l_reg = l_reg * alpha + ps;
    PK4(p0, 0, pa0); PK4(p0, 8, pa1); PK4(p1, 0, pa2); PK4(p1, 8, pa3);
}
__device__ __forceinline__ void linScale(f32x16& p0, f32x16& p1, float fr) {
    for (int r = 0; r < 16; ++r) p0[r] *= fr; for (int r = 0; r < 16; ++r) p1[r] *= fr;
}
__device__ __forceinline__ void linFinish(f32x16& p0, f32x16& p1, float& l_reg, bf16x8& pa0, bf16x8& pa1, bf16x8& pa2, bf16x8& pa3) {
    float ps = 0; for (int r = 0; r < 16; ++r) ps += p0[r]; for (int r = 0; r < 16; ++r) ps += p1[r];
    { auto rr = __builtin_amdgcn_permlane32_swap(__float_as_uint(ps), __float_as_uint(ps), false, false);
      ps = __uint_as_float(rr[0]) + __uint_as_float(rr[1]); }
    l_reg += ps;
    PK4(p0, 0, pa0); PK4(p0, 8, pa1); PK4(p1, 0, pa2); PK4(p1, 8, pa3);
}
#undef PK4
template <int KB, int MODE>
__device__ __forceinline__ void qkt(f32x16& p0, f32x16& p1, const char* K_lds, const float* ckl, int r32, int hi, const bf16x8* qr) {
    if constexpr (MODE == 0) {
        const float* c = ckl + KB * 64 + 4 * hi;
#pragma unroll
        for (int g = 0; g < 4; ++g) { const f32x4 a = *(const f32x4*)(c + 8 * g), b = *(const f32x4*)(c + 32 + 8 * g);
            p0[4 * g + 0] = a[0]; p0[4 * g + 1] = a[1]; p0[4 * g + 2] = a[2]; p0[4 * g + 3] = a[3];
            p1[4 * g + 0] = b[0]; p1[4 * g + 1] = b[1]; p1[4 * g + 2] = b[2]; p1[4 * g + 3] = b[3]; }
    } else { p0 = f32x16{}; p1 = f32x16{}; }
    const char* kb[4];
#pragma unroll
    for (int dd = 0; dd < 4; ++dd) kb[dd] = K_lds + KB * SHM_K + KSWZ(r32, (dd * 16 + hi * 8) * 2);
#pragma unroll
    for (int d0 = 0; d0 < 8; ++d0) { const char* a = kb[d0 & 3] + (d0 >> 2) * 128;
        bf16x8 b0 = *reinterpret_cast<const bf16x8*>(a);
        bf16x8 b1 = *reinterpret_cast<const bf16x8*>(a + 32 * 256);
        p0 = __builtin_amdgcn_mfma_f32_32x32x16_bf16(b0, qr[d0], p0, 0, 0, 0);
        p1 = __builtin_amdgcn_mfma_f32_32x32x16_bf16(b1, qr[d0], p1, 0, 0, 0); }
}
template <int VB>
__device__ __forceinline__ void pv_tile(f32x16* o, int vb0, bf16x8 pa0, bf16x8 pa1, bf16x8 pa2, bf16x8 pa3) {
#define TRRD(dst, off) asm volatile("ds_read_b64_tr_b16 %0, %1 offset:%2" : "=&v"(dst) : "v"(vb0), "i"(off) : "memory")
#define PV_D0(d0) do { s16x4 l0, l1, l2, l3, h0, h1, h2, h3; constexpr int b_ = VB * SHM_V + v_rd_off(d0, 0, 0);     \
        TRRD(l0, b_); TRRD(h0, b_ + 2048); TRRD(l1, b_ + 4096); TRRD(h1, b_ + 6144); TRRD(l2, b_ + 8192); TRRD(h2, b_ + 10240); TRRD(l3, b_ + 12288); TRRD(h3, b_ + 14336); \
        asm volatile("s_waitcnt lgkmcnt(0)" ::: "memory"); SBAR();                 \
        o[d0] = __builtin_amdgcn_mfma_f32_32x32x16_bf16(pa0, (bf16x8){l0[0], l0[1], l0[2], l0[3], h0[0], h0[1], h0[2], h0[3]}, o[d0], 0, 0, 0);   \
        o[d0] = __builtin_amdgcn_mfma_f32_32x32x16_bf16(pa1, (bf16x8){l1[0], l1[1], l1[2], l1[3], h1[0], h1[1], h1[2], h1[3]}, o[d0], 0, 0, 0);   \
        o[d0] = __builtin_amdgcn_mfma_f32_32x32x16_bf16(pa2, (bf16x8){l2[0], l2[1], l2[2], l2[3], h2[0], h2[1], h2[2], h2[3]}, o[d0], 0, 0, 0);   \
        o[d0] = __builtin_amdgcn_mfma_f32_32x32x16_bf16(pa3, (bf16x8){l3[0], l3[1], l3[2], l3[3], h3[0], h3[1], h3[2], h3[3]}, o[d0], 0, 0, 0); } while (0)
    PV_D0(0); PV_D0(1); PV_D0(2); PV_D0(3);
#undef PV_D0
#undef TRRD
}

struct BlockRef { const bf16* Q; const bf16* K; const bf16* V; bf16* O; const float* aux; int P0; };
constexpr int AUX_MEXP = 65536, AUX_AREF = 131072;
template <int MODE> struct Pitch { static constexpr int qp = MODE ? 512 : 6144, kp = MODE ? 512 : 6144, vp = 6144, op = MODE ? 1024 : 2048; };
struct Seam { bf16x8 qr[8]; bf16x8 st_v0, st_v1, st_k0, st_k1; float st_c; };
#define ROWK(R, PM, k0, rr) ((R).K + (size_t)(k0) * Pitch<PM>::kp + (unsigned)(((rr) * Pitch<PM>::kp) + sc))
#define ROWV(R, PM, k0, rr) ((R).V + (size_t)(k0) * Pitch<PM>::vp + (unsigned)(((rr) * Pitch<PM>::vp) + sc))
#define VMW() asm volatile("s_waitcnt vmcnt(0)" ::: "memory")
#define VMWN(n) asm volatile("s_waitcnt vmcnt(%0)" :: "i"(n) : "memory")
#define SLOAD_H(R, PM, k0) do { S.st_v0 = load8(ROWV(R, PM, k0, sr)); S.st_v1 = load8(ROWV(R, PM, k0, 32 + sr));              \
                         S.st_k0 = load8(ROWK(R, PM, k0, sr)); S.st_k1 = load8(ROWK(R, PM, k0, 32 + sr));                \
                         if constexpr (PM == 0) S.st_c = (R).aux[(k0) + (tid & 63)]; } while (0)
#define SWRITE_HK(bf) do { *(bf16x8*)(K_lds + (bf) * SHM_K + kws) = S.st_k0; *(bf16x8*)(K_lds + (bf) * SHM_K + kws + 32 * 256) = S.st_k1; \
                           if constexpr (MODE == 0) { if (tid < 64) ckl[(bf) * 64 + tid] = S.st_c; } } while (0)
#define SWRITE_HV(bf) do { *(bf16x8*)(V_lds + (bf) * SHM_V + vst0) = S.st_v0; *(bf16x8*)(V_lds + (bf) * SHM_V + vst1) = S.st_v1; } while (0)
#define SWRITE_H(bf) do { SWRITE_HV(bf); SWRITE_HK(bf); } while (0)
template <int MODE>
__device__ __forceinline__ void attn_prime(const BlockRef& cur, char* lds, Seam& S) {
    const int tid = threadIdx.x, wid = __builtin_amdgcn_readfirstlane(tid >> 6), lane = tid & 63, r32 = lane & 31, hi = lane >> 5;
    const int sr = tid >> 4, sc = (tid & 15) * 8, kws = KSWZ(sr, sc * 2), vst0 = v_st(sr, sc), vst1 = v_st(32 + sr, sc); char* V_lds = lds; char* K_lds = lds + 2 * SHM_V; float* ckl = (float*)(lds + OFF_CK);
#pragma unroll
    for (int d0 = 0; d0 < 8; ++d0) S.qr[d0] = load8(cur.Q + (size_t)(cur.P0 + wid * QBLK) * Pitch<MODE>::qp + (unsigned)(r32 * Pitch<MODE>::qp + d0 * 16 + hi * 8));
    SLOAD_H(cur, MODE, 0); VMW(); SWRITE_H(0);
    __syncthreads();
}
template <int MODE>
__device__ __forceinline__ void attn_block(const BlockRef& cur, const BlockRef& nxt, char* lds, Seam& S) {
    int tid0_ = threadIdx.x; asm volatile("" : "+v"(tid0_));
    const int tid = tid0_, wid = __builtin_amdgcn_readfirstlane(tid >> 6), lane = tid & 63, r32 = lane & 31, hi = lane >> 5;
    const int NT = cur.P0 / KVBLK + 4;
    const int qlo = cur.P0 + wid * QBLK, qm = qlo + r32 - 4 * hi;
    char* V_lds = lds; char* K_lds = lds + 2 * SHM_V;
    float* ws = (float*)(lds + OFF_WS) + wid * 64; float* li_l = ws, * al_l = ws + 32; float* ckl = (float*)(lds + OFF_CK);
    float m_reg = -1e30f, l_reg = 0; f32x16 o[4] = {};
    const int sr = tid >> 4, sc = (tid & 15) * 8, vst0 = v_st(sr, sc), vst1 = v_st(32 + sr, sc), kws = KSWZ(sr, sc * 2);
    const int vb0 = (int)(uintptr_t)V_lds + v_rd_base(lane);
    float m2row = 0.f; if constexpr (MODE == 1) m2row = cur.aux[qlo + r32];
#define RESC(a) do { if constexpr (MODE == 0) { if (__any((a) < 1.f)) { if (hi == 0) al_l[r32] = (a); asm volatile("s_waitcnt lgkmcnt(0)" ::: "memory");              \
                     for (int d_ = 0; d_ < 4; ++d_) for (int r = 0; r < 16; ++r) o[d_][r] *= al_l[crow(r, hi)]; } } } while (0)
#define KBASE(t) ((t) * KVBLK)
    f32x16 p0, p1; float mn, al; bf16x8 pa0, pa1, pa2, pa3;
#define STEP(t, BUF, LASTCHK) do {                                                                                               \
        float ar = 0.f; if constexpr (MODE == 1) ar = cur.aux[AUX_AREF + (t)];                                                    \
        const bool last_ = LASTCHK && ((t) + 1 >= NT);                                                                            \
        if (last_) { SLOAD_H(nxt, MODE, 0); } else { SLOAD_H(cur, MODE, KBASE((t) + 1)); }                                         \
        SBAR(); qkt<BUF, MODE>(p0, p1, K_lds, ckl, r32, hi, S.qr); SBAR();                                                          \
        if (last_) { _Pragma("unroll") for (int d0 = 0; d0 < 8; ++d0) S.qr[d0] = load8(nxt.Q + (size_t)(nxt.P0 + wid * QBLK) * Pitch<MODE>::qp + (unsigned)(r32 * Pitch<MODE>::qp + d0 * 16 + hi * 8)); SBAR(); } \
        { const int kb_ = KBASE(t); if (kb_ + KVBLK - 1 > qlo) mask_tile<MODE>(p0, p1, qm - kb_); }                               \
        if constexpr (MODE == 0) { partialSM(p0, p1, m_reg, mn, al); RESC(al); finishSM(p0, p1, al, l_reg, pa0, pa1, pa2, pa3); }    \
        else { linScale(p0, p1, __builtin_amdgcn_exp2f(ar - m2row)); linFinish(p0, p1, l_reg, pa0, pa1, pa2, pa3); }               \
        SBAR(); pv_tile<BUF>(o, vb0, pa0, pa1, pa2, pa3); SBAR();                                                                 \
        VMW(); SWRITE_H((BUF) ^ 1);                                                                                               \
        __syncthreads(); } while (0)
    for (int t = 0; t < NT; t += 2) { STEP(t, 0, false); STEP(t + 1, 1, true); }
    { float lv = l_reg; if constexpr (MODE == 1) lv = fmaxf(fabsf(l_reg), cur.aux[AUX_MEXP + qlo + r32]);
      if (hi == 0) li_l[r32] = lv; }
    asm volatile("s_waitcnt lgkmcnt(0)" ::: "memory");
    float rli[16];
#pragma unroll
    for (int r = 0; r < 16; ++r) rli[r] = __builtin_amdgcn_rcpf(li_l[crow(r, hi)]);
    bf16* Ow = cur.O + (size_t)(qlo) * Pitch<MODE>::op;
#pragma unroll
    for (int r = 0; r < 16; ++r) { const int orow = crow(r, hi);
#pragma unroll
        for (int d0 = 0; d0 < 4; ++d0) { const float v = o[d0][r] * rli[r];
            const float vn = __shfl_xor(v, 1);
            if ((r32 & 1) == 0) *(unsigned*)(Ow + (unsigned)(orow * Pitch<MODE>::op + d0 * 32 + r32)) = cvtpk(v, vn); } }
    asm volatile("s_waitcnt lgkmcnt(0)" ::: "memory");
#undef RESC
#undef KBASE
#undef STEP
}
#undef ROWK
#undef ROWV
#undef VMW
#undef VMWN
#undef SLOAD_H
#undef SWRITE_HK
#undef SWRITE_HV
#undef SWRITE_H
#undef SBAR
#undef KSWZ
}
#define LAS __attribute__((address_space(3)))
#define GAS __attribute__((address_space(1)))
#define RLX_AGENT __ATOMIC_RELAXED, __HIP_MEMORY_SCOPE_AGENT
#define XB_TMO      128
#define XB_XCNT(j)  (256  + 64 * (j))
#define XB_XSUB(j)  (1280 + 64 * (j))
#define XB_XGEN(j)  (2304 + 64 * (j))
#define XB_TOP      3328
#define XB_TOPGEN   3392
#define XCD_BAR_WORDS 3456
#define XB_SPIN_CAP (1u << 18)

__device__ __forceinline__ unsigned xb_ld(unsigned* p)              { return __hip_atomic_load(p, __ATOMIC_RELAXED, __HIP_MEMORY_SCOPE_AGENT); }
__device__ __forceinline__ unsigned xb_add(unsigned* p, unsigned v) { return __hip_atomic_fetch_add(p, v, __ATOMIC_RELAXED, __HIP_MEMORY_SCOPE_AGENT); }
__device__ __forceinline__ unsigned xb_xcc_id() { return (unsigned)__builtin_amdgcn_s_getreg((3 << 11) | 20) & 0xFu; }
#define XB_SPIN(cond, bar) do { unsigned _sp = 0; while (cond) { __builtin_amdgcn_s_sleep(1); \
    if ((++_sp & 255u) == 0u) { if (xb_ld(&(bar)[XB_TMO])) break; if (_sp > XB_SPIN_CAP) { atomicAdd(&(bar)[XB_TMO], 1u); break; } } } } while (0)

struct XcdBarrier {
    unsigned* bar; unsigned x;
    volatile LAS unsigned* st;
};

__device__ __forceinline__ XcdBarrier xcd_barrier_post(unsigned* bar, volatile LAS unsigned* st) {
    XcdBarrier b; b.bar = bar; b.x = xb_xcc_id(); b.st = st;
    if (threadIdx.x == 0) (void)xb_add(&bar[XB_XCNT(b.x)], 1u);
    return b;
}
__device__ __forceinline__ void xcd_barrier_complete(unsigned* bar, unsigned x, unsigned& nloc, unsigned& nx) {
    const unsigned G = gridDim.x * gridDim.y * gridDim.z;
    unsigned sum, cnt, mine, sp = 0u;
    for (;;) {
        sum = 0u; cnt = 0u; mine = 0u;
#pragma unroll
        for (unsigned j = 0; j < 16; ++j) { const unsigned c = xb_ld(&bar[XB_XCNT(j)]); sum += c; cnt += (c > 0u) ? 1u : 0u; mine = (j == x) ? c : mine; }
        if (sum == G) break;
        __builtin_amdgcn_s_sleep(1);
        if ((++sp & 255u) == 0u) { if (xb_ld(&bar[XB_TMO])) break; if (sp > XB_SPIN_CAP) { atomicAdd(&bar[XB_TMO], 1u); break; } }
    }
    nloc = mine > 0u ? mine : 1u; nx = cnt > 0u ? cnt : 1u;
}

__device__ __forceinline__ void xcd_barrier(const XcdBarrier& b) {
    asm volatile("s_waitcnt vmcnt(0)" ::: "memory");
    __syncthreads();
    if (threadIdx.x == 0) {
        unsigned* bar = b.bar;
        __builtin_amdgcn_s_waitcnt(0);
        unsigned nloc = b.st[0], nx = b.st[1];
        if (nloc == 0u) { xcd_barrier_complete(bar, b.x, nloc, nx); b.st[0] = nloc; b.st[1] = nx; }
        const unsigned old = xb_add(&bar[XB_XSUB(b.x)], 1u);
        const unsigned gen = old / nloc;
        if (old + 1u == (gen + 1u) * nloc) {
            __builtin_amdgcn_fence(__ATOMIC_RELEASE, "agent");
            asm volatile("s_waitcnt vmcnt(0)" ::: "memory");
            const unsigned og = xb_add(&bar[XB_TOP], 1u);
            const unsigned tg = og / nx;
            if (og + 1u == (tg + 1u) * nx) xb_add(&bar[XB_TOPGEN], 1u);
            else XB_SPIN(xb_ld(&bar[XB_TOPGEN]) == tg, bar);
            __builtin_amdgcn_fence(__ATOMIC_ACQUIRE, "agent");
            xb_add(&bar[XB_XGEN(b.x)], 1u);
            asm volatile("s_waitcnt vmcnt(0)" ::: "memory");
        } else {
            XB_SPIN(xb_ld(&bar[XB_XGEN(b.x)]) == gen, bar);
            __builtin_amdgcn_fence(__ATOMIC_ACQUIRE, "agent");
            asm volatile("s_waitcnt vmcnt(0)" ::: "memory");
        }
    }
    __syncthreads();
}
constexpr int NWAVES = 8, NTHREADS = NWAVES * 64;
constexpr int LDS_BYTES = 131072 + 4096;
static_assert(fa::LDS_BYTES <= 131072, "attention scratch fits the ring region");
constexpr size_t MiB = 1u << 20;
constexpr size_t WS_SS = 0;
constexpr size_t WS_BAR = 512 * 1024;
constexpr size_t WS_G = 1 * MiB;
constexpr size_t WS_CK = 2 * MiB;
constexpr size_t WS_A2 = 2 * MiB + 512 * 1024, WS_M2 = WS_A2 + 256 * 1024, WS_MEXP = WS_M2 + 256 * 1024, WS_AREF = WS_MEXP + 256 * 1024;
static_assert((WS_MEXP - WS_M2) / 4 == fa::AUX_MEXP && (WS_AREF - WS_M2) / 4 == fa::AUX_AREF, "aux offsets");
constexpr size_t WS_WIN = 4 * MiB, WS_WO = 29 * MiB, WS_WGU = 37 * MiB, WS_WD = 81 * MiB, WS_WPG = 103 * MiB, WS_WPP = 111 * MiB;
constexpr size_t WS_R1 = 112 * MiB;
constexpr size_t WS_R2 = 304 * MiB;
constexpr size_t WS_R3 = 368 * MiB;
constexpr size_t WS_HB = WS_R3, WS_MQ = WS_R3 + 32 * MiB, WS_MK = WS_R3 + 48 * MiB;
constexpr size_t WS_ERAW = 432 * MiB, WS_END = 496 * MiB;

struct Args {
    const float *x, *p, *w_norm_mix, *w_in, *fox_f_bias, *q_norm_w, *k_norm_w, *conv_w, *conv_b, *mi_bias, *mf_bias, *out_norm_w, *w_out, *w_norm_ffn,
                *w_gate, *w_up, *w_down, *w_norm_ple, *w_ple_gate, *w_ple_proj, *w_ple_post;
    float* out; unsigned char* ws;
};

__device__ __forceinline__ float wave_sum(float v) {
#pragma unroll
    for (int o = 1; o < 64; o <<= 1) v += __shfl_xor(v, o);
    return v;
}
__device__ __forceinline__ int win_src_col(int d) {
    if (d < 3072) return d;
    if (d < 5120) return d + 8;
    if (d < 6144) return d + 16;
    if (d < 6152) return 3072 + (d - 6144);
    if (d < 6160) return 5128 + (d - 6152);
    return -1;
}
struct TItem { const float* src4; bf16_t* dst; int ld, K; };
__device__ __forceinline__ TItem p0_item(const Args& A, int it, int lane) {
    constexpr int I_IN = (DM / 64) * (NIN / 32), I_O = (DM / 64) * (DM / 32), I_GU = (DM / 64) * (2 * DFF / 32), I_D = (DFF / 64) * (DM / 32), I_PG = I_O;
    unsigned char* ws = A.ws; const int n4 = 4 * (lane & 7), kr = lane >> 3; TItem t; int r = it;
    if (r < I_IN) { const int nblk = NIN / 32, kb = r / nblk, nb = r % nblk; const int sc = win_src_col(nb * 32 + n4);
        t.src4 = sc >= 0 ? A.w_in + (size_t)(kb * 64 + kr) * INC + sc : nullptr; t.ld = INC; t.K = DM; t.dst = (bf16_t*)(ws + WS_WIN) + (size_t)(nb * 32) * DM + kb * 64; return t; } r -= I_IN;
    if (r < I_O) { const int nblk = DM / 32, kb = r / nblk, nb = r % nblk; t.src4 = A.w_out + (size_t)(kb * 64 + kr) * DM + nb * 32 + n4; t.ld = DM; t.K = DM; t.dst = (bf16_t*)(ws + WS_WO) + (size_t)(nb * 32) * DM + kb * 64; return t; } r -= I_O;
    if (r < I_GU) { const int nblk = 2 * DFF / 32, kb = r / nblk, nb = r % nblk; const int d = nb * 32, pn = d >> 8, j = d & 255;
        t.src4 = ((j < 128) ? A.w_gate + 128 * pn + j : A.w_up + 128 * pn + (j - 128)) + (size_t)(kb * 64 + kr) * DFF + n4; t.ld = DFF; t.K = DM; t.dst = (bf16_t*)(ws + WS_WGU) + (size_t)d * DM + kb * 64; return t; } r -= I_GU;
    if (r < I_D) { const int nblk = DM / 32, kb = r / nblk, nb = r % nblk; t.src4 = A.w_down + (size_t)(kb * 64 + kr) * DM + nb * 32 + n4; t.ld = DM; t.K = DFF; t.dst = (bf16_t*)(ws + WS_WD) + (size_t)(nb * 32) * DFF + kb * 64; return t; } r -= I_D;
    if (r < I_PG) { const int nblk = DM / 32, kb = r / nblk, nb = r % nblk; t.src4 = A.w_ple_gate + (size_t)(kb * 64 + kr) * DM + nb * 32 + n4; t.ld = DM; t.K = DM; t.dst = (bf16_t*)(ws + WS_WPG) + (size_t)(nb * 32) * DM + kb * 64; return t; } r -= I_PG;
    { const int nblk = DM / 32, kb = r / nblk, nb = r % nblk; t.src4 = A.w_ple_proj + (size_t)(kb * 64 + kr) * DM + nb * 32 + n4; t.ld = DM; t.K = PLE; t.dst = (bf16_t*)(ws + WS_WPP) + (size_t)(nb * 32) * PLE + kb * 64; return t; }
}
__device__ __forceinline__ void p0_item_load(const TItem& t, f32x4 (&v)[8]) {
#pragma unroll
    for (int i = 0; i < 8; ++i) v[i] = t.src4 ? *(const f32x4*)(t.src4 + (size_t)(8 * i) * t.ld) : (f32x4){0.f, 0.f, 0.f, 0.f};
}
__device__ __forceinline__ void p0_item_store(const TItem& t, const f32x4 (&v)[8], LAS float* scr, int lane) {
    const int n4 = 4 * (lane & 7), kr = lane >> 3;
#pragma unroll
    for (int i = 0; i < 8; ++i) { LAS float* d = scr + (kr + 8 * i) * 33 + n4; d[0] = v[i].x; d[1] = v[i].y; d[2] = v[i].z; d[3] = v[i].w; }
    asm volatile("s_waitcnt lgkmcnt(0)" ::: "memory");
    const int c = lane & 7;
#pragma unroll
    for (int j = 0; j < 4; ++j) { const int n = (lane >> 3) + 8 * j; const LAS float* s = scr + (8 * c) * 33 + n;
        u32x4 o; o.x = cvtpk2(s[0 * 33], s[1 * 33]); o.y = cvtpk2(s[2 * 33], s[3 * 33]); o.z = cvtpk2(s[4 * 33], s[5 * 33]); o.w = cvtpk2(s[6 * 33], s[7 * 33]);
        *(u32x4*)(t.dst + (size_t)n * t.K + 8 * c) = o; }
    asm volatile("s_waitcnt lgkmcnt(0)" ::: "memory");
}
__device__ __forceinline__ void p0_prologue(const Args& A, LAS unsigned char* lds, int gw, int NGW, int lane, int wave) {
    LAS float* scr = (LAS float*)(lds + wave * 16384);
    unsigned char* ws = A.ws;
    constexpr int NITEMS = (DM / 64) * (NIN / 32) + 2 * (DM / 64) * (DM / 32) + (DM / 64) * (2 * DFF / 32) + (DFF / 64) * (DM / 32) + (PLE / 64) * (DM / 32);
    if (gw < NITEMS) {
        TItem cur = p0_item(A, gw, lane); f32x4 v[8]; p0_item_load(cur, v);
        for (int it = gw; it < NITEMS; it += NGW) {
            const bool more = it + NGW < NITEMS; TItem nx = cur; f32x4 w[8];
            if (more) { nx = p0_item(A, it + NGW, lane); p0_item_load(nx, w); }
            p0_item_store(cur, v, scr, lane);
            if (more) { cur = nx;
#pragma unroll
                for (int i = 0; i < 8; ++i) v[i] = w[i]; }
        }
    }
    bf16_t* XN = (bf16_t*)(ws + WS_R2);
    f32x4 wv[8];
#pragma unroll
    for (int j = 0; j < 8; ++j) wv[j] = ((const f32x4*)A.w_norm_mix)[64 * j + lane];
    {
        f32x4 v[8];
#pragma unroll
        for (int j = 0; j < 8; ++j) v[j] = ((const f32x4*)(A.x + (size_t)gw * DM) + lane)[64 * j];
        for (int m = gw; m < MROWS; m += NGW) {
            f32x4 nv[8]; const bool more = m + NGW < MROWS;
            if (more) {
#pragma unroll
                for (int j = 0; j < 8; ++j) nv[j] = ((const f32x4*)(A.x + (size_t)(m + NGW) * DM) + lane)[64 * j]; }
            float s = 0.f;
#pragma unroll
            for (int j = 0; j < 8; ++j) s += (v[j].x * v[j].x + v[j].y * v[j].y) + (v[j].z * v[j].z + v[j].w * v[j].w);
            const float rs = 1.f / sqrtf(wave_sum(s) * (1.f / DM) + EPS);
            u32x2* o8 = (u32x2*)(XN + (size_t)m * DM) + lane;
#pragma unroll
            for (int j = 0; j < 8; ++j) { const f32x4 y = v[j] * rs * wv[j]; u32x2 w; w.x = cvtpk2(y.x, y.y); w.y = cvtpk2(y.z, y.w); o8[64 * j] = w; }
            if (more) {
#pragma unroll
                for (int j = 0; j < 8; ++j) v[j] = nv[j]; }
        }
    }
    bf16_t* PB = (bf16_t*)(ws + WS_R3);
    for (int m = gw; m < MROWS; m += NGW) { const f32x4 v = ((const f32x4*)(A.p + (size_t)m * PLE))[lane]; u32x2 w; w.x = cvtpk2(v.x, v.y); w.y = cvtpk2(v.z, v.w); ((u32x2*)(PB + (size_t)m * PLE))[lane] = w; }
    float* ss = (float*)(ws + WS_SS);
    for (int i = gw * 64 + lane; i < 3 * MROWS; i += NGW * 64) ss[i] = 0.f;
}
__device__ __forceinline__ float logsigf(float x) { return fminf(x, 0.f) - log1pf(expf(-fabsf(x))); }
__device__ __forceinline__ void scan_sequence(const Args& A, int v, LAS float* red) {
    const int tid = threadIdx.x, lane = tid & 63, wid = tid >> 6;
    const bool fox = v < NB * AH; int b, h;
    if (fox) { b = v / AH; h = v % AH; } else { const int u = v - NB * AH; b = u / MH; h = u % MH; }
    const float* Gp = (const float*)(A.ws + WS_G) + (size_t)(b * SEQ + 8 * tid) * 16;
    const int fcol = fox ? h : 12 + h; const float fb = fox ? A.fox_f_bias[h] : A.mf_bias[h];
    float lf[8]; float run = 0.f;
#pragma unroll
    for (int i = 0; i < 8; ++i) { run += logsigf(Gp[i * 16 + fcol] + fb); lf[i] = run; }
    float incl = run;
#pragma unroll
    for (int o = 1; o < 64; o <<= 1) { const float t = __shfl_up(incl, o); if (lane >= o) incl += t; }
    if (lane == 63) red[wid] = incl;
    __syncthreads();
    float base = incl - run;
    for (int w = 0; w < wid; ++w) base += red[w];
    if (fox) {
        float* CK = (float*)(A.ws + WS_CK) + (size_t)(b * AH + h) * SEQ + 8 * tid;
#pragma unroll
        for (int i = 0; i < 8; ++i) CK[i] = -(base + lf[i]) * 11.313708498984761f;
    } else {
        const float ib = A.mi_bias[h];
        float a[8], lm[8]; float rm = -__builtin_inff();
#pragma unroll
        for (int i = 0; i < 8; ++i) { a[i] = (Gp[i * 16 + 8 + h] + ib) - (base + lf[i]); rm = fmaxf(rm, a[i]); lm[i] = rm; }
        float im = rm;
#pragma unroll
        for (int o = 1; o < 64; o <<= 1) { const float t = __shfl_up(im, o); if (lane >= o) im = fmaxf(im, t); }
        if (lane == 63) red[8 + wid] = im;
        __syncthreads();
        float ex = __shfl_up(im, 1); if (lane == 0) ex = -__builtin_inff();
        for (int w = 0; w < wid; ++w) ex = fmaxf(ex, red[8 + w]);
        const size_t o0 = (size_t)(b * MH + h) * SEQ + 8 * tid;
        float* A2 = (float*)(A.ws + WS_A2) + o0; float* M2 = (float*)(A.ws + WS_M2) + o0; float* ME = (float*)(A.ws + WS_MEXP) + o0;
#pragma unroll
        for (int i = 0; i < 8; ++i) { const float Mt = fmaxf(0.f, fmaxf(ex, lm[i])); A2[i] = a[i] * LOG2E; M2[i] = Mt * LOG2E; ME[i] = expf(-((base + lf[i]) + Mt)); }
        float tm = rm; tm = fmaxf(tm, __shfl_xor(tm, 1)); tm = fmaxf(tm, __shfl_xor(tm, 2)); tm = fmaxf(tm, __shfl_xor(tm, 4));
        if ((lane & 7) == 0) ((float*)(A.ws + WS_AREF))[(b * MH + h) * SEQ + (tid >> 3)] = tm * LOG2E;
    }
}
__device__ __forceinline__ void unpack8(const u32x4 w, float (&f)[8]) { f[0] = bflo(w.x); f[1] = bfhi(w.x); f[2] = bflo(w.y); f[3] = bfhi(w.y); f[4] = bflo(w.z); f[5] = bfhi(w.z); f[6] = bflo(w.w); f[7] = bfhi(w.w); }
__device__ __forceinline__ u32x4 pack8f(const float (&f)[8]) { u32x4 w; w.x = cvtpk2(f[0], f[1]); w.y = cvtpk2(f[2], f[3]); w.z = cvtpk2(f[4], f[5]); w.w = cvtpk2(f[6], f[7]); return w; }
__device__ __forceinline__ void qk_norm_rows(const Args& A, int gw, int NGW, int lane) {
    bf16_t* PROJ = (bf16_t*)(A.ws + WS_R1);
    const int d0 = (8 * lane) & 127;
    float qw[8], kw[8];
#pragma unroll
    for (int i = 0; i < 8; ++i) { qw[i] = A.q_norm_w[d0 + i]; kw[i] = A.k_norm_w[d0 + i]; }
    for (int m = gw; m < MROWS; m += NGW) {
        bf16_t* p = PROJ + (size_t)m * PROJ_LD + 8 * lane;
        u32x4 raw[4];
#pragma unroll
        for (int j = 0; j < 4; ++j) raw[j] = *(const u32x4*)(p + 512 * j);
#pragma unroll
        for (int j = 0; j < 4; ++j) { float f[8]; unpack8(raw[j], f); float s = 0.f;
#pragma unroll
            for (int i = 0; i < 8; ++i) s += f[i] * f[i];
            s += __shfl_xor(s, 1); s += __shfl_xor(s, 2); s += __shfl_xor(s, 4); s += __shfl_xor(s, 8);
            const float rs = 1.f / sqrtf(s * (1.f / 128.f) + EPS);
#pragma unroll
            for (int i = 0; i < 8; ++i) f[i] = f[i] * rs * (j < 2 ? qw[i] : kw[i]);
            *(u32x4*)(p + 512 * j) = pack8f(f); }
    }
}
template <int KPART> __device__ __forceinline__ void mconv_rows(const Args& A, int gw, int NGW, int lane) {
    const bf16_t* PROJ = (const bf16_t*)(A.ws + WS_R1) + (KPART ? PC_MK : PC_MQ) + 8 * lane;
    bf16_t* OUT = (bf16_t*)(A.ws + (KPART ? WS_MK : WS_MQ)) + 8 * lane;
    const int c0 = KPART * 512 + 8 * lane, hh = lane >> 4;
    float w[4][8], bb[8];
#pragma unroll
    for (int j = 0; j < 4; ++j)
#pragma unroll
        for (int i = 0; i < 8; ++i) w[j][i] = A.conv_w[j * 1024 + c0 + i];
#pragma unroll
    for (int i = 0; i < 8; ++i) bb[i] = A.conv_b[c0 + i];
    for (int m = gw; m < MROWS; m += NGW) {
        const int t = m & (SEQ - 1), b = m / SEQ;
        float acc[8];
#pragma unroll
        for (int i = 0; i < 8; ++i) acc[i] = bb[i];
#pragma unroll
        for (int j = 0; j < 4; ++j) { if (t - 3 + j >= 0) { float f[8]; unpack8(*(const u32x4*)(PROJ + (size_t)(m - 3 + j) * PROJ_LD), f);
#pragma unroll
                for (int i = 0; i < 8; ++i) acc[i] = fmaf(w[j][i], f[i], acc[i]); } }
        float sc;
        if (KPART) { const int bh = b * MH + hh; sc = exp2f(((const float*)(A.ws + WS_A2))[(size_t)bh * SEQ + t] - ((const float*)(A.ws + WS_AREF))[bh * SEQ + (t >> 6)]); }
        else sc = 0.08838834764831845f;
#pragma unroll
        for (int i = 0; i < 8; ++i) acc[i] = acc[i] * sigmoidf_(acc[i]) * sc;
        *(u32x4*)(OUT + (size_t)m * 512) = pack8f(acc);
    }
}
__device__ __forceinline__ void mlstm_out_rows(const Args& A, int gw, int NGW, int lane) {
    const bf16_t* HB = (const bf16_t*)(A.ws + WS_HB) + 16 * lane;
    const bf16_t* MO = (const bf16_t*)(A.ws + WS_R1) + PC_MO + 16 * lane;
    bf16_t* MIX = (bf16_t*)(A.ws + WS_R2) + 1024 + 16 * lane;
    float ow[16];
#pragma unroll
    for (int i = 0; i < 16; ++i) ow[i] = A.out_norm_w[16 * lane + i];
    for (int m = gw; m < MROWS; m += NGW) {
        float h[16], g[16];
        { float f[8]; unpack8(*(const u32x4*)(HB + (size_t)m * 1024), f);
#pragma unroll
          for (int i = 0; i < 8; ++i) h[i] = f[i];
          unpack8(*(const u32x4*)(HB + (size_t)m * 1024 + 8), f);
#pragma unroll
          for (int i = 0; i < 8; ++i) h[8 + i] = f[i];
          unpack8(*(const u32x4*)(MO + (size_t)m * PROJ_LD), f);
#pragma unroll
          for (int i = 0; i < 8; ++i) g[i] = f[i];
          unpack8(*(const u32x4*)(MO + (size_t)m * PROJ_LD + 8), f);
#pragma unroll
          for (int i = 0; i < 8; ++i) g[8 + i] = f[i]; }
        float s = 0.f;
#pragma unroll
        for (int i = 0; i < 16; ++i) s += h[i] * h[i];
        s += __shfl_xor(s, 1); s += __shfl_xor(s, 2); s += __shfl_xor(s, 4); s += __shfl_xor(s, 8);
        const float rs = 1.f / sqrtf(s * (1.f / 256.f) + EPS);
        float o[8];
#pragma unroll
        for (int i = 0; i < 8; ++i) o[i] = h[i] * rs * ow[i] * sigmoidf_(g[i]);
        *(u32x4*)(MIX + (size_t)m * DM) = pack8f(o);
#pragma unroll
        for (int i = 0; i < 8; ++i) o[i] = h[8 + i] * rs * ow[8 + i] * sigmoidf_(g[8 + i]);
        *(u32x4*)(MIX + (size_t)m * DM + 8) = pack8f(o);
    }
}
__device__ __forceinline__ fa::BlockRef p3_mblock(const Args& A, int w, int i) {
    const int x = w & 15, g = w >> 4; fa::BlockRef r; const int b = g / MH, h = g % MH; const size_t row0 = (size_t)b * SEQ;
    r.Q = (const fa::bf16*)(A.ws + WS_MQ) + row0 * 512 + h * 128; r.K = (const fa::bf16*)(A.ws + WS_MK) + row0 * 512 + h * 128;
    r.V = (const fa::bf16*)(A.ws + WS_R1) + row0 * PROJ_LD + PC_MV + h * 256 + i * 128; r.O = (fa::bf16*)(A.ws + WS_HB) + row0 * 1024 + h * 256 + i * 128;
    r.aux = (const float*)(A.ws + WS_M2) + (size_t)g * SEQ; r.P0 = x * 256; return r;
}
__device__ __forceinline__ fa::BlockRef p3_fblock(const Args& A, int w, int i) {
    const int x = w & 15, g = w >> 4; fa::BlockRef r; const int bh = 2 * g + i, b = bh / AH, h = bh % AH; const size_t row0 = (size_t)b * SEQ;
    const fa::bf16* PROJ = (const fa::bf16*)(A.ws + WS_R1) + row0 * PROJ_LD + h * 128;
    r.Q = PROJ + PC_AQ; r.K = PROJ + PC_AK; r.V = PROJ + PC_AV; r.O = (fa::bf16*)(A.ws + WS_R2) + row0 * DM + h * 128;
    r.aux = (const float*)(A.ws + WS_CK) + (size_t)bh * SEQ; r.P0 = (15 - x) * 256; return r;
}

#ifndef ONLY
#define ONLY -1
#endif
#ifndef REP0
#define REP0 1
#endif
#ifndef REP1
#define REP1 1
#endif
#ifndef REP3
#define REP3 1
#endif
#ifndef REP6
#define REP6 1
#endif
#ifndef REP2B
#define REP2B 1
#endif
#ifndef REP4
#define REP4 1
#endif
#ifndef XSYNC
#define XSYNC 0
#endif
#ifndef SKIPMASK
#define SKIPMASK 0
#endif
#define PH(k) if constexpr (ONLY < 0 ? !((SKIPMASK >> (k)) & 1) : ONLY == (k))
template <class T> __device__ __forceinline__ T* as_global(T* p) { return (T*)(__attribute__((address_space(1))) T*)p; }
__device__ __forceinline__ Args load_args() {
#if defined(__HIP_DEVICE_COMPILE__)
    const __attribute__((address_space(4))) Args* ap = (const __attribute__((address_space(4))) Args*)__builtin_amdgcn_kernarg_segment_ptr();
    asm volatile("" : "+s"(ap));
    Args a = *ap;
#define FX(f) a.f = as_global(a.f)
    FX(x); FX(p); FX(w_norm_mix); FX(w_in); FX(fox_f_bias); FX(q_norm_w); FX(k_norm_w); FX(conv_w); FX(conv_b); FX(mi_bias); FX(mf_bias); FX(out_norm_w); FX(w_out); FX(w_norm_ffn);
    FX(w_gate); FX(w_up); FX(w_down); FX(w_norm_ple); FX(w_ple_gate); FX(w_ple_proj); FX(w_ple_post); FX(out); FX(ws);
#undef FX
    return a;
#else
    return Args{};
#endif
}
#define ARGS() load_args()
__global__ void __launch_bounds__(NTHREADS, 2) fwd_megakernel(Args Aunused) {
    extern __shared__ __attribute__((aligned(16))) unsigned char lds[];
    cg::grid_group grid = cg::this_grid();
    LAS unsigned char* ldsl = (LAS unsigned char*)lds;
    const int G = gridDim.x, bx = blockIdx.x, NGW = G * NWAVES;
#define LANEVARS() int tid_ = threadIdx.x; asm volatile("" : "+v"(tid_)); const int lane = tid_ & 63, wave = __builtin_amdgcn_readfirstlane(tid_ >> 6), gw = bx * NWAVES + wave; (void)lane; (void)gw

    if (threadIdx.x < 16) ((volatile LAS unsigned*)(ldsl + 131072))[threadIdx.x] = 0u;
    { unsigned* bw = (unsigned*)(ARGS().ws + WS_BAR); if (bx == 0) for (int i = threadIdx.x; i < XCD_BAR_WORDS; i += NTHREADS) bw[i] = 0u; }
    __syncthreads();
    PH(0) for (int rep = 0; rep < REP0; ++rep) { const Args A = ARGS(); LANEVARS(); p0_prologue(A, ldsl, gw, NGW, lane, wave); }
    grid.sync();
    XcdBarrier xbar = xcd_barrier_post((unsigned*)(ARGS().ws + WS_BAR), (volatile LAS unsigned*)(ldsl + 131072));
#define GRID_BAR() xcd_barrier(xbar)
    for (int rep = 0; rep < XSYNC; ++rep) GRID_BAR();
    PH(1) for (int rep = 0; rep < REP1; ++rep) { const Args A = ARGS(); unsigned char* ws = A.ws;
        pg8::Gemm g{(const bf16_t*)(ws + WS_R2), (const bf16_t*)(ws + WS_WIN), MROWS, NIN, DM}; pg8::StaticOrder S; S.init(MROWS, NIN, G, bx);
        pg8::EpiProj E{(bf16_t*)(ws + WS_R1), (float*)(ws + WS_G)};
        pg8::gemm_phase<pg8::EpiProj, pg8::StaticOrder, true, true>(ldsl, g, S, E);
    }
    PH(10) { const Args A = ARGS(); unsigned char* ws = A.ws; float* SS = (float*)(ws + WS_SS);
        pg8::Gemm g{(const bf16_t*)(ws + WS_R3), (const bf16_t*)(ws + WS_WPP), MROWS, DM, PLE}; pg8::StaticOrder S; S.init(MROWS, DM, G, bx);
        pg8::EpiE E{(bf16_t*)(ws + WS_ERAW), SS};
        pg8::gemm_phase<pg8::EpiE, pg8::StaticOrder, true, true>(ldsl, g, S, E);
    }
    GRID_BAR();
    PH(2) { const Args A = ARGS(); for (int v = bx; v < NB * AH + NB * MH; v += G) { scan_sequence(A, v, (LAS float*)ldsl); __syncthreads(); } }
    PH(2) { const Args A = ARGS(); LANEVARS(); qk_norm_rows(A, gw, NGW, lane); }
    PH(2) { const Args A = ARGS(); LANEVARS(); mconv_rows<0>(A, gw, NGW, lane); }
    GRID_BAR();
    PH(2) for (int rep = 0; rep < REP2B; ++rep) { const Args A = ARGS(); LANEVARS(); mconv_rows<1>(A, gw, NGW, lane); }
    GRID_BAR();
    PH(3) for (int rep = 0; rep < REP3; ++rep) for (int w = bx; w < 256; w += G) { const Args A = ARGS();
        fa::Seam S;
#ifndef NO_M1
        { fa::BlockRef c = p3_mblock(A, w, 0); fa::attn_prime<1>(c, (char*)lds, S);
#pragma nounroll
          for (int i = 0; i < 2; ++i) { const fa::BlockRef n = p3_mblock(A, w, 1); fa::attn_block<1>(c, n, (char*)lds, S); c = n; } }
        asm volatile("s_waitcnt vmcnt(0)" ::: "memory"); __syncthreads();
#endif
#ifndef NO_M0
        { fa::BlockRef c = p3_fblock(A, w, 0); fa::attn_prime<0>(c, (char*)lds, S);
#pragma nounroll
          for (int i = 0; i < 2; ++i) { const fa::BlockRef n = p3_fblock(A, w, 1); fa::attn_block<0>(c, n, (char*)lds, S); c = n; } }
#endif
        asm volatile("s_waitcnt vmcnt(0)" ::: "memory");
        __syncthreads();
    }
    GRID_BAR();
    PH(4) for (int rep = 0; rep < REP4; ++rep) { const Args A = ARGS(); LANEVARS(); mlstm_out_rows(A, gw, NGW, lane); }
    GRID_BAR();
    PH(5) { const Args A = ARGS(); unsigned char* ws = A.ws; float* SS = (float*)(ws + WS_SS);
        pg8::Gemm g{(const bf16_t*)(ws + WS_R2), (const bf16_t*)(ws + WS_WO), MROWS, DM, DM}; pg8::StaticOrder S; S.init(MROWS, DM, G, bx);
        pg8::EpiRes E{A.x, A.out, (bf16_t*)(ws + WS_R3), A.w_norm_ffn, SS + MROWS};
        pg8::gemm_phase<pg8::EpiRes, pg8::StaticOrder, true, true>(ldsl, g, S, E);
    }
    GRID_BAR();
    PH(6) for (int rep = 0; rep < REP6; ++rep) { const Args A = ARGS(); unsigned char* ws = A.ws; float* SS = (float*)(ws + WS_SS);
        pg8::Gemm g{(const bf16_t*)(ws + WS_R3), (const bf16_t*)(ws + WS_WGU), MROWS, 2 * DFF, DM}; pg8::StaticOrder S; S.init(MROWS, 2 * DFF, G, bx);
        pg8::EpiSwiGLU E{(bf16_t*)(ws + WS_R1), SS + MROWS};
        pg8::gemm_phase<pg8::EpiSwiGLU, pg8::StaticOrder, true, true>(ldsl, g, S, E);
    }
    GRID_BAR();
    PH(7) { const Args A = ARGS(); unsigned char* ws = A.ws; float* SS = (float*)(ws + WS_SS);
        pg8::Gemm g{(const bf16_t*)(ws + WS_R1), (const bf16_t*)(ws + WS_WD), MROWS, DM, DFF}; pg8::StaticOrder S; S.init(MROWS, DM, G, bx);
        pg8::EpiRes E{A.out, A.out, (bf16_t*)(ws + WS_R2), A.w_norm_ple, SS + 2 * MROWS};
        pg8::gemm_phase<pg8::EpiRes, pg8::StaticOrder, true, true>(ldsl, g, S, E);
    }
    GRID_BAR();
    PH(8) { const Args A = ARGS(); unsigned char* ws = A.ws; float* SS = (float*)(ws + WS_SS);
        pg8::Gemm g{(const bf16_t*)(ws + WS_R2), (const bf16_t*)(ws + WS_WPG), MROWS, DM, DM}; pg8::StaticOrder S; S.init(MROWS, DM, G, bx);
        pg8::EpiFinal E{A.out, (const bf16_t*)(ws + WS_ERAW), A.w_ple_post, SS + 2 * MROWS, SS};
        pg8::gemm_phase<pg8::EpiFinal, pg8::StaticOrder, true, true>(ldsl, g, S, E);
    }
}

extern "C" void kernel_launch(void* const* d_in, const int* in_sizes, int n_in, void* d_out, int out_size, void* d_ws, size_t ws_size, hipStream_t stream) {
    static int grid = 0;
    if (grid == 0) {
        if (n_in != 21 || in_sizes[0] != MROWS * DM || out_size != MROWS * DM || ws_size < WS_END) {
            fprintf(stderr, "kernel_launch: unexpected shapes (n_in %d, in0 %d, out %d, ws %zu; need ws >= %zu)\n", n_in, n_in > 0 ? in_sizes[0] : -1, out_size, ws_size, (size_t)WS_END); grid = -1; return; }
        int dev = 0, cus = 0, per_cu = 0;
        (void)hipGetDevice(&dev); (void)hipDeviceGetAttribute(&cus, hipDeviceAttributeMultiprocessorCount, dev);
        if (hipFuncSetAttribute((const void*)fwd_megakernel, hipFuncAttributeMaxDynamicSharedMemorySize, LDS_BYTES) != hipSuccess) { fprintf(stderr, "kernel_launch: hipFuncSetAttribute failed\n"); grid = -1; return; }
        if (hipOccupancyMaxActiveBlocksPerMultiprocessor(&per_cu, (const void*)fwd_megakernel, NTHREADS, LDS_BYTES) != hipSuccess || per_cu < 1) { fprintf(stderr, "kernel_launch: occupancy query says %d blocks per CU\n", per_cu); per_cu = 1; }
        (void)hipGetLastError();
        if (per_cu > 1) per_cu = 1;
        grid = cus * per_cu;
    }
    if (grid < 0) return;
    Args a{};
    a.x = (const float*)d_in[0]; a.p = (const float*)d_in[1]; a.w_norm_mix = (const float*)d_in[2]; a.w_in = (const float*)d_in[3]; a.fox_f_bias = (const float*)d_in[4];
    a.q_norm_w = (const float*)d_in[5]; a.k_norm_w = (const float*)d_in[6]; a.conv_w = (const float*)d_in[7]; a.conv_b = (const float*)d_in[8]; a.mi_bias = (const float*)d_in[9];
    a.mf_bias = (const float*)d_in[10]; a.out_norm_w = (const float*)d_in[11]; a.w_out = (const float*)d_in[12]; a.w_norm_ffn = (const float*)d_in[13]; a.w_gate = (const float*)d_in[14];
    a.w_up = (const float*)d_in[15]; a.w_down = (const float*)d_in[16]; a.w_norm_ple = (const float*)d_in[17]; a.w_ple_gate = (const float*)d_in[18]; a.w_ple_proj = (const float*)d_in[19];
    a.w_ple_post = (const float*)d_in[20];
    a.out = (float*)d_out; a.ws = (unsigned char*)d_ws;
    void* args[] = {&a};
    hipError_t e = hipLaunchCooperativeKernel((const void*)fwd_megakernel, dim3(grid), dim3(NTHREADS), args, LDS_BYTES, stream);
    if (e != hipSuccess) fprintf(stderr, "kernel_launch: cooperative launch failed: %s (grid %d)\n", hipGetErrorString(e), grid);
}
```

```cpp
#include <hip/hip_runtime.h>
#include <hip/hip_cooperative_groups.h>
#include <hip/hip_bf16.h>
#include <cstdio>
#include <cstdint>
namespace cg = cooperative_groups;

constexpr int NB = 4, SEQ = 4096, DM = 2048, MROWS = NB * SEQ;
constexpr int PLE = 256, AH = 8, MH = 4, DFF = 5632, INC = 6160;
constexpr int PROJ_LD = 6144, NIN = 6400;
constexpr int PC_AQ = 0, PC_AK = 1024, PC_AV = 2048, PC_MQ = 3072, PC_MK = 3584, PC_MV = 4096, PC_MO = 5120;
constexpr float EPS = 1e-6f;
constexpr float LOG2E = 1.4426950408889634f;

typedef unsigned short bf16_t;
typedef float f32x4 __attribute__((ext_vector_type(4)));
typedef float f32x2 __attribute__((ext_vector_type(2)));
typedef unsigned u32x4 __attribute__((ext_vector_type(4)));
typedef unsigned u32x2 __attribute__((ext_vector_type(2)));
typedef __bf16 bf16x2_t __attribute__((ext_vector_type(2)));
__device__ __forceinline__ unsigned cvtpk2(float lo, float hi) { f32x2 v = {lo, hi}; bf16x2_t b = __builtin_convertvector(v, bf16x2_t); return __builtin_bit_cast(unsigned, b); }
__device__ __forceinline__ float bflo(unsigned w) { return __uint_as_float(w << 16); }
__device__ __forceinline__ float bfhi(unsigned w) { return __uint_as_float(w & 0xffff0000u); }
__device__ __forceinline__ float sigmoidf_(float x) { return __builtin_amdgcn_rcpf(1.f + __expf(-x)); }
namespace pg8 {
#define PG8_LAS __attribute__((address_space(3)))
typedef unsigned short bf16_t;
typedef short bf16x8 __attribute__((ext_vector_type(8)));
typedef float f32x4 __attribute__((ext_vector_type(4)));
typedef unsigned u32x4 __attribute__((ext_vector_type(4)));
constexpr int BM = 256, BK = 64, HALF = 128, HTB = HALF * BK * 2  , STAGE_BYTES = 8 * HTB, NXCD = 8, WGM = 8;

__host__ __device__ __forceinline__ int lds_byte(int r, int c) { const int st = (r >> 4) * 2 + (c >> 5), rr = r & 15, cc = c & 31, ob = rr * 64 + cc * 2; return st * 1024 + (ob ^ (((ob >> 9) & 1) << 5)); }
__host__ __device__ __forceinline__ void stage_rc(int b, int& R, int& C) { const int st = b / 1024, sb = b % 1024, swz = sb ^ (((sb >> 9) & 1) << 5); R = (st >> 1) * 16 + swz / 64; C = (st & 1) * 32 + (swz % 64) / 2; }
__host__ __device__ __forceinline__ int perm32(int rho) { const int n = rho >> 4, i = rho & 15; return 8 * (i >> 2) + 4 * n + (i & 3); }

struct Unit { int pm, pn; };
struct Gemm { const bf16_t* A; const bf16_t* Bt; int M, N, K; };

struct StaticOrder {
    int nM, nN, nwg, G, c;
    __host__ __device__ void init(int M, int N, int G_, int c_) { nM = M / BM; nN = N / BM; nwg = nM * nN; G = G_; c = c_; }
    __host__ __device__ bool next(int i, Unit& u) const {
        const long L = (long)i * G + c; if (L >= nwg) return false;
        int wgid = (int)L; { const int q = nwg / NXCD, r = nwg % NXCD, xcd = wgid % NXCD, off = wgid / NXCD; wgid = (xcd < r ? xcd * (q + 1) : r * (q + 1) + (xcd - r) * q) + off; }
        const int nig = WGM * nN, gid = wgid / nig, fm = gid * WGM, gsz = (nM - fm) < WGM ? (nM - fm) : WGM;
        u.pm = fm + ((wgid % nig) % gsz); u.pn = (wgid % nig) / gsz; return true;
    }
    __device__ __forceinline__ void a_ready(const Unit&) const {}
    __device__ __forceinline__ void done(const Unit&) const {}
};
__device__ __forceinline__ unsigned cvt_pk_bf16(float lo, float hi) { return ::cvtpk2(lo, hi); }
__device__ __forceinline__ float sumsq4(f32x4 v) { return (v[0] * v[0] + v[1] * v[1]) + (v[2] * v[2] + v[3] * v[3]); }
__device__ __forceinline__ void atomic_add_f32(float* p, float v) { __hip_atomic_fetch_add(p, v, __ATOMIC_RELAXED, __HIP_MEMORY_SCOPE_AGENT); }

__device__ __forceinline__ void zero_acc(f32x4 (&acc)[2][2][4][2]) {
#pragma unroll
    for (int a = 0; a < 2; ++a)
#pragma unroll
        for (int b = 0; b < 2; ++b)
#pragma unroll
            for (int m = 0; m < 4; ++m)
#pragma unroll
                for (int n = 0; n < 2; ++n) acc[a][b][m][n] = (f32x4){0.f, 0.f, 0.f, 0.f};
}
#define PG8_ZERO_INIT __device__ __forceinline__ void init(f32x4 (&acc)[2][2][4][2], const Unit&, int, int, int, int) const { zero_acc(acc); }

struct EpiProj {
    static constexpr bool PERM = true, AFTER_DRAIN = false;
    PG8_ZERO_INIT
    bf16_t* O; float* G; const float* ss0;
    __device__ __forceinline__ void operator()(const f32x4 (&acc)[2][2][4][2], const Unit& u, int wr, int wc, int fr, int fq) const {
        const int row0 = u.pm * BM + wr * 64 + fr;
        if (u.pn < 24) {
            const int col0 = u.pn * BM + wc * 32 + 8 * fq;
#pragma unroll
            for (int ai = 0; ai < 2; ++ai)
#pragma unroll
                for (int m = 0; m < 4; ++m) { const int row = row0 + ai * HALF + m * 16; const float rs = __builtin_amdgcn_rsqf(ss0[row] * (1.f / 2048.f) + 1e-6f); bf16_t* rowp = O + (size_t)row * 6144 + col0;
#pragma unroll
                    for (int bj = 0; bj < 2; ++bj) { const f32x4 v0 = acc[ai][bj][m][0] * rs, v1 = acc[ai][bj][m][1] * rs;
                        u32x4 w; w.x = cvt_pk_bf16(v0[0], v0[1]); w.y = cvt_pk_bf16(v0[2], v0[3]); w.z = cvt_pk_bf16(v1[0], v1[1]); w.w = cvt_pk_bf16(v1[2], v1[3]);
                        *(u32x4*)(rowp + bj * HALF) = w; } }
        } else if (wc == 0) {
            if (fq < 2) {
#pragma unroll
                for (int ai = 0; ai < 2; ++ai)
#pragma unroll
                    for (int m = 0; m < 4; ++m) { const int row = row0 + ai * HALF + m * 16; const float rs = __builtin_amdgcn_rsqf(ss0[row] * (1.f / 2048.f) + 1e-6f); float* gp = G + (size_t)row * 16 + 8 * fq;
                        *(f32x4*)(gp) = acc[ai][0][m][0] * rs; *(f32x4*)(gp + 4) = acc[ai][0][m][1] * rs; }
            }
        }
    }
};
struct EpiE {
    static constexpr bool PERM = true, AFTER_DRAIN = false;
    PG8_ZERO_INIT
    bf16_t* O; float* ss;
    __device__ __forceinline__ void operator()(const f32x4 (&acc)[2][2][4][2], const Unit& u, int wr, int wc, int fr, int fq) const {
        const int row0 = u.pm * BM + wr * 64 + fr, col0 = u.pn * BM + wc * 32 + 8 * fq;
#pragma unroll
        for (int ai = 0; ai < 2; ++ai)
#pragma unroll
            for (int m = 0; m < 4; ++m) { const int row = row0 + ai * HALF + m * 16; bf16_t* rowp = O + (size_t)row * 2048 + col0; float s = 0.f;
#pragma unroll
                for (int bj = 0; bj < 2; ++bj) { const f32x4 v0 = acc[ai][bj][m][0], v1 = acc[ai][bj][m][1]; s += sumsq4(v0) + sumsq4(v1);
                    u32x4 w; w.x = cvt_pk_bf16(v0[0], v0[1]); w.y = cvt_pk_bf16(v0[2], v0[3]); w.z = cvt_pk_bf16(v1[0], v1[1]); w.w = cvt_pk_bf16(v1[2], v1[3]);
                    *(u32x4*)(rowp + bj * HALF) = w; }
                s += __shfl_xor(s, 16); s += __shfl_xor(s, 32);
                if (fq == 0) atomic_add_f32(ss + row, s); }
    }
};
template <bool XINB> struct EpiRes {
    static constexpr bool PERM = true, AFTER_DRAIN = false;
    const void* xin; bf16_t* xout; float* ss; int live;
    __device__ __forceinline__ void init(f32x4 (&acc)[2][2][4][2], const Unit& u, int wr, int wc, int fr, int fq) const {
        const int row0 = u.pm * BM + wr * 64 + fr, col0 = u.pn * BM + wc * 32 + 8 * fq;
#pragma unroll
        for (int ai = 0; ai < 2; ++ai)
#pragma unroll
            for (int m = 0; m < 4; ++m) { const size_t off = (size_t)(row0 + ai * HALF + m * 16) * 2048 + col0;
#pragma unroll
                for (int bj = 0; bj < 2; ++bj) {
                    if constexpr (XINB) { const u32x4 w = *(const u32x4*)((const bf16_t*)xin + off + bj * HALF);
                        acc[ai][bj][m][0] = (f32x4){::bflo(w.x), ::bfhi(w.x), ::bflo(w.y), ::bfhi(w.y)}; acc[ai][bj][m][1] = (f32x4){::bflo(w.z), ::bfhi(w.z), ::bflo(w.w), ::bfhi(w.w)}; }
                    else { const float* rp = (const float*)xin + off + bj * HALF; acc[ai][bj][m][0] = *(const f32x4*)rp; acc[ai][bj][m][1] = *(const f32x4*)(rp + 4); } } }
    }
    __device__ __forceinline__ void operator()(const f32x4 (&acc)[2][2][4][2], const Unit& u, int wr, int wc, int fr, int fq) const {
        if (!live) {
#pragma unroll
            for (int ai = 0; ai < 2; ++ai)
#pragma unroll
                for (int m = 0; m < 4; ++m)
#pragma unroll
                    for (int bj = 0; bj < 2; ++bj)
#pragma unroll
                        for (int n = 0; n < 2; ++n) asm volatile("" :: "v"(acc[ai][bj][m][n]));
            return; }
        const int row0 = u.pm * BM + wr * 64 + fr, col0 = u.pn * BM + wc * 32 + 8 * fq;
#pragma unroll
        for (int ai = 0; ai < 2; ++ai)
#pragma unroll
            for (int m = 0; m < 4; ++m) { const int row = row0 + ai * HALF + m * 16; bf16_t* rowp = xout + (size_t)row * 2048 + col0; float s = 0.f;
#pragma unroll
                for (int bj = 0; bj < 2; ++bj) { const f32x4 v0 = acc[ai][bj][m][0], v1 = acc[ai][bj][m][1]; s += sumsq4(v0) + sumsq4(v1);
                    u32x4 w; w.x = cvt_pk_bf16(v0[0], v0[1]); w.y = cvt_pk_bf16(v0[2], v0[3]); w.z = cvt_pk_bf16(v1[0], v1[1]); w.w = cvt_pk_bf16(v1[2], v1[3]);
                    *(u32x4*)(rowp + bj * HALF) = w; }
                s += __shfl_xor(s, 16); s += __shfl_xor(s, 32);
                if (fq == 0) atomic_add_f32(ss + row, s); }
    }
};
struct EpiSwiGLU {
    static constexpr bool PERM = true, AFTER_DRAIN = false;
    PG8_ZERO_INIT
    bf16_t* O; const float* ss;
    __device__ __forceinline__ void operator()(const f32x4 (&acc)[2][2][4][2], const Unit& u, int wr, int wc, int fr, int fq) const {
        const int row0 = u.pm * BM + wr * 64 + fr, col0 = u.pn * HALF + wc * 32 + 8 * fq;
#pragma unroll
        for (int ai = 0; ai < 2; ++ai)
#pragma unroll
            for (int m = 0; m < 4; ++m) { const int row = row0 + ai * HALF + m * 16; const float rs = __builtin_amdgcn_rsqf(ss[row] * (1.f / 2048.f) + 1e-6f);
                float r[8];
#pragma unroll
                for (int n = 0; n < 2; ++n)
#pragma unroll
                    for (int e = 0; e < 4; ++e) { const float g = acc[ai][0][m][n][e] * rs, up = acc[ai][1][m][n][e] * rs; r[n * 4 + e] = g * __builtin_amdgcn_rcpf(1.f + __expf(-g)) * up; }
                u32x4 w; w.x = cvt_pk_bf16(r[0], r[1]); w.y = cvt_pk_bf16(r[2], r[3]); w.z = cvt_pk_bf16(r[4], r[5]); w.w = cvt_pk_bf16(r[6], r[7]);
                *(u32x4*)(O + (size_t)row * 5632 + col0) = w; }
    }
};
struct EpiFinal {
    static constexpr bool PERM = true, AFTER_DRAIN = false;
    PG8_ZERO_INIT
    float* out; const bf16_t* x2; const bf16_t* eraw; const float* wpost; const float* ss2; const float* ssE;
    __device__ __forceinline__ void operator()(const f32x4 (&acc)[2][2][4][2], const Unit& u, int wr, int wc, int fr, int fq) const {
        const int row0 = u.pm * BM + wr * 64 + fr, col0 = u.pn * BM + wc * 32 + 8 * fq;
        f32x4 wv[2][2];
#pragma unroll
        for (int bj = 0; bj < 2; ++bj)
#pragma unroll
            for (int n = 0; n < 2; ++n) wv[bj][n] = *(const f32x4*)(wpost + col0 + bj * HALF + n * 4);
#pragma unroll
        for (int ai = 0; ai < 2; ++ai)
#pragma unroll
            for (int m = 0; m < 4; ++m) { const int row = row0 + ai * HALF + m * 16; const size_t off = (size_t)row * 2048 + col0;
                const float rs = __builtin_amdgcn_rsqf(ss2[row] * (1.f / 2048.f) + 1e-6f), re = __builtin_amdgcn_rsqf(ssE[row] * (1.f / 2048.f) + 1e-6f);
#pragma unroll
                for (int bj = 0; bj < 2; ++bj) { const size_t o2 = off + bj * HALF; const u32x4 xw = *(const u32x4*)(x2 + o2), ew = *(const u32x4*)(eraw + o2);
                    const f32x4 xa = {::bflo(xw.x), ::bfhi(xw.x), ::bflo(xw.y), ::bfhi(xw.y)}, xb = {::bflo(xw.z), ::bfhi(xw.z), ::bflo(xw.w), ::bfhi(xw.w)};
                    f32x4 ea = {::bflo(ew.x), ::bfhi(ew.x), ::bflo(ew.y), ::bfhi(ew.y)}, eb = {::bflo(ew.z), ::bfhi(ew.z), ::bflo(ew.w), ::bfhi(ew.w)};
                    ea = ea * re * wv[bj][0]; eb = eb * re * wv[bj][1];
                    const f32x4 a0 = acc[ai][bj][m][0] * rs, a1 = acc[ai][bj][m][1] * rs; f32x4 o0, o1;
#pragma unroll
                    for (int e = 0; e < 4; ++e) { o0[e] = xa[e] + ::sigmoidf_(a0[e]) * ea[e]; o1[e] = xb[e] + ::sigmoidf_(a1[e]) * eb[e]; }
                    *(f32x4*)(out + o2) = o0; *(f32x4*)(out + o2 + 4) = o1; } }
    }
};
template <class Epi, class Sched, bool ALIGN_EPI = false, bool SP2 = false>
__device__ __forceinline__ void gemm_phase(PG8_LAS unsigned char* lds, const Gemm g, const Sched& S, const Epi& E) {
    int tid0_ = threadIdx.x; asm volatile("" : "+v"(tid0_));
    const int tid = tid0_, wid = __builtin_amdgcn_readfirstlane(tid >> 6), lane = tid & 63, wr = wid >> 2, wc = wid & 3, fr = lane & 15, fq = lane >> 4;
    int K0_ = g.K; asm volatile("" : "+s"(K0_));
    const int K = K0_, nt = K / BK;
    unsigned voffA[2], voffB[2];
#pragma unroll
    for (int i = 0; i < 2; ++i) { int R, C; stage_rc(tid * 16 + i * 8192, R, C); const int Rb = Epi::PERM ? ((R & ~31) + perm32(R & 31)) : R;
        voffA[i] = (unsigned)(R * K + C) * 2u; voffB[i] = (unsigned)(Rb * K + C) * 2u; }
    const size_t kstep = (size_t)(BK * 2);
    const size_t hstep = (size_t)HALF * K * 2;
    const size_t tstep = 2 * hstep;
    const unsigned ldsw = (unsigned)wid * 1024u;
    const int aoff = lds_byte(wr * 64 + fr, fq * 8), boff = lds_byte(wc * 32 + fr, fq * 8);
#define PG8_SA(b, h) (((b) * 2 + (h)) * HTB)
#define PG8_SB(b, h) ((4 + (b) * 2 + (h)) * HTB)
#define PG8_STAGE(bufoff, gbase, voff) do { _Pragma("unroll") for (int _i = 0; _i < 2; ++_i) \
        __builtin_amdgcn_global_load_lds((const unsigned*)((const char*)(gbase) + (voff)[_i]), (PG8_LAS unsigned*)(lds + (bufoff) + ldsw + _i * 8192), 16, 0, 0); } while (0)
#define PG8_LDA(dst, b, h) do { _Pragma("unroll") for (int m = 0; m < 4; ++m) _Pragma("unroll") for (int k = 0; k < 2; ++k) dst[m][k] = *(const PG8_LAS bf16x8*)(lds + PG8_SA(b, h) + aoff + m * 2048 + k * 1024); } while (0)
#define PG8_LDB(dst, b, h) do { _Pragma("unroll") for (int n = 0; n < 2; ++n) _Pragma("unroll") for (int k = 0; k < 2; ++k) dst[n][k] = *(const PG8_LAS bf16x8*)(lds + PG8_SB(b, h) + boff + n * 2048 + k * 1024); } while (0)
#define PG8_MMA(ai, bj, At, Bt) do { __builtin_amdgcn_s_setprio(1); _Pragma("unroll") for (int m = 0; m < 4; ++m) _Pragma("unroll") for (int n = 0; n < 2; ++n) _Pragma("unroll") for (int k = 0; k < 2; ++k) \
        acc[ai][bj][m][n] = __builtin_amdgcn_mfma_f32_16x16x32_bf16(Bt[n][k], At[m][k], acc[ai][bj][m][n], 0, 0, 0); __builtin_amdgcn_s_setprio(0); } while (0)
#define PG8_WAIT_V(n) asm volatile("s_waitcnt vmcnt(" #n ")" ::: "memory")
#define PG8_WAIT_L(n) asm volatile("s_waitcnt lgkmcnt(" #n ")" ::: "memory")
#define PG8_BAR __builtin_amdgcn_s_barrier()
#define PG8_SCHED __builtin_amdgcn_sched_barrier(0)
    Unit cur, nxt; int ui = 0;
    if (!S.next(0, cur)) return;
    f32x4 acc[2][2][4][2];
    E.init(acc, cur, wr, wc, fr, fq);
    bf16x8 At[4][2], B0[2][2], B1[2][2];
    const char* cA = (const char*)g.A + (size_t)cur.pm * tstep; const char* cB = (const char*)g.Bt + (size_t)cur.pn * tstep;
    S.a_ready(cur);
    if constexpr (SP2) {
        PG8_STAGE(PG8_SB(0, 0), cB, voffB); PG8_STAGE(PG8_SB(0, 1), cB + hstep, voffB); PG8_STAGE(PG8_SA(0, 0), cA, voffA); PG8_STAGE(PG8_SA(0, 1), cA + hstep, voffA);
        if (wr == 1) PG8_BAR;
        PG8_WAIT_V(2); PG8_BAR;
        PG8_STAGE(PG8_SB(1, 0), cB + kstep, voffB); PG8_STAGE(PG8_SA(1, 0), cA + kstep, voffA); PG8_STAGE(PG8_SB(1, 1), cB + hstep + kstep, voffB);
        PG8_WAIT_V(6); PG8_BAR;
    } else {
        PG8_STAGE(PG8_SB(0, 0), cB, voffB); PG8_STAGE(PG8_SA(0, 0), cA, voffA); PG8_STAGE(PG8_SB(0, 1), cB + hstep, voffB); PG8_STAGE(PG8_SA(0, 1), cA + hstep, voffA);
        if (wr == 1) PG8_BAR;
        PG8_WAIT_V(4); PG8_BAR;
        PG8_STAGE(PG8_SB(1, 0), cB + kstep, voffB); PG8_STAGE(PG8_SA(1, 0), cA + kstep, voffA); PG8_STAGE(PG8_SB(1, 1), cB + hstep + kstep, voffB);
        PG8_WAIT_V(6); PG8_BAR;
    }
    for (;;) {
        const bool has_next = S.next(ui + 1, nxt);
        const char* nA = has_next ? (const char*)g.A + (size_t)nxt.pm * tstep : cA; const char* nB = has_next ? (const char*)g.Bt + (size_t)nxt.pn * tstep : cB;
        for (int t = 0; t < nt; t += 2) {
            const bool last = (t == nt - 2);
            const char* a1 = cA + (size_t)(t + 1) * kstep;
            const char* a2 = last ? nA : cA + (size_t)(t + 2) * kstep; const char* b2 = last ? nB : cB + (size_t)(t + 2) * kstep;
            const char* a3 = a2 + kstep; const char* b3 = b2 + kstep;
            if (last && has_next) S.a_ready(nxt);
            if constexpr (SP2) {
            PG8_LDB(B0, 0, 0); PG8_LDB(B1, 0, 1); PG8_SCHED; PG8_LDA(At, 0, 0); PG8_STAGE(PG8_SA(1, 1), a1 + hstep, voffA);
            PG8_WAIT_V(8); PG8_WAIT_L(0); PG8_BAR; PG8_MMA(0, 0, At, B0); PG8_MMA(0, 1, At, B1); PG8_BAR; PG8_SCHED;
            PG8_LDA(At, 0, 1); PG8_STAGE(PG8_SB(0, 0), b2, voffB); PG8_STAGE(PG8_SB(0, 1), b2 + hstep, voffB); PG8_STAGE(PG8_SA(0, 0), a2, voffA);
            PG8_WAIT_V(8); PG8_WAIT_L(0); PG8_BAR; PG8_MMA(1, 0, At, B0); PG8_MMA(1, 1, At, B1); PG8_BAR; PG8_SCHED;
            PG8_LDB(B0, 1, 0); PG8_LDB(B1, 1, 1); PG8_SCHED; PG8_LDA(At, 1, 0); PG8_STAGE(PG8_SA(0, 1), a2 + hstep, voffA);
            PG8_WAIT_V(8); PG8_WAIT_L(0); PG8_BAR; PG8_MMA(0, 0, At, B0); PG8_MMA(0, 1, At, B1); PG8_BAR; PG8_SCHED;
            PG8_LDA(At, 1, 1); PG8_STAGE(PG8_SB(1, 0), b3, voffB); PG8_STAGE(PG8_SB(1, 1), b3 + hstep, voffB); PG8_STAGE(PG8_SA(1, 0), a3, voffA);
            PG8_WAIT_V(8); PG8_WAIT_L(0); PG8_BAR; PG8_MMA(1, 0, At, B0); PG8_MMA(1, 1, At, B1); PG8_BAR; PG8_SCHED;
            } else {
            PG8_LDB(B0, 0, 0); PG8_SCHED; PG8_LDA(At, 0, 0); PG8_STAGE(PG8_SA(1, 1), a1 + hstep, voffA);
            PG8_WAIT_L(8); PG8_BAR; PG8_WAIT_L(0); PG8_MMA(0, 0, At, B0); PG8_BAR; PG8_SCHED;
            PG8_LDB(B1, 0, 1); PG8_STAGE(PG8_SB(0, 0), b2, voffB);
            PG8_BAR; PG8_WAIT_L(0); PG8_MMA(0, 1, At, B1); PG8_BAR;
            PG8_LDA(At, 0, 1); PG8_STAGE(PG8_SA(0, 0), a2, voffA);
            PG8_BAR; PG8_WAIT_L(0); PG8_MMA(1, 0, At, B0); PG8_BAR; PG8_SCHED;
            PG8_STAGE(PG8_SB(0, 1), b2 + hstep, voffB);
            PG8_WAIT_V(6); PG8_BAR; PG8_MMA(1, 1, At, B1); PG8_BAR;
            PG8_LDB(B0, 1, 0); PG8_SCHED; PG8_LDA(At, 1, 0); PG8_STAGE(PG8_SA(0, 1), a2 + hstep, voffA);
            PG8_WAIT_L(8); PG8_BAR; PG8_WAIT_L(0); PG8_MMA(0, 0, At, B0); PG8_BAR; PG8_SCHED;
            PG8_LDB(B1, 1, 1); PG8_STAGE(PG8_SB(1, 0), b3, voffB);
            PG8_BAR; PG8_WAIT_L(0); PG8_MMA(0, 1, At, B1); PG8_BAR;
            PG8_LDA(At, 1, 1); PG8_STAGE(PG8_SA(1, 0), a3, voffA);
            PG8_BAR; PG8_WAIT_L(0); PG8_MMA(1, 0, At, B0); PG8_BAR; PG8_SCHED;
            PG8_STAGE(PG8_SB(1, 1), b3 + hstep, voffB);
            PG8_WAIT_V(6); PG8_BAR; PG8_MMA(1, 1, At, B1); PG8_BAR;
            }
        }
        if constexpr (ALIGN_EPI) { if (wr == 0) PG8_BAR; }
        if constexpr (!Epi::AFTER_DRAIN) { E(acc, cur, wr, wc, fr, fq); S.done(cur); }
        if (!has_next) break;
        E.init(acc, nxt, wr, wc, fr, fq);
        cur = nxt; cA = nA; cB = nB; ++ui;
        if constexpr (ALIGN_EPI) { if (wr == 1) PG8_BAR; }
    }
    PG8_WAIT_V(0);
    if constexpr (!ALIGN_EPI) { if (wr == 0) PG8_BAR; }
    PG8_BAR;
    if constexpr (Epi::AFTER_DRAIN) { E.fused(acc, cur, wr, wc, fr, fq, lds, wid, lane); S.done(cur); }
#undef PG8_SA
#undef PG8_SB
#undef PG8_STAGE
#undef PG8_LDA
#undef PG8_LDB
#undef PG8_MMA
#undef PG8_WAIT_V
#undef PG8_WAIT_L
#undef PG8_BAR
#undef PG8_SCHED
}
}
namespace fa {
using bf16 = __hip_bfloat16;
typedef short bf16x8 __attribute__((ext_vector_type(8)));
typedef short s16x4 __attribute__((ext_vector_type(4)));
typedef float f32x16 __attribute__((ext_vector_type(16)));
constexpr int D = 128, NW = 8, QBLK = 32, KVBLK = 64, QB = NW * QBLK;
constexpr int SHM_V = KVBLK * D * 2, SHM_K = KVBLK * D * 2;
constexpr int OFF_WS = 2 * SHM_V + 2 * SHM_K, OFF_CK = OFF_WS + NW * 64 * 4, LDS_BYTES = OFF_CK + 2 * 64 * 4;
constexpr float SCALE = 0.08838834764831845f;
constexpr float THR = 8.f;

#define KSWZ(row, colB) ((row) * 256 + ((colB) ^ (((row) & 7) << 4)))
#define SBAR() __builtin_amdgcn_sched_barrier(0)
__device__ __forceinline__ int v_st(int k, int c) { const int kk = (k & ~0xC) | ((k & 4) << 1) | ((k & 8) >> 1); return ((kk >> 3) * 4 + (c >> 5)) * 512 + ((kk & 7) * 32 + (c & 31)) * 2; }
__device__ __forceinline__ int v_rd_base(int lane) { return ((lane & 3) << 3) | (((lane >> 2) & 3) << 6) | (((lane >> 4) & 1) << 5) | (((lane >> 5) & 1) << 8); }
constexpr int v_rd_off(int d0, int ks, int half) { return d0 * 512 + ks * 4096 + half * 2048; }
__device__ __forceinline__ int crow(int r, int hi) { return (r & 3) + 8 * (r >> 2) + 4 * hi; }
__device__ __forceinline__ unsigned cvtpk(float lo, float hi) { return ::cvtpk2(lo, hi); }
__device__ __forceinline__ bf16x8 load8(const bf16* p) { return *reinterpret_cast<const bf16x8*>(p); }
template <int MODE> __device__ __forceinline__ void mask_tile(f32x16& p0, f32x16& p1, int dq) {
    const float NEG = MODE == 0 ? -__builtin_inff() : 0.f;
#pragma unroll
    for (int r = 0; r < 16; ++r) {
        const int c = (r & 3) + 8 * (r >> 2);
        if (dq - c < 0) p0[r] = NEG;
        if (dq - c - 32 < 0) p1[r] = NEG;
    }
}
__device__ __forceinline__ void partialSM(f32x16& p0, f32x16& p1, float& m_reg, float& mn, float& alpha) {
    float pmax = p0[0]; for (int r = 1; r < 16; ++r) pmax = fmaxf(pmax, p0[r]); for (int r = 0; r < 16; ++r) pmax = fmaxf(pmax, p1[r]);
    { auto rr = __builtin_amdgcn_permlane32_swap(__float_as_uint(pmax), __float_as_uint(pmax), false, false);
      pmax = fmaxf(__uint_as_float(rr[0]), __uint_as_float(rr[1])); }
    constexpr float C2 = 1.4426950408889634f * SCALE;
    if (__builtin_expect(__all((pmax - m_reg) * SCALE <= THR), 1)) { mn = m_reg; alpha = 1.f; }
    else { mn = fmaxf(m_reg, pmax); alpha = __builtin_amdgcn_exp2f((m_reg - mn) * C2); m_reg = mn; }
    const float mnL = -mn * C2;
    for (int r = 0; r < 16; ++r) p0[r] = fmaf(p0[r], C2, mnL); for (int r = 0; r < 16; ++r) p1[r] = fmaf(p1[r], C2, mnL);
    for (int r = 0; r < 16; ++r) p0[r] = __builtin_amdgcn_exp2f(p0[r]);
}
#define PK4(P, B_, OUT) do { unsigned a0 = cvtpk(P[B_+0], P[B_+1]), a1 = cvtpk(P[B_+2], P[B_+3]);                          \
        unsigned b0 = cvtpk(P[B_+4], P[B_+5]), b1 = cvtpk(P[B_+6], P[B_+7]);                                             \
        auto r0 = __builtin_amdgcn_permlane32_swap(a0, b0, false, false); auto r1 = __builtin_amdgcn_permlane32_swap(a1, b1, false, false); \
        u32x4 w = {r0[0], r1[0], r0[1], r1[1]}; OUT = *reinterpret_cast<bf16x8*>(&w); } while (0)
__device__ __forceinline__ void finishSM(f32x16& p0, f32x16& p1, float alpha, float& l_reg, bf16x8& pa0, bf16x8& pa1, bf16x8& pa2, bf16x8& pa3) {
    for (int r = 0; r < 16; ++r) p1[r] = __builtin_amdgcn_exp2f(p1[r]);
    float ps = 0; for (int r = 0; r < 16; ++r) ps += p0[r]; for (int r = 0; r < 16; ++r) ps += p1[r];
    { auto rr = __builtin_amdgcn_permlane32_swap(__float_as_uint(ps), __float_as_uint(ps), false, false);
      ps = __uint_as_float(rr[0]) + __uint_as_float(rr[1]); }
    l_reg = l_reg * alpha + ps;
    PK4(p0, 0, pa0); PK4(p0, 8, pa1); PK4(p1, 0, pa2); PK4(p1, 8, pa3);
}
__device__ __forceinline__ void linScale(f32x16& p0, f32x16& p1, float fr) {
    for (int r = 0; r < 16; ++r) p0[r] *= fr; for (int r = 0; r < 16; ++r) p1[r] *= fr;
}
__device__ __forceinline__ void linFinish(f32x16& p0, f32x16& p1, float& l_reg, bf16x8& pa0, bf16x8& pa1, bf16x8& pa2, bf16x8& pa3) {
    float ps = 0; for (int r = 0; r < 16; ++r) ps += p0[r]; for (int r = 0; r < 16; ++r) ps += p1[r];
    { auto rr = __builtin_amdgcn_permlane32_swap(__float_as_uint(ps), __float_as_uint(ps), false, false);
      ps = __uint_as_float(rr[0]) + __uint_as_float(rr[1]); }
    l_reg += ps;
    PK4(p0, 0, pa0); PK4(p0, 8, pa1); PK4(p1, 0, pa2); PK4(p1, 8, pa3);
}
#undef PK4
template <int KB, int MODE>
__device__ __forceinline__ void qkt(f32x16& p0, f32x16& p1, const char* K_lds, const float* ckl, int r32, int hi, const bf16x8* qr) {
    if constexpr (MODE == 0) {
        const float* c = ckl + KB * 64 + 4 * hi;
#pragma unroll
        for (int g = 0; g < 4; ++g) { const f32x4 a = *(const f32x4*)(c + 8 * g), b = *(const f32x4*)(c + 32 + 8 * g);
            p0[4 * g + 0] = a[0]; p0[4 * g + 1] = a[1]; p0[4 * g + 2] = a[2]; p0[4 * g + 3] = a[3];
            p1[4 * g + 0] = b[0]; p1[4 * g + 1] = b[1]; p1[4 * g + 2] = b[2]; p1[4 * g + 3] = b[3]; }
    } else { p0 = f32x16{}; p1 = f32x16{}; }
    const char* kb[4];
#pragma unroll
    for (int dd = 0; dd < 4; ++dd) kb[dd] = K_lds + KB * SHM_K + KSWZ(r32, (dd * 16 + hi * 8) * 2);
#pragma unroll
    for (int d0 = 0; d0 < 8; ++d0) { const char* a = kb[d0 & 3] + (d0 >> 2) * 128;
        bf16x8 b0 = *reinterpret_cast<const bf16x8*>(a);
        bf16x8 b1 = *reinterpret_cast<const bf16x8*>(a + 32 * 256);
        p0 = __builtin_amdgcn_mfma_f32_32x32x16_bf16(b0, qr[d0], p0, 0, 0, 0);
        p1 = __builtin_amdgcn_mfma_f32_32x32x16_bf16(b1, qr[d0], p1, 0, 0, 0); }
}
template <int VB>
__device__ __forceinline__ void pv_tile(f32x16* o, int vb0, bf16x8 pa0, bf16x8 pa1, bf16x8 pa2, bf16x8 pa3) {
#define TRRD(dst, off) asm volatile("ds_read_b64_tr_b16 %0, %1 offset:%2" : "=&v"(dst) : "v"(vb0), "i"(off) : "memory")
#define PV_D0(d0) do { s16x4 l0, l1, l2, l3, h0, h1, h2, h3; constexpr int b_ = VB * SHM_V + v_rd_off(d0, 0, 0);     \
        TRRD(l0, b_); TRRD(h0, b_ + 2048); TRRD(l1, b_ + 4096); TRRD(h1, b_ + 6144); TRRD(l2, b_ + 8192); TRRD(h2, b_ + 10240); TRRD(l3, b_ + 12288); TRRD(h3, b_ + 14336); \
        asm volatile("s_waitcnt lgkmcnt(0)" ::: "memory"); SBAR();                 \
        o[d0] = __builtin_amdgcn_mfma_f32_32x32x16_bf16(pa0, (bf16x8){l0[0], l0[1], l0[2], l0[3], h0[0], h0[1], h0[2], h0[3]}, o[d0], 0, 0, 0);   \
        o[d0] = __builtin_amdgcn_mfma_f32_32x32x16_bf16(pa1, (bf16x8){l1[0], l1[1], l1[2], l1[3], h1[0], h1[1], h1[2], h1[3]}, o[d0], 0, 0, 0);   \
        o[d0] = __builtin_amdgcn_mfma_f32_32x32x16_bf16(pa2, (bf16x8){l2[0], l2[1], l2[2], l2[3], h2[0], h2[1], h2[2], h2[3]}, o[d0], 0, 0, 0);   \
        o[d0] = __builtin_amdgcn_mfma_f32_32x32x16_bf16(pa3, (bf16x8){l3[0], l3[1], l3[2], l3[3], h3[0], h3[1], h3[2], h3[3]}, o[d0], 0, 0, 0); } while (0)
    PV_D0(0); PV_D0(1); PV_D0(2); PV_D0(3);
#undef PV_D0
#undef TRRD
}

struct BlockRef { const bf16* Q; const bf16* K; const bf16* V; bf16* O; const float* aux; int P0; };
constexpr int AUX_MEXP = 65536, AUX_AREF = 131072;
template <int MODE> struct Pitch { static constexpr int qp = MODE ? 512 : 6144, kp = MODE ? 512 : 6144, vp = 6144, op = MODE ? 1024 : 2048; };
struct Seam { bf16x8 qr[8]; bf16x8 st_v0, st_v1, st_k0, st_k1; float st_c; };
#define ROWK(R, PM, k0, rr) ((R).K + (size_t)(k0) * Pitch<PM>::kp + (unsigned)(((rr) * Pitch<PM>::kp) + sc))
#define ROWV(R, PM, k0, rr) ((R).V + (size_t)(k0) * Pitch<PM>::vp + (unsigned)(((rr) * Pitch<PM>::vp) + sc))
#define VMW() asm volatile("s_waitcnt vmcnt(0)" ::: "memory")
#define VMWN(n) asm volatile("s_waitcnt vmcnt(%0)" :: "i"(n) : "memory")
#define SLOAD_H(R, PM, k0) do { S.st_v0 = load8(ROWV(R, PM, k0, sr)); S.st_v1 = load8(ROWV(R, PM, k0, 32 + sr));              \
                         S.st_k0 = load8(ROWK(R, PM, k0, sr)); S.st_k1 = load8(ROWK(R, PM, k0, 32 + sr));                \
                         if constexpr (PM == 0) S.st_c = (R).aux[(k0) + (tid & 63)]; } while (0)
#define SWRITE_HK(bf) do { *(bf16x8*)(K_lds + (bf) * SHM_K + kws) = S.st_k0; *(bf16x8*)(K_lds + (bf) * SHM_K + kws + 32 * 256) = S.st_k1; \
                           if constexpr (MODE == 0) { if (tid < 64) ckl[(bf) * 64 + tid] = S.st_c; } } while (0)
#define SWRITE_HV(bf) do { *(bf16x8*)(V_lds + (bf) * SHM_V + vst0) = S.st_v0; *(bf16x8*)(V_lds + (bf) * SHM_V + vst1) = S.st_v1; } while (0)
#define SWRITE_H(bf) do { SWRITE_HV(bf); SWRITE_HK(bf); } while (0)
template <int MODE>
__device__ __forceinline__ void attn_prime(const BlockRef& cur, char* lds, Seam& S) {
    const int tid = threadIdx.x, wid = __builtin_amdgcn_readfirstlane(tid >> 6), lane = tid & 63, r32 = lane & 31, hi = lane >> 5;
    const int sr = tid >> 4, sc = (tid & 15) * 8, kws = KSWZ(sr, sc * 2), vst0 = v_st(sr, sc), vst1 = v_st(32 + sr, sc); char* V_lds = lds; char* K_lds = lds + 2 * SHM_V; float* ckl = (float*)(lds + OFF_CK);
#pragma unroll
    for (int d0 = 0; d0 < 8; ++d0) S.qr[d0] = load8(cur.Q + (size_t)(cur.P0 + wid * QBLK) * Pitch<MODE>::qp + (unsigned)(r32 * Pitch<MODE>::qp + d0 * 16 + hi * 8));
    SLOAD_H(cur, MODE, 0); VMW(); SWRITE_H(0);
    __syncthreads();
}
template <int MODE>
__device__ __forceinline__ void attn_block(const BlockRef& cur, const BlockRef& nxt, char* lds, Seam& S) {
    int tid0_ = threadIdx.x; asm volatile("" : "+v"(tid0_));
    const int tid = tid0_, wid = __builtin_amdgcn_readfirstlane(tid >> 6), lane = tid & 63, r32 = lane & 31, hi = lane >> 5;
    const int NT = cur.P0 / KVBLK + 4;
    const int qlo = cur.P0 + wid * QBLK, qm = qlo + r32 - 4 * hi;
    char* V_lds = lds; char* K_lds = lds + 2 * SHM_V;
    float* ws = (float*)(lds + OFF_WS) + wid * 64; float* li_l = ws, * al_l = ws + 32; float* ckl = (float*)(lds + OFF_CK);
    float m_reg = -1e30f, l_reg = 0; f32x16 o[4] = {};
    const int sr = tid >> 4, sc = (tid & 15) * 8, vst0 = v_st(sr, sc), vst1 = v_st(32 + sr, sc), kws = KSWZ(sr, sc * 2);
    const int vb0 = (int)(uintptr_t)V_lds + v_rd_base(lane);
    float m2row = 0.f; if constexpr (MODE == 1) m2row = cur.aux[qlo + r32];
#define RESC(a) do { if constexpr (MODE == 0) { if (__any((a) < 1.f)) { if (hi == 0) al_l[r32] = (a); asm volatile("s_waitcnt lgkmcnt(0)" ::: "memory");              \
                     for (int d_ = 0; d_ < 4; ++d_) for (int r = 0; r < 16; ++r) o[d_][r] *= al_l[crow(r, hi)]; } } } while (0)
#define KBASE(t) ((t) * KVBLK)
    f32x16 p0, p1; float mn, al; bf16x8 pa0, pa1, pa2, pa3;
#define STEP(t, BUF, LASTCHK) do {                                                                                               \
        float ar = 0.f; if constexpr (MODE == 1) ar = cur.aux[AUX_AREF + (t)];                                                    \
        const bool last_ = LASTCHK && ((t) + 1 >= NT);                                                                            \
        if (last_) { SLOAD_H(nxt, MODE, 0); } else { SLOAD_H(cur, MODE, KBASE((t) + 1)); }                                         \
        SBAR(); qkt<BUF, MODE>(p0, p1, K_lds, ckl, r32, hi, S.qr); SBAR();                                                          \
        if (last_) { _Pragma("unroll") for (int d0 = 0; d0 < 8; ++d0) S.qr[d0] = load8(nxt.Q + (size_t)(nxt.P0 + wid * QBLK) * Pitch<MODE>::qp + (unsigned)(r32 * Pitch<MODE>::qp + d0 * 16 + hi * 8)); SBAR(); } \
        { const int kb_ = KBASE(t); if (kb_ + KVBLK - 1 > qlo) mask_tile<MODE>(p0, p1, qm - kb_); }                               \
        if constexpr (MODE == 0) { partialSM(p0, p1, m_reg, mn, al); RESC(al); finishSM(p0, p1, al, l_reg, pa0, pa1, pa2, pa3); }    \
        else { linScale(p0, p1, __builtin_amdgcn_exp2f(ar - m2row)); linFinish(p0, p1, l_reg, pa0, pa1, pa2, pa3); }               \
        SBAR(); pv_tile<BUF>(o, vb0, pa0, pa1, pa2, pa3); SBAR();                                                                 \
        VMW(); SWRITE_H((BUF) ^ 1);                                                                                               \
        __syncthreads(); } while (0)
    for (int t = 0; t < NT; t += 2) { STEP(t, 0, false); STEP(t + 1, 1, true); }
    { float lv = l_reg; if constexpr (MODE == 1) lv = fmaxf(fabsf(l_reg), cur.aux[AUX_MEXP + qlo + r32]);
      if (hi == 0) li_l[r32] = lv; }
    asm volatile("s_waitcnt lgkmcnt(0)" ::: "memory");
    float rli[16];
#pragma unroll
    for (int r = 0; r < 16; ++r) rli[r] = __builtin_amdgcn_rcpf(li_l[crow(r, hi)]);
    bf16* Ow = cur.O + (size_t)(qlo) * Pitch<MODE>::op;
#pragma unroll
    for (int r = 0; r < 16; ++r) { const int orow = crow(r, hi);
#pragma unroll
        for (int d0 = 0; d0 < 4; ++d0) { const float v = o[d0][r] * rli[r];
            const float vn = __shfl_xor(v, 1);
            if ((r32 & 1) == 0) *(unsigned*)(Ow + (unsigned)(orow * Pitch<MODE>::op + d0 * 32 + r32)) = cvtpk(v, vn); } }
    asm volatile("s_waitcnt lgkmcnt(0)" ::: "memory");
#undef RESC
#undef KBASE
#undef STEP
}
#undef ROWK
#undef ROWV
#undef VMW
#undef VMWN
#undef SLOAD_H
#undef SWRITE_HK
#undef SWRITE_HV
#undef SWRITE_H
#undef SBAR
#undef KSWZ
}
#define LAS __attribute__((address_space(3)))
#define GAS __attribute__((address_space(1)))
#define RLX_AGENT __ATOMIC_RELAXED, __HIP_MEMORY_SCOPE_AGENT
#define XB_TMO      128
#define XB_XCNT(j)  (256  + 64 * (j))
#define XB_XSUB(j)  (1280 + 64 * (j))
#define XB_XGEN(j)  (2304 + 64 * (j))
#define XB_TOP      3328
#define XB_TOPGEN   3392
#define XCD_BAR_WORDS 3456
#define XB_SPIN_CAP (1u << 18)

__device__ __forceinline__ unsigned xb_ld(unsigned* p)              { return __hip_atomic_load(p, __ATOMIC_RELAXED, __HIP_MEMORY_SCOPE_AGENT); }
__device__ __forceinline__ unsigned xb_add(unsigned* p, unsigned v) { return __hip_atomic_fetch_add(p, v, __ATOMIC_RELAXED, __HIP_MEMORY_SCOPE_AGENT); }
__device__ __forceinline__ unsigned xb_xcc_id() { return (unsigned)__builtin_amdgcn_s_getreg((3 << 11) | 20) & 0xFu; }
#define XB_SPIN(cond, bar) do { unsigned _sp = 0; while (cond) { __builtin_amdgcn_s_sleep(1); \
    if ((++_sp & 255u) == 0u) { if (xb_ld(&(bar)[XB_TMO])) break; if (_sp > XB_SPIN_CAP) { atomicAdd(&(bar)[XB_TMO], 1u); break; } } } } while (0)

struct XcdBarrier {
    unsigned* bar; unsigned x;
    volatile LAS unsigned* st;
};

__device__ __forceinline__ XcdBarrier xcd_barrier_post(unsigned* bar, volatile LAS unsigned* st) {
    XcdBarrier b; b.bar = bar; b.x = xb_xcc_id(); b.st = st;
    if (threadIdx.x == 0) (void)xb_add(&bar[XB_XCNT(b.x)], 1u);
    return b;
}
__device__ __forceinline__ void xcd_barrier_complete(unsigned* bar, unsigned x, unsigned& nloc, unsigned& nx) {
    const unsigned G = gridDim.x * gridDim.y * gridDim.z;
    unsigned sum, cnt, mine, sp = 0u;
    for (;;) {
        sum = 0u; cnt = 0u; mine = 0u;
#pragma unroll
        for (unsigned j = 0; j < 16; ++j) { const unsigned c = xb_ld(&bar[XB_XCNT(j)]); sum += c; cnt += (c > 0u) ? 1u : 0u; mine = (j == x) ? c : mine; }
        if (sum == G) break;
        __builtin_amdgcn_s_sleep(1);
        if ((++sp & 255u) == 0u) { if (xb_ld(&bar[XB_TMO])) break; if (sp > XB_SPIN_CAP) { atomicAdd(&bar[XB_TMO], 1u); break; } }
    }
    nloc = mine > 0u ? mine : 1u; nx = cnt > 0u ? cnt : 1u;
}

__device__ __forceinline__ void xcd_barrier(const XcdBarrier& b) {
    asm volatile("s_waitcnt vmcnt(0)" ::: "memory");
    __syncthreads();
    if (threadIdx.x == 0) {
        unsigned* bar = b.bar;
        __builtin_amdgcn_s_waitcnt(0);
        unsigned nloc = b.st[0], nx = b.st[1];
        if (nloc == 0u) { xcd_barrier_complete(bar, b.x, nloc, nx); b.st[0] = nloc; b.st[1] = nx; }
        const unsigned old = xb_add(&bar[XB_XSUB(b.x)], 1u);
        const unsigned gen = old / nloc;
        if (old + 1u == (gen + 1u) * nloc) {
            __builtin_amdgcn_fence(__ATOMIC_RELEASE, "agent");
            asm volatile("s_waitcnt vmcnt(0)" ::: "memory");
            const unsigned og = xb_add(&bar[XB_TOP], 1u);
            const unsigned tg = og / nx;
            if (og + 1u == (tg + 1u) * nx) xb_add(&bar[XB_TOPGEN], 1u);
            else XB_SPIN(xb_ld(&bar[XB_TOPGEN]) == tg, bar);
            __builtin_amdgcn_fence(__ATOMIC_ACQUIRE, "agent");
            xb_add(&bar[XB_XGEN(b.x)], 1u);
            asm volatile("s_waitcnt vmcnt(0)" ::: "memory");
        } else {
            XB_SPIN(xb_ld(&bar[XB_XGEN(b.x)]) == gen, bar);
            __builtin_amdgcn_fence(__ATOMIC_ACQUIRE, "agent");
            asm volatile("s_waitcnt vmcnt(0)" ::: "memory");
        }
    }
    __syncthreads();
}
constexpr int NWAVES = 8, NTHREADS = NWAVES * 64;
constexpr int LDS_BYTES = 131072 + 4096;
static_assert(fa::LDS_BYTES <= 131072, "attention scratch fits the ring region");
constexpr size_t MiB = 1u << 20;
constexpr size_t WS_SS = 0;
constexpr size_t WS_BAR = 512 * 1024;
constexpr size_t WS_G = 1 * MiB;
constexpr size_t WS_CK = 2 * MiB;
constexpr size_t WS_A2 = 2 * MiB + 512 * 1024, WS_M2 = WS_A2 + 256 * 1024, WS_MEXP = WS_M2 + 256 * 1024, WS_AREF = WS_MEXP + 256 * 1024;
static_assert((WS_MEXP - WS_M2) / 4 == fa::AUX_MEXP && (WS_AREF - WS_M2) / 4 == fa::AUX_AREF, "aux offsets");
constexpr size_t WS_WIN = 4 * MiB, WS_WO = 29 * MiB, WS_WGU = 37 * MiB, WS_WD = 81 * MiB, WS_WPG = 103 * MiB, WS_WPP = 111 * MiB;
constexpr size_t WS_R1 = 112 * MiB;
constexpr size_t WS_R2 = 304 * MiB;
constexpr size_t WS_R3 = 368 * MiB;
constexpr size_t WS_HB = WS_R3, WS_MQ = WS_R3 + 32 * MiB, WS_MK = WS_R3 + 48 * MiB;
constexpr size_t WS_ERAW = 432 * MiB, WS_END = 496 * MiB;

struct Args {
    const float *x, *p, *w_norm_mix, *w_in, *fox_f_bias, *q_norm_w, *k_norm_w, *conv_w, *conv_b, *mi_bias, *mf_bias, *out_norm_w, *w_out, *w_norm_ffn,
                *w_gate, *w_up, *w_down, *w_norm_ple, *w_ple_gate, *w_ple_proj, *w_ple_post;
    float* out; unsigned char* ws;
};

__device__ __forceinline__ float wave_sum(float v) {
#pragma unroll
    for (int o = 1; o < 64; o <<= 1) v += __shfl_xor(v, o);
    return v;
}
__device__ __forceinline__ int win_src_col(int d) {
    if (d < 3072) return d;
    if (d < 5120) return d + 8;
    if (d < 6144) return d + 16;
    if (d < 6152) return 3072 + (d - 6144);
    if (d < 6160) return 5128 + (d - 6152);
    return -1;
}
struct TItem { const float* src4; const float* kw; bf16_t* dst; int ld, K; };
__device__ __forceinline__ TItem p0_item(const Args& A, int it, int lane) {
    constexpr int I_IN = (DM / 64) * (NIN / 32), I_O = (DM / 64) * (DM / 32), I_GU = (DM / 64) * (2 * DFF / 32), I_D = (DFF / 64) * (DM / 32), I_PG = I_O;
    unsigned char* ws = A.ws; const int n4 = 4 * (lane & 7), kr = lane >> 3; TItem t; int r = it;
    if (r < I_IN) { const int nblk = NIN / 32, kb = r / nblk, nb = r % nblk; const int sc = win_src_col(nb * 32 + n4);
        t.src4 = sc >= 0 ? A.w_in + (size_t)(kb * 64 + kr) * INC + sc : nullptr; t.kw = A.w_norm_mix + kb * 64 + kr; t.ld = INC; t.K = DM; t.dst = (bf16_t*)(ws + WS_WIN) + (size_t)(nb * 32) * DM + kb * 64; return t; } r -= I_IN;
    if (r < I_O) { const int nblk = DM / 32, kb = r / nblk, nb = r % nblk; t.src4 = A.w_out + (size_t)(kb * 64 + kr) * DM + nb * 32 + n4; t.kw = nullptr; t.ld = DM; t.K = DM; t.dst = (bf16_t*)(ws + WS_WO) + (size_t)(nb * 32) * DM + kb * 64; return t; } r -= I_O;
    if (r < I_GU) { const int nblk = 2 * DFF / 32, kb = r / nblk, nb = r % nblk; const int d = nb * 32, pn = d >> 8, j = d & 255;
        t.src4 = ((j < 128) ? A.w_gate + 128 * pn + j : A.w_up + 128 * pn + (j - 128)) + (size_t)(kb * 64 + kr) * DFF + n4; t.kw = A.w_norm_ffn + kb * 64 + kr; t.ld = DFF; t.K = DM; t.dst = (bf16_t*)(ws + WS_WGU) + (size_t)d * DM + kb * 64; return t; } r -= I_GU;
    if (r < I_D) { const int nblk = DM / 32, kb = r / nblk, nb = r % nblk; t.src4 = A.w_down + (size_t)(kb * 64 + kr) * DM + nb * 32 + n4; t.kw = nullptr; t.ld = DM; t.K = DFF; t.dst = (bf16_t*)(ws + WS_WD) + (size_t)(nb * 32) * DFF + kb * 64; return t; } r -= I_D;
    if (r < I_PG) { const int nblk = DM / 32, kb = r / nblk, nb = r % nblk; t.src4 = A.w_ple_gate + (size_t)(kb * 64 + kr) * DM + nb * 32 + n4; t.kw = A.w_norm_ple + kb * 64 + kr; t.ld = DM; t.K = DM; t.dst = (bf16_t*)(ws + WS_WPG) + (size_t)(nb * 32) * DM + kb * 64; return t; } r -= I_PG;
    { const int nblk = DM / 32, kb = r / nblk, nb = r % nblk; t.src4 = A.w_ple_proj + (size_t)(kb * 64 + kr) * DM + nb * 32 + n4; t.kw = nullptr; t.ld = DM; t.K = PLE; t.dst = (bf16_t*)(ws + WS_WPP) + (size_t)(nb * 32) * PLE + kb * 64; return t; }
}
__device__ __forceinline__ void p0_item_load(const TItem& t, f32x4 (&v)[8]) {
#pragma unroll
    for (int i = 0; i < 8; ++i) { v[i] = t.src4 ? *(const f32x4*)(t.src4 + (size_t)(8 * i) * t.ld) : (f32x4){0.f, 0.f, 0.f, 0.f}; if (t.kw) v[i] = v[i] * t.kw[8 * i]; }
}
__device__ __forceinline__ void p0_item_store(const TItem& t, const f32x4 (&v)[8], LAS float* scr, int lane) {
    const int n4 = 4 * (lane & 7), kr = lane >> 3;
#pragma unroll
    for (int i = 0; i < 8; ++i) { LAS float* d = scr + (kr + 8 * i) * 33 + n4; d[0] = v[i].x; d[1] = v[i].y; d[2] = v[i].z; d[3] = v[i].w; }
    asm volatile("s_waitcnt lgkmcnt(0)" ::: "memory");
    const int c = lane & 7;
#pragma unroll
    for (int j = 0; j < 4; ++j) { const int n = (lane >> 3) + 8 * j; const LAS float* s = scr + (8 * c) * 33 + n;
        u32x4 o; o.x = cvtpk2(s[0 * 33], s[1 * 33]); o.y = cvtpk2(s[2 * 33], s[3 * 33]); o.z = cvtpk2(s[4 * 33], s[5 * 33]); o.w = cvtpk2(s[6 * 33], s[7 * 33]);
        *(u32x4*)(t.dst + (size_t)n * t.K + 8 * c) = o; }
    asm volatile("s_waitcnt lgkmcnt(0)" ::: "memory");
}
__device__ __forceinline__ void p0_prologue(const Args& A, LAS unsigned char* lds, int gw, int NGW, int lane, int wave) {
    LAS float* scr = (LAS float*)(lds + wave * 16384);
    unsigned char* ws = A.ws;
    constexpr int NITEMS = (DM / 64) * (NIN / 32) + 2 * (DM / 64) * (DM / 32) + (DM / 64) * (2 * DFF / 32) + (DFF / 64) * (DM / 32) + (PLE / 64) * (DM / 32);
    if (gw < NITEMS) {
        TItem cur = p0_item(A, gw, lane); f32x4 v[8]; p0_item_load(cur, v);
        for (int it = gw; it < NITEMS; it += NGW) {
            const bool more = it + NGW < NITEMS; TItem nx = cur; f32x4 w[8];
            if (more) { nx = p0_item(A, it + NGW, lane); p0_item_load(nx, w); }
            p0_item_store(cur, v, scr, lane);
            if (more) { cur = nx;
#pragma unroll
                for (int i = 0; i < 8; ++i) v[i] = w[i]; }
        }
    }
    bf16_t* XB = (bf16_t*)(ws + WS_R2); float* ss0 = (float*)(ws + WS_SS) + 3 * MROWS;
    {
        f32x4 v[8];
#pragma unroll
        for (int j = 0; j < 8; ++j) v[j] = ((const f32x4*)(A.x + (size_t)gw * DM) + lane)[64 * j];
        for (int m = gw; m < MROWS; m += NGW) {
            f32x4 nv[8]; const bool more = m + NGW < MROWS;
            if (more) {
#pragma unroll
                for (int j = 0; j < 8; ++j) nv[j] = ((const f32x4*)(A.x + (size_t)(m + NGW) * DM) + lane)[64 * j]; }
            float s = 0.f; u32x2* o8 = (u32x2*)(XB + (size_t)m * DM) + lane;
#pragma unroll
            for (int j = 0; j < 8; ++j) { s += (v[j].x * v[j].x + v[j].y * v[j].y) + (v[j].z * v[j].z + v[j].w * v[j].w); u32x2 w; w.x = cvtpk2(v[j].x, v[j].y); w.y = cvtpk2(v[j].z, v[j].w); o8[64 * j] = w; }
            s = wave_sum(s); if (lane == 0) ss0[m] = s;
            if (more) {
#pragma unroll
                for (int j = 0; j < 8; ++j) v[j] = nv[j]; }
        }
    }
    bf16_t* PB = (bf16_t*)(ws + WS_R3);
    for (int m = gw; m < MROWS; m += NGW) { const f32x4 v = ((const f32x4*)(A.p + (size_t)m * PLE))[lane]; u32x2 w; w.x = cvtpk2(v.x, v.y); w.y = cvtpk2(v.z, v.w); ((u32x2*)(PB + (size_t)m * PLE))[lane] = w; }
    float* ss = (float*)(ws + WS_SS);
    for (int i = gw * 64 + lane; i < 3 * MROWS; i += NGW * 64) ss[i] = 0.f;
}
__device__ __forceinline__ float logsigf(float x) { return fminf(x, 0.f) - log1pf(expf(-fabsf(x))); }
__device__ __forceinline__ void scan_sequence(const Args& A, int v, LAS float* red) {
    const int tid = threadIdx.x, lane = tid & 63, wid = tid >> 6;
    const bool fox = v < NB * AH; int b, h;
    if (fox) { b = v / AH; h = v % AH; } else { const int u = v - NB * AH; b = u / MH; h = u % MH; }
    const float* Gp = (const float*)(A.ws + WS_G) + (size_t)(b * SEQ + 8 * tid) * 16;
    const int fcol = fox ? h : 12 + h; const float fb = fox ? A.fox_f_bias[h] : A.mf_bias[h];
    float lf[8]; float run = 0.f;
#pragma unroll
    for (int i = 0; i < 8; ++i) { run += logsigf(Gp[i * 16 + fcol] + fb); lf[i] = run; }
    float incl = run;
#pragma unroll
    for (int o = 1; o < 64; o <<= 1) { const float t = __shfl_up(incl, o); if (lane >= o) incl += t; }
    if (lane == 63) red[wid] = incl;
    __syncthreads();
    float base = incl - run;
    for (int w = 0; w < wid; ++w) base += red[w];
    if (fox) {
        float* CK = (float*)(A.ws + WS_CK) + (size_t)(b * AH + h) * SEQ + 8 * tid;
#pragma unroll
        for (int i = 0; i < 8; ++i) CK[i] = -(base + lf[i]) * 11.313708498984761f;
    } else {
        const float ib = A.mi_bias[h];
        float a[8], lm[8]; float rm = -__builtin_inff();
#pragma unroll
        for (int i = 0; i < 8; ++i) { a[i] = (Gp[i * 16 + 8 + h] + ib) - (base + lf[i]); rm = fmaxf(rm, a[i]); lm[i] = rm; }
        float im = rm;
#pragma unroll
        for (int o = 1; o < 64; o <<= 1) { const float t = __shfl_up(im, o); if (lane >= o) im = fmaxf(im, t); }
        if (lane == 63) red[8 + wid] = im;
        __syncthreads();
        float ex = __shfl_up(im, 1); if (lane == 0) ex = -__builtin_inff();
        for (int w = 0; w < wid; ++w) ex = fmaxf(ex, red[8 + w]);
        const size_t o0 = (size_t)(b * MH + h) * SEQ + 8 * tid;
        float* A2 = (float*)(A.ws + WS_A2) + o0; float* M2 = (float*)(A.ws + WS_M2) + o0; float* ME = (float*)(A.ws + WS_MEXP) + o0;
#pragma unroll
        for (int i = 0; i < 8; ++i) { const float Mt = fmaxf(0.f, fmaxf(ex, lm[i])); A2[i] = a[i] * LOG2E; M2[i] = Mt * LOG2E; ME[i] = expf(-((base + lf[i]) + Mt)); }
        float tm = rm; tm = fmaxf(tm, __shfl_xor(tm, 1)); tm = fmaxf(tm, __shfl_xor(tm, 2)); tm = fmaxf(tm, __shfl_xor(tm, 4));
        if ((lane & 7) == 0) ((float*)(A.ws + WS_AREF))[(b * MH + h) * SEQ + (tid >> 3)] = tm * LOG2E;
    }
}
__device__ __forceinline__ void unpack8(const u32x4 w, float (&f)[8]) { f[0] = bflo(w.x); f[1] = bfhi(w.x); f[2] = bflo(w.y); f[3] = bfhi(w.y); f[4] = bflo(w.z); f[5] = bfhi(w.z); f[6] = bflo(w.w); f[7] = bfhi(w.w); }
__device__ __forceinline__ u32x4 pack8f(const float (&f)[8]) { u32x4 w; w.x = cvtpk2(f[0], f[1]); w.y = cvtpk2(f[2], f[3]); w.z = cvtpk2(f[4], f[5]); w.w = cvtpk2(f[6], f[7]); return w; }
__device__ __forceinline__ void qk_norm_rows(const Args& A, int gw, int NGW, int lane) {
    bf16_t* PROJ = (bf16_t*)(A.ws + WS_R1);
    const int d0 = (8 * lane) & 127;
    float qw[8], kw[8];
#pragma unroll
    for (int i = 0; i < 8; ++i) { qw[i] = A.q_norm_w[d0 + i]; kw[i] = A.k_norm_w[d0 + i]; }
    for (int m = gw; m < MROWS; m += NGW) {
        bf16_t* p = PROJ + (size_t)m * PROJ_LD + 8 * lane;
        u32x4 raw[4];
#pragma unroll
        for (int j = 0; j < 4; ++j) raw[j] = *(const u32x4*)(p + 512 * j);
#pragma unroll
        for (int j = 0; j < 4; ++j) { float f[8]; unpack8(raw[j], f); float s = 0.f;
#pragma unroll
            for (int i = 0; i < 8; ++i) s += f[i] * f[i];
            s += __shfl_xor(s, 1); s += __shfl_xor(s, 2); s += __shfl_xor(s, 4); s += __shfl_xor(s, 8);
            const float rs = 1.f / sqrtf(s * (1.f / 128.f) + EPS);
#pragma unroll
            for (int i = 0; i < 8; ++i) f[i] = f[i] * rs * (j < 2 ? qw[i] : kw[i]);
            *(u32x4*)(p + 512 * j) = pack8f(f); }
    }
}
template <int KPART> __device__ __forceinline__ void mconv_rows(const Args& A, int gw, int NGW, int lane) {
    const bf16_t* PROJ = (const bf16_t*)(A.ws + WS_R1) + (KPART ? PC_MK : PC_MQ) + 8 * lane;
    bf16_t* OUT = (bf16_t*)(A.ws + (KPART ? WS_MK : WS_MQ)) + 8 * lane;
    const int c0 = KPART * 512 + 8 * lane, hh = lane >> 4;
    float w[4][8], bb[8];
#pragma unroll
    for (int j = 0; j < 4; ++j)
#pragma unroll
        for (int i = 0; i < 8; ++i) w[j][i] = A.conv_w[j * 1024 + c0 + i];
#pragma unroll
    for (int i = 0; i < 8; ++i) bb[i] = A.conv_b[c0 + i];
    for (int m = gw; m < MROWS; m += NGW) {
        const int t = m & (SEQ - 1), b = m / SEQ;
        float acc[8];
#pragma unroll
        for (int i = 0; i < 8; ++i) acc[i] = bb[i];
#pragma unroll
        for (int j = 0; j < 4; ++j) { if (t - 3 + j >= 0) { float f[8]; unpack8(*(const u32x4*)(PROJ + (size_t)(m - 3 + j) * PROJ_LD), f);
#pragma unroll
                for (int i = 0; i < 8; ++i) acc[i] = fmaf(w[j][i], f[i], acc[i]); } }
        float sc;
        if (KPART) { const int bh = b * MH + hh; sc = exp2f(((const float*)(A.ws + WS_A2))[(size_t)bh * SEQ + t] - ((const float*)(A.ws + WS_AREF))[bh * SEQ + (t >> 6)]); }
        else sc = 0.08838834764831845f;
#pragma unroll
        for (int i = 0; i < 8; ++i) acc[i] = acc[i] * sigmoidf_(acc[i]) * sc;
        *(u32x4*)(OUT + (size_t)m * 512) = pack8f(acc);
    }
}
__device__ __forceinline__ void mlstm_out_rows(const Args& A, int gw, int NGW, int lane) {
    const bf16_t* HB = (const bf16_t*)(A.ws + WS_HB) + 16 * lane;
    const bf16_t* MO = (const bf16_t*)(A.ws + WS_R1) + PC_MO + 16 * lane;
    bf16_t* MIX = (bf16_t*)(A.ws + WS_R2) + 1024 + 16 * lane;
    float ow[16];
#pragma unroll
    for (int i = 0; i < 16; ++i) ow[i] = A.out_norm_w[16 * lane + i];
    for (int m = gw; m < MROWS; m += NGW) {
        float h[16], g[16];
        { float f[8]; unpack8(*(const u32x4*)(HB + (size_t)m * 1024), f);
#pragma unroll
          for (int i = 0; i < 8; ++i) h[i] = f[i];
          unpack8(*(const u32x4*)(HB + (size_t)m * 1024 + 8), f);
#pragma unroll
          for (int i = 0; i < 8; ++i) h[8 + i] = f[i];
          unpack8(*(const u32x4*)(MO + (size_t)m * PROJ_LD), f);
#pragma unroll
          for (int i = 0; i < 8; ++i) g[i] = f[i];
          unpack8(*(const u32x4*)(MO + (size_t)m * PROJ_LD + 8), f);
#pragma unroll
          for (int i = 0; i < 8; ++i) g[8 + i] = f[i]; }
        float s = 0.f;
#pragma unroll
        for (int i = 0; i < 16; ++i) s += h[i] * h[i];
        s += __shfl_xor(s, 1); s += __shfl_xor(s, 2); s += __shfl_xor(s, 4); s += __shfl_xor(s, 8);
        const float rs = 1.f / sqrtf(s * (1.f / 256.f) + EPS);
        float o[8];
#pragma unroll
        for (int i = 0; i < 8; ++i) o[i] = h[i] * rs * ow[i] * sigmoidf_(g[i]);
        *(u32x4*)(MIX + (size_t)m * DM) = pack8f(o);
#pragma unroll
        for (int i = 0; i < 8; ++i) o[i] = h[8 + i] * rs * ow[8 + i] * sigmoidf_(g[8 + i]);
        *(u32x4*)(MIX + (size_t)m * DM + 8) = pack8f(o);
    }
}
__device__ __forceinline__ fa::BlockRef p3_mblock(const Args& A, int w, int i) {
    const int x = w & 15, g = w >> 4; fa::BlockRef r; const int b = g / MH, h = g % MH; const size_t row0 = (size_t)b * SEQ;
    r.Q = (const fa::bf16*)(A.ws + WS_MQ) + row0 * 512 + h * 128; r.K = (const fa::bf16*)(A.ws + WS_MK) + row0 * 512 + h * 128;
    r.V = (const fa::bf16*)(A.ws + WS_R1) + row0 * PROJ_LD + PC_MV + h * 256 + i * 128; r.O = (fa::bf16*)(A.ws + WS_HB) + row0 * 1024 + h * 256 + i * 128;
    r.aux = (const float*)(A.ws + WS_M2) + (size_t)g * SEQ; r.P0 = x * 256; return r;
}
__device__ __forceinline__ fa::BlockRef p3_fblock(const Args& A, int w, int i) {
    const int x = w & 15, g = w >> 4; fa::BlockRef r; const int bh = 2 * g + i, b = bh / AH, h = bh % AH; const size_t row0 = (size_t)b * SEQ;
    const fa::bf16* PROJ = (const fa::bf16*)(A.ws + WS_R1) + row0 * PROJ_LD + h * 128;
    r.Q = PROJ + PC_AQ; r.K = PROJ + PC_AK; r.V = PROJ + PC_AV; r.O = (fa::bf16*)(A.ws + WS_R2) + row0 * DM + h * 128;
    r.aux = (const float*)(A.ws + WS_CK) + (size_t)bh * SEQ; r.P0 = (15 - x) * 256; return r;
}

#ifndef ONLY
#define ONLY -1
#endif
#ifndef REP0
#define REP0 1
#endif
#ifndef REP1
#define REP1 1
#endif
#ifndef REP3
#define REP3 1
#endif
#ifndef REP6
#define REP6 1
#endif
#ifndef REP2B
#define REP2B 1
#endif
#ifndef REP4
#define REP4 1
#endif
#ifndef XSYNC
#define XSYNC 0
#endif
#ifndef REP5
#define REP5 1
#endif
#ifndef REP2A
#define REP2A 1
#endif
#ifndef SKIPMASK
#define SKIPMASK 0
#endif
#define PH(k) if constexpr (ONLY < 0 ? !((SKIPMASK >> (k)) & 1) : ONLY == (k))
template <class T> __device__ __forceinline__ T* as_global(T* p) { return (T*)(__attribute__((address_space(1))) T*)p; }
__device__ __forceinline__ Args load_args() {
#if defined(__HIP_DEVICE_COMPILE__)
    const __attribute__((address_space(4))) Args* ap = (const __attribute__((address_space(4))) Args*)__builtin_amdgcn_kernarg_segment_ptr();
    asm volatile("" : "+s"(ap));
    Args a = *ap;
#define FX(f) a.f = as_global(a.f)
    FX(x); FX(p); FX(w_norm_mix); FX(w_in); FX(fox_f_bias); FX(q_norm_w); FX(k_norm_w); FX(conv_w); FX(conv_b); FX(mi_bias); FX(mf_bias); FX(out_norm_w); FX(w_out); FX(w_norm_ffn);
    FX(w_gate); FX(w_up); FX(w_down); FX(w_norm_ple); FX(w_ple_gate); FX(w_ple_proj); FX(w_ple_post); FX(out); FX(ws);
#undef FX
    return a;
#else
    return Args{};
#endif
}
#define ARGS() load_args()
__global__ void __launch_bounds__(NTHREADS, 2) fwd_megakernel(Args Aunused) {
    extern __shared__ __attribute__((aligned(16))) unsigned char lds[];
    cg::grid_group grid = cg::this_grid();
    LAS unsigned char* ldsl = (LAS unsigned char*)lds;
    const int G = gridDim.x, bx = blockIdx.x, NGW = G * NWAVES;
#define LANEVARS() int tid_ = threadIdx.x; asm volatile("" : "+v"(tid_)); const int lane = tid_ & 63, wave = __builtin_amdgcn_readfirstlane(tid_ >> 6), gw = bx * NWAVES + wave; (void)lane; (void)gw

    if (threadIdx.x < 16) ((volatile LAS unsigned*)(ldsl + 131072))[threadIdx.x] = 0u;
    { unsigned* bw = (unsigned*)(ARGS().ws + WS_BAR); if (bx == 0) for (int i = threadIdx.x; i < XCD_BAR_WORDS; i += NTHREADS) bw[i] = 0u; }
    __syncthreads();
    PH(0) for (int rep = 0; rep < REP0; ++rep) { const Args A = ARGS(); LANEVARS(); p0_prologue(A, ldsl, gw, NGW, lane, wave); }
    grid.sync();
    XcdBarrier xbar = xcd_barrier_post((unsigned*)(ARGS().ws + WS_BAR), (volatile LAS unsigned*)(ldsl + 131072));
#define GRID_BAR() xcd_barrier(xbar)
    for (int rep = 0; rep < XSYNC; ++rep) GRID_BAR();
    PH(1) for (int rep = 0; rep < REP1; ++rep) { const Args A = ARGS(); unsigned char* ws = A.ws;
        pg8::Gemm g{(const bf16_t*)(ws + WS_R2), (const bf16_t*)(ws + WS_WIN), MROWS, NIN, DM}; pg8::StaticOrder S; S.init(MROWS, NIN, G, bx);
        pg8::EpiProj E{(bf16_t*)(ws + WS_R1), (float*)(ws + WS_G), (const float*)(ws + WS_SS) + 3 * MROWS};
        pg8::gemm_phase<pg8::EpiProj, pg8::StaticOrder, true, true>(ldsl, g, S, E);
    }
    PH(10) { const Args A = ARGS(); unsigned char* ws = A.ws; float* SS = (float*)(ws + WS_SS);
        pg8::Gemm g{(const bf16_t*)(ws + WS_R3), (const bf16_t*)(ws + WS_WPP), MROWS, DM, PLE}; pg8::StaticOrder S; S.init(MROWS, DM, G, bx);
        pg8::EpiE E{(bf16_t*)(ws + WS_ERAW), SS};
        pg8::gemm_phase<pg8::EpiE, pg8::StaticOrder, true, true>(ldsl, g, S, E);
    }
    GRID_BAR();
    PH(2) for (int rep = 0; rep < REP2A; ++rep) { const Args A = ARGS(); for (int v = bx; v < NB * AH + NB * MH; v += G) { scan_sequence(A, v, (LAS float*)ldsl); __syncthreads(); } }
    PH(2) { const Args A = ARGS(); LANEVARS(); qk_norm_rows(A, gw, NGW, lane); }
    PH(2) for (int rep = 0; rep < REP2A; ++rep) { const Args A = ARGS(); LANEVARS(); mconv_rows<0>(A, gw, NGW, lane); }
    GRID_BAR();
    PH(2) for (int rep = 0; rep < REP2B; ++rep) { const Args A = ARGS(); LANEVARS(); mconv_rows<1>(A, gw, NGW, lane); }
    GRID_BAR();
    PH(3) for (int rep = 0; rep < REP3; ++rep) for (int w = bx; w < 256; w += G) { const Args A = ARGS();
        fa::Seam S;
#ifndef NO_M1
        { fa::BlockRef c = p3_mblock(A, w, 0); fa::attn_prime<1>(c, (char*)lds, S);
#pragma nounroll
          for (int i = 0; i < 2; ++i) { const fa::BlockRef n = p3_mblock(A, w, 1); fa::attn_block<1>(c, n, (char*)lds, S); c = n; } }
        asm volatile("s_waitcnt vmcnt(0)" ::: "memory"); __syncthreads();
#endif
#ifndef NO_M0
        { fa::BlockRef c = p3_fblock(A, w, 0); fa::attn_prime<0>(c, (char*)lds, S);
#pragma nounroll
          for (int i = 0; i < 2; ++i) { const fa::BlockRef n = p3_fblock(A, w, 1); fa::attn_block<0>(c, n, (char*)lds, S); c = n; } }
#endif
        asm volatile("s_waitcnt vmcnt(0)" ::: "memory");
        __syncthreads();
    }
    GRID_BAR();
    PH(4) for (int rep = 0; rep < REP4; ++rep) { const Args A = ARGS(); LANEVARS(); mlstm_out_rows(A, gw, NGW, lane); }
    GRID_BAR();
    PH(5) for (int rep = 0; rep < REP5; ++rep) { const Args A = ARGS(); unsigned char* ws = A.ws; float* SS = (float*)(ws + WS_SS);
        pg8::Gemm g{(const bf16_t*)(ws + WS_R2), (const bf16_t*)(ws + WS_WO), MROWS, DM, DM}; pg8::StaticOrder S; S.init(MROWS, DM, G, bx);
        pg8::EpiRes<false> E{A.x, (bf16_t*)(ws + WS_R3), SS + MROWS, rep == 0};
        pg8::gemm_phase<pg8::EpiRes<false>, pg8::StaticOrder, true, true>(ldsl, g, S, E);
    }
    GRID_BAR();
    PH(6) for (int rep = 0; rep < REP6; ++rep) { const Args A = ARGS(); unsigned char* ws = A.ws; float* SS = (float*)(ws + WS_SS);
        pg8::Gemm g{(const bf16_t*)(ws + WS_R3), (const bf16_t*)(ws + WS_WGU), MROWS, 2 * DFF, DM}; pg8::StaticOrder S; S.init(MROWS, 2 * DFF, G, bx);
        pg8::EpiSwiGLU E{(bf16_t*)(ws + WS_R1), SS + MROWS};
        pg8::gemm_phase<pg8::EpiSwiGLU, pg8::StaticOrder, true, true>(ldsl, g, S, E);
    }
    GRID_BAR();
    PH(7) { const Args A = ARGS(); unsigned char* ws = A.ws; float* SS = (float*)(ws + WS_SS);
        pg8::Gemm g{(const bf16_t*)(ws + WS_R1), (const bf16_t*)(ws + WS_WD), MROWS, DM, DFF}; pg8::StaticOrder S; S.init(MROWS, DM, G, bx);
        pg8::EpiRes<true> E{(const void*)(ws + WS_R3), (bf16_t*)(ws + WS_R2), SS + 2 * MROWS, 1};
        pg8::gemm_phase<pg8::EpiRes<true>, pg8::StaticOrder, true, true>(ldsl, g, S, E);
    }
    GRID_BAR();
    PH(8) { const Args A = ARGS(); unsigned char* ws = A.ws; float* SS = (float*)(ws + WS_SS);
        pg8::Gemm g{(const bf16_t*)(ws + WS_R2), (const bf16_t*)(ws + WS_WPG), MROWS, DM, DM}; pg8::StaticOrder S; S.init(MROWS, DM, G, bx);
        pg8::EpiFinal E{A.out, (const bf16_t*)(ws + WS_R2), (const bf16_t*)(ws + WS_ERAW), A.w_ple_post, SS + 2 * MROWS, SS};
        pg8::gemm_phase<pg8::EpiFinal, pg8::StaticOrder, true, true>(ldsl, g, S, E);
    }
}

extern "C" void kernel_launch(void* const* d_in, const int* in_sizes, int n_in, void* d_out, int out_size, void* d_ws, size_t ws_size, hipStream_t stream) {
    static int grid = 0;
    if (grid == 0) {
        if (n_in != 21 || in_sizes[0] != MROWS * DM || out_size != MROWS * DM || ws_size < WS_END) {
            fprintf(stderr, "kernel_launch: unexpected shapes (n_in %d, in0 %d, out %d, ws %zu; need ws >= %zu)\n", n_in, n_in > 0 ? in_sizes[0] : -1, out_size, ws_size, (size_t)WS_END); grid = -1; return; }
        int dev = 0, cus = 0, per_cu = 0;
        (void)hipGetDevice(&dev); (void)hipDeviceGetAttribute(&cus, hipDeviceAttributeMultiprocessorCount, dev);
        if (hipFuncSetAttribute((const void*)fwd_megakernel, hipFuncAttributeMaxDynamicSharedMemorySize, LDS_BYTES) != hipSuccess) { fprintf(stderr, "kernel_launch: hipFuncSetAttribute failed\n"); grid = -1; return; }
        if (hipOccupancyMaxActiveBlocksPerMultiprocessor(&per_cu, (const void*)fwd_megakernel, NTHREADS, LDS_BYTES) != hipSuccess || per_cu < 1) { fprintf(stderr, "kernel_launch: occupancy query says %d blocks per CU\n", per_cu); per_cu = 1; }
        (void)hipGetLastError();
        if (per_cu > 1) per_cu = 1;
        grid = cus * per_cu;
    }
    if (grid < 0) return;
    Args a{};
    a.x = (const float*)d_in[0]; a.p = (const float*)d_in[1]; a.w_norm_mix = (const float*)d_in[2]; a.w_in = (const float*)d_in[3]; a.fox_f_bias = (const float*)d_in[4];
    a.q_norm_w = (const float*)d_in[5]; a.k_norm_w = (const float*)d_in[6]; a.conv_w = (const float*)d_in[7]; a.conv_b = (const float*)d_in[8]; a.mi_bias = (const float*)d_in[9];
    a.mf_bias = (const float*)d_in[10]; a.out_norm_w = (const float*)d_in[11]; a.w_out = (const float*)d_in[12]; a.w_norm_ffn = (const float*)d_in[13]; a.w_gate = (const float*)d_in[14];
    a.w_up = (const float*)d_in[15]; a.w_down = (const float*)d_in[16]; a.w_norm_ple = (const float*)d_in[17]; a.w_ple_gate = (const float*)d_in[18]; a.w_ple_proj = (const float*)d_in[19];
    a.w_ple_post = (const float*)d_in[20];
    a.out = (float*)d_out; a.ws = (unsigned char*)d_ws;
    void* args[] = {&a};
    hipError_t e = hipLaunchCooperativeKernel((const void*)fwd_megakernel, dim3(grid), dim3(NTHREADS), args, LDS_BYTES, stream);
    if (e != hipSuccess) fprintf(stderr, "kernel_launch: cooperative launch failed: %s (grid %d)\n", hipGetErrorString(e), grid);
}
```

```cpp
#include <hip/hip_runtime.h>
#include <hip/hip_cooperative_groups.h>
#include <hip/hip_bf16.h>
#include <cstdio>
#include <cstdint>
namespace cg = cooperative_groups;

constexpr int NB = 4, SEQ = 4096, DM = 2048, MROWS = NB * SEQ;
constexpr int PLE = 256, AH = 8, MH = 4, DFF = 5632, INC = 6160;
constexpr int PROJ_LD = 6144, NIN = 6400;
constexpr int PC_AQ = 0, PC_AK = 1024, PC_AV = 2048, PC_MQ = 3072, PC_MK = 3584, PC_MV = 4096, PC_MO = 5120;
constexpr float EPS = 1e-6f;
constexpr float LOG2E = 1.4426950408889634f;

typedef unsigned short bf16_t;
typedef float f32x4 __attribute__((ext_vector_type(4)));
typedef float f32x2 __attribute__((ext_vector_type(2)));
typedef unsigned u32x4 __attribute__((ext_vector_type(4)));
typedef unsigned u32x2 __attribute__((ext_vector_type(2)));
typedef __bf16 bf16x2_t __attribute__((ext_vector_type(2)));
__device__ __forceinline__ unsigned cvtpk2(float lo, float hi) { f32x2 v = {lo, hi}; bf16x2_t b = __builtin_convertvector(v, bf16x2_t); return __builtin_bit_cast(unsigned, b); }
__device__ __forceinline__ float bflo(unsigned w) { return __uint_as_float(w << 16); }
__device__ __forceinline__ float bfhi(unsigned w) { return __uint_as_float(w & 0xffff0000u); }
__device__ __forceinline__ float sigmoidf_(float x) { return __builtin_amdgcn_rcpf(1.f + __expf(-x)); }
namespace pg8 {
#define PG8_LAS __attribute__((address_space(3)))
typedef unsigned short bf16_t;
typedef short bf16x8 __attribute__((ext_vector_type(8)));
typedef float f32x4 __attribute__((ext_vector_type(4)));
typedef unsigned u32x4 __attribute__((ext_vector_type(4)));
constexpr int BM = 256, BK = 64, HALF = 128, HTB = HALF * BK * 2  , STAGE_BYTES = 8 * HTB, NXCD = 8, WGM = 8;

__host__ __device__ __forceinline__ int lds_byte(int r, int c) { const int st = (r >> 4) * 2 + (c >> 5), rr = r & 15, cc = c & 31, ob = rr * 64 + cc * 2; return st * 1024 + (ob ^ (((ob >> 9) & 1) << 5)); }
__host__ __device__ __forceinline__ void stage_rc(int b, int& R, int& C) { const int st = b / 1024, sb = b % 1024, swz = sb ^ (((sb >> 9) & 1) << 5); R = (st >> 1) * 16 + swz / 64; C = (st & 1) * 32 + (swz % 64) / 2; }
__host__ __device__ __forceinline__ int perm32(int rho) { const int n = rho >> 4, i = rho & 15; return 8 * (i >> 2) + 4 * n + (i & 3); }

struct Unit { int pm, pn; };
struct Gemm { const bf16_t* A; const bf16_t* Bt; int M, N, K; };

struct StaticOrder {
    int nM, nN, nwg, G, c;
    __host__ __device__ void init(int M, int N, int G_, int c_) { nM = M / BM; nN = N / BM; nwg = nM * nN; G = G_; c = c_; }
    __host__ __device__ bool next(int i, Unit& u) const {
        const long L = (long)i * G + c; if (L >= nwg) return false;
        int wgid = (int)L; { const int q = nwg / NXCD, r = nwg % NXCD, xcd = wgid % NXCD, off = wgid / NXCD; wgid = (xcd < r ? xcd * (q + 1) : r * (q + 1) + (xcd - r) * q) + off; }
        const int nig = WGM * nN, gid = wgid / nig, fm = gid * WGM, gsz = (nM - fm) < WGM ? (nM - fm) : WGM;
        u.pm = fm + ((wgid % nig) % gsz); u.pn = (wgid % nig) / gsz; return true;
    }
    __device__ __forceinline__ void a_ready(const Unit&) const {}
    __device__ __forceinline__ void done(const Unit&) const {}
};
__device__ __forceinline__ unsigned cvt_pk_bf16(float lo, float hi) { return ::cvtpk2(lo, hi); }
__device__ __forceinline__ float sumsq4(f32x4 v) { return (v[0] * v[0] + v[1] * v[1]) + (v[2] * v[2] + v[3] * v[3]); }
__device__ __forceinline__ void atomic_add_f32(float* p, float v) { __hip_atomic_fetch_add(p, v, __ATOMIC_RELAXED, __HIP_MEMORY_SCOPE_AGENT); }

__device__ __forceinline__ void zero_acc(f32x4 (&acc)[2][2][4][2]) {
#pragma unroll
    for (int a = 0; a < 2; ++a)
#pragma unroll
        for (int b = 0; b < 2; ++b)
#pragma unroll
            for (int m = 0; m < 4; ++m)
#pragma unroll
                for (int n = 0; n < 2; ++n) acc[a][b][m][n] = (f32x4){0.f, 0.f, 0.f, 0.f};
}
#define PG8_ZERO_INIT __device__ __forceinline__ void init(f32x4 (&acc)[2][2][4][2], const Unit&, int, int, int, int) const { zero_acc(acc); }

struct EpiProj {
    static constexpr bool PERM = true, AFTER_DRAIN = false;
    PG8_ZERO_INIT
    bf16_t* O; const float* ss0;
    __device__ __forceinline__ void operator()(const f32x4 (&acc)[2][2][4][2], const Unit& u, int wr, int wc, int fr, int fq) const {
        const int row0 = u.pm * BM + wr * 64 + fr, col0 = u.pn * BM + wc * 32 + 8 * fq;
#pragma unroll
        for (int ai = 0; ai < 2; ++ai)
#pragma unroll
            for (int m = 0; m < 4; ++m) { const int row = row0 + ai * HALF + m * 16; const float rs = __builtin_amdgcn_rsqf(ss0[row] * (1.f / 2048.f) + 1e-6f); bf16_t* rowp = O + (size_t)row * 6144 + col0;
#pragma unroll
                for (int bj = 0; bj < 2; ++bj) { const f32x4 v0 = acc[ai][bj][m][0] * rs, v1 = acc[ai][bj][m][1] * rs;
                    u32x4 w; w.x = cvt_pk_bf16(v0[0], v0[1]); w.y = cvt_pk_bf16(v0[2], v0[3]); w.z = cvt_pk_bf16(v1[0], v1[1]); w.w = cvt_pk_bf16(v1[2], v1[3]);
                    *(u32x4*)(rowp + bj * HALF) = w; } }
    }
};
struct EpiE {
    static constexpr bool PERM = true, AFTER_DRAIN = false;
    PG8_ZERO_INIT
    bf16_t* O; float* ss;
    __device__ __forceinline__ void operator()(const f32x4 (&acc)[2][2][4][2], const Unit& u, int wr, int wc, int fr, int fq) const {
        const int row0 = u.pm * BM + wr * 64 + fr, col0 = u.pn * BM + wc * 32 + 8 * fq;
#pragma unroll
        for (int ai = 0; ai < 2; ++ai)
#pragma unroll
            for (int m = 0; m < 4; ++m) { const int row = row0 + ai * HALF + m * 16; bf16_t* rowp = O + (size_t)row * 2048 + col0; float s = 0.f;
#pragma unroll
                for (int bj = 0; bj < 2; ++bj) { const f32x4 v0 = acc[ai][bj][m][0], v1 = acc[ai][bj][m][1]; s += sumsq4(v0) + sumsq4(v1);
                    u32x4 w; w.x = cvt_pk_bf16(v0[0], v0[1]); w.y = cvt_pk_bf16(v0[2], v0[3]); w.z = cvt_pk_bf16(v1[0], v1[1]); w.w = cvt_pk_bf16(v1[2], v1[3]);
                    *(u32x4*)(rowp + bj * HALF) = w; }
                s += __shfl_xor(s, 16); s += __shfl_xor(s, 32);
                if (fq == 0) atomic_add_f32(ss + row, s); }
    }
};
template <bool XINB> struct EpiRes {
    static constexpr bool PERM = true, AFTER_DRAIN = false;
    const void* xin; bf16_t* xout; float* ss; int live;
    __device__ __forceinline__ void init(f32x4 (&acc)[2][2][4][2], const Unit& u, int wr, int wc, int fr, int fq) const {
        const int row0 = u.pm * BM + wr * 64 + fr, col0 = u.pn * BM + wc * 32 + 8 * fq;
#pragma unroll
        for (int ai = 0; ai < 2; ++ai)
#pragma unroll
            for (int m = 0; m < 4; ++m) { const size_t off = (size_t)(row0 + ai * HALF + m * 16) * 2048 + col0;
#pragma unroll
                for (int bj = 0; bj < 2; ++bj) {
                    if constexpr (XINB) { const u32x4 w = *(const u32x4*)((const bf16_t*)xin + off + bj * HALF);
                        acc[ai][bj][m][0] = (f32x4){::bflo(w.x), ::bfhi(w.x), ::bflo(w.y), ::bfhi(w.y)}; acc[ai][bj][m][1] = (f32x4){::bflo(w.z), ::bfhi(w.z), ::bflo(w.w), ::bfhi(w.w)}; }
                    else { const float* rp = (const float*)xin + off + bj * HALF; acc[ai][bj][m][0] = *(const f32x4*)rp; acc[ai][bj][m][1] = *(const f32x4*)(rp + 4); } } }
    }
    __device__ __forceinline__ void operator()(const f32x4 (&acc)[2][2][4][2], const Unit& u, int wr, int wc, int fr, int fq) const {
        if (!live) {
#pragma unroll
            for (int ai = 0; ai < 2; ++ai)
#pragma unroll
                for (int m = 0; m < 4; ++m)
#pragma unroll
                    for (int bj = 0; bj < 2; ++bj)
#pragma unroll
                        for (int n = 0; n < 2; ++n) asm volatile("" :: "v"(acc[ai][bj][m][n]));
            return; }
        const int row0 = u.pm * BM + wr * 64 + fr, col0 = u.pn * BM + wc * 32 + 8 * fq;
#pragma unroll
        for (int ai = 0; ai < 2; ++ai)
#pragma unroll
            for (int m = 0; m < 4; ++m) { const int row = row0 + ai * HALF + m * 16; bf16_t* rowp = xout + (size_t)row * 2048 + col0; float s = 0.f;
#pragma unroll
                for (int bj = 0; bj < 2; ++bj) { const f32x4 v0 = acc[ai][bj][m][0], v1 = acc[ai][bj][m][1]; s += sumsq4(v0) + sumsq4(v1);
                    u32x4 w; w.x = cvt_pk_bf16(v0[0], v0[1]); w.y = cvt_pk_bf16(v0[2], v0[3]); w.z = cvt_pk_bf16(v1[0], v1[1]); w.w = cvt_pk_bf16(v1[2], v1[3]);
                    *(u32x4*)(rowp + bj * HALF) = w; }
                s += __shfl_xor(s, 16); s += __shfl_xor(s, 32);
                if (fq == 0) atomic_add_f32(ss + row, s); }
    }
};
struct EpiSwiGLU {
    static constexpr bool PERM = true, AFTER_DRAIN = false;
    PG8_ZERO_INIT
    bf16_t* O; const float* ss;
    __device__ __forceinline__ void operator()(const f32x4 (&acc)[2][2][4][2], const Unit& u, int wr, int wc, int fr, int fq) const {
        const int row0 = u.pm * BM + wr * 64 + fr, col0 = u.pn * HALF + wc * 32 + 8 * fq;
#pragma unroll
        for (int ai = 0; ai < 2; ++ai)
#pragma unroll
            for (int m = 0; m < 4; ++m) { const int row = row0 + ai * HALF + m * 16; const float rs = __builtin_amdgcn_rsqf(ss[row] * (1.f / 2048.f) + 1e-6f);
                float r[8];
#pragma unroll
                for (int n = 0; n < 2; ++n)
#pragma unroll
                    for (int e = 0; e < 4; ++e) { const float g = acc[ai][0][m][n][e] * rs, up = acc[ai][1][m][n][e] * rs; r[n * 4 + e] = g * __builtin_amdgcn_rcpf(1.f + __expf(-g)) * up; }
                u32x4 w; w.x = cvt_pk_bf16(r[0], r[1]); w.y = cvt_pk_bf16(r[2], r[3]); w.z = cvt_pk_bf16(r[4], r[5]); w.w = cvt_pk_bf16(r[6], r[7]);
                *(u32x4*)(O + (size_t)row * 5632 + col0) = w; }
    }
};
struct EpiFinal {
    static constexpr bool PERM = true, AFTER_DRAIN = false;
    PG8_ZERO_INIT
    float* out; const bf16_t* x2; const bf16_t* eraw; const float* wpost; const float* ss2; const float* ssE;
    __device__ __forceinline__ void operator()(const f32x4 (&acc)[2][2][4][2], const Unit& u, int wr, int wc, int fr, int fq) const {
        const int row0 = u.pm * BM + wr * 64 + fr, col0 = u.pn * BM + wc * 32 + 8 * fq;
        f32x4 wv[2][2];
#pragma unroll
        for (int bj = 0; bj < 2; ++bj)
#pragma unroll
            for (int n = 0; n < 2; ++n) wv[bj][n] = *(const f32x4*)(wpost + col0 + bj * HALF + n * 4);
#pragma unroll
        for (int ai = 0; ai < 2; ++ai)
#pragma unroll
            for (int m = 0; m < 4; ++m) { const int row = row0 + ai * HALF + m * 16; const size_t off = (size_t)row * 2048 + col0;
                const float rs = __builtin_amdgcn_rsqf(ss2[row] * (1.f / 2048.f) + 1e-6f), re = __builtin_amdgcn_rsqf(ssE[row] * (1.f / 2048.f) + 1e-6f);
#pragma unroll
                for (int bj = 0; bj < 2; ++bj) { const size_t o2 = off + bj * HALF; const u32x4 xw = *(const u32x4*)(x2 + o2), ew = *(const u32x4*)(eraw + o2);
                    const f32x4 xa = {::bflo(xw.x), ::bfhi(xw.x), ::bflo(xw.y), ::bfhi(xw.y)}, xb = {::bflo(xw.z), ::bfhi(xw.z), ::bflo(xw.w), ::bfhi(xw.w)};
                    f32x4 ea = {::bflo(ew.x), ::bfhi(ew.x), ::bflo(ew.y), ::bfhi(ew.y)}, eb = {::bflo(ew.z), ::bfhi(ew.z), ::bflo(ew.w), ::bfhi(ew.w)};
                    ea = ea * re * wv[bj][0]; eb = eb * re * wv[bj][1];
                    const f32x4 a0 = acc[ai][bj][m][0] * rs, a1 = acc[ai][bj][m][1] * rs; f32x4 o0, o1;
#pragma unroll
                    for (int e = 0; e < 4; ++e) { o0[e] = xa[e] + ::sigmoidf_(a0[e]) * ea[e]; o1[e] = xb[e] + ::sigmoidf_(a1[e]) * eb[e]; }
                    *(f32x4*)(out + o2) = o0; *(f32x4*)(out + o2 + 4) = o1; } }
    }
};
template <class Epi, class Sched, bool ALIGN_EPI = false, bool SP2 = false>
__device__ __forceinline__ void gemm_phase(PG8_LAS unsigned char* lds, const Gemm g, const Sched& S, const Epi& E) {
    int tid0_ = threadIdx.x; asm volatile("" : "+v"(tid0_));
    const int tid = tid0_, wid = __builtin_amdgcn_readfirstlane(tid >> 6), lane = tid & 63, wr = wid >> 2, wc = wid & 3, fr = lane & 15, fq = lane >> 4;
    int K0_ = g.K; asm volatile("" : "+s"(K0_));
    const int K = K0_, nt = K / BK;
    unsigned voffA[2], voffB[2];
#pragma unroll
    for (int i = 0; i < 2; ++i) { int R, C; stage_rc(tid * 16 + i * 8192, R, C); const int Rb = Epi::PERM ? ((R & ~31) + perm32(R & 31)) : R;
        voffA[i] = (unsigned)(R * K + C) * 2u; voffB[i] = (unsigned)(Rb * K + C) * 2u; }
    const size_t kstep = (size_t)(BK * 2);
    const size_t hstep = (size_t)HALF * K * 2;
    const size_t tstep = 2 * hstep;
    const unsigned ldsw = (unsigned)wid * 1024u;
    const int aoff = lds_byte(wr * 64 + fr, fq * 8), boff = lds_byte(wc * 32 + fr, fq * 8);
#define PG8_SA(b, h) (((b) * 2 + (h)) * HTB)
#define PG8_SB(b, h) ((4 + (b) * 2 + (h)) * HTB)
#define PG8_STAGE(bufoff, gbase, voff) do { _Pragma("unroll") for (int _i = 0; _i < 2; ++_i) \
        __builtin_amdgcn_global_load_lds((const unsigned*)((const char*)(gbase) + (voff)[_i]), (PG8_LAS unsigned*)(lds + (bufoff) + ldsw + _i * 8192), 16, 0, 0); } while (0)
#define PG8_LDA(dst, b, h) do { _Pragma("unroll") for (int m = 0; m < 4; ++m) _Pragma("unroll") for (int k = 0; k < 2; ++k) dst[m][k] = *(const PG8_LAS bf16x8*)(lds + PG8_SA(b, h) + aoff + m * 2048 + k * 1024); } while (0)
#define PG8_LDB(dst, b, h) do { _Pragma("unroll") for (int n = 0; n < 2; ++n) _Pragma("unroll") for (int k = 0; k < 2; ++k) dst[n][k] = *(const PG8_LAS bf16x8*)(lds + PG8_SB(b, h) + boff + n * 2048 + k * 1024); } while (0)
#define PG8_MMA(ai, bj, At, Bt) do { __builtin_amdgcn_s_setprio(1); _Pragma("unroll") for (int m = 0; m < 4; ++m) _Pragma("unroll") for (int n = 0; n < 2; ++n) _Pragma("unroll") for (int k = 0; k < 2; ++k) \
        acc[ai][bj][m][n] = __builtin_amdgcn_mfma_f32_16x16x32_bf16(Bt[n][k], At[m][k], acc[ai][bj][m][n], 0, 0, 0); __builtin_amdgcn_s_setprio(0); } while (0)
#define PG8_WAIT_V(n) asm volatile("s_waitcnt vmcnt(" #n ")" ::: "memory")
#define PG8_WAIT_L(n) asm volatile("s_waitcnt lgkmcnt(" #n ")" ::: "memory")
#define PG8_BAR __builtin_amdgcn_s_barrier()
#define PG8_SCHED __builtin_amdgcn_sched_barrier(0)
    Unit cur, nxt; int ui = 0;
    if (!S.next(0, cur)) return;
    f32x4 acc[2][2][4][2];
    E.init(acc, cur, wr, wc, fr, fq);
    bf16x8 At[4][2], B0[2][2], B1[2][2];
    const char* cA = (const char*)g.A + (size_t)cur.pm * tstep; const char* cB = (const char*)g.Bt + (size_t)cur.pn * tstep;
    S.a_ready(cur);
    if constexpr (SP2) {
        PG8_STAGE(PG8_SB(0, 0), cB, voffB); PG8_STAGE(PG8_SB(0, 1), cB + hstep, voffB); PG8_STAGE(PG8_SA(0, 0), cA, voffA); PG8_STAGE(PG8_SA(0, 1), cA + hstep, voffA);
        if (wr == 1) PG8_BAR;
        PG8_WAIT_V(2); PG8_BAR;
        PG8_STAGE(PG8_SB(1, 0), cB + kstep, voffB); PG8_STAGE(PG8_SA(1, 0), cA + kstep, voffA); PG8_STAGE(PG8_SB(1, 1), cB + hstep + kstep, voffB);
        PG8_WAIT_V(6); PG8_BAR;
    } else {
        PG8_STAGE(PG8_SB(0, 0), cB, voffB); PG8_STAGE(PG8_SA(0, 0), cA, voffA); PG8_STAGE(PG8_SB(0, 1), cB + hstep, voffB); PG8_STAGE(PG8_SA(0, 1), cA + hstep, voffA);
        if (wr == 1) PG8_BAR;
        PG8_WAIT_V(4); PG8_BAR;
        PG8_STAGE(PG8_SB(1, 0), cB + kstep, voffB); PG8_STAGE(PG8_SA(1, 0), cA + kstep, voffA); PG8_STAGE(PG8_SB(1, 1), cB + hstep + kstep, voffB);
        PG8_WAIT_V(6); PG8_BAR;
    }
    for (;;) {
        const bool has_next = S.next(ui + 1, nxt);
        const char* nA = has_next ? (const char*)g.A + (size_t)nxt.pm * tstep : cA; const char* nB = has_next ? (const char*)g.Bt + (size_t)nxt.pn * tstep : cB;
        for (int t = 0; t < nt; t += 2) {
            const bool last = (t == nt - 2);
            const char* a1 = cA + (size_t)(t + 1) * kstep;
            const char* a2 = last ? nA : cA + (size_t)(t + 2) * kstep; const char* b2 = last ? nB : cB + (size_t)(t + 2) * kstep;
            const char* a3 = a2 + kstep; const char* b3 = b2 + kstep;
            if (last && has_next) S.a_ready(nxt);
            if constexpr (SP2) {
            PG8_LDB(B0, 0, 0); PG8_LDB(B1, 0, 1); PG8_SCHED; PG8_LDA(At, 0, 0); PG8_STAGE(PG8_SA(1, 1), a1 + hstep, voffA);
            PG8_WAIT_V(8); PG8_WAIT_L(0); PG8_BAR; PG8_MMA(0, 0, At, B0); PG8_MMA(0, 1, At, B1); PG8_BAR; PG8_SCHED;
            PG8_LDA(At, 0, 1); PG8_STAGE(PG8_SB(0, 0), b2, voffB); PG8_STAGE(PG8_SB(0, 1), b2 + hstep, voffB); PG8_STAGE(PG8_SA(0, 0), a2, voffA);
            PG8_WAIT_V(8); PG8_WAIT_L(0); PG8_BAR; PG8_MMA(1, 0, At, B0); PG8_MMA(1, 1, At, B1); PG8_BAR; PG8_SCHED;
            PG8_LDB(B0, 1, 0); PG8_LDB(B1, 1, 1); PG8_SCHED; PG8_LDA(At, 1, 0); PG8_STAGE(PG8_SA(0, 1), a2 + hstep, voffA);
            PG8_WAIT_V(8); PG8_WAIT_L(0); PG8_BAR; PG8_MMA(0, 0, At, B0); PG8_MMA(0, 1, At, B1); PG8_BAR; PG8_SCHED;
            PG8_LDA(At, 1, 1); PG8_STAGE(PG8_SB(1, 0), b3, voffB); PG8_STAGE(PG8_SB(1, 1), b3 + hstep, voffB); PG8_STAGE(PG8_SA(1, 0), a3, voffA);
            PG8_WAIT_V(8); PG8_WAIT_L(0); PG8_BAR; PG8_MMA(1, 0, At, B0); PG8_MMA(1, 1, At, B1); PG8_BAR; PG8_SCHED;
            } else {
            PG8_LDB(B0, 0, 0); PG8_SCHED; PG8_LDA(At, 0, 0); PG8_STAGE(PG8_SA(1, 1), a1 + hstep, voffA);
            PG8_WAIT_L(8); PG8_BAR; PG8_WAIT_L(0); PG8_MMA(0, 0, At, B0); PG8_BAR; PG8_SCHED;
            PG8_LDB(B1, 0, 1); PG8_STAGE(PG8_SB(0, 0), b2, voffB);
            PG8_BAR; PG8_WAIT_L(0); PG8_MMA(0, 1, At, B1); PG8_BAR;
            PG8_LDA(At, 0, 1); PG8_STAGE(PG8_SA(0, 0), a2, voffA);
            PG8_BAR; PG8_WAIT_L(0); PG8_MMA(1, 0, At, B0); PG8_BAR; PG8_SCHED;
            PG8_STAGE(PG8_SB(0, 1), b2 + hstep, voffB);
            PG8_WAIT_V(6); PG8_BAR; PG8_MMA(1, 1, At, B1); PG8_BAR;
            PG8_LDB(B0, 1, 0); PG8_SCHED; PG8_LDA(At, 1, 0); PG8_STAGE(PG8_SA(0, 1), a2 + hstep, voffA);
            PG8_WAIT_L(8); PG8_BAR; PG8_WAIT_L(0); PG8_MMA(0, 0, At, B0); PG8_BAR; PG8_SCHED;
            PG8_LDB(B1, 1, 1); PG8_STAGE(PG8_SB(1, 0), b3, voffB);
            PG8_BAR; PG8_WAIT_L(0); PG8_MMA(0, 1, At, B1); PG8_BAR;
            PG8_LDA(At, 1, 1); PG8_STAGE(PG8_SA(1, 0), a3, voffA);
            PG8_BAR; PG8_WAIT_L(0); PG8_MMA(1, 0, At, B0); PG8_BAR; PG8_SCHED;
            PG8_STAGE(PG8_SB(1, 1), b3 + hstep, voffB);
            PG8_WAIT_V(6); PG8_BAR; PG8_MMA(1, 1, At, B1); PG8_BAR;
            }
        }
        if constexpr (ALIGN_EPI) { if (wr == 0) PG8_BAR; }
        if constexpr (!Epi::AFTER_DRAIN) { E(acc, cur, wr, wc, fr, fq); S.done(cur); }
        if (!has_next) break;
        E.init(acc, nxt, wr, wc, fr, fq);
        cur = nxt; cA = nA; cB = nB; ++ui;
        if constexpr (ALIGN_EPI) { if (wr == 1) PG8_BAR; }
    }
    PG8_WAIT_V(0);
    if constexpr (!ALIGN_EPI) { if (wr == 0) PG8_BAR; }
    PG8_BAR;
    if constexpr (Epi::AFTER_DRAIN) { E.fused(acc, cur, wr, wc, fr, fq, lds, wid, lane); S.done(cur); }
#undef PG8_SA
#undef PG8_SB
#undef PG8_STAGE
#undef PG8_LDA
#undef PG8_LDB
#undef PG8_MMA
#undef PG8_WAIT_V
#undef PG8_WAIT_L
#undef PG8_BAR
#undef PG8_SCHED
}
}
namespace fa {
using bf16 = __hip_bfloat16;
typedef short bf16x8 __attribute__((ext_vector_type(8)));
typedef short s16x4 __attribute__((ext_vector_type(4)));
typedef float f32x16 __attribute__((ext_vector_type(16)));
constexpr int D = 128, NW = 8, QBLK = 32, KVBLK = 64, QB = NW * QBLK;
constexpr int SHM_V = KVBLK * D * 2, SHM_K = KVBLK * D * 2;
constexpr int OFF_WS = 2 * SHM_V + 2 * SHM_K, OFF_CK = OFF_WS + NW * 64 * 4, LDS_BYTES = OFF_CK + 2 * 64 * 4;
constexpr float SCALE = 0.08838834764831845f;
constexpr float THR = 8.f;

#define KSWZ(row, colB) ((row) * 256 + ((colB) ^ (((row) & 7) << 4)))
#define SBAR() __builtin_amdgcn_sched_barrier(0)
__device__ __forceinline__ int v_st(int k, int c) { const int kk = (k & ~0xC) | ((k & 4) << 1) | ((k & 8) >> 1); return ((kk >> 3) * 4 + (c >> 5)) * 512 + ((kk & 7) * 32 + (c & 31)) * 2; }
__device__ __forceinline__ int v_rd_base(int lane) { return ((lane & 3) << 3) | (((lane >> 2) & 3) << 6) | (((lane >> 4) & 1) << 5) | (((lane >> 5) & 1) << 8); }
constexpr int v_rd_off(int d0, int ks, int half) { return d0 * 512 + ks * 4096 + half * 2048; }
__device__ __forceinline__ int crow(int r, int hi) { return (r & 3) + 8 * (r >> 2) + 4 * hi; }
__device__ __forceinline__ unsigned cvtpk(float lo, float hi) { return ::cvtpk2(lo, hi); }
__device__ __forceinline__ bf16x8 load8(const bf16* p) { return *reinterpret_cast<const bf16x8*>(p); }
template <int MODE> __device__ __forceinline__ void mask_tile(f32x16& p0, f32x16& p1, int dq) {
    const float NEG = MODE == 0 ? -__builtin_inff() : 0.f;
#pragma unroll
    for (int r = 0; r < 16; ++r) {
        const int c = (r & 3) + 8 * (r >> 2);
        if (dq - c < 0) p0[r] = NEG;
        if (dq - c - 32 < 0) p1[r] = NEG;
    }
}
__device__ __forceinline__ void partialSM(f32x16& p0, f32x16& p1, float& m_reg, float& mn, float& alpha) {
    float pmax = p0[0]; for (int r = 1; r < 16; ++r) pmax = fmaxf(pmax, p0[r]); for (int r = 0; r < 16; ++r) pmax = fmaxf(pmax, p1[r]);
    { auto rr = __builtin_amdgcn_permlane32_swap(__float_as_uint(pmax), __float_as_uint(pmax), false, false);
      pmax = fmaxf(__uint_as_float(rr[0]), __uint_as_float(rr[1])); }
    constexpr float C2 = 1.4426950408889634f * SCALE;
    if (__builtin_expect(__all((pmax - m_reg) * SCALE <= THR), 1)) { mn = m_reg; alpha = 1.f; }
    else { mn = fmaxf(m_reg, pmax); alpha = __builtin_amdgcn_exp2f((m_reg - mn) * C2); m_reg = mn; }
    const float mnL = -mn * C2;
    for (int r = 0; r < 16; ++r) p0[r] = fmaf(p0[r], C2, mnL); for (int r = 0; r < 16; ++r) p1[r] = fmaf(p1[r], C2, mnL);
    for (int r = 0; r < 16; ++r) p0[r] = __builtin_amdgcn_exp2f(p0[r]);
}
#define PK4(P, B_, OUT) do { unsigned a0 = cvtpk(P[B_+0], P[B_+1]), a1 = cvtpk(P[B_+2], P[B_+3]);                          \
        unsigned b0 = cvtpk(P[B_+4], P[B_+5]), b1 = cvtpk(P[B_+6], P[B_+7]);                                             \
        auto r0 = __builtin_amdgcn_permlane32_swap(a0, b0, false, false); auto r1 = __builtin_amdgcn_permlane32_swap(a1, b1, false, false); \
        u32x4 w = {r0[0], r1[0], r0[1], r1[1]}; OUT = *reinterpret_cast<bf16x8*>(&w); } while (0)
__device__ __forceinline__ void finishSM(f32x16& p0, f32x16& p1, float alpha, float& l_reg, bf16x8& pa0, bf16x8& pa1, bf16x8& pa2, bf16x8& pa3) {
    for (int r = 0; r < 16; ++r) p1[r] = __builtin_amdgcn_exp2f(p1[r]);
    float ps = 0; for (int r = 0; r < 16; ++r) ps += p0[r]; for (int r = 0; r < 16; ++r) ps += p1[r];
    { auto rr = __builtin_amdgcn_permlane32_swap(__float_as_uint(ps), __float_as_uint(ps), false, false);
      ps = __uint_as_float(rr[0]) + __uint_as_float(rr[1]); }
    l_reg = l_reg * alpha + ps;
    PK4(p0, 0, pa0); PK4(p0, 8, pa1); PK4(p1, 0, pa2); PK4(p1, 8, pa3);
}
__device__ __forceinline__ void linScale(f32x16& p0, f32x16& p1, float fr) {
    for (int r = 0; r < 16; ++r) p0[r] *= fr; for (int r = 0; r < 16; ++r) p1[r] *= fr;
}
__device__ __forceinline__ void linFinish(f32x16& p0, f32x16& p1, float& l_reg, bf16x8& pa0, bf16x8& pa1, bf16x8& pa2, bf16x8& pa3) {
    float ps = 0; for (int r = 0; r < 16; ++r) ps += p0[r]; for (int r = 0; r < 16; ++r) ps += p1[r];
    { auto rr = __builtin_amdgcn_permlane32_swap(__float_as_uint(ps), __float_as_uint(ps), false, false);
      ps = __uint_as_float(rr[0]) + __uint_as_float(rr[1]); }
    l_reg += ps;
    PK4(p0, 0, pa0); PK4(p0, 8, pa1); PK4(p1, 0, pa2); PK4(p1, 8, pa3);
}
#undef PK4
template <int KB, int MODE>
__device__ __forceinline__ void qkt(f32x16& p0, f32x16& p1, const char* K_lds, const float* ckl, int r32, int hi, const bf16x8* qr) {
    if constexpr (MODE == 0) {
        const float* c = ckl + KB * 64 + 4 * hi;
#pragma unroll
        for (int g = 0; g < 4; ++g) { const f32x4 a = *(const f32x4*)(c + 8 * g), b = *(const f32x4*)(c + 32 + 8 * g);
            p0[4 * g + 0] = a[0]; p0[4 * g + 1] = a[1]; p0[4 * g + 2] = a[2]; p0[4 * g + 3] = a[3];
            p1[4 * g + 0] = b[0]; p1[4 * g + 1] = b[1]; p1[4 * g + 2] = b[2]; p1[4 * g + 3] = b[3]; }
    } else { p0 = f32x16{}; p1 = f32x16{}; }
    const char* kb[4];
#pragma unroll
    for (int dd = 0; dd < 4; ++dd) kb[dd] = K_lds + KB * SHM_K + KSWZ(r32, (dd * 16 + hi * 8) * 2);
#pragma unroll
    for (int d0 = 0; d0 < 8; ++d0) { const char* a = kb[d0 & 3] + (d0 >> 2) * 128;
        bf16x8 b0 = *reinterpret_cast<const bf16x8*>(a);
        bf16x8 b1 = *reinterpret_cast<const bf16x8*>(a + 32 * 256);
        p0 = __builtin_amdgcn_mfma_f32_32x32x16_bf16(b0, qr[d0], p0, 0, 0, 0);
        p1 = __builtin_amdgcn_mfma_f32_32x32x16_bf16(b1, qr[d0], p1, 0, 0, 0); }
}
template <int VB>
__device__ __forceinline__ void pv_tile(f32x16* o, int vb0, bf16x8 pa0, bf16x8 pa1, bf16x8 pa2, bf16x8 pa3) {
#define TRRD(dst, off) asm volatile("ds_read_b64_tr_b16 %0, %1 offset:%2" : "=&v"(dst) : "v"(vb0), "i"(off) : "memory")
#define PV_D0(d0) do { s16x4 l0, l1, l2, l3, h0, h1, h2, h3; constexpr int b_ = VB * SHM_V + v_rd_off(d0, 0, 0);     \
        TRRD(l0, b_); TRRD(h0, b_ + 2048); TRRD(l1, b_ + 4096); TRRD(h1, b_ + 6144); TRRD(l2, b_ + 8192); TRRD(h2, b_ + 10240); TRRD(l3, b_ + 12288); TRRD(h3, b_ + 14336); \
        asm volatile("s_waitcnt lgkmcnt(0)" ::: "memory"); SBAR();                 \
        o[d0] = __builtin_amdgcn_mfma_f32_32x32x16_bf16(pa0, (bf16x8){l0[0], l0[1], l0[2], l0[3], h0[0], h0[1], h0[2], h0[3]}, o[d0], 0, 0, 0);   \
        o[d0] = __builtin_amdgcn_mfma_f32_32x32x16_bf16(pa1, (bf16x8){l1[0], l1[1], l1[2], l1[3], h1[0], h1[1], h1[2], h1[3]}, o[d0], 0, 0, 0);   \
        o[d0] = __builtin_amdgcn_mfma_f32_32x32x16_bf16(pa2, (bf16x8){l2[0], l2[1], l2[2], l2[3], h2[0], h2[1], h2[2], h2[3]}, o[d0], 0, 0, 0);   \
        o[d0] = __builtin_amdgcn_mfma_f32_32x32x16_bf16(pa3, (bf16x8){l3[0], l3[1], l3[2], l3[3], h3[0], h3[1], h3[2], h3[3]}, o[d0], 0, 0, 0); } while (0)
    PV_D0(0); PV_D0(1); PV_D0(2); PV_D0(3);
#undef PV_D0
#undef TRRD
}

struct BlockRef { const bf16* Q; const bf16* K; const bf16* V; bf16* O; const float* aux; int P0; };
constexpr int AUX_MEXP = 65536, AUX_AREF = 131072;
template <int MODE> struct Pitch { static constexpr int qp = MODE ? 512 : 6144, kp = MODE ? 512 : 6144, vp = 6144, op = MODE ? 1024 : 2048; };
struct Seam { bf16x8 qr[8]; bf16x8 st_v0, st_v1, st_k0, st_k1; float st_c; };
#define ROWK(R, PM, k0, rr) ((R).K + (size_t)(k0) * Pitch<PM>::kp + (unsigned)(((rr) * Pitch<PM>::kp) + sc))
#define ROWV(R, PM, k0, rr) ((R).V + (size_t)(k0) * Pitch<PM>::vp + (unsigned)(((rr) * Pitch<PM>::vp) + sc))
#define VMW() asm volatile("s_waitcnt vmcnt(0)" ::: "memory")
#define VMWN(n) asm volatile("s_waitcnt vmcnt(%0)" :: "i"(n) : "memory")
#define SLOAD_H(R, PM, k0) do { S.st_v0 = load8(ROWV(R, PM, k0, sr)); S.st_v1 = load8(ROWV(R, PM, k0, 32 + sr));              \
                         S.st_k0 = load8(ROWK(R, PM, k0, sr)); S.st_k1 = load8(ROWK(R, PM, k0, 32 + sr));                \
                         if constexpr (PM == 0) S.st_c = (R).aux[(k0) + (tid & 63)]; } while (0)
#define SWRITE_HK(bf) do { *(bf16x8*)(K_lds + (bf) * SHM_K + kws) = S.st_k0; *(bf16x8*)(K_lds + (bf) * SHM_K + kws + 32 * 256) = S.st_k1; \
                           if constexpr (MODE == 0) { if (tid < 64) ckl[(bf) * 64 + tid] = S.st_c; } } while (0)
#define SWRITE_HV(bf) do { *(bf16x8*)(V_lds + (bf) * SHM_V + vst0) = S.st_v0; *(bf16x8*)(V_lds + (bf) * SHM_V + vst1) = S.st_v1; } while (0)
#define SWRITE_H(bf) do { SWRITE_HV(bf); SWRITE_HK(bf); } while (0)
template <int MODE>
__device__ __forceinline__ void attn_prime(const BlockRef& cur, char* lds, Seam& S) {
    const int tid = threadIdx.x, wid = __builtin_amdgcn_readfirstlane(tid >> 6), lane = tid & 63, r32 = lane & 31, hi = lane >> 5;
    const int sr = tid >> 4, sc = (tid & 15) * 8, kws = KSWZ(sr, sc * 2), vst0 = v_st(sr, sc), vst1 = v_st(32 + sr, sc); char* V_lds = lds; char* K_lds = lds + 2 * SHM_V; float* ckl = (float*)(lds + OFF_CK);
#pragma unroll
    for (int d0 = 0; d0 < 8; ++d0) S.qr[d0] = load8(cur.Q + (size_t)(cur.P0 + wid * QBLK) * Pitch<MODE>::qp + (unsigned)(r32 * Pitch<MODE>::qp + d0 * 16 + hi * 8));
    SLOAD_H(cur, MODE, 0); VMW(); SWRITE_H(0);
    __syncthreads();
}
template <int MODE>
__device__ __forceinline__ void attn_block(const BlockRef& cur, const BlockRef& nxt, char* lds, Seam& S) {
    int tid0_ = threadIdx.x; asm volatile("" : "+v"(tid0_));
    const int tid = tid0_, wid = __builtin_amdgcn_readfirstlane(tid >> 6), lane = tid & 63, r32 = lane & 31, hi = lane >> 5;
    const int NT = cur.P0 / KVBLK + 4;
    const int qlo = cur.P0 + wid * QBLK, qm = qlo + r32 - 4 * hi;
    char* V_lds = lds; char* K_lds = lds + 2 * SHM_V;
    float* ws = (float*)(lds + OFF_WS) + wid * 64; float* li_l = ws, * al_l = ws + 32; float* ckl = (float*)(lds + OFF_CK);
    float m_reg = -1e30f, l_reg = 0; f32x16 o[4] = {};
    const int sr = tid >> 4, sc = (tid & 15) * 8, vst0 = v_st(sr, sc), vst1 = v_st(32 + sr, sc), kws = KSWZ(sr, sc * 2);
    const int vb0 = (int)(uintptr_t)V_lds + v_rd_base(lane);
    float m2row = 0.f; if constexpr (MODE == 1) m2row = cur.aux[qlo + r32];
#define RESC(a) do { if constexpr (MODE == 0) { if (__any((a) < 1.f)) { if (hi == 0) al_l[r32] = (a); asm volatile("s_waitcnt lgkmcnt(0)" ::: "memory");              \
                     for (int d_ = 0; d_ < 4; ++d_) for (int r = 0; r < 16; ++r) o[d_][r] *= al_l[crow(r, hi)]; } } } while (0)
#define KBASE(t) ((t) * KVBLK)
    f32x16 p0, p1; float mn, al; bf16x8 pa0, pa1, pa2, pa3;
#define STEP(t, BUF, LASTCHK) do {                                                                                               \
        float ar = 0.f; if constexpr (MODE == 1) ar = cur.aux[AUX_AREF + (t)];                                                    \
        const bool last_ = LASTCHK && ((t) + 1 >= NT);                                                                            \
        if (last_) { SLOAD_H(nxt, MODE, 0); } else { SLOAD_H(cur, MODE, KBASE((t) + 1)); }                                         \
        SBAR(); qkt<BUF, MODE>(p0, p1, K_lds, ckl, r32, hi, S.qr); SBAR();                                                          \
        if (last_) { _Pragma("unroll") for (int d0 = 0; d0 < 8; ++d0) S.qr[d0] = load8(nxt.Q + (size_t)(nxt.P0 + wid * QBLK) * Pitch<MODE>::qp + (unsigned)(r32 * Pitch<MODE>::qp + d0 * 16 + hi * 8)); SBAR(); } \
        { const int kb_ = KBASE(t); if (kb_ + KVBLK - 1 > qlo) mask_tile<MODE>(p0, p1, qm - kb_); }                               \
        if constexpr (MODE == 0) { partialSM(p0, p1, m_reg, mn, al); RESC(al); finishSM(p0, p1, al, l_reg, pa0, pa1, pa2, pa3); }    \
        else { linScale(p0, p1, __builtin_amdgcn_exp2f(ar - m2row)); linFinish(p0, p1, l_reg, pa0, pa1, pa2, pa3); }               \
        SBAR(); pv_tile<BUF>(o, vb0, pa0, pa1, pa2, pa3); SBAR();                                                                 \
        VMW(); SWRITE_H((BUF) ^ 1);                                                                                               \
        __syncthreads(); } while (0)
    for (int t = 0; t < NT; t += 2) { STEP(t, 0, false); STEP(t + 1, 1, true); }
    { float lv = l_reg; if constexpr (MODE == 1) lv = fmaxf(fabsf(l_reg), cur.aux[AUX_MEXP + qlo + r32]);
      if (hi == 0) li_l[r32] = lv; }
    asm volatile("s_waitcnt lgkmcnt(0)" ::: "memory");
    float rli[16];
#pragma unroll
    for (int r = 0; r < 16; ++r) rli[r] = __builtin_amdgcn_rcpf(li_l[crow(r, hi)]);
    bf16* Ow = cur.O + (size_t)(qlo) * Pitch<MODE>::op;
#pragma unroll
    for (int r = 0; r < 16; ++r) { const int orow = crow(r, hi);
#pragma unroll
        for (int d0 = 0; d0 < 4; ++d0) { const float v = o[d0][r] * rli[r];
            const float vn = __shfl_xor(v, 1);
            if ((r32 & 1) == 0) *(unsigned*)(Ow + (unsigned)(orow * Pitch<MODE>::op + d0 * 32 + r32)) = cvtpk(v, vn); } }
    asm volatile("s_waitcnt lgkmcnt(0)" ::: "memory");
#undef RESC
#undef KBASE
#undef STEP
}
#undef ROWK
#undef ROWV
#undef VMW
#undef VMWN
#undef SLOAD_H
#undef SWRITE_HK
#undef SWRITE_HV
#undef SWRITE_H
#undef SBAR
#undef KSWZ
}
#define LAS __attribute__((address_space(3)))
#define GAS __attribute__((address_space(1)))
#define RLX_AGENT __ATOMIC_RELAXED, __HIP_MEMORY_SCOPE_AGENT
#define XB_TMO      128
#define XB_XCNT(j)  (256  + 64 * (j))
#define XB_XSUB(j)  (1280 + 64 * (j))
#define XB_XGEN(j)  (2304 + 64 * (j))
#define XB_TOP      3328
#define XB_TOPGEN   3392
#define XCD_BAR_WORDS 3456
#define XB_SPIN_CAP (1u << 18)

__device__ __forceinline__ unsigned xb_ld(unsigned* p)              { return __hip_atomic_load(p, __ATOMIC_RELAXED, __HIP_MEMORY_SCOPE_AGENT); }
__device__ __forceinline__ unsigned xb_add(unsigned* p, unsigned v) { return __hip_atomic_fetch_add(p, v, __ATOMIC_RELAXED, __HIP_MEMORY_SCOPE_AGENT); }
__device__ __forceinline__ unsigned xb_xcc_id() { return (unsigned)__builtin_amdgcn_s_getreg((3 << 11) | 20) & 0xFu; }
#define XB_SPIN(cond, bar) do { unsigned _sp = 0; while (cond) { __builtin_amdgcn_s_sleep(1); \
    if ((++_sp & 255u) == 0u) { if (xb_ld(&(bar)[XB_TMO])) break; if (_sp > XB_SPIN_CAP) { atomicAdd(&(bar)[XB_TMO], 1u); break; } } } } while (0)

struct XcdBarrier {
    unsigned* bar; unsigned x;
    volatile LAS unsigned* st;
};

__device__ __forceinline__ XcdBarrier xcd_barrier_post(unsigned* bar, volatile LAS unsigned* st) {
    XcdBarrier b; b.bar = bar; b.x = xb_xcc_id(); b.st = st;
    if (threadIdx.x == 0) (void)xb_add(&bar[XB_XCNT(b.x)], 1u);
    return b;
}
__device__ __forceinline__ void xcd_barrier_complete(unsigned* bar, unsigned x, unsigned& nloc, unsigned& nx) {
    const unsigned G = gridDim.x * gridDim.y * gridDim.z;
    unsigned sum, cnt, mine, sp = 0u;
    for (;;) {
        sum = 0u; cnt = 0u; mine = 0u;
#pragma unroll
        for (unsigned j = 0; j < 16; ++j) { const unsigned c = xb_ld(&bar[XB_XCNT(j)]); sum += c; cnt += (c > 0u) ? 1u : 0u; mine = (j == x) ? c : mine; }
        if (sum == G) break;
        __builtin_amdgcn_s_sleep(1);
        if ((++sp & 255u) == 0u) { if (xb_ld(&bar[XB_TMO])) break; if (sp > XB_SPIN_CAP) { atomicAdd(&bar[XB_TMO], 1u); break; } }
    }
    nloc = mine > 0u ? mine : 1u; nx = cnt > 0u ? cnt : 1u;
}

__device__ __forceinline__ void xcd_barrier(const XcdBarrier& b) {
    asm volatile("s_waitcnt vmcnt(0)" ::: "memory");
    __syncthreads();
    if (threadIdx.x == 0) {
        unsigned* bar = b.bar;
        __builtin_amdgcn_s_waitcnt(0);
        unsigned nloc = b.st[0], nx = b.st[1];
        if (nloc == 0u) { xcd_barrier_complete(bar, b.x, nloc, nx); b.st[0] = nloc; b.st[1] = nx; }
        const unsigned old = xb_add(&bar[XB_XSUB(b.x)], 1u);
        const unsigned gen = old / nloc;
        if (old + 1u == (gen + 1u) * nloc) {
            __builtin_amdgcn_fence(__ATOMIC_RELEASE, "agent");
            asm volatile("s_waitcnt vmcnt(0)" ::: "memory");
            const unsigned og = xb_add(&bar[XB_TOP], 1u);
            const unsigned tg = og / nx;
            if (og + 1u == (tg + 1u) * nx) xb_add(&bar[XB_TOPGEN], 1u);
            else XB_SPIN(xb_ld(&bar[XB_TOPGEN]) == tg, bar);
            __builtin_amdgcn_fence(__ATOMIC_ACQUIRE, "agent");
            xb_add(&bar[XB_XGEN(b.x)], 1u);
            asm volatile("s_waitcnt vmcnt(0)" ::: "memory");
        } else {
            XB_SPIN(xb_ld(&bar[XB_XGEN(b.x)]) == gen, bar);
            __builtin_amdgcn_fence(__ATOMIC_ACQUIRE, "agent");
            asm volatile("s_waitcnt vmcnt(0)" ::: "memory");
        }
    }
    __syncthreads();
}
constexpr int NWAVES = 8, NTHREADS = NWAVES * 64;
constexpr int LDS_BYTES = 131072 + 4096;
static_assert(fa::LDS_BYTES <= 131072, "attention scratch fits the ring region");
constexpr size_t MiB = 1u << 20;
constexpr size_t WS_SS = 0;
constexpr size_t WS_BAR = 512 * 1024;
constexpr size_t WS_G = 1 * MiB;
constexpr size_t WS_CK = 2 * MiB;
constexpr size_t WS_A2 = 2 * MiB + 512 * 1024, WS_M2 = WS_A2 + 256 * 1024, WS_MEXP = WS_M2 + 256 * 1024, WS_AREF = WS_MEXP + 256 * 1024;
static_assert((WS_MEXP - WS_M2) / 4 == fa::AUX_MEXP && (WS_AREF - WS_M2) / 4 == fa::AUX_AREF, "aux offsets");
constexpr size_t WS_WIN = 4 * MiB, WS_WO = 29 * MiB, WS_WGU = 37 * MiB, WS_WD = 81 * MiB, WS_WPG = 103 * MiB, WS_WPP = 111 * MiB;
constexpr size_t WS_R1 = 112 * MiB;
constexpr size_t WS_R2 = 304 * MiB;
constexpr size_t WS_R3 = 368 * MiB;
constexpr size_t WS_HB = WS_R3, WS_MQ = WS_R3 + 32 * MiB, WS_MK = WS_R3 + 48 * MiB;
constexpr size_t WS_ERAW = 432 * MiB, WS_END = 496 * MiB;

struct Args {
    const float *x, *p, *w_norm_mix, *w_in, *fox_f_bias, *q_norm_w, *k_norm_w, *conv_w, *conv_b, *mi_bias, *mf_bias, *out_norm_w, *w_out, *w_norm_ffn,
                *w_gate, *w_up, *w_down, *w_norm_ple, *w_ple_gate, *w_ple_proj, *w_ple_post;
    float* out; unsigned char* ws;
};

__device__ __forceinline__ float wave_sum(float v) {
#pragma unroll
    for (int o = 1; o < 64; o <<= 1) v += __shfl_xor(v, o);
    return v;
}
__device__ __forceinline__ int win_src_col(int d) {
    if (d < 3072) return d;
    if (d < 5120) return d + 8;
    if (d < 6144) return d + 16;
    if (d < 6152) return 3072 + (d - 6144);
    if (d < 6160) return 5128 + (d - 6152);
    return -1;
}
struct TItem { const float* src4; const float* kw; bf16_t* dst; int ld, K; };
__device__ __forceinline__ TItem p0_item(const Args& A, int it, int lane) {
    constexpr int I_IN = (DM / 64) * (NIN / 32), I_O = (DM / 64) * (DM / 32), I_GU = (DM / 64) * (2 * DFF / 32), I_D = (DFF / 64) * (DM / 32), I_PG = I_O;
    unsigned char* ws = A.ws; const int n4 = 4 * (lane & 7), kr = lane >> 3; TItem t; int r = it;
    if (r < I_IN) { const int nblk = NIN / 32, kb = r / nblk, nb = r % nblk; const int sc = win_src_col(nb * 32 + n4);
        t.src4 = sc >= 0 ? A.w_in + (size_t)(kb * 64 + kr) * INC + sc : nullptr; t.kw = A.w_norm_mix + kb * 64 + kr; t.ld = INC; t.K = DM; t.dst = (bf16_t*)(ws + WS_WIN) + (size_t)(nb * 32) * DM + kb * 64; return t; } r -= I_IN;
    if (r < I_O) { const int nblk = DM / 32, kb = r / nblk, nb = r % nblk; t.src4 = A.w_out + (size_t)(kb * 64 + kr) * DM + nb * 32 + n4; t.kw = nullptr; t.ld = DM; t.K = DM; t.dst = (bf16_t*)(ws + WS_WO) + (size_t)(nb * 32) * DM + kb * 64; return t; } r -= I_O;
    if (r < I_GU) { const int nblk = 2 * DFF / 32, kb = r / nblk, nb = r % nblk; const int d = nb * 32, pn = d >> 8, j = d & 255;
        t.src4 = ((j < 128) ? A.w_gate + 128 * pn + j : A.w_up + 128 * pn + (j - 128)) + (size_t)(kb * 64 + kr) * DFF + n4; t.kw = A.w_norm_ffn + kb * 64 + kr; t.ld = DFF; t.K = DM; t.dst = (bf16_t*)(ws + WS_WGU) + (size_t)d * DM + kb * 64; return t; } r -= I_GU;
    if (r < I_D) { const int nblk = DM / 32, kb = r / nblk, nb = r % nblk; t.src4 = A.w_down + (size_t)(kb * 64 + kr) * DM + nb * 32 + n4; t.kw = nullptr; t.ld = DM; t.K = DFF; t.dst = (bf16_t*)(ws + WS_WD) + (size_t)(nb * 32) * DFF + kb * 64; return t; } r -= I_D;
    if (r < I_PG) { const int nblk = DM / 32, kb = r / nblk, nb = r % nblk; t.src4 = A.w_ple_gate + (size_t)(kb * 64 + kr) * DM + nb * 32 + n4; t.kw = A.w_norm_ple + kb * 64 + kr; t.ld = DM; t.K = DM; t.dst = (bf16_t*)(ws + WS_WPG) + (size_t)(nb * 32) * DM + kb * 64; return t; } r -= I_PG;
    { const int nblk = DM / 32, kb = r / nblk, nb = r % nblk; t.src4 = A.w_ple_proj + (size_t)(kb * 64 + kr) * DM + nb * 32 + n4; t.kw = nullptr; t.ld = DM; t.K = PLE; t.dst = (bf16_t*)(ws + WS_WPP) + (size_t)(nb * 32) * PLE + kb * 64; return t; }
}
__device__ __forceinline__ void p0_item_load(const TItem& t, f32x4 (&v)[8]) {
#pragma unroll
    for (int i = 0; i < 8; ++i) { v[i] = t.src4 ? *(const f32x4*)(t.src4 + (size_t)(8 * i) * t.ld) : (f32x4){0.f, 0.f, 0.f, 0.f}; if (t.kw) v[i] = v[i] * t.kw[8 * i]; }
}
__device__ __forceinline__ void p0_item_store(const TItem& t, const f32x4 (&v)[8], LAS float* scr, int lane) {
    const int n4 = 4 * (lane & 7), kr = lane >> 3;
#pragma unroll
    for (int i = 0; i < 8; ++i) { LAS float* d = scr + (kr + 8 * i) * 33 + n4; d[0] = v[i].x; d[1] = v[i].y; d[2] = v[i].z; d[3] = v[i].w; }
    asm volatile("s_waitcnt lgkmcnt(0)" ::: "memory");
    const int c = lane & 7;
#pragma unroll
    for (int j = 0; j < 4; ++j) { const int n = (lane >> 3) + 8 * j; const LAS float* s = scr + (8 * c) * 33 + n;
        u32x4 o; o.x = cvtpk2(s[0 * 33], s[1 * 33]); o.y = cvtpk2(s[2 * 33], s[3 * 33]); o.z = cvtpk2(s[4 * 33], s[5 * 33]); o.w = cvtpk2(s[6 * 33], s[7 * 33]);
        *(u32x4*)(t.dst + (size_t)n * t.K + 8 * c) = o; }
    asm volatile("s_waitcnt lgkmcnt(0)" ::: "memory");
}
__device__ __forceinline__ void p0_prologue(const Args& A, LAS unsigned char* lds, int gw, int NGW, int lane, int wave) {
    LAS float* scr = (LAS float*)(lds + wave * 16384);
    unsigned char* ws = A.ws;
    constexpr int NITEMS = (DM / 64) * (NIN / 32) + 2 * (DM / 64) * (DM / 32) + (DM / 64) * (2 * DFF / 32) + (DFF / 64) * (DM / 32) + (PLE / 64) * (DM / 32);
    if (gw < NITEMS) {
        TItem cur = p0_item(A, gw, lane); f32x4 v[8]; p0_item_load(cur, v);
        for (int it = gw; it < NITEMS; it += NGW) {
            const bool more = it + NGW < NITEMS; TItem nx = cur; f32x4 w[8];
            if (more) { nx = p0_item(A, it + NGW, lane); p0_item_load(nx, w); }
            p0_item_store(cur, v, scr, lane);
            if (more) { cur = nx;
#pragma unroll
                for (int i = 0; i < 8; ++i) v[i] = w[i]; }
        }
    }
    bf16_t* XB = (bf16_t*)(ws + WS_R2); float* ss0 = (float*)(ws + WS_SS) + 3 * MROWS;
    {
        f32x4 v[8];
#pragma unroll
        for (int j = 0; j < 8; ++j) v[j] = ((const f32x4*)(A.x + (size_t)gw * DM) + lane)[64 * j];
        for (int m = gw; m < MROWS; m += NGW) {
            f32x4 nv[8]; const bool more = m + NGW < MROWS;
            if (more) {
#pragma unroll
                for (int j = 0; j < 8; ++j) nv[j] = ((const f32x4*)(A.x + (size_t)(m + NGW) * DM) + lane)[64 * j]; }
            float s = 0.f; u32x2* o8 = (u32x2*)(XB + (size_t)m * DM) + lane;
#pragma unroll
            for (int j = 0; j < 8; ++j) { s += (v[j].x * v[j].x + v[j].y * v[j].y) + (v[j].z * v[j].z + v[j].w * v[j].w); u32x2 w; w.x = cvtpk2(v[j].x, v[j].y); w.y = cvtpk2(v[j].z, v[j].w); o8[64 * j] = w; }
            s = wave_sum(s); if (lane == 0) ss0[m] = s;
            if (more) {
#pragma unroll
                for (int j = 0; j < 8; ++j) v[j] = nv[j]; }
        }
    }
    bf16_t* PB = (bf16_t*)(ws + WS_R3);
    for (int m = gw; m < MROWS; m += NGW) { const f32x4 v = ((const f32x4*)(A.p + (size_t)m * PLE))[lane]; u32x2 w; w.x = cvtpk2(v.x, v.y); w.y = cvtpk2(v.z, v.w); ((u32x2*)(PB + (size_t)m * PLE))[lane] = w; }
    float* ss = (float*)(ws + WS_SS);
    for (int i = gw * 64 + lane; i < 3 * MROWS; i += NGW * 64) ss[i] = 0.f;
}
__device__ __forceinline__ void gate_cols(const Args& A, LAS unsigned char* ldsl, int bx, int G) {
    typedef short bf16x8_ __attribute__((ext_vector_type(8))); typedef float f32x16_ __attribute__((ext_vector_type(16)));
    int tid0_ = threadIdx.x; asm volatile("" : "+v"(tid0_));
    const int tid = tid0_, lane = tid & 63, r32 = lane & 31, hi = lane >> 5, wave = __builtin_amdgcn_readfirstlane(tid >> 6);
    const bf16_t* XB = (const bf16_t*)(A.ws + WS_R2); const bf16_t* Wg = (const bf16_t*)(A.ws + WS_WIN) + (size_t)6144 * DM;
    float* Gout = (float*)(A.ws + WS_G); const float* ss0 = (const float*)(A.ws + WS_SS) + 3 * MROWS;
    LAS float* red = (LAS float*)ldsl;
    for (int t = bx; t < MROWS / 32; t += G) {
        const int row0 = t * 32; f32x16_ acc = {};
        const bf16_t* ap = XB + (size_t)(row0 + r32) * DM + wave * 256 + 8 * hi; const bf16_t* bp = Wg + (size_t)r32 * DM + wave * 256 + 8 * hi;
        bf16x8_ av[16], bv[16];
#pragma unroll
        for (int ks = 0; ks < 16; ++ks) { av[ks] = *(const bf16x8_*)(ap + 16 * ks); bv[ks] = *(const bf16x8_*)(bp + 16 * ks); }
#pragma unroll
        for (int ks = 0; ks < 16; ++ks) acc = __builtin_amdgcn_mfma_f32_32x32x16_bf16(av[ks], bv[ks], acc, 0, 0, 0);
        LAS float* rp = red + (wave * 64 + lane) * 16;
#pragma unroll
        for (int r = 0; r < 16; ++r) rp[r] = acc[r];
        __syncthreads();
        for (int e = tid; e < 1024; e += NTHREADS) { float s = 0.f;
#pragma unroll
            for (int w = 0; w < 8; ++w) s += red[w * 1024 + e];
            const int ln = e >> 4, r = e & 15, col = ln & 31, row = row0 + (r & 3) + 8 * (r >> 2) + 4 * (ln >> 5);
            if (col < 16) Gout[(size_t)row * 16 + col] = s * (1.f / sqrtf(ss0[row] * (1.f / DM) + EPS)); }
        __syncthreads();
    }
}
__device__ __forceinline__ float logsigf(float x) { return fminf(x, 0.f) - log1pf(expf(-fabsf(x))); }
__device__ __forceinline__ void scan_sequence(const Args& A, int v, LAS float* red) {
    const int tid = threadIdx.x, lane = tid & 63, wid = tid >> 6;
    const bool fox = v < NB * AH; int b, h;
    if (fox) { b = v / AH; h = v % AH; } else { const int u = v - NB * AH; b = u / MH; h = u % MH; }
    const float* Gp = (const float*)(A.ws + WS_G) + (size_t)(b * SEQ + 8 * tid) * 16;
    const int fcol = fox ? h : 12 + h; const float fb = fox ? A.fox_f_bias[h] : A.mf_bias[h];
    float lf[8]; float run = 0.f;
#pragma unroll
    for (int i = 0; i < 8; ++i) { run += logsigf(Gp[i * 16 + fcol] + fb); lf[i] = run; }
    float incl = run;
#pragma unroll
    for (int o = 1; o < 64; o <<= 1) { const float t = __shfl_up(incl, o); if (lane >= o) incl += t; }
    if (lane == 63) red[wid] = incl;
    __syncthreads();
    float base = incl - run;
    for (int w = 0; w < wid; ++w) base += red[w];
    if (fox) {
        float* CK = (float*)(A.ws + WS_CK) + (size_t)(b * AH + h) * SEQ + 8 * tid;
#pragma unroll
        for (int i = 0; i < 8; ++i) CK[i] = -(base + lf[i]) * 11.313708498984761f;
    } else {
        const float ib = A.mi_bias[h];
        float a[8], lm[8]; float rm = -__builtin_inff();
#pragma unroll
        for (int i = 0; i < 8; ++i) { a[i] = (Gp[i * 16 + 8 + h] + ib) - (base + lf[i]); rm = fmaxf(rm, a[i]); lm[i] = rm; }
        float im = rm;
#pragma unroll
        for (int o = 1; o < 64; o <<= 1) { const float t = __shfl_up(im, o); if (lane >= o) im = fmaxf(im, t); }
        if (lane == 63) red[8 + wid] = im;
        __syncthreads();
        float ex = __shfl_up(im, 1); if (lane == 0) ex = -__builtin_inff();
        for (int w = 0; w < wid; ++w) ex = fmaxf(ex, red[8 + w]);
        const size_t o0 = (size_t)(b * MH + h) * SEQ + 8 * tid;
        float* A2 = (float*)(A.ws + WS_A2) + o0; float* M2 = (float*)(A.ws + WS_M2) + o0; float* ME = (float*)(A.ws + WS_MEXP) + o0;
#pragma unroll
        for (int i = 0; i < 8; ++i) { const float Mt = fmaxf(0.f, fmaxf(ex, lm[i])); A2[i] = a[i] * LOG2E; M2[i] = Mt * LOG2E; ME[i] = expf(-((base + lf[i]) + Mt)); }
        float tm = rm; tm = fmaxf(tm, __shfl_xor(tm, 1)); tm = fmaxf(tm, __shfl_xor(tm, 2)); tm = fmaxf(tm, __shfl_xor(tm, 4));
        if ((lane & 7) == 0) ((float*)(A.ws + WS_AREF))[(b * MH + h) * SEQ + (tid >> 3)] = tm * LOG2E;
    }
}
__device__ __forceinline__ void unpack8(const u32x4 w, float (&f)[8]) { f[0] = bflo(w.x); f[1] = bfhi(w.x); f[2] = bflo(w.y); f[3] = bfhi(w.y); f[4] = bflo(w.z); f[5] = bfhi(w.z); f[6] = bflo(w.w); f[7] = bfhi(w.w); }
__device__ __forceinline__ u32x4 pack8f(const float (&f)[8]) { u32x4 w; w.x = cvtpk2(f[0], f[1]); w.y = cvtpk2(f[2], f[3]); w.z = cvtpk2(f[4], f[5]); w.w = cvtpk2(f[6], f[7]); return w; }
__device__ __forceinline__ void qk_norm_rows(const Args& A, int gw, int NGW, int lane) {
    bf16_t* PROJ = (bf16_t*)(A.ws + WS_R1);
    const int d0 = (8 * lane) & 127;
    float qw[8], kw[8];
#pragma unroll
    for (int i = 0; i < 8; ++i) { qw[i] = A.q_norm_w[d0 + i]; kw[i] = A.k_norm_w[d0 + i]; }
    for (int m = gw; m < MROWS; m += NGW) {
        bf16_t* p = PROJ + (size_t)m * PROJ_LD + 8 * lane;
        u32x4 raw[4];
#pragma unroll
        for (int j = 0; j < 4; ++j) raw[j] = *(const u32x4*)(p + 512 * j);
#pragma unroll
        for (int j = 0; j < 4; ++j) { float f[8]; unpack8(raw[j], f); float s = 0.f;
#pragma unroll
            for (int i = 0; i < 8; ++i) s += f[i] * f[i];
            s += __shfl_xor(s, 1); s += __shfl_xor(s, 2); s += __shfl_xor(s, 4); s += __shfl_xor(s, 8);
            const float rs = 1.f / sqrtf(s * (1.f / 128.f) + EPS);
#pragma unroll
            for (int i = 0; i < 8; ++i) f[i] = f[i] * rs * (j < 2 ? qw[i] : kw[i]);
            *(u32x4*)(p + 512 * j) = pack8f(f); }
    }
}
template <int KPART> __device__ __forceinline__ void mconv_rows(const Args& A, int gw, int NGW, int lane) {
    const bf16_t* PROJ = (const bf16_t*)(A.ws + WS_R1) + (KPART ? PC_MK : PC_MQ) + 8 * lane;
    bf16_t* OUT = (bf16_t*)(A.ws + (KPART ? WS_MK : WS_MQ)) + 8 * lane;
    const int c0 = KPART * 512 + 8 * lane, hh = lane >> 4;
    float w[4][8], bb[8];
#pragma unroll
    for (int j = 0; j < 4; ++j)
#pragma unroll
        for (int i = 0; i < 8; ++i) w[j][i] = A.conv_w[j * 1024 + c0 + i];
#pragma unroll
    for (int i = 0; i < 8; ++i) bb[i] = A.conv_b[c0 + i];
    for (int m = gw; m < MROWS; m += NGW) {
        const int t = m & (SEQ - 1), b = m / SEQ;
        float acc[8];
#pragma unroll
        for (int i = 0; i < 8; ++i) acc[i] = bb[i];
#pragma unroll
        for (int j = 0; j < 4; ++j) { if (t - 3 + j >= 0) { float f[8]; unpack8(*(const u32x4*)(PROJ + (size_t)(m - 3 + j) * PROJ_LD), f);
#pragma unroll
                for (int i = 0; i < 8; ++i) acc[i] = fmaf(w[j][i], f[i], acc[i]); } }
        float sc;
        if (KPART) { const int bh = b * MH + hh; sc = exp2f(((const float*)(A.ws + WS_A2))[(size_t)bh * SEQ + t] - ((const float*)(A.ws + WS_AREF))[bh * SEQ + (t >> 6)]); }
        else sc = 0.08838834764831845f;
#pragma unroll
        for (int i = 0; i < 8; ++i) acc[i] = acc[i] * sigmoidf_(acc[i]) * sc;
        *(u32x4*)(OUT + (size_t)m * 512) = pack8f(acc);
    }
}
__device__ __forceinline__ void mlstm_out_rows(const Args& A, int gw, int NGW, int lane) {
    const bf16_t* HB = (const bf16_t*)(A.ws + WS_HB) + 16 * lane;
    const bf16_t* MO = (const bf16_t*)(A.ws + WS_R1) + PC_MO + 16 * lane;
    bf16_t* MIX = (bf16_t*)(A.ws + WS_R2) + 1024 + 16 * lane;
    float ow[16];
#pragma unroll
    for (int i = 0; i < 16; ++i) ow[i] = A.out_norm_w[16 * lane + i];
    for (int m = gw; m < MROWS; m += NGW) {
        float h[16], g[16];
        { float f[8]; unpack8(*(const u32x4*)(HB + (size_t)m * 1024), f);
#pragma unroll
          for (int i = 0; i < 8; ++i) h[i] = f[i];
          unpack8(*(const u32x4*)(HB + (size_t)m * 1024 + 8), f);
#pragma unroll
          for (int i = 0; i < 8; ++i) h[8 + i] = f[i];
          unpack8(*(const u32x4*)(MO + (size_t)m * PROJ_LD), f);
#pragma unroll
          for (int i = 0; i < 8; ++i) g[i] = f[i];
          unpack8(*(const u32x4*)(MO + (size_t)m * PROJ_LD + 8), f);
#pragma unroll
          for (int i = 0; i < 8; ++i) g[8 + i] = f[i]; }
        float s = 0.f;
#pragma unroll
        for (int i = 0; i < 16; ++i) s += h[i] * h[i];
        s += __shfl_xor(s, 1); s += __shfl_xor(s, 2); s += __shfl_xor(s, 4); s += __shfl_xor(s, 8);
        const float rs = 1.f / sqrtf(s * (1.f / 256.f) + EPS);
        float o[8];
#pragma unroll
        for (int i = 0; i < 8; ++i) o[i] = h[i] * rs * ow[i] * sigmoidf_(g[i]);
        *(u32x4*)(MIX + (size_t)m * DM) = pack8f(o);
#pragma unroll
        for (int i = 0; i < 8; ++i) o[i] = h[8 + i] * rs * ow[8 + i] * sigmoidf_(g[8 + i]);
        *(u32x4*)(MIX + (size_t)m * DM + 8) = pack8f(o);
    }
}
__device__ __forceinline__ fa::BlockRef p3_mblock(const Args& A, int w, int i) {
    const int x = w & 15, g = w >> 4; fa::BlockRef r; const int b = g / MH, h = g % MH; const size_t row0 = (size_t)b * SEQ;
    r.Q = (const fa::bf16*)(A.ws + WS_MQ) + row0 * 512 + h * 128; r.K = (const fa::bf16*)(A.ws + WS_MK) + row0 * 512 + h * 128;
    r.V = (const fa::bf16*)(A.ws + WS_R1) + row0 * PROJ_LD + PC_MV + h * 256 + i * 128; r.O = (fa::bf16*)(A.ws + WS_HB) + row0 * 1024 + h * 256 + i * 128;
    r.aux = (const float*)(A.ws + WS_M2) + (size_t)g * SEQ; r.P0 = x * 256; return r;
}
__device__ __forceinline__ fa::BlockRef p3_fblock(const Args& A, int w, int i) {
    const int x = w & 15, g = w >> 4; fa::BlockRef r; const int bh = 2 * g + i, b = bh / AH, h = bh % AH; const size_t row0 = (size_t)b * SEQ;
    const fa::bf16* PROJ = (const fa::bf16*)(A.ws + WS_R1) + row0 * PROJ_LD + h * 128;
    r.Q = PROJ + PC_AQ; r.K = PROJ + PC_AK; r.V = PROJ + PC_AV; r.O = (fa::bf16*)(A.ws + WS_R2) + row0 * DM + h * 128;
    r.aux = (const float*)(A.ws + WS_CK) + (size_t)bh * SEQ; r.P0 = (15 - x) * 256; return r;
}

#ifndef ONLY
#define ONLY -1
#endif
#ifndef REP0
#define REP0 1
#endif
#ifndef REP1
#define REP1 1
#endif
#ifndef REP3
#define REP3 1
#endif
#ifndef REP6
#define REP6 1
#endif
#ifndef REP2B
#define REP2B 1
#endif
#ifndef REP4
#define REP4 1
#endif
#ifndef XSYNC
#define XSYNC 0
#endif
#ifndef REP5
#define REP5 1
#endif
#ifndef REP2A
#define REP2A 1
#endif
#ifndef SKIPMASK
#define SKIPMASK 0
#endif
#define PH(k) if constexpr (ONLY < 0 ? !((SKIPMASK >> (k)) & 1) : ONLY == (k))
template <class T> __device__ __forceinline__ T* as_global(T* p) { return (T*)(__attribute__((address_space(1))) T*)p; }
__device__ __forceinline__ Args load_args() {
#if defined(__HIP_DEVICE_COMPILE__)
    const __attribute__((address_space(4))) Args* ap = (const __attribute__((address_space(4))) Args*)__builtin_amdgcn_kernarg_segment_ptr();
    asm volatile("" : "+s"(ap));
    Args a = *ap;
#define FX(f) a.f = as_global(a.f)
    FX(x); FX(p); FX(w_norm_mix); FX(w_in); FX(fox_f_bias); FX(q_norm_w); FX(k_norm_w); FX(conv_w); FX(conv_b); FX(mi_bias); FX(mf_bias); FX(out_norm_w); FX(w_out); FX(w_norm_ffn);
    FX(w_gate); FX(w_up); FX(w_down); FX(w_norm_ple); FX(w_ple_gate); FX(w_ple_proj); FX(w_ple_post); FX(out); FX(ws);
#undef FX
    return a;
#else
    return Args{};
#endif
}
#define ARGS() load_args()
__global__ void __launch_bounds__(NTHREADS, 2) fwd_megakernel(Args Aunused) {
    extern __shared__ __attribute__((aligned(16))) unsigned char lds[];
    cg::grid_group grid = cg::this_grid();
    LAS unsigned char* ldsl = (LAS unsigned char*)lds;
    const int G = gridDim.x, bx = blockIdx.x, NGW = G * NWAVES;
#define LANEVARS() int tid_ = threadIdx.x; asm volatile("" : "+v"(tid_)); const int lane = tid_ & 63, wave = __builtin_amdgcn_readfirstlane(tid_ >> 6), gw = bx * NWAVES + wave; (void)lane; (void)gw

    if (threadIdx.x < 16) ((volatile LAS unsigned*)(ldsl + 131072))[threadIdx.x] = 0u;
    { unsigned* bw = (unsigned*)(ARGS().ws + WS_BAR); if (bx == 0) for (int i = threadIdx.x; i < XCD_BAR_WORDS; i += NTHREADS) bw[i] = 0u; }
    __syncthreads();
    PH(0) for (int rep = 0; rep < REP0; ++rep) { const Args A = ARGS(); LANEVARS(); p0_prologue(A, ldsl, gw, NGW, lane, wave); }
    grid.sync();
    XcdBarrier xbar = xcd_barrier_post((unsigned*)(ARGS().ws + WS_BAR), (volatile LAS unsigned*)(ldsl + 131072));
#define GRID_BAR() xcd_barrier(xbar)
    for (int rep = 0; rep < XSYNC; ++rep) GRID_BAR();
    PH(1) { const Args A = ARGS(); gate_cols(A, ldsl, bx, G); }
    PH(1) for (int rep = 0; rep < REP1; ++rep) { const Args A = ARGS(); unsigned char* ws = A.ws;
        pg8::Gemm g{(const bf16_t*)(ws + WS_R2), (const bf16_t*)(ws + WS_WIN), MROWS, PROJ_LD, DM}; pg8::StaticOrder S; S.init(MROWS, PROJ_LD, G, bx);
        pg8::EpiProj E{(bf16_t*)(ws + WS_R1), (const float*)(ws + WS_SS) + 3 * MROWS};
        pg8::gemm_phase<pg8::EpiProj, pg8::StaticOrder, true, true>(ldsl, g, S, E);
    }
    PH(10) { const Args A = ARGS(); unsigned char* ws = A.ws; float* SS = (float*)(ws + WS_SS);
        pg8::Gemm g{(const bf16_t*)(ws + WS_R3), (const bf16_t*)(ws + WS_WPP), MROWS, DM, PLE}; pg8::StaticOrder S; S.init(MROWS, DM, G, bx);
        pg8::EpiE E{(bf16_t*)(ws + WS_ERAW), SS};
        pg8::gemm_phase<pg8::EpiE, pg8::StaticOrder, true, true>(ldsl, g, S, E);
    }
    GRID_BAR();
    PH(2) for (int rep = 0; rep < REP2A; ++rep) { const Args A = ARGS(); for (int v = bx; v < NB * AH + NB * MH; v += G) { scan_sequence(A, v, (LAS float*)ldsl); __syncthreads(); } }
    PH(2) { const Args A = ARGS(); LANEVARS(); qk_norm_rows(A, gw, NGW, lane); }
    PH(2) for (int rep = 0; rep < REP2A; ++rep) { const Args A = ARGS(); LANEVARS(); mconv_rows<0>(A, gw, NGW, lane); }
    GRID_BAR();
    PH(2) for (int rep = 0; rep < REP2B; ++rep) { const Args A = ARGS(); LANEVARS(); mconv_rows<1>(A, gw, NGW, lane); }
    GRID_BAR();
    PH(3) for (int rep = 0; rep < REP3; ++rep) for (int w = bx; w < 256; w += G) { const Args A = ARGS();
        fa::Seam S;
#ifndef NO_M1
        { fa::BlockRef c = p3_mblock(A, w, 0); fa::attn_prime<1>(c, (char*)lds, S);
#pragma nounroll
          for (int i = 0; i < 2; ++i) { const fa::BlockRef n = p3_mblock(A, w, 1); fa::attn_block<1>(c, n, (char*)lds, S); c = n; } }
        asm volatile("s_waitcnt vmcnt(0)" ::: "memory"); __syncthreads();
#endif
#ifndef NO_M0
        { fa::BlockRef c = p3_fblock(A, w, 0); fa::attn_prime<0>(c, (char*)lds, S);
#pragma nounroll
          for (int i = 0; i < 2; ++i) { const fa::BlockRef n = p3_fblock(A, w, 1); fa::attn_block<0>(c, n, (char*)lds, S); c = n; } }
#endif
        asm volatile("s_waitcnt vmcnt(0)" ::: "memory");
        __syncthreads();
    }
    GRID_BAR();
    PH(4) for (int rep = 0; rep < REP4; ++rep) { const Args A = ARGS(); LANEVARS(); mlstm_out_rows(A, gw, NGW, lane); }
    GRID_BAR();
    PH(5) for (int rep = 0; rep < REP5; ++rep) { const Args A = ARGS(); unsigned char* ws = A.ws; float* SS = (float*)(ws + WS_SS);
        pg8::Gemm g{(const bf16_t*)(ws + WS_R2), (const bf16_t*)(ws + WS_WO), MROWS, DM, DM}; pg8::StaticOrder S; S.init(MROWS, DM, G, bx);
        pg8::EpiRes<false> E{A.x, (bf16_t*)(ws + WS_R3), SS + MROWS, rep == 0};
        pg8::gemm_phase<pg8::EpiRes<false>, pg8::StaticOrder, true, true>(ldsl, g, S, E);
    }
    GRID_BAR();
    PH(6) for (int rep = 0; rep < REP6; ++rep) { const Args A = ARGS(); unsigned char* ws = A.ws; float* SS = (float*)(ws + WS_SS);
        pg8::Gemm g{(const bf16_t*)(ws + WS_R3), (const bf16_t*)(ws + WS_WGU), MROWS, 2 * DFF, DM}; pg8::StaticOrder S; S.init(MROWS, 2 * DFF, G, bx);
        pg8::EpiSwiGLU E{(bf16_t*)(ws + WS_R1), SS + MROWS};
        pg8::gemm_phase<pg8::EpiSwiGLU, pg8::StaticOrder, true, true>(ldsl, g, S, E);
    }
    GRID_BAR();
    PH(7) { const Args A = ARGS(); unsigned char* ws = A.ws; float* SS = (float*)(ws + WS_SS);
        pg8::Gemm g{(const bf16_t*)(ws + WS_R1), (const bf16_t*)(ws + WS_WD), MROWS, DM, DFF}; pg8::StaticOrder S; S.init(MROWS, DM, G, bx);
        pg8::EpiRes<true> E{(const void*)(ws + WS_R3), (bf16_t*)(ws + WS_R2), SS + 2 * MROWS, 1};
        pg8::gemm_phase<pg8::EpiRes<true>, pg8::StaticOrder, true, true>(ldsl, g, S, E);
    }
    GRID_BAR();
    PH(8) { const Args A = ARGS(); unsigned char* ws = A.ws; float* SS = (float*)(ws + WS_SS);
        pg8::Gemm g{(const bf16_t*)(ws + WS_R2), (const bf16_t*)(ws + WS_WPG), MROWS, DM, DM}; pg8::StaticOrder S; S.init(MROWS, DM, G, bx);
        pg8::EpiFinal E{A.out, (const bf16_t*)(ws + WS_R2), (const bf16_t*)(ws + WS_ERAW), A.w_ple_post, SS + 2 * MROWS, SS};
        pg8::gemm_phase<pg8::EpiFinal, pg8::StaticOrder, true, true>(ldsl, g, S, E);
    }
}

extern "C" void kernel_launch(void* const* d_in, const int* in_sizes, int n_in, void* d_out, int out_size, void* d_ws, size_t ws_size, hipStream_t stream) {
    static int grid = 0;
    if (grid == 0) {
        if (n_in != 21 || in_sizes[0] != MROWS * DM || out_size != MROWS * DM || ws_size < WS_END) {
            fprintf(stderr, "kernel_launch: unexpected shapes (n_in %d, in0 %d, out %d, ws %zu; need ws >= %zu)\n", n_in, n_in > 0 ? in_sizes[0] : -1, out_size, ws_size, (size_t)WS_END); grid = -1; return; }
        int dev = 0, cus = 0, per_cu = 0;
        (void)hipGetDevice(&dev); (void)hipDeviceGetAttribute(&cus, hipDeviceAttributeMultiprocessorCount, dev);
        if (hipFuncSetAttribute((const void*)fwd_megakernel, hipFuncAttributeMaxDynamicSharedMemorySize, LDS_BYTES) != hipSuccess) { fprintf(stderr, "kernel_launch: hipFuncSetAttribute failed\n"); grid = -1; return; }
        if (hipOccupancyMaxActiveBlocksPerMultiprocessor(&per_cu, (const void*)fwd_megakernel, NTHREADS, LDS_BYTES) != hipSuccess || per_cu < 1) { fprintf(stderr, "kernel_launch: occupancy query says %d blocks per CU\n", per_cu); per_cu = 1; }
        (void)hipGetLastError();
        if (per_cu > 1) per_cu = 1;
        grid = cus * per_cu;
    }
    if (grid < 0) return;
    Args a{};
    a.x = (const float*)d_in[0]; a.p = (const float*)d_in[1]; a.w_norm_mix = (const float*)d_in[2]; a.w_in = (const float*)d_in[3]; a.fox_f_bias = (const float*)d_in[4];
    a.q_norm_w = (const float*)d_in[5]; a.k_norm_w = (const float*)d_in[6]; a.conv_w = (const float*)d_in[7]; a.conv_b = (const float*)d_in[8]; a.mi_bias = (const float*)d_in[9];
    a.mf_bias = (const float*)d_in[10]; a.out_norm_w = (const float*)d_in[11]; a.w_out = (const float*)d_in[12]; a.w_norm_ffn = (const float*)d_in[13]; a.w_gate = (const float*)d_in[14];
    a.w_up = (const float*)d_in[15]; a.w_down = (const float*)d_in[16]; a.w_norm_ple = (const float*)d_in[17]; a.w_ple_gate = (const float*)d_in[18]; a.w_ple_proj = (const float*)d_in[19];
    a.w_ple_post = (const float*)d_in[20];
    a.out = (float*)d_out; a.ws = (unsigned char*)d_ws;
    void* args[] = {&a};
    hipError_t e = hipLaunchCooperativeKernel((const void*)fwd_megakernel, dim3(grid), dim3(NTHREADS), args, LDS_BYTES, stream);
    if (e != hipSuccess) fprintf(stderr, "kernel_launch: cooperative launch failed: %s (grid %d)\n", hipGetErrorString(e), grid);
}
```

```cpp
#include <hip/hip_runtime.h>
#include <hip/hip_cooperative_groups.h>
#include <hip/hip_bf16.h>
#include <cstdio>
#include <cstdint>
namespace cg = cooperative_groups;

constexpr int NB = 4, SEQ = 4096, DM = 2048, MROWS = NB * SEQ;
constexpr int PLE = 256, AH = 8, MH = 4, DFF = 5632, INC = 6160;
constexpr int PROJ_LD = 6144, NIN = 6400;
constexpr int PC_AQ = 0, PC_AK = 1024, PC_AV = 2048, PC_MQ = 3072, PC_MK = 3584, PC_MV = 4096, PC_MO = 5120;
constexpr float EPS = 1e-6f;
constexpr float LOG2E = 1.4426950408889634f;

typedef unsigned short bf16_t;
typedef float f32x4 __attribute__((ext_vector_type(4)));
typedef float f32x2 __attribute__((ext_vector_type(2)));
typedef unsigned u32x4 __attribute__((ext_vector_type(4)));
typedef unsigned u32x2 __attribute__((ext_vector_type(2)));
typedef __bf16 bf16x2_t __attribute__((ext_vector_type(2)));
__device__ __forceinline__ unsigned cvtpk2(float lo, float hi) { f32x2 v = {lo, hi}; bf16x2_t b = __builtin_convertvector(v, bf16x2_t); return __builtin_bit_cast(unsigned, b); }
__device__ __forceinline__ float bflo(unsigned w) { return __uint_as_float(w << 16); }
__device__ __forceinline__ float bfhi(unsigned w) { return __uint_as_float(w & 0xffff0000u); }
__device__ __forceinline__ float sigmoidf_(float x) { return __builtin_amdgcn_rcpf(1.f + __expf(-x)); }
namespace pg8 {
#define PG8_LAS __attribute__((address_space(3)))
typedef unsigned short bf16_t;
typedef short bf16x8 __attribute__((ext_vector_type(8)));
typedef float f32x4 __attribute__((ext_vector_type(4)));
typedef unsigned u32x4 __attribute__((ext_vector_type(4)));
constexpr int BM = 256, BK = 64, HALF = 128, HTB = HALF * BK * 2  , STAGE_BYTES = 8 * HTB, NXCD = 8, WGM = 8;

__host__ __device__ __forceinline__ int lds_byte(int r, int c) { const int st = (r >> 4) * 2 + (c >> 5), rr = r & 15, cc = c & 31, ob = rr * 64 + cc * 2; return st * 1024 + (ob ^ (((ob >> 9) & 1) << 5)); }
__host__ __device__ __forceinline__ void stage_rc(int b, int& R, int& C) { const int st = b / 1024, sb = b % 1024, swz = sb ^ (((sb >> 9) & 1) << 5); R = (st >> 1) * 16 + swz / 64; C = (st & 1) * 32 + (swz % 64) / 2; }
__host__ __device__ __forceinline__ int perm32(int rho) { const int n = rho >> 4, i = rho & 15; return 8 * (i >> 2) + 4 * n + (i & 3); }

struct Unit { int pm, pn; };
struct Gemm { const bf16_t* A; const bf16_t* Bt; int M, N, K; };

struct StaticOrder {
    int nM, nN, nwg, G, c;
    __host__ __device__ void init(int M, int N, int G_, int c_) { nM = M / BM; nN = N / BM; nwg = nM * nN; G = G_; c = c_; }
    __host__ __device__ bool next(int i, Unit& u) const {
        const long L = (long)i * G + c; if (L >= nwg) return false;
        int wgid = (int)L; { const int q = nwg / NXCD, r = nwg % NXCD, xcd = wgid % NXCD, off = wgid / NXCD; wgid = (xcd < r ? xcd * (q + 1) : r * (q + 1) + (xcd - r) * q) + off; }
        const int nig = WGM * nN, gid = wgid / nig, fm = gid * WGM, gsz = (nM - fm) < WGM ? (nM - fm) : WGM;
        u.pm = fm + ((wgid % nig) % gsz); u.pn = (wgid % nig) / gsz; return true;
    }
    __device__ __forceinline__ void a_ready(const Unit&) const {}
    __device__ __forceinline__ void done(const Unit&) const {}
};
__device__ __forceinline__ unsigned cvt_pk_bf16(float lo, float hi) { return ::cvtpk2(lo, hi); }
__device__ __forceinline__ float sumsq4(f32x4 v) { return (v[0] * v[0] + v[1] * v[1]) + (v[2] * v[2] + v[3] * v[3]); }
__device__ __forceinline__ void atomic_add_f32(float* p, float v) { __hip_atomic_fetch_add(p, v, __ATOMIC_RELAXED, __HIP_MEMORY_SCOPE_AGENT); }

__device__ __forceinline__ void zero_acc(f32x4 (&acc)[2][2][4][2]) {
#pragma unroll
    for (int a = 0; a < 2; ++a)
#pragma unroll
        for (int b = 0; b < 2; ++b)
#pragma unroll
            for (int m = 0; m < 4; ++m)
#pragma unroll
                for (int n = 0; n < 2; ++n) acc[a][b][m][n] = (f32x4){0.f, 0.f, 0.f, 0.f};
}
#define PG8_ZERO_INIT __device__ __forceinline__ void init(f32x4 (&acc)[2][2][4][2], const Unit&, int, int, int, int) const { zero_acc(acc); }

struct EpiProj {
    static constexpr bool PERM = true, AFTER_DRAIN = false;
    PG8_ZERO_INIT
    bf16_t* O; const float* ss0;
    __device__ __forceinline__ void operator()(const f32x4 (&acc)[2][2][4][2], const Unit& u, int wr, int wc, int fr, int fq) const {
        const int row0 = u.pm * BM + wr * 64 + fr, col0 = u.pn * BM + wc * 32 + 8 * fq;
#pragma unroll
        for (int ai = 0; ai < 2; ++ai)
#pragma unroll
            for (int m = 0; m < 4; ++m) { const int row = row0 + ai * HALF + m * 16; const float rs = __builtin_amdgcn_rsqf(ss0[row] * (1.f / 2048.f) + 1e-6f); bf16_t* rowp = O + (size_t)row * 6144 + col0;
#pragma unroll
                for (int bj = 0; bj < 2; ++bj) { const f32x4 v0 = acc[ai][bj][m][0] * rs, v1 = acc[ai][bj][m][1] * rs;
                    u32x4 w; w.x = cvt_pk_bf16(v0[0], v0[1]); w.y = cvt_pk_bf16(v0[2], v0[3]); w.z = cvt_pk_bf16(v1[0], v1[1]); w.w = cvt_pk_bf16(v1[2], v1[3]);
                    *(u32x4*)(rowp + bj * HALF) = w; } }
    }
};
struct EpiE {
    static constexpr bool PERM = true, AFTER_DRAIN = false;
    PG8_ZERO_INIT
    bf16_t* O; float* ss;
    __device__ __forceinline__ void operator()(const f32x4 (&acc)[2][2][4][2], const Unit& u, int wr, int wc, int fr, int fq) const {
        const int row0 = u.pm * BM + wr * 64 + fr, col0 = u.pn * BM + wc * 32 + 8 * fq;
#pragma unroll
        for (int ai = 0; ai < 2; ++ai)
#pragma unroll
            for (int m = 0; m < 4; ++m) { const int row = row0 + ai * HALF + m * 16; bf16_t* rowp = O + (size_t)row * 2048 + col0; float s = 0.f;
#pragma unroll
                for (int bj = 0; bj < 2; ++bj) { const f32x4 v0 = acc[ai][bj][m][0], v1 = acc[ai][bj][m][1]; s += sumsq4(v0) + sumsq4(v1);
                    u32x4 w; w.x = cvt_pk_bf16(v0[0], v0[1]); w.y = cvt_pk_bf16(v0[2], v0[3]); w.z = cvt_pk_bf16(v1[0], v1[1]); w.w = cvt_pk_bf16(v1[2], v1[3]);
                    *(u32x4*)(rowp + bj * HALF) = w; }
                s += __shfl_xor(s, 16); s += __shfl_xor(s, 32);
                if (fq == 0) atomic_add_f32(ss + row, s); }
    }
};
template <bool XINB> struct EpiRes {
    static constexpr bool PERM = true, AFTER_DRAIN = false;
    const void* xin; bf16_t* xout; float* ss; int live;
    __device__ __forceinline__ void init(f32x4 (&acc)[2][2][4][2], const Unit& u, int wr, int wc, int fr, int fq) const {
        const int row0 = u.pm * BM + wr * 64 + fr, col0 = u.pn * BM + wc * 32 + 8 * fq;
#pragma unroll
        for (int ai = 0; ai < 2; ++ai)
#pragma unroll
            for (int m = 0; m < 4; ++m) { const size_t off = (size_t)(row0 + ai * HALF + m * 16) * 2048 + col0;
#pragma unroll
                for (int bj = 0; bj < 2; ++bj) {
                    if constexpr (XINB) { const u32x4 w = *(const u32x4*)((const bf16_t*)xin + off + bj * HALF);
                        acc[ai][bj][m][0] = (f32x4){::bflo(w.x), ::bfhi(w.x), ::bflo(w.y), ::bfhi(w.y)}; acc[ai][bj][m][1] = (f32x4){::bflo(w.z), ::bfhi(w.z), ::bflo(w.w), ::bfhi(w.w)}; }
                    else { const float* rp = (const float*)xin + off + bj * HALF; acc[ai][bj][m][0] = *(const f32x4*)rp; acc[ai][bj][m][1] = *(const f32x4*)(rp + 4); } } }
    }
    __device__ __forceinline__ void operator()(const f32x4 (&acc)[2][2][4][2], const Unit& u, int wr, int wc, int fr, int fq) const {
        if (!live) {
#pragma unroll
            for (int ai = 0; ai < 2; ++ai)
#pragma unroll
                for (int m = 0; m < 4; ++m)
#pragma unroll
                    for (int bj = 0; bj < 2; ++bj)
#pragma unroll
                        for (int n = 0; n < 2; ++n) asm volatile("" :: "v"(acc[ai][bj][m][n]));
            return; }
        const int row0 = u.pm * BM + wr * 64 + fr, col0 = u.pn * BM + wc * 32 + 8 * fq;
#pragma unroll
        for (int ai = 0; ai < 2; ++ai)
#pragma unroll
            for (int m = 0; m < 4; ++m) { const int row = row0 + ai * HALF + m * 16; bf16_t* rowp = xout + (size_t)row * 2048 + col0; float s = 0.f;
#pragma unroll
                for (int bj = 0; bj < 2; ++bj) { const f32x4 v0 = acc[ai][bj][m][0], v1 = acc[ai][bj][m][1]; s += sumsq4(v0) + sumsq4(v1);
                    u32x4 w; w.x = cvt_pk_bf16(v0[0], v0[1]); w.y = cvt_pk_bf16(v0[2], v0[3]); w.z = cvt_pk_bf16(v1[0], v1[1]); w.w = cvt_pk_bf16(v1[2], v1[3]);
                    *(u32x4*)(rowp + bj * HALF) = w; }
                s += __shfl_xor(s, 16); s += __shfl_xor(s, 32);
                if (fq == 0) atomic_add_f32(ss + row, s); }
    }
};
struct EpiSwiGLU {
    static constexpr bool PERM = true, AFTER_DRAIN = false;
    PG8_ZERO_INIT
    bf16_t* O; const float* ss;
    __device__ __forceinline__ void operator()(const f32x4 (&acc)[2][2][4][2], const Unit& u, int wr, int wc, int fr, int fq) const {
        const int row0 = u.pm * BM + wr * 64 + fr, col0 = u.pn * HALF + wc * 32 + 8 * fq;
#pragma unroll
        for (int ai = 0; ai < 2; ++ai)
#pragma unroll
            for (int m = 0; m < 4; ++m) { const int row = row0 + ai * HALF + m * 16; const float rs = __builtin_amdgcn_rsqf(ss[row] * (1.f / 2048.f) + 1e-6f);
                float r[8];
#pragma unroll
                for (int n = 0; n < 2; ++n)
#pragma unroll
                    for (int e = 0; e < 4; ++e) { const float g = acc[ai][0][m][n][e] * rs, up = acc[ai][1][m][n][e] * rs; r[n * 4 + e] = g * __builtin_amdgcn_rcpf(1.f + __expf(-g)) * up; }
                u32x4 w; w.x = cvt_pk_bf16(r[0], r[1]); w.y = cvt_pk_bf16(r[2], r[3]); w.z = cvt_pk_bf16(r[4], r[5]); w.w = cvt_pk_bf16(r[6], r[7]);
                *(u32x4*)(O + (size_t)row * 5632 + col0) = w; }
    }
};
struct EpiFinal {
    static constexpr bool PERM = true, AFTER_DRAIN = false;
    PG8_ZERO_INIT
    float* out; const bf16_t* x2; const bf16_t* eraw; const float* wpost; const float* ss2; const float* ssE;
    __device__ __forceinline__ void operator()(const f32x4 (&acc)[2][2][4][2], const Unit& u, int wr, int wc, int fr, int fq) const {
        const int row0 = u.pm * BM + wr * 64 + fr, col0 = u.pn * BM + wc * 32 + 8 * fq;
        f32x4 wv[2][2];
#pragma unroll
        for (int bj = 0; bj < 2; ++bj)
#pragma unroll
            for (int n = 0; n < 2; ++n) wv[bj][n] = *(const f32x4*)(wpost + col0 + bj * HALF + n * 4);
#pragma unroll
        for (int ai = 0; ai < 2; ++ai)
#pragma unroll
            for (int m = 0; m < 4; ++m) { const int row = row0 + ai * HALF + m * 16; const size_t off = (size_t)row * 2048 + col0;
                const float rs = __builtin_amdgcn_rsqf(ss2[row] * (1.f / 2048.f) + 1e-6f), re = __builtin_amdgcn_rsqf(ssE[row] * (1.f / 2048.f) + 1e-6f);
#pragma unroll
                for (int bj = 0; bj < 2; ++bj) { const size_t o2 = off + bj * HALF; const u32x4 xw = *(const u32x4*)(x2 + o2), ew = *(const u32x4*)(eraw + o2);
                    const f32x4 xa = {::bflo(xw.x), ::bfhi(xw.x), ::bflo(xw.y), ::bfhi(xw.y)}, xb = {::bflo(xw.z), ::bfhi(xw.z), ::bflo(xw.w), ::bfhi(xw.w)};
                    f32x4 ea = {::bflo(ew.x), ::bfhi(ew.x), ::bflo(ew.y), ::bfhi(ew.y)}, eb = {::bflo(ew.z), ::bfhi(ew.z), ::bflo(ew.w), ::bfhi(ew.w)};
                    ea = ea * re * wv[bj][0]; eb = eb * re * wv[bj][1];
                    const f32x4 a0 = acc[ai][bj][m][0] * rs, a1 = acc[ai][bj][m][1] * rs; f32x4 o0, o1;
#pragma unroll
                    for (int e = 0; e < 4; ++e) { o0[e] = xa[e] + ::sigmoidf_(a0[e]) * ea[e]; o1[e] = xb[e] + ::sigmoidf_(a1[e]) * eb[e]; }
                    *(f32x4*)(out + o2) = o0; *(f32x4*)(out + o2 + 4) = o1; } }
    }
};
template <class Epi, class Sched, bool ALIGN_EPI = false, bool SP2 = false>
__device__ __forceinline__ void gemm_phase(PG8_LAS unsigned char* lds, const Gemm g, const Sched& S, const Epi& E) {
    int tid0_ = threadIdx.x; asm volatile("" : "+v"(tid0_));
    const int tid = tid0_, wid = __builtin_amdgcn_readfirstlane(tid >> 6), lane = tid & 63, wr = wid >> 2, wc = wid & 3, fr = lane & 15, fq = lane >> 4;
    int K0_ = g.K; asm volatile("" : "+s"(K0_));
    const int K = K0_, nt = K / BK;
    unsigned voffA[2], voffB[2];
#pragma unroll
    for (int i = 0; i < 2; ++i) { int R, C; stage_rc(tid * 16 + i * 8192, R, C); const int Rb = Epi::PERM ? ((R & ~31) + perm32(R & 31)) : R;
        voffA[i] = (unsigned)(R * K + C) * 2u; voffB[i] = (unsigned)(Rb * K + C) * 2u; }
    const size_t kstep = (size_t)(BK * 2);
    const size_t hstep = (size_t)HALF * K * 2;
    const size_t tstep = 2 * hstep;
    const unsigned ldsw = (unsigned)wid * 1024u;
    const int aoff = lds_byte(wr * 64 + fr, fq * 8), boff = lds_byte(wc * 32 + fr, fq * 8);
#define PG8_SA(b, h) (((b) * 2 + (h)) * HTB)
#define PG8_SB(b, h) ((4 + (b) * 2 + (h)) * HTB)
#define PG8_STAGE(bufoff, gbase, voff) do { _Pragma("unroll") for (int _i = 0; _i < 2; ++_i) \
        __builtin_amdgcn_global_load_lds((const unsigned*)((const char*)(gbase) + (voff)[_i]), (PG8_LAS unsigned*)(lds + (bufoff) + ldsw + _i * 8192), 16, 0, 0); } while (0)
#define PG8_LDA(dst, b, h) do { _Pragma("unroll") for (int m = 0; m < 4; ++m) _Pragma("unroll") for (int k = 0; k < 2; ++k) dst[m][k] = *(const PG8_LAS bf16x8*)(lds + PG8_SA(b, h) + aoff + m * 2048 + k * 1024); } while (0)
#define PG8_LDB(dst, b, h) do { _Pragma("unroll") for (int n = 0; n < 2; ++n) _Pragma("unroll") for (int k = 0; k < 2; ++k) dst[n][k] = *(const PG8_LAS bf16x8*)(lds + PG8_SB(b, h) + boff + n * 2048 + k * 1024); } while (0)
#define PG8_MMA(ai, bj, At, Bt) do { __builtin_amdgcn_s_setprio(1); _Pragma("unroll") for (int m = 0; m < 4; ++m) _Pragma("unroll") for (int n = 0; n < 2; ++n) _Pragma("unroll") for (int k = 0; k < 2; ++k) \
        acc[ai][bj][m][n] = __builtin_amdgcn_mfma_f32_16x16x32_bf16(Bt[n][k], At[m][k], acc[ai][bj][m][n], 0, 0, 0); __builtin_amdgcn_s_setprio(0); } while (0)
#define PG8_WAIT_V(n) asm volatile("s_waitcnt vmcnt(" #n ")" ::: "memory")
#define PG8_WAIT_L(n) asm volatile("s_waitcnt lgkmcnt(" #n ")" ::: "memory")
#define PG8_BAR __builtin_amdgcn_s_barrier()
#define PG8_SCHED __builtin_amdgcn_sched_barrier(0)
    Unit cur, nxt; int ui = 0;
    if (!S.next(0, cur)) return;
    f32x4 acc[2][2][4][2];
    E.init(acc, cur, wr, wc, fr, fq);
    bf16x8 At[4][2], B0[2][2], B1[2][2];
    const char* cA = (const char*)g.A + (size_t)cur.pm * tstep; const char* cB = (const char*)g.Bt + (size_t)cur.pn * tstep;
    S.a_ready(cur);
    if constexpr (SP2) {
        PG8_STAGE(PG8_SB(0, 0), cB, voffB); PG8_STAGE(PG8_SB(0, 1), cB + hstep, voffB); PG8_STAGE(PG8_SA(0, 0), cA, voffA); PG8_STAGE(PG8_SA(0, 1), cA + hstep, voffA);
        if (wr == 1) PG8_BAR;
        PG8_WAIT_V(2); PG8_BAR;
        PG8_STAGE(PG8_SB(1, 0), cB + kstep, voffB); PG8_STAGE(PG8_SA(1, 0), cA + kstep, voffA); PG8_STAGE(PG8_SB(1, 1), cB + hstep + kstep, voffB);
        PG8_WAIT_V(6); PG8_BAR;
    } else {
        PG8_STAGE(PG8_SB(0, 0), cB, voffB); PG8_STAGE(PG8_SA(0, 0), cA, voffA); PG8_STAGE(PG8_SB(0, 1), cB + hstep, voffB); PG8_STAGE(PG8_SA(0, 1), cA + hstep, voffA);
        if (wr == 1) PG8_BAR;
        PG8_WAIT_V(4); PG8_BAR;
        PG8_STAGE(PG8_SB(1, 0), cB + kstep, voffB); PG8_STAGE(PG8_SA(1, 0), cA + kstep, voffA); PG8_STAGE(PG8_SB(1, 1), cB + hstep + kstep, voffB);
        PG8_WAIT_V(6); PG8_BAR;
    }
    for (;;) {
        const bool has_next = S.next(ui + 1, nxt);
        const char* nA = has_next ? (const char*)g.A + (size_t)nxt.pm * tstep : cA; const char* nB = has_next ? (const char*)g.Bt + (size_t)nxt.pn * tstep : cB;
        for (int t = 0; t < nt; t += 2) {
            const bool last = (t == nt - 2);
            const char* a1 = cA + (size_t)(t + 1) * kstep;
            const char* a2 = last ? nA : cA + (size_t)(t + 2) * kstep; const char* b2 = last ? nB : cB + (size_t)(t + 2) * kstep;
            const char* a3 = a2 + kstep; const char* b3 = b2 + kstep;
            if (last && has_next) S.a_ready(nxt);
            if constexpr (SP2) {
            PG8_LDB(B0, 0, 0); PG8_LDB(B1, 0, 1); PG8_SCHED; PG8_LDA(At, 0, 0); PG8_STAGE(PG8_SA(1, 1), a1 + hstep, voffA);
            PG8_WAIT_V(8); PG8_WAIT_L(0); PG8_BAR; PG8_MMA(0, 0, At, B0); PG8_MMA(0, 1, At, B1); PG8_BAR; PG8_SCHED;
            PG8_LDA(At, 0, 1); PG8_STAGE(PG8_SB(0, 0), b2, voffB); PG8_STAGE(PG8_SB(0, 1), b2 + hstep, voffB); PG8_STAGE(PG8_SA(0, 0), a2, voffA);
            PG8_WAIT_V(8); PG8_WAIT_L(0); PG8_BAR; PG8_MMA(1, 0, At, B0); PG8_MMA(1, 1, At, B1); PG8_BAR; PG8_SCHED;
            PG8_LDB(B0, 1, 0); PG8_LDB(B1, 1, 1); PG8_SCHED; PG8_LDA(At, 1, 0); PG8_STAGE(PG8_SA(0, 1), a2 + hstep, voffA);
            PG8_WAIT_V(8); PG8_WAIT_L(0); PG8_BAR; PG8_MMA(0, 0, At, B0); PG8_MMA(0, 1, At, B1); PG8_BAR; PG8_SCHED;
            PG8_LDA(At, 1, 1); PG8_STAGE(PG8_SB(1, 0), b3, voffB); PG8_STAGE(PG8_SB(1, 1), b3 + hstep, voffB); PG8_STAGE(PG8_SA(1, 0), a3, voffA);
            PG8_WAIT_V(8); PG8_WAIT_L(0); PG8_BAR; PG8_MMA(1, 0, At, B0); PG8_MMA(1, 1, At, B1); PG8_BAR; PG8_SCHED;
            } else {
            PG8_LDB(B0, 0, 0); PG8_SCHED; PG8_LDA(At, 0, 0); PG8_STAGE(PG8_SA(1, 1), a1 + hstep, voffA);
            PG8_WAIT_L(8); PG8_BAR; PG8_WAIT_L(0); PG8_MMA(0, 0, At, B0); PG8_BAR; PG8_SCHED;
            PG8_LDB(B1, 0, 1); PG8_STAGE(PG8_SB(0, 0), b2, voffB);
            PG8_BAR; PG8_WAIT_L(0); PG8_MMA(0, 1, At, B1); PG8_BAR;
            PG8_LDA(At, 0, 1); PG8_STAGE(PG8_SA(0, 0), a2, voffA);
            PG8_BAR; PG8_WAIT_L(0); PG8_MMA(1, 0, At, B0); PG8_BAR; PG8_SCHED;
            PG8_STAGE(PG8_SB(0, 1), b2 + hstep, voffB);
            PG8_WAIT_V(6); PG8_BAR; PG8_MMA(1, 1, At, B1); PG8_BAR;
            PG8_LDB(B0, 1, 0); PG8_SCHED; PG8_LDA(At, 1, 0); PG8_STAGE(PG8_SA(0, 1), a2 + hstep, voffA);
            PG8_WAIT_L(8); PG8_BAR; PG8_WAIT_L(0); PG8_MMA(0, 0, At, B0); PG8_BAR; PG8_SCHED;
            PG8_LDB(B1, 1, 1); PG8_STAGE(PG8_SB(1, 0), b3, voffB);
            PG8_BAR; PG8_WAIT_L(0); PG8_MMA(0, 1, At, B1); PG8_BAR;
            PG8_LDA(At, 1, 1); PG8_STAGE(PG8_SA(1, 0), a3, voffA);
            PG8_BAR; PG8_WAIT_L(0); PG8_MMA(1, 0, At, B0); PG8_BAR; PG8_SCHED;
            PG8_STAGE(PG8_SB(1, 1), b3 + hstep, voffB);
            PG8_WAIT_V(6); PG8_BAR; PG8_MMA(1, 1, At, B1); PG8_BAR;
            }
        }
        if constexpr (ALIGN_EPI) { if (wr == 0) PG8_BAR; }
        if constexpr (!Epi::AFTER_DRAIN) { E(acc, cur, wr, wc, fr, fq); S.done(cur); }
        if (!has_next) break;
        E.init(acc, nxt, wr, wc, fr, fq);
        cur = nxt; cA = nA; cB = nB; ++ui;
        if constexpr (ALIGN_EPI) { if (wr == 1) PG8_BAR; }
    }
    PG8_WAIT_V(0);
    if constexpr (!ALIGN_EPI) { if (wr == 0) PG8_BAR; }
    PG8_BAR;
    if constexpr (Epi::AFTER_DRAIN) { E.fused(acc, cur, wr, wc, fr, fq, lds, wid, lane); S.done(cur); }
#undef PG8_SA
#undef PG8_SB
#undef PG8_STAGE
#undef PG8_LDA
#undef PG8_LDB
#undef PG8_MMA
#undef PG8_WAIT_V
#undef PG8_WAIT_L
#undef PG8_BAR
#undef PG8_SCHED
}
}
namespace fa {
using bf16 = __hip_bfloat16;
typedef short bf16x8 __attribute__((ext_vector_type(8)));
typedef short s16x4 __attribute__((ext_vector_type(4)));
typedef float f32x16 __attribute__((ext_vector_type(16)));
constexpr int D = 128, NW = 8, QBLK = 32, KVBLK = 64, QB = NW * QBLK;
constexpr int SHM_V = KVBLK * D * 2, SHM_K = KVBLK * D * 2;
constexpr int OFF_WS = 2 * SHM_V + 2 * SHM_K, OFF_CK = OFF_WS + NW * 64 * 4, LDS_BYTES = OFF_CK + 2 * 64 * 4;
constexpr float SCALE = 0.08838834764831845f;
constexpr float THR = 8.f;

#define KSWZ(row, colB) ((row) * 256 + ((colB) ^ (((row) & 7) << 4)))
#define SBAR() __builtin_amdgcn_sched_barrier(0)
__device__ __forceinline__ int v_st(int k, int c) { const int kk = (k & ~0xC) | ((k & 4) << 1) | ((k & 8) >> 1); return ((kk >> 3) * 4 + (c >> 5)) * 512 + ((kk & 7) * 32 + (c & 31)) * 2; }
__device__ __forceinline__ int v_rd_base(int lane) { return ((lane & 3) << 3) | (((lane >> 2) & 3) << 6) | (((lane >> 4) & 1) << 5) | (((lane >> 5) & 1) << 8); }
constexpr int v_rd_off(int d0, int ks, int half) { return d0 * 512 + ks * 4096 + half * 2048; }
__device__ __forceinline__ int crow(int r, int hi) { return (r & 3) + 8 * (r >> 2) + 4 * hi; }
__device__ __forceinline__ unsigned cvtpk(float lo, float hi) { return ::cvtpk2(lo, hi); }
__device__ __forceinline__ bf16x8 load8(const bf16* p) { return *reinterpret_cast<const bf16x8*>(p); }
template <int MODE> __device__ __forceinline__ void mask_tile(f32x16& p0, f32x16& p1, int dq) {
    const float NEG = MODE == 0 ? -__builtin_inff() : 0.f;
#pragma unroll
    for (int r = 0; r < 16; ++r) {
        const int c = (r & 3) + 8 * (r >> 2);
        if (dq - c < 0) p0[r] = NEG;
        if (dq - c - 32 < 0) p1[r] = NEG;
    }
}
__device__ __forceinline__ void partialSM(f32x16& p0, f32x16& p1, float& m_reg, float& mn, float& alpha) {
    float pmax = p0[0]; for (int r = 1; r < 16; ++r) pmax = fmaxf(pmax, p0[r]); for (int r = 0; r < 16; ++r) pmax = fmaxf(pmax, p1[r]);
    { auto rr = __builtin_amdgcn_permlane32_swap(__float_as_uint(pmax), __float_as_uint(pmax), false, false);
      pmax = fmaxf(__uint_as_float(rr[0]), __uint_as_float(rr[1])); }
    constexpr float C2 = 1.4426950408889634f * SCALE;
    if (__builtin_expect(__all((pmax - m_reg) * SCALE <= THR), 1)) { mn = m_reg; alpha = 1.f; }
    else { mn = fmaxf(m_reg, pmax); alpha = __builtin_amdgcn_exp2f((m_reg - mn) * C2); m_reg = mn; }
    const float mnL = -mn * C2;
    for (int r = 0; r < 16; ++r) p0[r] = fmaf(p0[r], C2, mnL); for (int r = 0; r < 16; ++r) p1[r] = fmaf(p1[r], C2, mnL);
    for (int r = 0; r < 16; ++r) p0[r] = __builtin_amdgcn_exp2f(p0[r]);
}
#define PK4(P, B_, OUT) do { unsigned a0 = cvtpk(P[B_+0], P[B_+1]), a1 = cvtpk(P[B_+2], P[B_+3]);                          \
        unsigned b0 = cvtpk(P[B_+4], P[B_+5]), b1 = cvtpk(P[B_+6], P[B_+7]);                                             \
        auto r0 = __builtin_amdgcn_permlane32_swap(a0, b0, false, false); auto r1 = __builtin_amdgcn_permlane32_swap(a1, b1, false, false); \
        u32x4 w = {r0[0], r1[0], r0[1], r1[1]}; OUT = *reinterpret_cast<bf16x8*>(&w); } while (0)
__device__ __forceinline__ void finishSM(f32x16& p0, f32x16& p1, float alpha, float& l_reg, bf16x8& pa0, bf16x8& pa1, bf16x8& pa2, bf16x8& pa3) {
    for (int r = 0; r < 16; ++r) p1[r] = __builtin_amdgcn_exp2f(p1[r]);
    float ps = 0; for (int r = 0; r < 16; ++r) ps += p0[r]; for (int r = 0; r < 16; ++r) ps += p1[r];
    { auto rr = __builtin_amdgcn_permlane32_swap(__float_as_uint(ps), __float_as_uint(ps), false, false);
      ps = __uint_as_float(rr[0]) + __uint_as_float(rr[1]); }
    l_reg = l_reg * alpha + ps;
    PK4(p0, 0, pa0); PK4(p0, 8, pa1); PK4(p1, 0, pa2); PK4(p1, 8, pa3);
}
__device__ __forceinline__ void linScale(f32x16& p0, f32x16& p1, float fr) {
    for (int r = 0; r < 16; ++r) p0[r] *= fr; for (int r = 0; r < 16; ++r) p1[r] *= fr;
}
__device__ __forceinline__ void linFinish(f32x16& p0, f32x16& p1, float& l_reg, bf16x8& pa0, bf16x8& pa1, bf16x8& pa2, bf16x8& pa3) {
    float ps = 0; for (int r = 0; r < 16; ++r) ps += p0[r]; for (int r = 0; r < 16; ++r) ps += p1[r];
    { auto rr = __builtin_amdgcn_permlane32_swap(__float_as_uint(ps), __float_as_uint(ps), false, false);
      ps = __uint_as_float(rr[0]) + __uint_as_float(rr[1]); }
    l_reg += ps;
    PK4(p0, 0, pa0); PK4(p0, 8, pa1); PK4(p1, 0, pa2); PK4(p1, 8, pa3);
}
#undef PK4
template <int KB, int MODE>
__device__ __forceinline__ void qkt(f32x16& p0, f32x16& p1, const char* K_lds, const float* ckl, int r32, int hi, const bf16x8* qr) {
    if constexpr (MODE == 0) {
        const float* c = ckl + KB * 64 + 4 * hi;
#pragma unroll
        for (int g = 0; g < 4; ++g) { const f32x4 a = *(const f32x4*)(c + 8 * g), b = *(const f32x4*)(c + 32 + 8 * g);
            p0[4 * g + 0] = a[0]; p0[4 * g + 1] = a[1]; p0[4 * g + 2] = a[2]; p0[4 * g + 3] = a[3];
            p1[4 * g + 0] = b[0]; p1[4 * g + 1] = b[1]; p1[4 * g + 2] = b[2]; p1[4 * g + 3] = b[3]; }
    } else { p0 = f32x16{}; p1 = f32x16{}; }
    const char* kb[4];
#pragma unroll
    for (int dd = 0; dd < 4; ++dd) kb[dd] = K_lds + KB * SHM_K + KSWZ(r32, (dd * 16 + hi * 8) * 2);
#pragma unroll
    for (int d0 = 0; d0 < 8; ++d0) { const char* a = kb[d0 & 3] + (d0 >> 2) * 128;
        bf16x8 b0 = *reinterpret_cast<const bf16x8*>(a);
        bf16x8 b1 = *reinterpret_cast<const bf16x8*>(a + 32 * 256);
        p0 = __builtin_amdgcn_mfma_f32_32x32x16_bf16(b0, qr[d0], p0, 0, 0, 0);
        p1 = __builtin_amdgcn_mfma_f32_32x32x16_bf16(b1, qr[d0], p1, 0, 0, 0); }
}
template <int VB>
__device__ __forceinline__ void pv_tile(f32x16* o, int vb0, bf16x8 pa0, bf16x8 pa1, bf16x8 pa2, bf16x8 pa3) {
#define TRRD(dst, off) asm volatile("ds_read_b64_tr_b16 %0, %1 offset:%2" : "=&v"(dst) : "v"(vb0), "i"(off) : "memory")
#define PV_D0(d0) do { s16x4 l0, l1, l2, l3, h0, h1, h2, h3; constexpr int b_ = VB * SHM_V + v_rd_off(d0, 0, 0);     \
        TRRD(l0, b_); TRRD(h0, b_ + 2048); TRRD(l1, b_ + 4096); TRRD(h1, b_ + 6144); TRRD(l2, b_ + 8192); TRRD(h2, b_ + 10240); TRRD(l3, b_ + 12288); TRRD(h3, b_ + 14336); \
        asm volatile("s_waitcnt lgkmcnt(0)" ::: "memory"); SBAR();                 \
        o[d0] = __builtin_amdgcn_mfma_f32_32x32x16_bf16(pa0, (bf16x8){l0[0], l0[1], l0[2], l0[3], h0[0], h0[1], h0[2], h0[3]}, o[d0], 0, 0, 0);   \
        o[d0] = __builtin_amdgcn_mfma_f32_32x32x16_bf16(pa1, (bf16x8){l1[0], l1[1], l1[2], l1[3], h1[0], h1[1], h1[2], h1[3]}, o[d0], 0, 0, 0);   \
        o[d0] = __builtin_amdgcn_mfma_f32_32x32x16_bf16(pa2, (bf16x8){l2[0], l2[1], l2[2], l2[3], h2[0], h2[1], h2[2], h2[3]}, o[d0], 0, 0, 0);   \
        o[d0] = __builtin_amdgcn_mfma_f32_32x32x16_bf16(pa3, (bf16x8){l3[0], l3[1], l3[2], l3[3], h3[0], h3[1], h3[2], h3[3]}, o[d0], 0, 0, 0); } while (0)
    PV_D0(0); PV_D0(1); PV_D0(2); PV_D0(3);
#undef PV_D0
#undef TRRD
}

struct BlockRef { const bf16* Q; const bf16* K; const bf16* V; bf16* O; const float* aux; int P0; };
constexpr int AUX_MEXP = 65536, AUX_AREF = 131072;
template <int MODE> struct Pitch { static constexpr int qp = MODE ? 512 : 6144, kp = MODE ? 512 : 6144, vp = 6144, op = MODE ? 1024 : 2048; };
struct Seam { bf16x8 qr[8]; bf16x8 st_v0, st_v1, st_k0, st_k1; float st_c; };
#define ROWK(R, PM, k0, rr) ((R).K + (size_t)(k0) * Pitch<PM>::kp + (unsigned)(((rr) * Pitch<PM>::kp) + sc))
#define ROWV(R, PM, k0, rr) ((R).V + (size_t)(k0) * Pitch<PM>::vp + (unsigned)(((rr) * Pitch<PM>::vp) + sc))
#define VMW() asm volatile("s_waitcnt vmcnt(0)" ::: "memory")
#define VMWN(n) asm volatile("s_waitcnt vmcnt(%0)" :: "i"(n) : "memory")
#define SLOAD_H(R, PM, k0) do { S.st_v0 = load8(ROWV(R, PM, k0, sr)); S.st_v1 = load8(ROWV(R, PM, k0, 32 + sr));              \
                         S.st_k0 = load8(ROWK(R, PM, k0, sr)); S.st_k1 = load8(ROWK(R, PM, k0, 32 + sr));                \
                         if constexpr (PM == 0) S.st_c = (R).aux[(k0) + (tid & 63)]; } while (0)
#define SWRITE_HK(bf) do { *(bf16x8*)(K_lds + (bf) * SHM_K + kws) = S.st_k0; *(bf16x8*)(K_lds + (bf) * SHM_K + kws + 32 * 256) = S.st_k1; \
                           if constexpr (MODE == 0) { if (tid < 64) ckl[(bf) * 64 + tid] = S.st_c; } } while (0)
#define SWRITE_HV(bf) do { *(bf16x8*)(V_lds + (bf) * SHM_V + vst0) = S.st_v0; *(bf16x8*)(V_lds + (bf) * SHM_V + vst1) = S.st_v1; } while (0)
#define SWRITE_H(bf) do { SWRITE_HV(bf); SWRITE_HK(bf); } while (0)
template <int MODE>
__device__ __forceinline__ void attn_prime(const BlockRef& cur, char* lds, Seam& S) {
    const int tid = threadIdx.x, wid = __builtin_amdgcn_readfirstlane(tid >> 6), lane = tid & 63, r32 = lane & 31, hi = lane >> 5;
    const int sr = tid >> 4, sc = (tid & 15) * 8, kws = KSWZ(sr, sc * 2), vst0 = v_st(sr, sc), vst1 = v_st(32 + sr, sc); char* V_lds = lds; char* K_lds = lds + 2 * SHM_V; float* ckl = (float*)(lds + OFF_CK);
#pragma unroll
    for (int d0 = 0; d0 < 8; ++d0) S.qr[d0] = load8(cur.Q + (size_t)(cur.P0 + wid * QBLK) * Pitch<MODE>::qp + (unsigned)(r32 * Pitch<MODE>::qp + d0 * 16 + hi * 8));
    SLOAD_H(cur, MODE, 0); VMW(); SWRITE_H(0);
    __syncthreads();
}
template <int MODE>
__device__ __forceinline__ void attn_block(const BlockRef& cur, const BlockRef& nxt, char* lds, Seam& S) {
    int tid0_ = threadIdx.x; asm volatile("" : "+v"(tid0_));
    const int tid = tid0_, wid = __builtin_amdgcn_readfirstlane(tid >> 6), lane = tid & 63, r32 = lane & 31, hi = lane >> 5;
    const int NT = cur.P0 / KVBLK + 4;
    const int qlo = cur.P0 + wid * QBLK, qm = qlo + r32 - 4 * hi;
    char* V_lds = lds; char* K_lds = lds + 2 * SHM_V;
    float* ws = (float*)(lds + OFF_WS) + wid * 64; float* li_l = ws, * al_l = ws + 32; float* ckl = (float*)(lds + OFF_CK);
    float m_reg = -1e30f, l_reg = 0; f32x16 o[4] = {};
    const int sr = tid >> 4, sc = (tid & 15) * 8, vst0 = v_st(sr, sc), vst1 = v_st(32 + sr, sc), kws = KSWZ(sr, sc * 2);
    const int vb0 = (int)(uintptr_t)V_lds + v_rd_base(lane);
    float m2row = 0.f; if constexpr (MODE == 1) m2row = cur.aux[qlo + r32];
#define RESC(a) do { if constexpr (MODE == 0) { if (__any((a) < 1.f)) { if (hi == 0) al_l[r32] = (a); asm volatile("s_waitcnt lgkmcnt(0)" ::: "memory");              \
                     for (int d_ = 0; d_ < 4; ++d_) for (int r = 0; r < 16; ++r) o[d_][r] *= al_l[crow(r, hi)]; } } } while (0)
#define KBASE(t) ((t) * KVBLK)
    f32x16 p0, p1; float mn, al; bf16x8 pa0, pa1, pa2, pa3;
#define STEP(t, BUF, LASTCHK) do {                                                                                               \
        float ar = 0.f; if constexpr (MODE == 1) ar = cur.aux[AUX_AREF + (t)];                                                    \
        const bool last_ = LASTCHK && ((t) + 1 >= NT);                                                                            \
        if (last_) { SLOAD_H(nxt, MODE, 0); } else { SLOAD_H(cur, MODE, KBASE((t) + 1)); }                                         \
        SBAR(); qkt<BUF, MODE>(p0, p1, K_lds, ckl, r32, hi, S.qr); SBAR();                                                          \
        if (last_) { _Pragma("unroll") for (int d0 = 0; d0 < 8; ++d0) S.qr[d0] = load8(nxt.Q + (size_t)(nxt.P0 + wid * QBLK) * Pitch<MODE>::qp + (unsigned)(r32 * Pitch<MODE>::qp + d0 * 16 + hi * 8)); SBAR(); } \
        { const int kb_ = KBASE(t); if (kb_ + KVBLK - 1 > qlo) mask_tile<MODE>(p0, p1, qm - kb_); }                               \
        if constexpr (MODE == 0) { partialSM(p0, p1, m_reg, mn, al); RESC(al); finishSM(p0, p1, al, l_reg, pa0, pa1, pa2, pa3); }    \
        else { linScale(p0, p1, __builtin_amdgcn_exp2f(ar - m2row)); linFinish(p0, p1, l_reg, pa0, pa1, pa2, pa3); }               \
        SBAR(); pv_tile<BUF>(o, vb0, pa0, pa1, pa2, pa3); SBAR();                                                                 \
        VMW(); SWRITE_H((BUF) ^ 1);                                                                                               \
        __syncthreads(); } while (0)
    for (int t = 0; t < NT; t += 2) { STEP(t, 0, false); STEP(t + 1, 1, true); }
    { float lv = l_reg; if constexpr (MODE == 1) lv = fmaxf(fabsf(l_reg), cur.aux[AUX_MEXP + qlo + r32]);
      if (hi == 0) li_l[r32] = lv; }
    asm volatile("s_waitcnt lgkmcnt(0)" ::: "memory");
    float rli[16];
#pragma unroll
    for (int r = 0; r < 16; ++r) rli[r] = __builtin_amdgcn_rcpf(li_l[crow(r, hi)]);
    bf16* Ow = cur.O + (size_t)(qlo) * Pitch<MODE>::op;
#pragma unroll
    for (int r = 0; r < 16; ++r) { const int orow = crow(r, hi);
#pragma unroll
        for (int d0 = 0; d0 < 4; ++d0) { const float v = o[d0][r] * rli[r];
            const float vn = __shfl_xor(v, 1);
            if ((r32 & 1) == 0) *(unsigned*)(Ow + (unsigned)(orow * Pitch<MODE>::op + d0 * 32 + r32)) = cvtpk(v, vn); } }
    asm volatile("s_waitcnt lgkmcnt(0)" ::: "memory");
#undef RESC
#undef KBASE
#undef STEP
}
#define TRRD2(dst, base, off) asm volatile("ds_read_b64_tr_b16 %0, %1 offset:%2" : "=&v"(dst) : "v"(base), "i"(off) : "memory")
#define FRAG8(l, h) (bf16x8){l[0], l[1], l[2], l[3], h[0], h[1], h[2], h[3]}
struct StateRef { const bf16* K; const bf16* V; bf16* U; float* nU; float scale; int P0; };
__device__ __forceinline__ void mlstm_state_block(const StateRef& R, char* lds) {
    int tid0_ = threadIdx.x; asm volatile("" : "+v"(tid0_));
    const int tid = tid0_, wid = __builtin_amdgcn_readfirstlane(tid >> 6), lane = tid & 63, r32 = lane & 31, hi = lane >> 5;
    const int sr = tid >> 4, sc = (tid & 15) * 8, vst0 = v_st(sr, sc), vst1 = v_st(32 + sr, sc);
    bf16x8 sva0, sva1, svb0, svb1, sk0, sk1;
#define MS_LOAD(t) do { const bf16* vp_ = R.V + (size_t)(R.P0 + (t) * 64) * 6144; const bf16* kp_ = R.K + (size_t)(R.P0 + (t) * 64) * 512;                 \
        sva0 = load8(vp_ + (unsigned)(sr * 6144 + sc)); sva1 = load8(vp_ + (unsigned)((32 + sr) * 6144 + sc));                                          \
        svb0 = load8(vp_ + (unsigned)(sr * 6144 + 128 + sc)); svb1 = load8(vp_ + (unsigned)((32 + sr) * 6144 + 128 + sc));                              \
        sk0 = load8(kp_ + (unsigned)(sr * 512 + sc)); sk1 = load8(kp_ + (unsigned)((32 + sr) * 512 + sc)); } while (0)
#define MS_WRITE(b) do { char* B_ = lds + (b) * 49152; *(bf16x8*)(B_ + vst0) = sva0; *(bf16x8*)(B_ + vst1) = sva1; *(bf16x8*)(B_ + 16384 + vst0) = svb0;           \
        *(bf16x8*)(B_ + 16384 + vst1) = svb1; *(bf16x8*)(B_ + 32768 + vst0) = sk0; *(bf16x8*)(B_ + 32768 + vst1) = sk1; } while (0)
    f32x16 acc[4] = {}; f32x16 accn = {};
    const int half = wid >> 2, d0 = wid & 3;
    const int rb = (int)(uintptr_t)lds + v_rd_base(lane);
    const int vbw = rb + half * 16384 + d0 * 512, kbw = rb + 32768, knw = kbw + (wid & 3) * 512;
    const bf16x8 ones = {0x3F80, 0x3F80, 0x3F80, 0x3F80, 0x3F80, 0x3F80, 0x3F80, 0x3F80};
#define MS_KSTEP(BUF, ks) do { s16x4 bl, bh, al0, ah0, al1, ah1, al2, ah2, al3, ah3, nl, nh;                                                             \
        TRRD2(bl, vbw, (BUF) * 49152 + (ks) * 4096); TRRD2(bh, vbw, (BUF) * 49152 + (ks) * 4096 + 2048);                                                  \
        TRRD2(al0, kbw, (BUF) * 49152 + 0 * 512 + (ks) * 4096); TRRD2(ah0, kbw, (BUF) * 49152 + 0 * 512 + (ks) * 4096 + 2048);                            \
        TRRD2(al1, kbw, (BUF) * 49152 + 1 * 512 + (ks) * 4096); TRRD2(ah1, kbw, (BUF) * 49152 + 1 * 512 + (ks) * 4096 + 2048);                            \
        TRRD2(al2, kbw, (BUF) * 49152 + 2 * 512 + (ks) * 4096); TRRD2(ah2, kbw, (BUF) * 49152 + 2 * 512 + (ks) * 4096 + 2048);                            \
        TRRD2(al3, kbw, (BUF) * 49152 + 3 * 512 + (ks) * 4096); TRRD2(ah3, kbw, (BUF) * 49152 + 3 * 512 + (ks) * 4096 + 2048);                            \
        TRRD2(nl, knw, (BUF) * 49152 + (ks) * 4096); TRRD2(nh, knw, (BUF) * 49152 + (ks) * 4096 + 2048);                                                  \
        asm volatile("s_waitcnt lgkmcnt(0)" ::: "memory"); SBAR();                                                                                        \
        const bf16x8 bfr = FRAG8(bl, bh);                                                                                                                 \
        acc[0] = __builtin_amdgcn_mfma_f32_32x32x16_bf16(FRAG8(al0, ah0), bfr, acc[0], 0, 0, 0);                                                          \
        acc[1] = __builtin_amdgcn_mfma_f32_32x32x16_bf16(FRAG8(al1, ah1), bfr, acc[1], 0, 0, 0);                                                          \
        acc[2] = __builtin_amdgcn_mfma_f32_32x32x16_bf16(FRAG8(al2, ah2), bfr, acc[2], 0, 0, 0);                                                          \
        acc[3] = __builtin_amdgcn_mfma_f32_32x32x16_bf16(FRAG8(al3, ah3), bfr, acc[3], 0, 0, 0);                                                          \
        accn = __builtin_amdgcn_mfma_f32_32x32x16_bf16(FRAG8(nl, nh), ones, accn, 0, 0, 0); SBAR(); } while (0)
#define MS_TILE(t, BUF) do { if ((t) + 1 < 4) MS_LOAD((t) + 1); SBAR();                                                                                   \
        MS_KSTEP(BUF, 0); MS_KSTEP(BUF, 1); MS_KSTEP(BUF, 2); MS_KSTEP(BUF, 3);                                                                            \
        if ((t) + 1 < 4) { VMW(); MS_WRITE((BUF) ^ 1); } __syncthreads(); } while (0)
    MS_LOAD(0); VMW(); MS_WRITE(0); __syncthreads();
    MS_TILE(0, 0); MS_TILE(1, 1); MS_TILE(2, 0); MS_TILE(3, 1);
#pragma unroll
    for (int e0 = 0; e0 < 4; ++e0)
#pragma unroll
        for (int r = 0; r < 16; ++r) { const float v = acc[e0][r] * R.scale, vn = __shfl_xor(v, 1);
            if ((r32 & 1) == 0) *(unsigned*)(R.U + (unsigned)((32 * e0 + crow(r, hi)) * 256 + 128 * half + 32 * d0 + r32)) = cvtpk(v, vn); }
    if (wid < 4 && r32 == 0) {
#pragma unroll
        for (int r = 0; r < 16; ++r) R.nU[32 * wid + crow(r, hi)] = accn[r] * R.scale; }
#undef MS_LOAD
#undef MS_WRITE
#undef MS_KSTEP
#undef MS_TILE
}
__device__ __forceinline__ bf16x8 scale8(bf16x8 v, float w) {
    const u32x4 u = __builtin_bit_cast(u32x4, v); u32x4 r;
    r.x = cvtpk(::bflo(u.x) * w, ::bfhi(u.x) * w); r.y = cvtpk(::bflo(u.y) * w, ::bfhi(u.y) * w); r.z = cvtpk(::bflo(u.z) * w, ::bfhi(u.z) * w); r.w = cvtpk(::bflo(u.w) * w, ::bfhi(u.w) * w);
    return __builtin_bit_cast(bf16x8, r);
}
struct OutRef { const bf16* Q; const bf16* K; const bf16* V; const bf16* C; const float* nC; bf16* O; const float* aux; float aref, mprev; int P0; };
__device__ __forceinline__ void mlstm_out_pass(const OutRef& R, char* lds) {
    int tid0_ = threadIdx.x; asm volatile("" : "+v"(tid0_));
    const int tid = tid0_, wid = __builtin_amdgcn_readfirstlane(tid >> 6), lane = tid & 63, r32 = lane & 31, hi = lane >> 5;
    const int qlo = R.P0 + wid * QBLK, qm = qlo + r32 - 4 * hi;
    char* V_lds = lds; char* K_lds = lds + 2 * SHM_V;
    float* ws = (float*)(lds + OFF_WS) + wid * 64; float* li_l = ws; const float* ckl = nullptr;
    const int sr = tid >> 4, sc = (tid & 15) * 8, vst0 = v_st(sr, sc), vst1 = v_st(32 + sr, sc), kws = KSWZ(sr, sc * 2);
    const int vb0 = (int)(uintptr_t)V_lds + v_rd_base(lane);
    bf16x8 qr[8], st_v0, st_v1, st_k0, st_k1;
#pragma unroll
    for (int d0 = 0; d0 < 8; ++d0) qr[d0] = load8(R.Q + (size_t)qlo * 512 + (unsigned)(r32 * 512 + d0 * 16 + hi * 8));
    const float m2row = R.aux[qlo + r32];
    const float fr = __builtin_amdgcn_exp2f(R.aref - m2row), wst = __builtin_amdgcn_exp2f(R.mprev - m2row);
    float l_reg = 0.f; f32x16 o[4] = {}; f32x16 p0, p1; bf16x8 pa0, pa1, pa2, pa3;
#define MO_LOADKV(t) do { const bf16* vp_ = R.V + (size_t)(R.P0 + (t) * 64) * 6144; const bf16* kp_ = R.K + (size_t)(R.P0 + (t) * 64) * 512;               \
        st_v0 = load8(vp_ + (unsigned)(sr * 6144 + sc)); st_v1 = load8(vp_ + (unsigned)((32 + sr) * 6144 + sc));                                        \
        st_k0 = load8(kp_ + (unsigned)(sr * 512 + sc)); st_k1 = load8(kp_ + (unsigned)((32 + sr) * 512 + sc)); } while (0)
#define MO_LOADC(j) do { const bf16* cp_ = R.C + (size_t)((j) * 64) * 256; st_v0 = load8(cp_ + (unsigned)(sr * 256 + sc)); st_v1 = load8(cp_ + (unsigned)((32 + sr) * 256 + sc)); } while (0)
#define MO_WRITEV(b) do { *(bf16x8*)(V_lds + (b) * SHM_V + vst0) = st_v0; *(bf16x8*)(V_lds + (b) * SHM_V + vst1) = st_v1; } while (0)
#define MO_WRITEK(b) do { *(bf16x8*)(K_lds + (b) * SHM_K + kws) = st_k0; *(bf16x8*)(K_lds + (b) * SHM_K + kws + 32 * 256) = st_k1; } while (0)
    MO_LOADKV(0); VMW(); MO_WRITEV(0); MO_WRITEK(0); __syncthreads();
#define MO_STEP(i, BUF) do {                                                                                                                             \
        if ((i) + 1 < 4) MO_LOADKV((i) + 1); else if ((i) + 1 < 6) MO_LOADC((i) + 1 - 4);                                                                 \
        SBAR();                                                                                                                                         \
        if ((i) < 4) { qkt<BUF, 1>(p0, p1, K_lds, ckl, r32, hi, qr); SBAR();                                                                              \
            { const int kb_ = R.P0 + (i) * 64; if (kb_ + KVBLK - 1 > qlo) mask_tile<1>(p0, p1, qm - kb_); }                                                \
            linScale(p0, p1, fr); linFinish(p0, p1, l_reg, pa0, pa1, pa2, pa3); }                                                                         \
        else { pa0 = scale8(qr[4 * ((i) - 4) + 0], wst); pa1 = scale8(qr[4 * ((i) - 4) + 1], wst); pa2 = scale8(qr[4 * ((i) - 4) + 2], wst); pa3 = scale8(qr[4 * ((i) - 4) + 3], wst); } \
        SBAR(); pv_tile<BUF>(o, vb0, pa0, pa1, pa2, pa3); SBAR();                                                                                        \
        if ((i) + 1 < 6) { VMW(); MO_WRITEV((BUF) ^ 1); if ((i) + 1 < 4) MO_WRITEK((BUF) ^ 1); }                                                          \
        __syncthreads(); } while (0)
    MO_STEP(0, 0); MO_STEP(1, 1); MO_STEP(2, 0); MO_STEP(3, 1); MO_STEP(4, 0); MO_STEP(5, 1);
    { float qn = 0.f;
#pragma unroll
      for (int d0 = 0; d0 < 8; ++d0) { const u32x4 u = __builtin_bit_cast(u32x4, qr[d0]); const f32x4 na = *(const f32x4*)(R.nC + d0 * 16 + hi * 8), nb = *(const f32x4*)(R.nC + d0 * 16 + hi * 8 + 4);
          qn += ::bflo(u.x) * na[0] + ::bfhi(u.x) * na[1] + ::bflo(u.y) * na[2] + ::bfhi(u.y) * na[3] + ::bflo(u.z) * nb[0] + ::bfhi(u.z) * nb[1] + ::bflo(u.w) * nb[2] + ::bfhi(u.w) * nb[3]; }
      auto rr = __builtin_amdgcn_permlane32_swap(__float_as_uint(qn), __float_as_uint(qn), false, false);
      l_reg += wst * (__uint_as_float(rr[0]) + __uint_as_float(rr[1])); }
    { const float lv = fmaxf(fabsf(l_reg), R.aux[AUX_MEXP + qlo + r32]); if (hi == 0) li_l[r32] = lv; }
    asm volatile("s_waitcnt lgkmcnt(0)" ::: "memory");
    float rli[16];
#pragma unroll
    for (int r = 0; r < 16; ++r) rli[r] = __builtin_amdgcn_rcpf(li_l[crow(r, hi)]);
    bf16* Ow = R.O + (size_t)qlo * 1024;
#pragma unroll
    for (int r = 0; r < 16; ++r) { const int orow = crow(r, hi);
#pragma unroll
        for (int d0 = 0; d0 < 4; ++d0) { const float v = o[d0][r] * rli[r]; const float vn = __shfl_xor(v, 1);
            if ((r32 & 1) == 0) *(unsigned*)(Ow + (unsigned)(orow * 1024 + d0 * 32 + r32)) = cvtpk(v, vn); } }
    asm volatile("s_waitcnt lgkmcnt(0)" ::: "memory");
    __syncthreads();
#undef MO_LOADKV
#undef MO_LOADC
#undef MO_WRITEV
#undef MO_WRITEK
#undef MO_STEP
}
#undef TRRD2
#undef FRAG8
#undef ROWK
#undef ROWV
#undef VMW
#undef VMWN
#undef SLOAD_H
#undef SWRITE_HK
#undef SWRITE_HV
#undef SWRITE_H
#undef SBAR
#undef KSWZ
}
#define LAS __attribute__((address_space(3)))
#define GAS __attribute__((address_space(1)))
#define RLX_AGENT __ATOMIC_RELAXED, __HIP_MEMORY_SCOPE_AGENT
#define XB_TMO      128
#define XB_XCNT(j)  (256  + 64 * (j))
#define XB_XSUB(j)  (1280 + 64 * (j))
#define XB_XGEN(j)  (2304 + 64 * (j))
#define XB_TOP      3328
#define XB_TOPGEN   3392
#define XCD_BAR_WORDS 3456
#define XB_SPIN_CAP (1u << 18)

__device__ __forceinline__ unsigned xb_ld(unsigned* p)              { return __hip_atomic_load(p, __ATOMIC_RELAXED, __HIP_MEMORY_SCOPE_AGENT); }
__device__ __forceinline__ unsigned xb_add(unsigned* p, unsigned v) { return __hip_atomic_fetch_add(p, v, __ATOMIC_RELAXED, __HIP_MEMORY_SCOPE_AGENT); }
__device__ __forceinline__ unsigned xb_xcc_id() { return (unsigned)__builtin_amdgcn_s_getreg((3 << 11) | 20) & 0xFu; }
#define XB_SPIN(cond, bar) do { unsigned _sp = 0; while (cond) { __builtin_amdgcn_s_sleep(1); \
    if ((++_sp & 255u) == 0u) { if (xb_ld(&(bar)[XB_TMO])) break; if (_sp > XB_SPIN_CAP) { atomicAdd(&(bar)[XB_TMO], 1u); break; } } } } while (0)

struct XcdBarrier {
    unsigned* bar; unsigned x;
    volatile LAS unsigned* st;
};

__device__ __forceinline__ XcdBarrier xcd_barrier_post(unsigned* bar, volatile LAS unsigned* st) {
    XcdBarrier b; b.bar = bar; b.x = xb_xcc_id(); b.st = st;
    if (threadIdx.x == 0) (void)xb_add(&bar[XB_XCNT(b.x)], 1u);
    return b;
}
__device__ __forceinline__ void xcd_barrier_complete(unsigned* bar, unsigned x, unsigned& nloc, unsigned& nx) {
    const unsigned G = gridDim.x * gridDim.y * gridDim.z;
    unsigned sum, cnt, mine, sp = 0u;
    for (;;) {
        sum = 0u; cnt = 0u; mine = 0u;
#pragma unroll
        for (unsigned j = 0; j < 16; ++j) { const unsigned c = xb_ld(&bar[XB_XCNT(j)]); sum += c; cnt += (c > 0u) ? 1u : 0u; mine = (j == x) ? c : mine; }
        if (sum == G) break;
        __builtin_amdgcn_s_sleep(1);
        if ((++sp & 255u) == 0u) { if (xb_ld(&bar[XB_TMO])) break; if (sp > XB_SPIN_CAP) { atomicAdd(&bar[XB_TMO], 1u); break; } }
    }
    nloc = mine > 0u ? mine : 1u; nx = cnt > 0u ? cnt : 1u;
}

__device__ __forceinline__ void xcd_barrier(const XcdBarrier& b) {
    asm volatile("s_waitcnt vmcnt(0)" ::: "memory");
    __syncthreads();
    if (threadIdx.x == 0) {
        unsigned* bar = b.bar;
        __builtin_amdgcn_s_waitcnt(0);
        unsigned nloc = b.st[0], nx = b.st[1];
        if (nloc == 0u) { xcd_barrier_complete(bar, b.x, nloc, nx); b.st[0] = nloc; b.st[1] = nx; }
        const unsigned old = xb_add(&bar[XB_XSUB(b.x)], 1u);
        const unsigned gen = old / nloc;
        if (old + 1u == (gen + 1u) * nloc) {
            __builtin_amdgcn_fence(__ATOMIC_RELEASE, "agent");
            asm volatile("s_waitcnt vmcnt(0)" ::: "memory");
            const unsigned og = xb_add(&bar[XB_TOP], 1u);
            const unsigned tg = og / nx;
            if (og + 1u == (tg + 1u) * nx) xb_add(&bar[XB_TOPGEN], 1u);
            else XB_SPIN(xb_ld(&bar[XB_TOPGEN]) == tg, bar);
            __builtin_amdgcn_fence(__ATOMIC_ACQUIRE, "agent");
            xb_add(&bar[XB_XGEN(b.x)], 1u);
            asm volatile("s_waitcnt vmcnt(0)" ::: "memory");
        } else {
            XB_SPIN(xb_ld(&bar[XB_XGEN(b.x)]) == gen, bar);
            __builtin_amdgcn_fence(__ATOMIC_ACQUIRE, "agent");
            asm volatile("s_waitcnt vmcnt(0)" ::: "memory");
        }
    }
    __syncthreads();
}
constexpr int NWAVES = 8, NTHREADS = NWAVES * 64;
constexpr int LDS_BYTES = 131072 + 4096;
static_assert(fa::LDS_BYTES <= 131072, "attention scratch fits the ring region");
constexpr size_t MiB = 1u << 20;
constexpr size_t WS_SS = 0;
constexpr size_t WS_BAR = 512 * 1024;
constexpr size_t WS_G = 1 * MiB;
constexpr size_t WS_CK = 2 * MiB;
constexpr size_t WS_A2 = 2 * MiB + 512 * 1024, WS_M2 = WS_A2 + 256 * 1024, WS_MEXP = WS_M2 + 256 * 1024, WS_AREF = WS_MEXP + 256 * 1024;
static_assert((WS_MEXP - WS_M2) / 4 == fa::AUX_MEXP && (WS_AREF - WS_M2) / 4 == fa::AUX_AREF, "aux offsets");
constexpr size_t WS_WIN = 4 * MiB, WS_WO = 29 * MiB, WS_WGU = 37 * MiB, WS_WD = 81 * MiB, WS_WPG = 103 * MiB, WS_WPP = 111 * MiB;
constexpr size_t WS_R1 = 112 * MiB;
constexpr size_t WS_R2 = 304 * MiB;
constexpr size_t WS_R3 = 368 * MiB;
constexpr size_t WS_HB = WS_R3, WS_MQ = WS_R3 + 32 * MiB, WS_MK = WS_R3 + 48 * MiB;
constexpr size_t WS_ERAW = 432 * MiB;
constexpr size_t WS_UB = 496 * MiB, WS_END = 512 * MiB;
constexpr size_t WS_CB = WS_WIN, WS_NU = WS_WIN + 16 * MiB, WS_NC = WS_NU + 128 * 1024;
constexpr size_t WS_GB = WS_BAR + 16384;

struct Args {
    const float *x, *p, *w_norm_mix, *w_in, *fox_f_bias, *q_norm_w, *k_norm_w, *conv_w, *conv_b, *mi_bias, *mf_bias, *out_norm_w, *w_out, *w_norm_ffn,
                *w_gate, *w_up, *w_down, *w_norm_ple, *w_ple_gate, *w_ple_proj, *w_ple_post;
    float* out; unsigned char* ws;
};

__device__ __forceinline__ float wave_sum(float v) {
#pragma unroll
    for (int o = 1; o < 64; o <<= 1) v += __shfl_xor(v, o);
    return v;
}
__device__ __forceinline__ int win_src_col(int d) {
    if (d < 3072) return d;
    if (d < 5120) return d + 8;
    if (d < 6144) return d + 16;
    if (d < 6152) return 3072 + (d - 6144);
    if (d < 6160) return 5128 + (d - 6152);
    return -1;
}
struct TItem { const float* src4; const float* kw; bf16_t* dst; int ld, K; };
__device__ __forceinline__ TItem p0_item(const Args& A, int it, int lane) {
    constexpr int I_IN = (DM / 64) * (NIN / 32), I_O = (DM / 64) * (DM / 32), I_GU = (DM / 64) * (2 * DFF / 32), I_D = (DFF / 64) * (DM / 32), I_PG = I_O;
    unsigned char* ws = A.ws; const int n4 = 4 * (lane & 7), kr = lane >> 3; TItem t; int r = it;
    if (r < I_IN) { const int nblk = NIN / 32, kb = r / nblk, nb = r % nblk; const int sc = win_src_col(nb * 32 + n4);
        t.src4 = sc >= 0 ? A.w_in + (size_t)(kb * 64 + kr) * INC + sc : nullptr; t.kw = A.w_norm_mix + kb * 64 + kr; t.ld = INC; t.K = DM; t.dst = (bf16_t*)(ws + WS_WIN) + (size_t)(nb * 32) * DM + kb * 64; return t; } r -= I_IN;
    if (r < I_O) { const int nblk = DM / 32, kb = r / nblk, nb = r % nblk; t.src4 = A.w_out + (size_t)(kb * 64 + kr) * DM + nb * 32 + n4; t.kw = nullptr; t.ld = DM; t.K = DM; t.dst = (bf16_t*)(ws + WS_WO) + (size_t)(nb * 32) * DM + kb * 64; return t; } r -= I_O;
    if (r < I_GU) { const int nblk = 2 * DFF / 32, kb = r / nblk, nb = r % nblk; const int d = nb * 32, pn = d >> 8, j = d & 255;
        t.src4 = ((j < 128) ? A.w_gate + 128 * pn + j : A.w_up + 128 * pn + (j - 128)) + (size_t)(kb * 64 + kr) * DFF + n4; t.kw = A.w_norm_ffn + kb * 64 + kr; t.ld = DFF; t.K = DM; t.dst = (bf16_t*)(ws + WS_WGU) + (size_t)d * DM + kb * 64; return t; } r -= I_GU;
    if (r < I_D) { const int nblk = DM / 32, kb = r / nblk, nb = r % nblk; t.src4 = A.w_down + (size_t)(kb * 64 + kr) * DM + nb * 32 + n4; t.kw = nullptr; t.ld = DM; t.K = DFF; t.dst = (bf16_t*)(ws + WS_WD) + (size_t)(nb * 32) * DFF + kb * 64; return t; } r -= I_D;
    if (r < I_PG) { const int nblk = DM / 32, kb = r / nblk, nb = r % nblk; t.src4 = A.w_ple_gate + (size_t)(kb * 64 + kr) * DM + nb * 32 + n4; t.kw = A.w_norm_ple + kb * 64 + kr; t.ld = DM; t.K = DM; t.dst = (bf16_t*)(ws + WS_WPG) + (size_t)(nb * 32) * DM + kb * 64; return t; } r -= I_PG;
    { const int nblk = DM / 32, kb = r / nblk, nb = r % nblk; t.src4 = A.w_ple_proj + (size_t)(kb * 64 + kr) * DM + nb * 32 + n4; t.kw = nullptr; t.ld = DM; t.K = PLE; t.dst = (bf16_t*)(ws + WS_WPP) + (size_t)(nb * 32) * PLE + kb * 64; return t; }
}
__device__ __forceinline__ void p0_item_load(const TItem& t, f32x4 (&v)[8]) {
#pragma unroll
    for (int i = 0; i < 8; ++i) { v[i] = t.src4 ? *(const f32x4*)(t.src4 + (size_t)(8 * i) * t.ld) : (f32x4){0.f, 0.f, 0.f, 0.f}; if (t.kw) v[i] = v[i] * t.kw[8 * i]; }
}
__device__ __forceinline__ void p0_item_store(const TItem& t, const f32x4 (&v)[8], LAS float* scr, int lane) {
    const int n4 = 4 * (lane & 7), kr = lane >> 3;
#pragma unroll
    for (int i = 0; i < 8; ++i) { LAS float* d = scr + (kr + 8 * i) * 33 + n4; d[0] = v[i].x; d[1] = v[i].y; d[2] = v[i].z; d[3] = v[i].w; }
    asm volatile("s_waitcnt lgkmcnt(0)" ::: "memory");
    const int c = lane & 7;
#pragma unroll
    for (int j = 0; j < 4; ++j) { const int n = (lane >> 3) + 8 * j; const LAS float* s = scr + (8 * c) * 33 + n;
        u32x4 o; o.x = cvtpk2(s[0 * 33], s[1 * 33]); o.y = cvtpk2(s[2 * 33], s[3 * 33]); o.z = cvtpk2(s[4 * 33], s[5 * 33]); o.w = cvtpk2(s[6 * 33], s[7 * 33]);
        *(u32x4*)(t.dst + (size_t)n * t.K + 8 * c) = o; }
    asm volatile("s_waitcnt lgkmcnt(0)" ::: "memory");
}
__device__ __forceinline__ void p0_prologue(const Args& A, LAS unsigned char* lds, int gw, int NGW, int lane, int wave) {
    LAS float* scr = (LAS float*)(lds + wave * 16384);
    unsigned char* ws = A.ws;
    constexpr int NITEMS = (DM / 64) * (NIN / 32) + 2 * (DM / 64) * (DM / 32) + (DM / 64) * (2 * DFF / 32) + (DFF / 64) * (DM / 32) + (PLE / 64) * (DM / 32);
    if (gw < NITEMS) {
        TItem cur = p0_item(A, gw, lane); f32x4 v[8]; p0_item_load(cur, v);
        for (int it = gw; it < NITEMS; it += NGW) {
            const bool more = it + NGW < NITEMS; TItem nx = cur; f32x4 w[8];
            if (more) { nx = p0_item(A, it + NGW, lane); p0_item_load(nx, w); }
            p0_item_store(cur, v, scr, lane);
            if (more) { cur = nx;
#pragma unroll
                for (int i = 0; i < 8; ++i) v[i] = w[i]; }
        }
    }
    bf16_t* XB = (bf16_t*)(ws + WS_R2); float* ss0 = (float*)(ws + WS_SS) + 3 * MROWS;
    {
        f32x4 v[8];
#pragma unroll
        for (int j = 0; j < 8; ++j) v[j] = ((const f32x4*)(A.x + (size_t)gw * DM) + lane)[64 * j];
        for (int m = gw; m < MROWS; m += NGW) {
            f32x4 nv[8]; const bool more = m + NGW < MROWS;
            if (more) {
#pragma unroll
                for (int j = 0; j < 8; ++j) nv[j] = ((const f32x4*)(A.x + (size_t)(m + NGW) * DM) + lane)[64 * j]; }
            float s = 0.f; u32x2* o8 = (u32x2*)(XB + (size_t)m * DM) + lane;
#pragma unroll
            for (int j = 0; j < 8; ++j) { s += (v[j].x * v[j].x + v[j].y * v[j].y) + (v[j].z * v[j].z + v[j].w * v[j].w); u32x2 w; w.x = cvtpk2(v[j].x, v[j].y); w.y = cvtpk2(v[j].z, v[j].w); o8[64 * j] = w; }
            s = wave_sum(s); if (lane == 0) ss0[m] = s;
            if (more) {
#pragma unroll
                for (int j = 0; j < 8; ++j) v[j] = nv[j]; }
        }
    }
    bf16_t* PB = (bf16_t*)(ws + WS_R3);
    for (int m = gw; m < MROWS; m += NGW) { const f32x4 v = ((const f32x4*)(A.p + (size_t)m * PLE))[lane]; u32x2 w; w.x = cvtpk2(v.x, v.y); w.y = cvtpk2(v.z, v.w); ((u32x2*)(PB + (size_t)m * PLE))[lane] = w; }
    float* ss = (float*)(ws + WS_SS);
    for (int i = gw * 64 + lane; i < 3 * MROWS; i += NGW * 64) ss[i] = 0.f;
}
__device__ __forceinline__ void gate_cols(const Args& A, LAS unsigned char* ldsl, int bx, int G) {
    typedef short bf16x8_ __attribute__((ext_vector_type(8))); typedef float f32x16_ __attribute__((ext_vector_type(16)));
    int tid0_ = threadIdx.x; asm volatile("" : "+v"(tid0_));
    const int tid = tid0_, lane = tid & 63, r32 = lane & 31, hi = lane >> 5, wave = __builtin_amdgcn_readfirstlane(tid >> 6);
    const bf16_t* XB = (const bf16_t*)(A.ws + WS_R2); const bf16_t* Wg = (const bf16_t*)(A.ws + WS_WIN) + (size_t)6144 * DM;
    float* Gout = (float*)(A.ws + WS_G); const float* ss0 = (const float*)(A.ws + WS_SS) + 3 * MROWS;
    LAS float* red = (LAS float*)ldsl;
    for (int t = bx; t < MROWS / 32; t += G) {
        const int row0 = t * 32; f32x16_ acc = {};
        const bf16_t* ap = XB + (size_t)(row0 + r32) * DM + wave * 256 + 8 * hi; const bf16_t* bp = Wg + (size_t)r32 * DM + wave * 256 + 8 * hi;
        bf16x8_ av[16], bv[16];
#pragma unroll
        for (int ks = 0; ks < 16; ++ks) { av[ks] = *(const bf16x8_*)(ap + 16 * ks); bv[ks] = *(const bf16x8_*)(bp + 16 * ks); }
#pragma unroll
        for (int ks = 0; ks < 16; ++ks) acc = __builtin_amdgcn_mfma_f32_32x32x16_bf16(av[ks], bv[ks], acc, 0, 0, 0);
        LAS float* rp = red + (wave * 64 + lane) * 16;
#pragma unroll
        for (int r = 0; r < 16; ++r) rp[r] = acc[r];
        __syncthreads();
        for (int e = tid; e < 1024; e += NTHREADS) { float s = 0.f;
#pragma unroll
            for (int w = 0; w < 8; ++w) s += red[w * 1024 + e];
            const int ln = e >> 4, r = e & 15, col = ln & 31, row = row0 + (r & 3) + 8 * (r >> 2) + 4 * (ln >> 5);
            if (col < 16) Gout[(size_t)row * 16 + col] = s * (1.f / sqrtf(ss0[row] * (1.f / DM) + EPS)); }
        __syncthreads();
    }
}
__device__ __forceinline__ float logsigf(float x) { return fminf(x, 0.f) - log1pf(expf(-fabsf(x))); }
__device__ __forceinline__ void scan_sequence(const Args& A, int v, LAS float* red) {
    const int tid = threadIdx.x, lane = tid & 63, wid = tid >> 6;
    const bool fox = v < NB * AH; int b, h;
    if (fox) { b = v / AH; h = v % AH; } else { const int u = v - NB * AH; b = u / MH; h = u % MH; }
    const float* Gp = (const float*)(A.ws + WS_G) + (size_t)(b * SEQ + 8 * tid) * 16;
    const int fcol = fox ? h : 12 + h; const float fb = fox ? A.fox_f_bias[h] : A.mf_bias[h];
    float lf[8]; float run = 0.f;
#pragma unroll
    for (int i = 0; i < 8; ++i) { run += logsigf(Gp[i * 16 + fcol] + fb); lf[i] = run; }
    float incl = run;
#pragma unroll
    for (int o = 1; o < 64; o <<= 1) { const float t = __shfl_up(incl, o); if (lane >= o) incl += t; }
    if (lane == 63) red[wid] = incl;
    __syncthreads();
    float base = incl - run;
    for (int w = 0; w < wid; ++w) base += red[w];
    if (fox) {
        float* CK = (float*)(A.ws + WS_CK) + (size_t)(b * AH + h) * SEQ + 8 * tid;
#pragma unroll
        for (int i = 0; i < 8; ++i) CK[i] = -(base + lf[i]) * 11.313708498984761f;
    } else {
        const float ib = A.mi_bias[h];
        float a[8], lm[8]; float rm = -__builtin_inff();
#pragma unroll
        for (int i = 0; i < 8; ++i) { a[i] = (Gp[i * 16 + 8 + h] + ib) - (base + lf[i]); rm = fmaxf(rm, a[i]); lm[i] = rm; }
        float im = rm;
#pragma unroll
        for (int o = 1; o < 64; o <<= 1) { const float t = __shfl_up(im, o); if (lane >= o) im = fmaxf(im, t); }
        if (lane == 63) red[8 + wid] = im;
        __syncthreads();
        float ex = __shfl_up(im, 1); if (lane == 0) ex = -__builtin_inff();
        for (int w = 0; w < wid; ++w) ex = fmaxf(ex, red[8 + w]);
        const size_t o0 = (size_t)(b * MH + h) * SEQ + 8 * tid;
        float* A2 = (float*)(A.ws + WS_A2) + o0; float* M2 = (float*)(A.ws + WS_M2) + o0; float* ME = (float*)(A.ws + WS_MEXP) + o0;
#pragma unroll
        for (int i = 0; i < 8; ++i) { const float Mt = fmaxf(0.f, fmaxf(ex, lm[i])); A2[i] = a[i] * LOG2E; M2[i] = Mt * LOG2E; ME[i] = expf(-((base + lf[i]) + Mt)); }
        float tm = rm; tm = fmaxf(tm, __shfl_xor(tm, 1)); tm = fmaxf(tm, __shfl_xor(tm, 2)); tm = fmaxf(tm, __shfl_xor(tm, 4)); tm = fmaxf(tm, __shfl_xor(tm, 8)); tm = fmaxf(tm, __shfl_xor(tm, 16));
        if ((lane & 31) == 0) ((float*)(A.ws + WS_AREF))[(b * MH + h) * SEQ + (tid >> 5)] = tm * LOG2E;
    }
}
__device__ __forceinline__ void unpack8(const u32x4 w, float (&f)[8]) { f[0] = bflo(w.x); f[1] = bfhi(w.x); f[2] = bflo(w.y); f[3] = bfhi(w.y); f[4] = bflo(w.z); f[5] = bfhi(w.z); f[6] = bflo(w.w); f[7] = bfhi(w.w); }
__device__ __forceinline__ u32x4 pack8f(const float (&f)[8]) { u32x4 w; w.x = cvtpk2(f[0], f[1]); w.y = cvtpk2(f[2], f[3]); w.z = cvtpk2(f[4], f[5]); w.w = cvtpk2(f[6], f[7]); return w; }
__device__ __forceinline__ void qk_norm_rows(const Args& A, int gw, int NGW, int lane) {
    bf16_t* PROJ = (bf16_t*)(A.ws + WS_R1);
    const int d0 = (8 * lane) & 127;
    float qw[8], kw[8];
#pragma unroll
    for (int i = 0; i < 8; ++i) { qw[i] = A.q_norm_w[d0 + i]; kw[i] = A.k_norm_w[d0 + i]; }
    for (int m = gw; m < MROWS; m += NGW) {
        bf16_t* p = PROJ + (size_t)m * PROJ_LD + 8 * lane;
        u32x4 raw[4];
#pragma unroll
        for (int j = 0; j < 4; ++j) raw[j] = *(const u32x4*)(p + 512 * j);
#pragma unroll
        for (int j = 0; j < 4; ++j) { float f[8]; unpack8(raw[j], f); float s = 0.f;
#pragma unroll
            for (int i = 0; i < 8; ++i) s += f[i] * f[i];
            s += __shfl_xor(s, 1); s += __shfl_xor(s, 2); s += __shfl_xor(s, 4); s += __shfl_xor(s, 8);
            const float rs = 1.f / sqrtf(s * (1.f / 128.f) + EPS);
#pragma unroll
            for (int i = 0; i < 8; ++i) f[i] = f[i] * rs * (j < 2 ? qw[i] : kw[i]);
            *(u32x4*)(p + 512 * j) = pack8f(f); }
    }
}
template <int KPART> __device__ __forceinline__ void mconv_rows(const Args& A, int gw, int NGW, int lane) {
    const bf16_t* PROJ = (const bf16_t*)(A.ws + WS_R1) + (KPART ? PC_MK : PC_MQ) + 8 * lane;
    bf16_t* OUT = (bf16_t*)(A.ws + (KPART ? WS_MK : WS_MQ)) + 8 * lane;
    const int c0 = KPART * 512 + 8 * lane, hh = lane >> 4;
    float w[4][8], bb[8];
#pragma unroll
    for (int j = 0; j < 4; ++j)
#pragma unroll
        for (int i = 0; i < 8; ++i) w[j][i] = A.conv_w[j * 1024 + c0 + i];
#pragma unroll
    for (int i = 0; i < 8; ++i) bb[i] = A.conv_b[c0 + i];
    for (int m = gw; m < MROWS; m += NGW) {
        const int t = m & (SEQ - 1), b = m / SEQ;
        float acc[8];
#pragma unroll
        for (int i = 0; i < 8; ++i) acc[i] = bb[i];
#pragma unroll
        for (int j = 0; j < 4; ++j) { if (t - 3 + j >= 0) { float f[8]; unpack8(*(const u32x4*)(PROJ + (size_t)(m - 3 + j) * PROJ_LD), f);
#pragma unroll
                for (int i = 0; i < 8; ++i) acc[i] = fmaf(w[j][i], f[i], acc[i]); } }
        float sc;
        if (KPART) { const int bh = b * MH + hh; sc = exp2f(((const float*)(A.ws + WS_A2))[(size_t)bh * SEQ + t] - ((const float*)(A.ws + WS_AREF))[bh * SEQ + (t >> 8)]); }
        else sc = 0.08838834764831845f;
#pragma unroll
        for (int i = 0; i < 8; ++i) acc[i] = acc[i] * sigmoidf_(acc[i]) * sc;
        *(u32x4*)(OUT + (size_t)m * 512) = pack8f(acc);
    }
}
__device__ __forceinline__ void mlstm_out_rows(const Args& A, int gw, int NGW, int lane) {
    const bf16_t* HB = (const bf16_t*)(A.ws + WS_HB) + 16 * lane;
    const bf16_t* MO = (const bf16_t*)(A.ws + WS_R1) + PC_MO + 16 * lane;
    bf16_t* MIX = (bf16_t*)(A.ws + WS_R2) + 1024 + 16 * lane;
    float ow[16];
#pragma unroll
    for (int i = 0; i < 16; ++i) ow[i] = A.out_norm_w[16 * lane + i];
    for (int m = gw; m < MROWS; m += NGW) {
        float h[16], g[16];
        { float f[8]; unpack8(*(const u32x4*)(HB + (size_t)m * 1024), f);
#pragma unroll
          for (int i = 0; i < 8; ++i) h[i] = f[i];
          unpack8(*(const u32x4*)(HB + (size_t)m * 1024 + 8), f);
#pragma unroll
          for (int i = 0; i < 8; ++i) h[8 + i] = f[i];
          unpack8(*(const u32x4*)(MO + (size_t)m * PROJ_LD), f);
#pragma unroll
          for (int i = 0; i < 8; ++i) g[i] = f[i];
          unpack8(*(const u32x4*)(MO + (size_t)m * PROJ_LD + 8), f);
#pragma unroll
          for (int i = 0; i < 8; ++i) g[8 + i] = f[i]; }
        float s = 0.f;
#pragma unroll
        for (int i = 0; i < 16; ++i) s += h[i] * h[i];
        s += __shfl_xor(s, 1); s += __shfl_xor(s, 2); s += __shfl_xor(s, 4); s += __shfl_xor(s, 8);
        const float rs = 1.f / sqrtf(s * (1.f / 256.f) + EPS);
        float o[8];
#pragma unroll
        for (int i = 0; i < 8; ++i) o[i] = h[i] * rs * ow[i] * sigmoidf_(g[i]);
        *(u32x4*)(MIX + (size_t)m * DM) = pack8f(o);
#pragma unroll
        for (int i = 0; i < 8; ++i) o[i] = h[8 + i] * rs * ow[8 + i] * sigmoidf_(g[8 + i]);
        *(u32x4*)(MIX + (size_t)m * DM + 8) = pack8f(o);
    }
}
__device__ __forceinline__ void group_barrier(unsigned* cnt, unsigned target) {
    asm volatile("s_waitcnt vmcnt(0)" ::: "memory");
    __syncthreads();
    if (threadIdx.x == 0) {
        __builtin_amdgcn_fence(__ATOMIC_RELEASE, "agent");
        asm volatile("s_waitcnt vmcnt(0)" ::: "memory");
        (void)__hip_atomic_fetch_add(cnt, 1u, RLX_AGENT);
        unsigned sp = 0;
        while (__hip_atomic_load(cnt, RLX_AGENT) < target) { __builtin_amdgcn_s_sleep(1); if (++sp > (1u << 22)) break; }
        __builtin_amdgcn_fence(__ATOMIC_ACQUIRE, "agent");
        asm volatile("s_waitcnt vmcnt(0)" ::: "memory");
    }
    __syncthreads();
}
__device__ __forceinline__ void mlstm_scan(const Args& A, int g, int x) {
    int tid_ = threadIdx.x; asm volatile("" : "+v"(tid_));
    const float* M2 = (const float*)(A.ws + WS_M2) + (size_t)g * SEQ;
    const bf16_t* U = (const bf16_t*)(A.ws + WS_UB) + (size_t)g * 16 * 32768 + 2048 * x + 4 * tid_;
    bf16_t* C = (bf16_t*)(A.ws + WS_CB) + (size_t)g * 16 * 32768 + 2048 * x + 4 * tid_;
    u32x2 uu[15];
#pragma unroll
    for (int b = 0; b < 15; ++b) uu[b] = *(const u32x2*)(U + (size_t)b * 32768);
    f32x4 c = {0.f, 0.f, 0.f, 0.f}; *(u32x2*)C = (u32x2){0u, 0u};
    float mp = 0.f;
#pragma unroll
    for (int b = 0; b < 15; ++b) { const float me = M2[256 * b + 255]; const float gdec = (b == 0) ? 0.f : __builtin_amdgcn_exp2f(mp - me); mp = me;
        c = c * gdec + (f32x4){bflo(uu[b].x), bfhi(uu[b].x), bflo(uu[b].y), bfhi(uu[b].y)};
        u32x2 w; w.x = cvtpk2(c[0], c[1]); w.y = cvtpk2(c[2], c[3]); *(u32x2*)(C + (size_t)(b + 1) * 32768) = w; }
    if (x == 0 && tid_ < 128) {
        const float* nU = (const float*)(A.ws + WS_NU) + (size_t)g * 16 * 128 + tid_; float* nC = (float*)(A.ws + WS_NC) + (size_t)g * 16 * 128 + tid_;
        float n = 0.f; nC[0] = 0.f; float mq = 0.f;
        for (int b = 0; b < 15; ++b) { const float me = M2[256 * b + 255]; const float gdec = (b == 0) ? 0.f : __builtin_amdgcn_exp2f(mq - me); mq = me; n = n * gdec + nU[b * 128]; nC[(b + 1) * 128] = n; }
    }
}
__device__ __forceinline__ fa::BlockRef p3_fblock(const Args& A, int w, int i) {
    const int x = w & 15, g = w >> 4; fa::BlockRef r; const int bh = 2 * g + (x >> 3), b = bh / AH, h = bh % AH; const size_t row0 = (size_t)b * SEQ;
    const fa::bf16* PROJ = (const fa::bf16*)(A.ws + WS_R1) + row0 * PROJ_LD + h * 128;
    r.Q = PROJ + PC_AQ; r.K = PROJ + PC_AK; r.V = PROJ + PC_AV; r.O = (fa::bf16*)(A.ws + WS_R2) + row0 * DM + h * 128;
    r.aux = (const float*)(A.ws + WS_CK) + (size_t)bh * SEQ; r.P0 = (i == 0 ? (x & 7) : 15 - (x & 7)) * 256; return r;
}

#ifndef ONLY
#define ONLY -1
#endif
#ifndef REP0
#define REP0 1
#endif
#ifndef REP1
#define REP1 1
#endif
#ifndef REP3
#define REP3 1
#endif
#ifndef REP6
#define REP6 1
#endif
#ifndef REP2B
#define REP2B 1
#endif
#ifndef REP4
#define REP4 1
#endif
#ifndef XSYNC
#define XSYNC 0
#endif
#ifndef REP5
#define REP5 1
#endif
#ifndef REP2A
#define REP2A 1
#endif
#ifndef SKIPMASK
#define SKIPMASK 0
#endif
#define PH(k) if constexpr (ONLY < 0 ? !((SKIPMASK >> (k)) & 1) : ONLY == (k))
template <class T> __device__ __forceinline__ T* as_global(T* p) { return (T*)(__attribute__((address_space(1))) T*)p; }
__device__ __forceinline__ Args load_args() {
#if defined(__HIP_DEVICE_COMPILE__)
    const __attribute__((address_space(4))) Args* ap = (const __attribute__((address_space(4))) Args*)__builtin_amdgcn_kernarg_segment_ptr();
    asm volatile("" : "+s"(ap));
    Args a = *ap;
#define FX(f) a.f = as_global(a.f)
    FX(x); FX(p); FX(w_norm_mix); FX(w_in); FX(fox_f_bias); FX(q_norm_w); FX(k_norm_w); FX(conv_w); FX(conv_b); FX(mi_bias); FX(mf_bias); FX(out_norm_w); FX(w_out); FX(w_norm_ffn);
    FX(w_gate); FX(w_up); FX(w_down); FX(w_norm_ple); FX(w_ple_gate); FX(w_ple_proj); FX(w_ple_post); FX(out); FX(ws);
#undef FX
    return a;
#else
    return Args{};
#endif
}
#define ARGS() load_args()
__global__ void __launch_bounds__(NTHREADS, 2) fwd_megakernel(Args Aunused) {
    extern __shared__ __attribute__((aligned(16))) unsigned char lds[];
    cg::grid_group grid = cg::this_grid();
    LAS unsigned char* ldsl = (LAS unsigned char*)lds;
    const int G = gridDim.x, bx = blockIdx.x, NGW = G * NWAVES;
#define LANEVARS() int tid_ = threadIdx.x; asm volatile("" : "+v"(tid_)); const int lane = tid_ & 63, wave = __builtin_amdgcn_readfirstlane(tid_ >> 6), gw = bx * NWAVES + wave; (void)lane; (void)gw

    if (threadIdx.x < 16) ((volatile LAS unsigned*)(ldsl + 131072))[threadIdx.x] = 0u;
    { unsigned* bw = (unsigned*)(ARGS().ws + WS_BAR); if (bx == 0) for (int i = threadIdx.x; i < 4096 + 16 * 64; i += NTHREADS) bw[i] = 0u; }
    __syncthreads();
    PH(0) for (int rep = 0; rep < REP0; ++rep) { const Args A = ARGS(); LANEVARS(); p0_prologue(A, ldsl, gw, NGW, lane, wave); }
    grid.sync();
    XcdBarrier xbar = xcd_barrier_post((unsigned*)(ARGS().ws + WS_BAR), (volatile LAS unsigned*)(ldsl + 131072));
#define GRID_BAR() xcd_barrier(xbar)
    for (int rep = 0; rep < XSYNC; ++rep) GRID_BAR();
    PH(1) { const Args A = ARGS(); gate_cols(A, ldsl, bx, G); }
    PH(1) for (int rep = 0; rep < REP1; ++rep) { const Args A = ARGS(); unsigned char* ws = A.ws;
        pg8::Gemm g{(const bf16_t*)(ws + WS_R2), (const bf16_t*)(ws + WS_WIN), MROWS, PROJ_LD, DM}; pg8::StaticOrder S; S.init(MROWS, PROJ_LD, G, bx);
        pg8::EpiProj E{(bf16_t*)(ws + WS_R1), (const float*)(ws + WS_SS) + 3 * MROWS};
        pg8::gemm_phase<pg8::EpiProj, pg8::StaticOrder, true, true>(ldsl, g, S, E);
    }
    PH(10) { const Args A = ARGS(); unsigned char* ws = A.ws; float* SS = (float*)(ws + WS_SS);
        pg8::Gemm g{(const bf16_t*)(ws + WS_R3), (const bf16_t*)(ws + WS_WPP), MROWS, DM, PLE}; pg8::StaticOrder S; S.init(MROWS, DM, G, bx);
        pg8::EpiE E{(bf16_t*)(ws + WS_ERAW), SS};
        pg8::gemm_phase<pg8::EpiE, pg8::StaticOrder, true, true>(ldsl, g, S, E);
    }
    GRID_BAR();
    PH(2) for (int rep = 0; rep < REP2A; ++rep) { const Args A = ARGS(); for (int v = bx; v < NB * AH + NB * MH; v += G) { scan_sequence(A, v, (LAS float*)ldsl); __syncthreads(); } }
    PH(2) { const Args A = ARGS(); LANEVARS(); qk_norm_rows(A, gw, NGW, lane); }
    PH(2) for (int rep = 0; rep < REP2A; ++rep) { const Args A = ARGS(); LANEVARS(); mconv_rows<0>(A, gw, NGW, lane); }
    GRID_BAR();
    PH(2) for (int rep = 0; rep < REP2B; ++rep) { const Args A = ARGS(); LANEVARS(); mconv_rows<1>(A, gw, NGW, lane); }
    GRID_BAR();
    PH(3) for (int rep = 0; rep < REP3; ++rep) { const Args A = ARGS(); const int w = bx & 255, x = w & 15, g = w >> 4;
        unsigned char* ws = A.ws; unsigned* gcnt = (unsigned*)(ws + WS_GB) + 64 * g;
        const int b = g / MH, h = g % MH; const size_t row0 = (size_t)b * SEQ;
        const float* M2 = (const float*)(ws + WS_M2) + (size_t)g * SEQ; const float aref = ((const float*)(ws + WS_AREF))[g * SEQ + x];
        const fa::bf16* MQp = (const fa::bf16*)(ws + WS_MQ) + row0 * 512 + h * 128; const fa::bf16* MKp = (const fa::bf16*)(ws + WS_MK) + row0 * 512 + h * 128;
        const fa::bf16* MVp = (const fa::bf16*)(ws + WS_R1) + row0 * PROJ_LD + PC_MV + h * 256;
        { fa::StateRef R{MKp, MVp, (fa::bf16*)(ws + WS_UB) + (size_t)(g * 16 + x) * 32768, (float*)(ws + WS_NU) + (g * 16 + x) * 128, exp2f(aref - M2[256 * x + 255]), 256 * x};
          fa::mlstm_state_block(R, (char*)lds); }
        group_barrier(gcnt, 16u * (2 * rep + 1));
        mlstm_scan(A, g, x);
        group_barrier(gcnt, 16u * (2 * rep + 2));
#pragma nounroll
        for (int half = 0; half < 2; ++half) {
            fa::OutRef R{MQp, MKp, MVp + half * 128, (const fa::bf16*)(ws + WS_CB) + (size_t)(g * 16 + x) * 32768 + half * 128, (const float*)(ws + WS_NC) + (g * 16 + x) * 128,
                         (fa::bf16*)(ws + WS_HB) + row0 * 1024 + h * 256 + half * 128, M2, aref, x > 0 ? M2[256 * x - 1] : 0.f, 256 * x};
            fa::mlstm_out_pass(R, (char*)lds); }
        fa::Seam S;
        { fa::BlockRef c = p3_fblock(A, w, 0); fa::attn_prime<0>(c, (char*)lds, S);
#pragma nounroll
          for (int i = 0; i < 2; ++i) { const fa::BlockRef n = p3_fblock(A, w, 1); fa::attn_block<0>(c, n, (char*)lds, S); c = n; } }
        asm volatile("s_waitcnt vmcnt(0)" ::: "memory");
        __syncthreads();
    }
    GRID_BAR();
    PH(4) for (int rep = 0; rep < REP4; ++rep) { const Args A = ARGS(); LANEVARS(); mlstm_out_rows(A, gw, NGW, lane); }
    GRID_BAR();
    PH(5) for (int rep = 0; rep < REP5; ++rep) { const Args A = ARGS(); unsigned char* ws = A.ws; float* SS = (float*)(ws + WS_SS);
        pg8::Gemm g{(const bf16_t*)(ws + WS_R2), (const bf16_t*)(ws + WS_WO), MROWS, DM, DM}; pg8::StaticOrder S; S.init(MROWS, DM, G, bx);
        pg8::EpiRes<false> E{A.x, (bf16_t*)(ws + WS_R3), SS + MROWS, rep == 0};
        pg8::gemm_phase<pg8::EpiRes<false>, pg8::StaticOrder, true, true>(ldsl, g, S, E);
    }
    GRID_BAR();
    PH(6) for (int rep = 0; rep < REP6; ++rep) { const Args A = ARGS(); unsigned char* ws = A.ws; float* SS = (float*)(ws + WS_SS);
        pg8::Gemm g{(const bf16_t*)(ws + WS_R3), (const bf16_t*)(ws + WS_WGU), MROWS, 2 * DFF, DM}; pg8::StaticOrder S; S.init(MROWS, 2 * DFF, G, bx);
        pg8::EpiSwiGLU E{(bf16_t*)(ws + WS_R1), SS + MROWS};
        pg8::gemm_phase<pg8::EpiSwiGLU, pg8::StaticOrder, true, true>(ldsl, g, S, E);
    }
    GRID_BAR();
    PH(7) { const Args A = ARGS(); unsigned char* ws = A.ws; float* SS = (float*)(ws + WS_SS);
        pg8::Gemm g{(const bf16_t*)(ws + WS_R1), (const bf16_t*)(ws + WS_WD), MROWS, DM, DFF}; pg8::StaticOrder S; S.init(MROWS, DM, G, bx);
        pg8::EpiRes<true> E{(const void*)(ws + WS_R3), (bf16_t*)(ws + WS_R2), SS + 2 * MROWS, 1};
        pg8::gemm_phase<pg8::EpiRes<true>, pg8::StaticOrder, true, true>(ldsl, g, S, E);
    }
    GRID_BAR();
    PH(8) { const Args A = ARGS(); unsigned char* ws = A.ws; float* SS = (float*)(ws + WS_SS);
        pg8::Gemm g{(const bf16_t*)(ws + WS_R2), (const bf16_t*)(ws + WS_WPG), MROWS, DM, DM}; pg8::StaticOrder S; S.init(MROWS, DM, G, bx);
        pg8::EpiFinal E{A.out, (const bf16_t*)(ws + WS_R2), (const bf16_t*)(ws + WS_ERAW), A.w_ple_post, SS + 2 * MROWS, SS};
        pg8::gemm_phase<pg8::EpiFinal, pg8::StaticOrder, true, true>(ldsl, g, S, E);
    }
}

extern "C" void kernel_launch(void* const* d_in, const int* in_sizes, int n_in, void* d_out, int out_size, void* d_ws, size_t ws_size, hipStream_t stream) {
    static int grid = 0;
    if (grid == 0) {
        if (n_in != 21 || in_sizes[0] != MROWS * DM || out_size != MROWS * DM || ws_size < WS_END) {
            fprintf(stderr, "kernel_launch: unexpected shapes (n_in %d, in0 %d, out %d, ws %zu; need ws >= %zu)\n", n_in, n_in > 0 ? in_sizes[0] : -1, out_size, ws_size, (size_t)WS_END); grid = -1; return; }
        int dev = 0, cus = 0, per_cu = 0;
        (void)hipGetDevice(&dev); (void)hipDeviceGetAttribute(&cus, hipDeviceAttributeMultiprocessorCount, dev);
        if (hipFuncSetAttribute((const void*)fwd_megakernel, hipFuncAttributeMaxDynamicSharedMemorySize, LDS_BYTES) != hipSuccess) { fprintf(stderr, "kernel_launch: hipFuncSetAttribute failed\n"); grid = -1; return; }
        if (hipOccupancyMaxActiveBlocksPerMultiprocessor(&per_cu, (const void*)fwd_megakernel, NTHREADS, LDS_BYTES) != hipSuccess || per_cu < 1) { fprintf(stderr, "kernel_launch: occupancy query says %d blocks per CU\n", per_cu); per_cu = 1; }
        (void)hipGetLastError();
        if (per_cu > 1) per_cu = 1;
        grid = cus * per_cu;
        if (grid != 256) { fprintf(stderr, "kernel_launch: this kernel is laid out for a 256-CU device (got %d workgroups)\n", grid); grid = -1; return; }
    }
    if (grid < 0) return;
    Args a{};
    a.x = (const float*)d_in[0]; a.p = (const float*)d_in[1]; a.w_norm_mix = (const float*)d_in[2]; a.w_in = (const float*)d_in[3]; a.fox_f_bias = (const float*)d_in[4];
    a.q_norm_w = (const float*)d_in[5]; a.k_norm_w = (const float*)d_in[6]; a.conv_w = (const float*)d_in[7]; a.conv_b = (const float*)d_in[8]; a.mi_bias = (const float*)d_in[9];
    a.mf_bias = (const float*)d_in[10]; a.out_norm_w = (const float*)d_in[11]; a.w_out = (const float*)d_in[12]; a.w_norm_ffn = (const float*)d_in[13]; a.w_gate = (const float*)d_in[14];
    a.w_up = (const float*)d_in[15]; a.w_down = (const float*)d_in[16]; a.w_norm_ple = (const float*)d_in[17]; a.w_ple_gate = (const float*)d_in[18]; a.w_ple_proj = (const float*)d_in[19];
    a.w_ple_post = (const float*)d_in[20];
    a.out = (float*)d_out; a.ws = (unsigned char*)d_ws;
    void* args[] = {&a};
    hipError_t e = hipLaunchCooperativeKernel((const void*)fwd_megakernel, dim3(grid), dim3(NTHREADS), args, LDS_BYTES, stream);
    if (e != hipSuccess) fprintf(stderr, "kernel_launch: cooperative launch failed: %s (grid %d)\n", hipGetErrorString(e), grid);
}
```

```cpp
#include <hip/hip_runtime.h>
#include <hip/hip_cooperative_groups.h>
#include <hip/hip_bf16.h>
#include <cstdio>
#include <cstdint>
namespace cg = cooperative_groups;

constexpr int NB = 4, SEQ = 4096, DM = 2048, MROWS = NB * SEQ;
constexpr int PLE = 256, AH = 8, MH = 4, DFF = 5632, INC = 6160;
constexpr int PROJ_LD = 6144, NIN = 6400;
constexpr int PC_AQ = 0, PC_AK = 1024, PC_AV = 2048, PC_MQ = 3072, PC_MK = 3584, PC_MV = 4096, PC_MO = 5120;
constexpr float EPS = 1e-6f;
constexpr float LOG2E = 1.4426950408889634f;

typedef unsigned short bf16_t;
typedef float f32x4 __attribute__((ext_vector_type(4)));
typedef float f32x2 __attribute__((ext_vector_type(2)));
typedef unsigned u32x4 __attribute__((ext_vector_type(4)));
typedef unsigned u32x2 __attribute__((ext_vector_type(2)));
typedef __bf16 bf16x2_t __attribute__((ext_vector_type(2)));
__device__ __forceinline__ unsigned cvtpk2(float lo, float hi) { f32x2 v = {lo, hi}; bf16x2_t b = __builtin_convertvector(v, bf16x2_t); return __builtin_bit_cast(unsigned, b); }
__device__ __forceinline__ float bflo(unsigned w) { return __uint_as_float(w << 16); }
__device__ __forceinline__ float bfhi(unsigned w) { return __uint_as_float(w & 0xffff0000u); }
__device__ __forceinline__ float sigmoidf_(float x) { return __builtin_amdgcn_rcpf(1.f + __expf(-x)); }
namespace pg8 {
#define PG8_LAS __attribute__((address_space(3)))
typedef unsigned short bf16_t;
typedef short bf16x8 __attribute__((ext_vector_type(8)));
typedef float f32x4 __attribute__((ext_vector_type(4)));
typedef unsigned u32x4 __attribute__((ext_vector_type(4)));
constexpr int BM = 256, BK = 64, HALF = 128, HTB = HALF * BK * 2  , STAGE_BYTES = 8 * HTB, NXCD = 8, WGM = 8;

__host__ __device__ __forceinline__ int lds_byte(int r, int c) { const int st = (r >> 4) * 2 + (c >> 5), rr = r & 15, cc = c & 31, ob = rr * 64 + cc * 2; return st * 1024 + (ob ^ (((ob >> 9) & 1) << 5)); }
__host__ __device__ __forceinline__ void stage_rc(int b, int& R, int& C) { const int st = b / 1024, sb = b % 1024, swz = sb ^ (((sb >> 9) & 1) << 5); R = (st >> 1) * 16 + swz / 64; C = (st & 1) * 32 + (swz % 64) / 2; }
__host__ __device__ __forceinline__ int perm32(int rho) { const int n = rho >> 4, i = rho & 15; return 8 * (i >> 2) + 4 * n + (i & 3); }

struct Unit { int pm, pn; };
struct Gemm { const bf16_t* A; const bf16_t* Bt; int M, N, K; };

struct StaticOrder {
    int nM, nN, nwg, G, c;
    __host__ __device__ void init(int M, int N, int G_, int c_) { nM = M / BM; nN = N / BM; nwg = nM * nN; G = G_; c = c_; }
    __host__ __device__ bool next(int i, Unit& u) const {
        const long L = (long)i * G + c; if (L >= nwg) return false;
        int wgid = (int)L; { const int q = nwg / NXCD, r = nwg % NXCD, xcd = wgid % NXCD, off = wgid / NXCD; wgid = (xcd < r ? xcd * (q + 1) : r * (q + 1) + (xcd - r) * q) + off; }
        const int nig = WGM * nN, gid = wgid / nig, fm = gid * WGM, gsz = (nM - fm) < WGM ? (nM - fm) : WGM;
        u.pm = fm + ((wgid % nig) % gsz); u.pn = (wgid % nig) / gsz; return true;
    }
    __device__ __forceinline__ void a_ready(const Unit&) const {}
    __device__ __forceinline__ void done(const Unit&) const {}
};
__device__ __forceinline__ unsigned cvt_pk_bf16(float lo, float hi) { return ::cvtpk2(lo, hi); }
__device__ __forceinline__ float sumsq4(f32x4 v) { return (v[0] * v[0] + v[1] * v[1]) + (v[2] * v[2] + v[3] * v[3]); }
__device__ __forceinline__ void atomic_add_f32(float* p, float v) { __hip_atomic_fetch_add(p, v, __ATOMIC_RELAXED, __HIP_MEMORY_SCOPE_AGENT); }

__device__ __forceinline__ void zero_acc(f32x4 (&acc)[2][2][4][2]) {
#pragma unroll
    for (int a = 0; a < 2; ++a)
#pragma unroll
        for (int b = 0; b < 2; ++b)
#pragma unroll
            for (int m = 0; m < 4; ++m)
#pragma unroll
                for (int n = 0; n < 2; ++n) acc[a][b][m][n] = (f32x4){0.f, 0.f, 0.f, 0.f};
}
#define PG8_ZERO_INIT __device__ __forceinline__ void init(f32x4 (&acc)[2][2][4][2], const Unit&, int, int, int, int) const { zero_acc(acc); }

struct EpiProj {
    static constexpr bool PERM = true, AFTER_DRAIN = false;
    PG8_ZERO_INIT
    bf16_t* O; const float* ss0;
    __device__ __forceinline__ void operator()(const f32x4 (&acc)[2][2][4][2], const Unit& u, int wr, int wc, int fr, int fq) const {
        const int row0 = u.pm * BM + wr * 64 + fr, col0 = u.pn * BM + wc * 32 + 8 * fq;
#pragma unroll
        for (int ai = 0; ai < 2; ++ai)
#pragma unroll
            for (int m = 0; m < 4; ++m) { const int row = row0 + ai * HALF + m * 16; const float rs = __builtin_amdgcn_rsqf(ss0[row] * (1.f / 2048.f) + 1e-6f); bf16_t* rowp = O + (size_t)row * 6144 + col0;
#pragma unroll
                for (int bj = 0; bj < 2; ++bj) { const f32x4 v0 = acc[ai][bj][m][0] * rs, v1 = acc[ai][bj][m][1] * rs;
                    u32x4 w; w.x = cvt_pk_bf16(v0[0], v0[1]); w.y = cvt_pk_bf16(v0[2], v0[3]); w.z = cvt_pk_bf16(v1[0], v1[1]); w.w = cvt_pk_bf16(v1[2], v1[3]);
                    *(u32x4*)(rowp + bj * HALF) = w; } }
    }
};
struct EpiE {
    static constexpr bool PERM = true, AFTER_DRAIN = false;
    PG8_ZERO_INIT
    bf16_t* O; float* ss;
    __device__ __forceinline__ void operator()(const f32x4 (&acc)[2][2][4][2], const Unit& u, int wr, int wc, int fr, int fq) const {
        const int row0 = u.pm * BM + wr * 64 + fr, col0 = u.pn * BM + wc * 32 + 8 * fq;
#pragma unroll
        for (int ai = 0; ai < 2; ++ai)
#pragma unroll
            for (int m = 0; m < 4; ++m) { const int row = row0 + ai * HALF + m * 16; bf16_t* rowp = O + (size_t)row * 2048 + col0; float s = 0.f;
#pragma unroll
                for (int bj = 0; bj < 2; ++bj) { const f32x4 v0 = acc[ai][bj][m][0], v1 = acc[ai][bj][m][1]; s += sumsq4(v0) + sumsq4(v1);
                    u32x4 w; w.x = cvt_pk_bf16(v0[0], v0[1]); w.y = cvt_pk_bf16(v0[2], v0[3]); w.z = cvt_pk_bf16(v1[0], v1[1]); w.w = cvt_pk_bf16(v1[2], v1[3]);
                    *(u32x4*)(rowp + bj * HALF) = w; }
                s += __shfl_xor(s, 16); s += __shfl_xor(s, 32);
                if (fq == 0) atomic_add_f32(ss + row, s); }
    }
};
template <bool XINB> struct EpiRes {
    static constexpr bool PERM = true, AFTER_DRAIN = false;
    const void* xin; bf16_t* xout; float* ss; int live;
    __device__ __forceinline__ void init(f32x4 (&acc)[2][2][4][2], const Unit& u, int wr, int wc, int fr, int fq) const {
        const int row0 = u.pm * BM + wr * 64 + fr, col0 = u.pn * BM + wc * 32 + 8 * fq;
#pragma unroll
        for (int ai = 0; ai < 2; ++ai)
#pragma unroll
            for (int m = 0; m < 4; ++m) { const size_t off = (size_t)(row0 + ai * HALF + m * 16) * 2048 + col0;
#pragma unroll
                for (int bj = 0; bj < 2; ++bj) {
                    if constexpr (XINB) { const u32x4 w = *(const u32x4*)((const bf16_t*)xin + off + bj * HALF);
                        acc[ai][bj][m][0] = (f32x4){::bflo(w.x), ::bfhi(w.x), ::bflo(w.y), ::bfhi(w.y)}; acc[ai][bj][m][1] = (f32x4){::bflo(w.z), ::bfhi(w.z), ::bflo(w.w), ::bfhi(w.w)}; }
                    else { const float* rp = (const float*)xin + off + bj * HALF; acc[ai][bj][m][0] = *(const f32x4*)rp; acc[ai][bj][m][1] = *(const f32x4*)(rp + 4); } } }
    }
    __device__ __forceinline__ void operator()(const f32x4 (&acc)[2][2][4][2], const Unit& u, int wr, int wc, int fr, int fq) const {
        if (!live) {
#pragma unroll
            for (int ai = 0; ai < 2; ++ai)
#pragma unroll
                for (int m = 0; m < 4; ++m)
#pragma unroll
                    for (int bj = 0; bj < 2; ++bj)
#pragma unroll
                        for (int n = 0; n < 2; ++n) asm volatile("" :: "v"(acc[ai][bj][m][n]));
            return; }
        const int row0 = u.pm * BM + wr * 64 + fr, col0 = u.pn * BM + wc * 32 + 8 * fq;
#pragma unroll
        for (int ai = 0; ai < 2; ++ai)
#pragma unroll
            for (int m = 0; m < 4; ++m) { const int row = row0 + ai * HALF + m * 16; bf16_t* rowp = xout + (size_t)row * 2048 + col0; float s = 0.f;
#pragma unroll
                for (int bj = 0; bj < 2; ++bj) { const f32x4 v0 = acc[ai][bj][m][0], v1 = acc[ai][bj][m][1]; s += sumsq4(v0) + sumsq4(v1);
                    u32x4 w; w.x = cvt_pk_bf16(v0[0], v0[1]); w.y = cvt_pk_bf16(v0[2], v0[3]); w.z = cvt_pk_bf16(v1[0], v1[1]); w.w = cvt_pk_bf16(v1[2], v1[3]);
                    *(u32x4*)(rowp + bj * HALF) = w; }
                s += __shfl_xor(s, 16); s += __shfl_xor(s, 32);
                if (fq == 0) atomic_add_f32(ss + row, s); }
    }
};
struct EpiSwiGLU {
    static constexpr bool PERM = true, AFTER_DRAIN = false;
    PG8_ZERO_INIT
    bf16_t* O; const float* ss;
    __device__ __forceinline__ void operator()(const f32x4 (&acc)[2][2][4][2], const Unit& u, int wr, int wc, int fr, int fq) const {
        const int row0 = u.pm * BM + wr * 64 + fr, col0 = u.pn * HALF + wc * 32 + 8 * fq;
#pragma unroll
        for (int ai = 0; ai < 2; ++ai)
#pragma unroll
            for (int m = 0; m < 4; ++m) { const int row = row0 + ai * HALF + m * 16; const float rs = __builtin_amdgcn_rsqf(ss[row] * (1.f / 2048.f) + 1e-6f);
                float r[8];
#pragma unroll
                for (int n = 0; n < 2; ++n)
#pragma unroll
                    for (int e = 0; e < 4; ++e) { const float g = acc[ai][0][m][n][e] * rs, up = acc[ai][1][m][n][e] * rs; r[n * 4 + e] = g * __builtin_amdgcn_rcpf(1.f + __expf(-g)) * up; }
                u32x4 w; w.x = cvt_pk_bf16(r[0], r[1]); w.y = cvt_pk_bf16(r[2], r[3]); w.z = cvt_pk_bf16(r[4], r[5]); w.w = cvt_pk_bf16(r[6], r[7]);
                *(u32x4*)(O + (size_t)row * 5632 + col0) = w; }
    }
};
struct EpiFinal {
    static constexpr bool PERM = true, AFTER_DRAIN = false;
    PG8_ZERO_INIT
    float* out; const bf16_t* x2; const bf16_t* eraw; const float* wpost; const float* ss2; const float* ssE;
    __device__ __forceinline__ void operator()(const f32x4 (&acc)[2][2][4][2], const Unit& u, int wr, int wc, int fr, int fq) const {
        const int row0 = u.pm * BM + wr * 64 + fr, col0 = u.pn * BM + wc * 32 + 8 * fq;
        f32x4 wv[2][2];
#pragma unroll
        for (int bj = 0; bj < 2; ++bj)
#pragma unroll
            for (int n = 0; n < 2; ++n) wv[bj][n] = *(const f32x4*)(wpost + col0 + bj * HALF + n * 4);
#pragma unroll
        for (int ai = 0; ai < 2; ++ai)
#pragma unroll
            for (int m = 0; m < 4; ++m) { const int row = row0 + ai * HALF + m * 16; const size_t off = (size_t)row * 2048 + col0;
                const float rs = __builtin_amdgcn_rsqf(ss2[row] * (1.f / 2048.f) + 1e-6f), re = __builtin_amdgcn_rsqf(ssE[row] * (1.f / 2048.f) + 1e-6f);
#pragma unroll
                for (int bj = 0; bj < 2; ++bj) { const size_t o2 = off + bj * HALF; const u32x4 xw = *(const u32x4*)(x2 + o2), ew = *(const u32x4*)(eraw + o2);
                    const f32x4 xa = {::bflo(xw.x), ::bfhi(xw.x), ::bflo(xw.y), ::bfhi(xw.y)}, xb = {::bflo(xw.z), ::bfhi(xw.z), ::bflo(xw.w), ::bfhi(xw.w)};
                    f32x4 ea = {::bflo(ew.x), ::bfhi(ew.x), ::bflo(ew.y), ::bfhi(ew.y)}, eb = {::bflo(ew.z), ::bfhi(ew.z), ::bflo(ew.w), ::bfhi(ew.w)};
                    ea = ea * re * wv[bj][0]; eb = eb * re * wv[bj][1];
                    const f32x4 a0 = acc[ai][bj][m][0] * rs, a1 = acc[ai][bj][m][1] * rs; f32x4 o0, o1;
#pragma unroll
                    for (int e = 0; e < 4; ++e) { o0[e] = xa[e] + ::sigmoidf_(a0[e]) * ea[e]; o1[e] = xb[e] + ::sigmoidf_(a1[e]) * eb[e]; }
                    *(f32x4*)(out + o2) = o0; *(f32x4*)(out + o2 + 4) = o1; } }
    }
};
template <class Epi, class Sched, bool ALIGN_EPI = false, bool SP2 = false>
__device__ __forceinline__ void gemm_phase(PG8_LAS unsigned char* lds, const Gemm g, const Sched& S, const Epi& E) {
    int tid0_ = threadIdx.x; asm volatile("" : "+v"(tid0_));
    const int tid = tid0_, wid = __builtin_amdgcn_readfirstlane(tid >> 6), lane = tid & 63, wr = wid >> 2, wc = wid & 3, fr = lane & 15, fq = lane >> 4;
    int K0_ = g.K; asm volatile("" : "+s"(K0_));
    const int K = K0_, nt = K / BK;
    unsigned voffA[2], voffB[2];
#pragma unroll
    for (int i = 0; i < 2; ++i) { int R, C; stage_rc(tid * 16 + i * 8192, R, C); const int Rb = Epi::PERM ? ((R & ~31) + perm32(R & 31)) : R;
        voffA[i] = (unsigned)(R * K + C) * 2u; voffB[i] = (unsigned)(Rb * K + C) * 2u; }
    const size_t kstep = (size_t)(BK * 2);
    const size_t hstep = (size_t)HALF * K * 2;
    const size_t tstep = 2 * hstep;
    const unsigned ldsw = (unsigned)wid * 1024u;
    const int aoff = lds_byte(wr * 64 + fr, fq * 8), boff = lds_byte(wc * 32 + fr, fq * 8);
#define PG8_SA(b, h) (((b) * 2 + (h)) * HTB)
#define PG8_SB(b, h) ((4 + (b) * 2 + (h)) * HTB)
#define PG8_STAGE(bufoff, gbase, voff) do { _Pragma("unroll") for (int _i = 0; _i < 2; ++_i) \
        __builtin_amdgcn_global_load_lds((const unsigned*)((const char*)(gbase) + (voff)[_i]), (PG8_LAS unsigned*)(lds + (bufoff) + ldsw + _i * 8192), 16, 0, 0); } while (0)
#define PG8_LDA(dst, b, h) do { _Pragma("unroll") for (int m = 0; m < 4; ++m) _Pragma("unroll") for (int k = 0; k < 2; ++k) dst[m][k] = *(const PG8_LAS bf16x8*)(lds + PG8_SA(b, h) + aoff + m * 2048 + k * 1024); } while (0)
#define PG8_LDB(dst, b, h) do { _Pragma("unroll") for (int n = 0; n < 2; ++n) _Pragma("unroll") for (int k = 0; k < 2; ++k) dst[n][k] = *(const PG8_LAS bf16x8*)(lds + PG8_SB(b, h) + boff + n * 2048 + k * 1024); } while (0)
#define PG8_MMA(ai, bj, At, Bt) do { __builtin_amdgcn_s_setprio(1); _Pragma("unroll") for (int m = 0; m < 4; ++m) _Pragma("unroll") for (int n = 0; n < 2; ++n) _Pragma("unroll") for (int k = 0; k < 2; ++k) \
        acc[ai][bj][m][n] = __builtin_amdgcn_mfma_f32_16x16x32_bf16(Bt[n][k], At[m][k], acc[ai][bj][m][n], 0, 0, 0); __builtin_amdgcn_s_setprio(0); } while (0)
#define PG8_WAIT_V(n) asm volatile("s_waitcnt vmcnt(" #n ")" ::: "memory")
#define PG8_WAIT_L(n) asm volatile("s_waitcnt lgkmcnt(" #n ")" ::: "memory")
#define PG8_BAR __builtin_amdgcn_s_barrier()
#define PG8_SCHED __builtin_amdgcn_sched_barrier(0)
    Unit cur, nxt; int ui = 0;
    if (!S.next(0, cur)) return;
    f32x4 acc[2][2][4][2];
    E.init(acc, cur, wr, wc, fr, fq);
    bf16x8 At[4][2], B0[2][2], B1[2][2];
    const char* cA = (const char*)g.A + (size_t)cur.pm * tstep; const char* cB = (const char*)g.Bt + (size_t)cur.pn * tstep;
    S.a_ready(cur);
    if constexpr (SP2) {
        PG8_STAGE(PG8_SB(0, 0), cB, voffB); PG8_STAGE(PG8_SB(0, 1), cB + hstep, voffB); PG8_STAGE(PG8_SA(0, 0), cA, voffA); PG8_STAGE(PG8_SA(0, 1), cA + hstep, voffA);
        if (wr == 1) PG8_BAR;
        PG8_WAIT_V(2); PG8_BAR;
        PG8_STAGE(PG8_SB(1, 0), cB + kstep, voffB); PG8_STAGE(PG8_SA(1, 0), cA + kstep, voffA); PG8_STAGE(PG8_SB(1, 1), cB + hstep + kstep, voffB);
        PG8_WAIT_V(6); PG8_BAR;
    } else {
        PG8_STAGE(PG8_SB(0, 0), cB, voffB); PG8_STAGE(PG8_SA(0, 0), cA, voffA); PG8_STAGE(PG8_SB(0, 1), cB + hstep, voffB); PG8_STAGE(PG8_SA(0, 1), cA + hstep, voffA);
        if (wr == 1) PG8_BAR;
        PG8_WAIT_V(4); PG8_BAR;
        PG8_STAGE(PG8_SB(1, 0), cB + kstep, voffB); PG8_STAGE(PG8_SA(1, 0), cA + kstep, voffA); PG8_STAGE(PG8_SB(1, 1), cB + hstep + kstep, voffB);
        PG8_WAIT_V(6); PG8_BAR;
    }
    for (;;) {
        const bool has_next = S.next(ui + 1, nxt);
        const char* nA = has_next ? (const char*)g.A + (size_t)nxt.pm * tstep : cA; const char* nB = has_next ? (const char*)g.Bt + (size_t)nxt.pn * tstep : cB;
        for (int t = 0; t < nt; t += 2) {
            const bool last = (t == nt - 2);
            const char* a1 = cA + (size_t)(t + 1) * kstep;
            const char* a2 = last ? nA : cA + (size_t)(t + 2) * kstep; const char* b2 = last ? nB : cB + (size_t)(t + 2) * kstep;
            const char* a3 = a2 + kstep; const char* b3 = b2 + kstep;
            if (last && has_next) S.a_ready(nxt);
            if constexpr (SP2) {
            PG8_LDB(B0, 0, 0); PG8_LDB(B1, 0, 1); PG8_SCHED; PG8_LDA(At, 0, 0); PG8_STAGE(PG8_SA(1, 1), a1 + hstep, voffA);
            PG8_WAIT_V(8); PG8_WAIT_L(0); PG8_BAR; PG8_MMA(0, 0, At, B0); PG8_MMA(0, 1, At, B1); PG8_BAR; PG8_SCHED;
            PG8_LDA(At, 0, 1); PG8_STAGE(PG8_SB(0, 0), b2, voffB); PG8_STAGE(PG8_SB(0, 1), b2 + hstep, voffB); PG8_STAGE(PG8_SA(0, 0), a2, voffA);
            PG8_WAIT_V(8); PG8_WAIT_L(0); PG8_BAR; PG8_MMA(1, 0, At, B0); PG8_MMA(1, 1, At, B1); PG8_BAR; PG8_SCHED;
            PG8_LDB(B0, 1, 0); PG8_LDB(B1, 1, 1); PG8_SCHED; PG8_LDA(At, 1, 0); PG8_STAGE(PG8_SA(0, 1), a2 + hstep, voffA);
            PG8_WAIT_V(8); PG8_WAIT_L(0); PG8_BAR; PG8_MMA(0, 0, At, B0); PG8_MMA(0, 1, At, B1); PG8_BAR; PG8_SCHED;
            PG8_LDA(At, 1, 1); PG8_STAGE(PG8_SB(1, 0), b3, voffB); PG8_STAGE(PG8_SB(1, 1), b3 + hstep, voffB); PG8_STAGE(PG8_SA(1, 0), a3, voffA);
            PG8_WAIT_V(8); PG8_WAIT_L(0); PG8_BAR; PG8_MMA(1, 0, At, B0); PG8_MMA(1, 1, At, B1); PG8_BAR; PG8_SCHED;
            } else {
            PG8_LDB(B0, 0, 0); PG8_SCHED; PG8_LDA(At, 0, 0); PG8_STAGE(PG8_SA(1, 1), a1 + hstep, voffA);
            PG8_WAIT_L(8); PG8_BAR; PG8_WAIT_L(0); PG8_MMA(0, 0, At, B0); PG8_BAR; PG8_SCHED;
            PG8_LDB(B1, 0, 1); PG8_STAGE(PG8_SB(0, 0), b2, voffB);
            PG8_BAR; PG8_WAIT_L(0); PG8_MMA(0, 1, At, B1); PG8_BAR;
            PG8_LDA(At, 0, 1); PG8_STAGE(PG8_SA(0, 0), a2, voffA);
            PG8_BAR; PG8_WAIT_L(0); PG8_MMA(1, 0, At, B0); PG8_BAR; PG8_SCHED;
            PG8_STAGE(PG8_SB(0, 1), b2 + hstep, voffB);
            PG8_WAIT_V(6); PG8_BAR; PG8_MMA(1, 1, At, B1); PG8_BAR;
            PG8_LDB(B0, 1, 0); PG8_SCHED; PG8_LDA(At, 1, 0); PG8_STAGE(PG8_SA(0, 1), a2 + hstep, voffA);
            PG8_WAIT_L(8); PG8_BAR; PG8_WAIT_L(0); PG8_MMA(0, 0, At, B0); PG8_BAR; PG8_SCHED;
            PG8_LDB(B1, 1, 1); PG8_STAGE(PG8_SB(1, 0), b3, voffB);
            PG8_BAR; PG8_WAIT_L(0); PG8_MMA(0, 1, At, B1); PG8_BAR;
            PG8_LDA(At, 1, 1); PG8_STAGE(PG8_SA(1, 0), a3, voffA);
            PG8_BAR; PG8_WAIT_L(0); PG8_MMA(1, 0, At, B0); PG8_BAR; PG8_SCHED;
            PG8_STAGE(PG8_SB(1, 1), b3 + hstep, voffB);
            PG8_WAIT_V(6); PG8_BAR; PG8_MMA(1, 1, At, B1); PG8_BAR;
            }
        }
        if constexpr (ALIGN_EPI) { if (wr == 0) PG8_BAR; }
        if constexpr (!Epi::AFTER_DRAIN) { E(acc, cur, wr, wc, fr, fq); S.done(cur); }
        if (!has_next) break;
        E.init(acc, nxt, wr, wc, fr, fq);
        cur = nxt; cA = nA; cB = nB; ++ui;
        if constexpr (ALIGN_EPI) { if (wr == 1) PG8_BAR; }
    }
    PG8_WAIT_V(0);
    if constexpr (!ALIGN_EPI) { if (wr == 0) PG8_BAR; }
    PG8_BAR;
    if constexpr (Epi::AFTER_DRAIN) { E.fused(acc, cur, wr, wc, fr, fq, lds, wid, lane); S.done(cur); }
#undef PG8_SA
#undef PG8_SB
#undef PG8_STAGE
#undef PG8_LDA
#undef PG8_LDB
#undef PG8_MMA
#undef PG8_WAIT_V
#undef PG8_WAIT_L
#undef PG8_BAR
#undef PG8_SCHED
}
}
namespace fa {
using bf16 = __hip_bfloat16;
typedef short bf16x8 __attribute__((ext_vector_type(8)));
typedef short s16x4 __attribute__((ext_vector_type(4)));
typedef float f32x16 __attribute__((ext_vector_type(16)));
constexpr int D = 128, NW = 8, QBLK = 32, KVBLK = 64, QB = NW * QBLK;
constexpr int SHM_V = KVBLK * D * 2, SHM_K = KVBLK * D * 2;
constexpr int OFF_WS = 2 * SHM_V + 2 * SHM_K, OFF_CK = OFF_WS + NW * 64 * 4, LDS_BYTES = OFF_CK + 2 * 64 * 4;
constexpr float SCALE = 0.08838834764831845f;
constexpr float THR = 8.f;

#define KSWZ(row, colB) ((row) * 256 + ((colB) ^ (((row) & 7) << 4)))
#define SBAR() __builtin_amdgcn_sched_barrier(0)
__device__ __forceinline__ int v_st(int k, int c) { const int kk = (k & ~0xC) | ((k & 4) << 1) | ((k & 8) >> 1); return ((kk >> 3) * 4 + (c >> 5)) * 512 + ((kk & 7) * 32 + (c & 31)) * 2; }
__device__ __forceinline__ int v_rd_base(int lane) { return ((lane & 3) << 3) | (((lane >> 2) & 3) << 6) | (((lane >> 4) & 1) << 5) | (((lane >> 5) & 1) << 8); }
constexpr int v_rd_off(int d0, int ks, int half) { return d0 * 512 + ks * 4096 + half * 2048; }
__device__ __forceinline__ int crow(int r, int hi) { return (r & 3) + 8 * (r >> 2) + 4 * hi; }
__device__ __forceinline__ unsigned cvtpk(float lo, float hi) { return ::cvtpk2(lo, hi); }
__device__ __forceinline__ bf16x8 load8(const bf16* p) { return *reinterpret_cast<const bf16x8*>(p); }
template <int MODE> __device__ __forceinline__ void mask_tile(f32x16& p0, f32x16& p1, int dq) {
    const float NEG = MODE == 0 ? -__builtin_inff() : 0.f;
#pragma unroll
    for (int r = 0; r < 16; ++r) {
        const int c = (r & 3) + 8 * (r >> 2);
        if (dq - c < 0) p0[r] = NEG;
        if (dq - c - 32 < 0) p1[r] = NEG;
    }
}
__device__ __forceinline__ void partialSM(f32x16& p0, f32x16& p1, float& m_reg, float& mn, float& alpha) {
    float pmax = p0[0]; for (int r = 1; r < 16; ++r) pmax = fmaxf(pmax, p0[r]); for (int r = 0; r < 16; ++r) pmax = fmaxf(pmax, p1[r]);
    { auto rr = __builtin_amdgcn_permlane32_swap(__float_as_uint(pmax), __float_as_uint(pmax), false, false);
      pmax = fmaxf(__uint_as_float(rr[0]), __uint_as_float(rr[1])); }
    constexpr float C2 = 1.4426950408889634f * SCALE;
    if (__builtin_expect(__all((pmax - m_reg) * SCALE <= THR), 1)) { mn = m_reg; alpha = 1.f; }
    else { mn = fmaxf(m_reg, pmax); alpha = __builtin_amdgcn_exp2f((m_reg - mn) * C2); m_reg = mn; }
    const float mnL = -mn * C2;
    for (int r = 0; r < 16; ++r) p0[r] = fmaf(p0[r], C2, mnL); for (int r = 0; r < 16; ++r) p1[r] = fmaf(p1[r], C2, mnL);
    for (int r = 0; r < 16; ++r) p0[r] = __builtin_amdgcn_exp2f(p0[r]);
}
#define PK4(P, B_, OUT) do { unsigned a0 = cvtpk(P[B_+0], P[B_+1]), a1 = cvtpk(P[B_+2], P[B_+3]);                          \
        unsigned b0 = cvtpk(P[B_+4], P[B_+5]), b1 = cvtpk(P[B_+6], P[B_+7]);                                             \
        auto r0 = __builtin_amdgcn_permlane32_swap(a0, b0, false, false); auto r1 = __builtin_amdgcn_permlane32_swap(a1, b1, false, false); \
        u32x4 w = {r0[0], r1[0], r0[1], r1[1]}; OUT = *reinterpret_cast<bf16x8*>(&w); } while (0)
__device__ __forceinline__ void finishSM(f32x16& p0, f32x16& p1, float alpha, float& l_reg, bf16x8& pa0, bf16x8& pa1, bf16x8& pa2, bf16x8& pa3) {
    for (int r = 0; r < 16; ++r) p1[r] = __builtin_amdgcn_exp2f(p1[r]);
    float ps = 0; for (int r = 0; r < 16; ++r) ps += p0[r]; for (int r = 0; r < 16; ++r) ps += p1[r];
    { auto rr = __builtin_amdgcn_permlane32_swap(__float_as_uint(ps), __float_as_uint(ps), false, false);
      ps = __uint_as_float(rr[0]) + __uint_as_float(rr[1]); }
    l_reg = l_reg * alpha + ps;
    PK4(p0, 0, pa0); PK4(p0, 8, pa1); PK4(p1, 0, pa2); PK4(p1, 8, pa3);
}
__device__ __forceinline__ void linScale(f32x16& p0, f32x16& p1, float fr) {
    for (int r = 0; r < 16; ++r) p0[r] *= fr; for (int r = 0; r < 16; ++r) p1[r] *= fr;
}
__device__ __forceinline__ void linFinish(f32x16& p0, f32x16& p1, float& l_reg, bf16x8& pa0, bf16x8& pa1, bf16x8& pa2, bf16x8& pa3) {
    float ps = 0; for (int r = 0; r < 16; ++r) ps += p0[r]; for (int r = 0; r < 16; ++r) ps += p1[r];
    { auto rr = __builtin_amdgcn_permlane32_swap(__float_as_uint(ps), __float_as_uint(ps), false, false);
      ps = __uint_as_float(rr[0]) + __uint_as_float(rr[1]); }
    l_reg += ps;
    PK4(p0, 0, pa0); PK4(p0, 8, pa1); PK4(p1, 0, pa2); PK4(p1, 8, pa3);
}
#undef PK4
template <int KB, int MODE>
__device__ __forceinline__ void qkt(f32x16& p0, f32x16& p1, const char* K_lds, const float* ckl, int r32, int hi, const bf16x8* qr) {
    if constexpr (MODE == 0) {
        const float* c = ckl + KB * 64 + 4 * hi;
#pragma unroll
        for (int g = 0; g < 4; ++g) { const f32x4 a = *(const f32x4*)(c + 8 * g), b = *(const f32x4*)(c + 32 + 8 * g);
            p0[4 * g + 0] = a[0]; p0[4 * g + 1] = a[1]; p0[4 * g + 2] = a[2]; p0[4 * g + 3] = a[3];
            p1[4 * g + 0] = b[0]; p1[4 * g + 1] = b[1]; p1[4 * g + 2] = b[2]; p1[4 * g + 3] = b[3]; }
    } else { p0 = f32x16{}; p1 = f32x16{}; }
    const char* kb[4];
#pragma unroll
    for (int dd = 0; dd < 4; ++dd) kb[dd] = K_lds + KB * SHM_K + KSWZ(r32, (dd * 16 + hi * 8) * 2);
#pragma unroll
    for (int d0 = 0; d0 < 8; ++d0) { const char* a = kb[d0 & 3] + (d0 >> 2) * 128;
        bf16x8 b0 = *reinterpret_cast<const bf16x8*>(a);
        bf16x8 b1 = *reinterpret_cast<const bf16x8*>(a + 32 * 256);
        p0 = __builtin_amdgcn_mfma_f32_32x32x16_bf16(b0, qr[d0], p0, 0, 0, 0);
        p1 = __builtin_amdgcn_mfma_f32_32x32x16_bf16(b1, qr[d0], p1, 0, 0, 0); }
}
template <int VB>
__device__ __forceinline__ void pv_tile(f32x16* o, int vb0, bf16x8 pa0, bf16x8 pa1, bf16x8 pa2, bf16x8 pa3) {
#define TRRD(dst, off) asm volatile("ds_read_b64_tr_b16 %0, %1 offset:%2" : "=&v"(dst) : "v"(vb0), "i"(off) : "memory")
#define PV_D0(d0) do { s16x4 l0, l1, l2, l3, h0, h1, h2, h3; constexpr int b_ = VB * SHM_V + v_rd_off(d0, 0, 0);     \
        TRRD(l0, b_); TRRD(h0, b_ + 2048); TRRD(l1, b_ + 4096); TRRD(h1, b_ + 6144); TRRD(l2, b_ + 8192); TRRD(h2, b_ + 10240); TRRD(l3, b_ + 12288); TRRD(h3, b_ + 14336); \
        asm volatile("s_waitcnt lgkmcnt(0)" ::: "memory"); SBAR();                 \
        o[d0] = __builtin_amdgcn_mfma_f32_32x32x16_bf16(pa0, (bf16x8){l0[0], l0[1], l0[2], l0[3], h0[0], h0[1], h0[2], h0[3]}, o[d0], 0, 0, 0);   \
        o[d0] = __builtin_amdgcn_mfma_f32_32x32x16_bf16(pa1, (bf16x8){l1[0], l1[1], l1[2], l1[3], h1[0], h1[1], h1[2], h1[3]}, o[d0], 0, 0, 0);   \
        o[d0] = __builtin_amdgcn_mfma_f32_32x32x16_bf16(pa2, (bf16x8){l2[0], l2[1], l2[2], l2[3], h2[0], h2[1], h2[2], h2[3]}, o[d0], 0, 0, 0);   \
        o[d0] = __builtin_amdgcn_mfma_f32_32x32x16_bf16(pa3, (bf16x8){l3[0], l3[1], l3[2], l3[3], h3[0], h3[1], h3[2], h3[3]}, o[d0], 0, 0, 0); } while (0)
    PV_D0(0); PV_D0(1); PV_D0(2); PV_D0(3);
#undef PV_D0
#undef TRRD
}

struct BlockRef { const bf16* Q; const bf16* K; const bf16* V; bf16* O; const float* aux; int P0; };
constexpr int AUX_MEXP = 65536, AUX_AREF = 131072;
template <int MODE> struct Pitch { static constexpr int qp = MODE ? 512 : 6144, kp = MODE ? 512 : 6144, vp = 6144, op = MODE ? 1024 : 2048; };
struct Seam { bf16x8 qr[8]; bf16x8 st_v0, st_v1, st_k0, st_k1; float st_c; };
#define ROWK(R, PM, k0, rr) ((R).K + (size_t)(k0) * Pitch<PM>::kp + (unsigned)(((rr) * Pitch<PM>::kp) + sc))
#define ROWV(R, PM, k0, rr) ((R).V + (size_t)(k0) * Pitch<PM>::vp + (unsigned)(((rr) * Pitch<PM>::vp) + sc))
#define VMW() asm volatile("s_waitcnt vmcnt(0)" ::: "memory")
#define VMWN(n) asm volatile("s_waitcnt vmcnt(%0)" :: "i"(n) : "memory")
#define SLOAD_H(R, PM, k0) do { S.st_v0 = load8(ROWV(R, PM, k0, sr)); S.st_v1 = load8(ROWV(R, PM, k0, 32 + sr));              \
                         S.st_k0 = load8(ROWK(R, PM, k0, sr)); S.st_k1 = load8(ROWK(R, PM, k0, 32 + sr));                \
                         if constexpr (PM == 0) S.st_c = (R).aux[(k0) + (tid & 63)]; } while (0)
#define SWRITE_HK(bf) do { *(bf16x8*)(K_lds + (bf) * SHM_K + kws) = S.st_k0; *(bf16x8*)(K_lds + (bf) * SHM_K + kws + 32 * 256) = S.st_k1; \
                           if constexpr (MODE == 0) { if (tid < 64) ckl[(bf) * 64 + tid] = S.st_c; } } while (0)
#define SWRITE_HV(bf) do { *(bf16x8*)(V_lds + (bf) * SHM_V + vst0) = S.st_v0; *(bf16x8*)(V_lds + (bf) * SHM_V + vst1) = S.st_v1; } while (0)
#define SWRITE_H(bf) do { SWRITE_HV(bf); SWRITE_HK(bf); } while (0)
template <int MODE>
__device__ __forceinline__ void attn_prime(const BlockRef& cur, char* lds, Seam& S) {
    const int tid = threadIdx.x, wid = __builtin_amdgcn_readfirstlane(tid >> 6), lane = tid & 63, r32 = lane & 31, hi = lane >> 5;
    const int sr = tid >> 4, sc = (tid & 15) * 8, kws = KSWZ(sr, sc * 2), vst0 = v_st(sr, sc), vst1 = v_st(32 + sr, sc); char* V_lds = lds; char* K_lds = lds + 2 * SHM_V; float* ckl = (float*)(lds + OFF_CK);
#pragma unroll
    for (int d0 = 0; d0 < 8; ++d0) S.qr[d0] = load8(cur.Q + (size_t)(cur.P0 + wid * QBLK) * Pitch<MODE>::qp + (unsigned)(r32 * Pitch<MODE>::qp + d0 * 16 + hi * 8));
    SLOAD_H(cur, MODE, 0); VMW(); SWRITE_H(0);
    __syncthreads();
}
template <int MODE>
__device__ __forceinline__ void attn_block(const BlockRef& cur, const BlockRef& nxt, char* lds, Seam& S) {
    int tid0_ = threadIdx.x; asm volatile("" : "+v"(tid0_));
    const int tid = tid0_, wid = __builtin_amdgcn_readfirstlane(tid >> 6), lane = tid & 63, r32 = lane & 31, hi = lane >> 5;
    const int NT = cur.P0 / KVBLK + 4;
    const int qlo = cur.P0 + wid * QBLK, qm = qlo + r32 - 4 * hi;
    char* V_lds = lds; char* K_lds = lds + 2 * SHM_V;
    float* ws = (float*)(lds + OFF_WS) + wid * 64; float* li_l = ws, * al_l = ws + 32; float* ckl = (float*)(lds + OFF_CK);
    float m_reg = -1e30f, l_reg = 0; f32x16 o[4] = {};
    const int sr = tid >> 4, sc = (tid & 15) * 8, vst0 = v_st(sr, sc), vst1 = v_st(32 + sr, sc), kws = KSWZ(sr, sc * 2);
    const int vb0 = (int)(uintptr_t)V_lds + v_rd_base(lane);
    float m2row = 0.f; if constexpr (MODE == 1) m2row = cur.aux[qlo + r32];
#define RESC(a) do { if constexpr (MODE == 0) { if (__any((a) < 1.f)) { if (hi == 0) al_l[r32] = (a); asm volatile("s_waitcnt lgkmcnt(0)" ::: "memory");              \
                     for (int d_ = 0; d_ < 4; ++d_) for (int r = 0; r < 16; ++r) o[d_][r] *= al_l[crow(r, hi)]; } } } while (0)
#define KBASE(t) ((t) * KVBLK)
    f32x16 p0, p1; float mn, al; bf16x8 pa0, pa1, pa2, pa3;
#define STEP(t, BUF, LASTCHK) do {                                                                                               \
        float ar = 0.f; if constexpr (MODE == 1) ar = cur.aux[AUX_AREF + (t)];                                                    \
        const bool last_ = LASTCHK && ((t) + 1 >= NT);                                                                            \
        if (last_) { SLOAD_H(nxt, MODE, 0); } else { SLOAD_H(cur, MODE, KBASE((t) + 1)); }                                         \
        SBAR(); qkt<BUF, MODE>(p0, p1, K_lds, ckl, r32, hi, S.qr); SBAR();                                                          \
        if (last_) { _Pragma("unroll") for (int d0 = 0; d0 < 8; ++d0) S.qr[d0] = load8(nxt.Q + (size_t)(nxt.P0 + wid * QBLK) * Pitch<MODE>::qp + (unsigned)(r32 * Pitch<MODE>::qp + d0 * 16 + hi * 8)); SBAR(); } \
        { const int kb_ = KBASE(t); if (kb_ + KVBLK - 1 > qlo) mask_tile<MODE>(p0, p1, qm - kb_); }                               \
        if constexpr (MODE == 0) { partialSM(p0, p1, m_reg, mn, al); RESC(al); finishSM(p0, p1, al, l_reg, pa0, pa1, pa2, pa3); }    \
        else { linScale(p0, p1, __builtin_amdgcn_exp2f(ar - m2row)); linFinish(p0, p1, l_reg, pa0, pa1, pa2, pa3); }               \
        SBAR(); pv_tile<BUF>(o, vb0, pa0, pa1, pa2, pa3); SBAR();                                                                 \
        VMW(); SWRITE_H((BUF) ^ 1);                                                                                               \
        __syncthreads(); } while (0)
    for (int t = 0; t < NT; t += 2) { STEP(t, 0, false); STEP(t + 1, 1, true); }
    { float lv = l_reg; if constexpr (MODE == 1) lv = fmaxf(fabsf(l_reg), cur.aux[AUX_MEXP + qlo + r32]);
      if (hi == 0) li_l[r32] = lv; }
    asm volatile("s_waitcnt lgkmcnt(0)" ::: "memory");
    float rli[16];
#pragma unroll
    for (int r = 0; r < 16; ++r) rli[r] = __builtin_amdgcn_rcpf(li_l[crow(r, hi)]);
    bf16* Ow = cur.O + (size_t)(qlo) * Pitch<MODE>::op;
#pragma unroll
    for (int r = 0; r < 16; ++r) { const int orow = crow(r, hi);
#pragma unroll
        for (int d0 = 0; d0 < 4; ++d0) { const float v = o[d0][r] * rli[r];
            const float vn = __shfl_xor(v, 1);
            if ((r32 & 1) == 0) *(unsigned*)(Ow + (unsigned)(orow * Pitch<MODE>::op + d0 * 32 + r32)) = cvtpk(v, vn); } }
    asm volatile("s_waitcnt lgkmcnt(0)" ::: "memory");
#undef RESC
#undef KBASE
#undef STEP
}
#define TRRD2(dst, base, off) asm volatile("ds_read_b64_tr_b16 %0, %1 offset:%2" : "=&v"(dst) : "v"(base), "i"(off) : "memory")
#define FRAG8(l, h) (bf16x8){l[0], l[1], l[2], l[3], h[0], h[1], h[2], h[3]}
__device__ __forceinline__ bf16x8 scale8(bf16x8 v, float w) {
    const u32x4 u = __builtin_bit_cast(u32x4, v); u32x4 r;
    r.x = cvtpk(::bflo(u.x) * w, ::bfhi(u.x) * w); r.y = cvtpk(::bflo(u.y) * w, ::bfhi(u.y) * w); r.z = cvtpk(::bflo(u.z) * w, ::bfhi(u.z) * w); r.w = cvtpk(::bflo(u.w) * w, ::bfhi(u.w) * w);
    return __builtin_bit_cast(bf16x8, r);
}
struct StateRef { const bf16* K; const bf16* V; bf16* U; float* nU; const float* a2; float aref, scale; int P0; };
__device__ __forceinline__ void mlstm_state_block(const StateRef& R, char* lds) {
    int tid0_ = threadIdx.x; asm volatile("" : "+v"(tid0_));
    const int tid = tid0_, wid = __builtin_amdgcn_readfirstlane(tid >> 6), lane = tid & 63, r32 = lane & 31, hi = lane >> 5;
    const int sr = tid >> 4, sc = (tid & 15) * 8, vst0 = v_st(sr, sc), vst1 = v_st(32 + sr, sc);
    bf16x8 sva0, sva1, svb0, svb1, sk0, sk1; float sf0, sf1;
#define MS_LOAD(t) do { const bf16* vp_ = R.V + (size_t)(R.P0 + (t) * 64) * 6144; const bf16* kp_ = R.K + (size_t)(R.P0 + (t) * 64) * 512;                 \
        sva0 = load8(vp_ + (unsigned)(sr * 6144 + sc)); sva1 = load8(vp_ + (unsigned)((32 + sr) * 6144 + sc));                                          \
        svb0 = load8(vp_ + (unsigned)(sr * 6144 + 128 + sc)); svb1 = load8(vp_ + (unsigned)((32 + sr) * 6144 + 128 + sc));                              \
        sk0 = load8(kp_ + (unsigned)(sr * 512 + sc)); sk1 = load8(kp_ + (unsigned)((32 + sr) * 512 + sc));                                              \
        sf0 = R.a2[R.P0 + (t) * 64 + sr]; sf1 = R.a2[R.P0 + (t) * 64 + 32 + sr]; } while (0)
#define MS_WRITE(b) do { char* B_ = lds + (b) * 49152; sk0 = scale8(sk0, __builtin_amdgcn_exp2f(sf0 - R.aref)); sk1 = scale8(sk1, __builtin_amdgcn_exp2f(sf1 - R.aref)); *(bf16x8*)(B_ + vst0) = sva0; *(bf16x8*)(B_ + vst1) = sva1; *(bf16x8*)(B_ + 16384 + vst0) = svb0;           \
        *(bf16x8*)(B_ + 16384 + vst1) = svb1; *(bf16x8*)(B_ + 32768 + vst0) = sk0; *(bf16x8*)(B_ + 32768 + vst1) = sk1; } while (0)
    f32x16 acc[4] = {}; f32x16 accn = {};
    const int half = wid >> 2, d0 = wid & 3;
    const int rb = (int)(uintptr_t)lds + v_rd_base(lane);
    const int vbw = rb + half * 16384 + d0 * 512, kbw = rb + 32768, knw = kbw + (wid & 3) * 512;
    const bf16x8 ones = {0x3F80, 0x3F80, 0x3F80, 0x3F80, 0x3F80, 0x3F80, 0x3F80, 0x3F80};
#define MS_KSTEP(BUF, ks) do { s16x4 bl, bh, al0, ah0, al1, ah1, al2, ah2, al3, ah3, nl, nh;                                                             \
        TRRD2(bl, vbw, (BUF) * 49152 + (ks) * 4096); TRRD2(bh, vbw, (BUF) * 49152 + (ks) * 4096 + 2048);                                                  \
        TRRD2(al0, kbw, (BUF) * 49152 + 0 * 512 + (ks) * 4096); TRRD2(ah0, kbw, (BUF) * 49152 + 0 * 512 + (ks) * 4096 + 2048);                            \
        TRRD2(al1, kbw, (BUF) * 49152 + 1 * 512 + (ks) * 4096); TRRD2(ah1, kbw, (BUF) * 49152 + 1 * 512 + (ks) * 4096 + 2048);                            \
        TRRD2(al2, kbw, (BUF) * 49152 + 2 * 512 + (ks) * 4096); TRRD2(ah2, kbw, (BUF) * 49152 + 2 * 512 + (ks) * 4096 + 2048);                            \
        TRRD2(al3, kbw, (BUF) * 49152 + 3 * 512 + (ks) * 4096); TRRD2(ah3, kbw, (BUF) * 49152 + 3 * 512 + (ks) * 4096 + 2048);                            \
        TRRD2(nl, knw, (BUF) * 49152 + (ks) * 4096); TRRD2(nh, knw, (BUF) * 49152 + (ks) * 4096 + 2048);                                                  \
        asm volatile("s_waitcnt lgkmcnt(0)" ::: "memory"); SBAR();                                                                                        \
        const bf16x8 bfr = FRAG8(bl, bh);                                                                                                                 \
        acc[0] = __builtin_amdgcn_mfma_f32_32x32x16_bf16(FRAG8(al0, ah0), bfr, acc[0], 0, 0, 0);                                                          \
        acc[1] = __builtin_amdgcn_mfma_f32_32x32x16_bf16(FRAG8(al1, ah1), bfr, acc[1], 0, 0, 0);                                                          \
        acc[2] = __builtin_amdgcn_mfma_f32_32x32x16_bf16(FRAG8(al2, ah2), bfr, acc[2], 0, 0, 0);                                                          \
        acc[3] = __builtin_amdgcn_mfma_f32_32x32x16_bf16(FRAG8(al3, ah3), bfr, acc[3], 0, 0, 0);                                                          \
        accn = __builtin_amdgcn_mfma_f32_32x32x16_bf16(FRAG8(nl, nh), ones, accn, 0, 0, 0); SBAR(); } while (0)
#define MS_TILE(t, BUF) do { if ((t) + 1 < 4) MS_LOAD((t) + 1); SBAR();                                                                                   \
        MS_KSTEP(BUF, 0); MS_KSTEP(BUF, 1); MS_KSTEP(BUF, 2); MS_KSTEP(BUF, 3);                                                                            \
        if ((t) + 1 < 4) { VMW(); MS_WRITE((BUF) ^ 1); } __syncthreads(); } while (0)
    MS_LOAD(0); VMW(); MS_WRITE(0); __syncthreads();
    MS_TILE(0, 0); MS_TILE(1, 1); MS_TILE(2, 0); MS_TILE(3, 1);
#pragma unroll
    for (int e0 = 0; e0 < 4; ++e0)
#pragma unroll
        for (int r = 0; r < 16; ++r) { const float v = acc[e0][r] * R.scale, vn = __shfl_xor(v, 1);
            if ((r32 & 1) == 0) *(unsigned*)(R.U + (unsigned)((32 * e0 + crow(r, hi)) * 256 + 128 * half + 32 * d0 + r32)) = cvtpk(v, vn); }
    if (wid < 4 && r32 == 0) {
#pragma unroll
        for (int r = 0; r < 16; ++r) R.nU[32 * wid + crow(r, hi)] = accn[r] * R.scale; }
#undef MS_LOAD
#undef MS_WRITE
#undef MS_KSTEP
#undef MS_TILE
}
struct OutRef { const bf16* Q; const bf16* K; const bf16* V; const bf16* C; const float* nC; bf16* O; const float* aux; const float* a2; float aref, mprev; int P0; };
__device__ __forceinline__ void mlstm_out_pass(const OutRef& R, char* lds) {
    int tid0_ = threadIdx.x; asm volatile("" : "+v"(tid0_));
    const int tid = tid0_, wid = __builtin_amdgcn_readfirstlane(tid >> 6), lane = tid & 63, r32 = lane & 31, hi = lane >> 5;
    const int qlo = R.P0 + wid * QBLK, qm = qlo + r32 - 4 * hi;
    char* V_lds = lds; char* K_lds = lds + 2 * SHM_V;
    float* ws = (float*)(lds + OFF_WS) + wid * 64; float* li_l = ws; const float* ckl = nullptr;
    const int sr = tid >> 4, sc = (tid & 15) * 8, vst0 = v_st(sr, sc), vst1 = v_st(32 + sr, sc), kws = KSWZ(sr, sc * 2);
    const int vb0 = (int)(uintptr_t)V_lds + v_rd_base(lane);
    bf16x8 qr[8], st_v0, st_v1, st_k0, st_k1; float sf0 = 0.f, sf1 = 0.f;
#pragma unroll
    for (int d0 = 0; d0 < 8; ++d0) qr[d0] = load8(R.Q + (size_t)qlo * 512 + (unsigned)(r32 * 512 + d0 * 16 + hi * 8));
    const float m2row = R.aux[qlo + r32];
    const float fr = __builtin_amdgcn_exp2f(R.aref - m2row), wst = __builtin_amdgcn_exp2f(R.mprev - m2row);
    float l_reg = 0.f; f32x16 o[4] = {}; f32x16 p0, p1; bf16x8 pa0, pa1, pa2, pa3;
#define MO_LOADKV(t) do { const bf16* vp_ = R.V + (size_t)(R.P0 + (t) * 64) * 6144; const bf16* kp_ = R.K + (size_t)(R.P0 + (t) * 64) * 512;               \
        st_v0 = load8(vp_ + (unsigned)(sr * 6144 + sc)); st_v1 = load8(vp_ + (unsigned)((32 + sr) * 6144 + sc));                                        \
        st_k0 = load8(kp_ + (unsigned)(sr * 512 + sc)); st_k1 = load8(kp_ + (unsigned)((32 + sr) * 512 + sc));                                          \
        sf0 = R.a2[R.P0 + (t) * 64 + sr]; sf1 = R.a2[R.P0 + (t) * 64 + 32 + sr]; } while (0)
#define MO_LOADC(j) do { const bf16* cp_ = R.C + (size_t)((j) * 64) * 256; st_v0 = load8(cp_ + (unsigned)(sr * 256 + sc)); st_v1 = load8(cp_ + (unsigned)((32 + sr) * 256 + sc)); } while (0)
#define MO_WRITEV(b) do { *(bf16x8*)(V_lds + (b) * SHM_V + vst0) = st_v0; *(bf16x8*)(V_lds + (b) * SHM_V + vst1) = st_v1; } while (0)
#define MO_WRITEK(b) do { *(bf16x8*)(K_lds + (b) * SHM_K + kws) = scale8(st_k0, __builtin_amdgcn_exp2f(sf0 - R.aref)); *(bf16x8*)(K_lds + (b) * SHM_K + kws + 32 * 256) = scale8(st_k1, __builtin_amdgcn_exp2f(sf1 - R.aref)); } while (0)
    MO_LOADKV(0); VMW(); MO_WRITEV(0); MO_WRITEK(0); __syncthreads();
#define MO_STEP(i, BUF) do {                                                                                                                             \
        if ((i) + 1 < 4) MO_LOADKV((i) + 1); else if ((i) + 1 < 6) MO_LOADC((i) + 1 - 4);                                                                 \
        SBAR();                                                                                                                                         \
        if ((i) < 4) { qkt<BUF, 1>(p0, p1, K_lds, ckl, r32, hi, qr); SBAR();                                                                              \
            { const int kb_ = R.P0 + (i) * 64; if (kb_ + KVBLK - 1 > qlo) mask_tile<1>(p0, p1, qm - kb_); }                                                \
            linScale(p0, p1, fr); linFinish(p0, p1, l_reg, pa0, pa1, pa2, pa3); }                                                                         \
        else { pa0 = scale8(qr[4 * ((i) - 4) + 0], wst); pa1 = scale8(qr[4 * ((i) - 4) + 1], wst); pa2 = scale8(qr[4 * ((i) - 4) + 2], wst); pa3 = scale8(qr[4 * ((i) - 4) + 3], wst); } \
        SBAR(); pv_tile<BUF>(o, vb0, pa0, pa1, pa2, pa3); SBAR();                                                                                        \
        if ((i) + 1 < 6) { VMW(); MO_WRITEV((BUF) ^ 1); if ((i) + 1 < 4) MO_WRITEK((BUF) ^ 1); }                                                          \
        __syncthreads(); } while (0)
    MO_STEP(0, 0); MO_STEP(1, 1); MO_STEP(2, 0); MO_STEP(3, 1); MO_STEP(4, 0); MO_STEP(5, 1);
    { float qn = 0.f;
#pragma unroll
      for (int d0 = 0; d0 < 8; ++d0) { const u32x4 u = __builtin_bit_cast(u32x4, qr[d0]); const f32x4 na = *(const f32x4*)(R.nC + d0 * 16 + hi * 8), nb = *(const f32x4*)(R.nC + d0 * 16 + hi * 8 + 4);
          qn += ::bflo(u.x) * na[0] + ::bfhi(u.x) * na[1] + ::bflo(u.y) * na[2] + ::bfhi(u.y) * na[3] + ::bflo(u.z) * nb[0] + ::bfhi(u.z) * nb[1] + ::bflo(u.w) * nb[2] + ::bfhi(u.w) * nb[3]; }
      auto rr = __builtin_amdgcn_permlane32_swap(__float_as_uint(qn), __float_as_uint(qn), false, false);
      l_reg += wst * (__uint_as_float(rr[0]) + __uint_as_float(rr[1])); }
    { const float lv = fmaxf(fabsf(l_reg), R.aux[AUX_MEXP + qlo + r32]); if (hi == 0) li_l[r32] = lv; }
    asm volatile("s_waitcnt lgkmcnt(0)" ::: "memory");
    float rli[16];
#pragma unroll
    for (int r = 0; r < 16; ++r) rli[r] = __builtin_amdgcn_rcpf(li_l[crow(r, hi)]);
    bf16* Ow = R.O + (size_t)qlo * 1024;
#pragma unroll
    for (int r = 0; r < 16; ++r) { const int orow = crow(r, hi);
#pragma unroll
        for (int d0 = 0; d0 < 4; ++d0) { const float v = o[d0][r] * rli[r]; const float vn = __shfl_xor(v, 1);
            if ((r32 & 1) == 0) *(unsigned*)(Ow + (unsigned)(orow * 1024 + d0 * 32 + r32)) = cvtpk(v, vn); } }
    asm volatile("s_waitcnt lgkmcnt(0)" ::: "memory");
    __syncthreads();
#undef MO_LOADKV
#undef MO_LOADC
#undef MO_WRITEV
#undef MO_WRITEK
#undef MO_STEP
}
#undef TRRD2
#undef FRAG8
#undef ROWK
#undef ROWV
#undef VMW
#undef VMWN
#undef SLOAD_H
#undef SWRITE_HK
#undef SWRITE_HV
#undef SWRITE_H
#undef SBAR
#undef KSWZ
}
#define LAS __attribute__((address_space(3)))
#define GAS __attribute__((address_space(1)))
#define RLX_AGENT __ATOMIC_RELAXED, __HIP_MEMORY_SCOPE_AGENT
#define XB_TMO      128
#define XB_XCNT(j)  (256  + 64 * (j))
#define XB_XSUB(j)  (1280 + 64 * (j))
#define XB_XGEN(j)  (2304 + 64 * (j))
#define XB_TOP      3328
#define XB_TOPGEN   3392
#define XCD_BAR_WORDS 3456
#define XB_SPIN_CAP (1u << 18)

__device__ __forceinline__ unsigned xb_ld(unsigned* p)              { return __hip_atomic_load(p, __ATOMIC_RELAXED, __HIP_MEMORY_SCOPE_AGENT); }
__device__ __forceinline__ unsigned xb_add(unsigned* p, unsigned v) { return __hip_atomic_fetch_add(p, v, __ATOMIC_RELAXED, __HIP_MEMORY_SCOPE_AGENT); }
__device__ __forceinline__ unsigned xb_xcc_id() { return (unsigned)__builtin_amdgcn_s_getreg((3 << 11) | 20) & 0xFu; }
#define XB_SPIN(cond, bar) do { unsigned _sp = 0; while (cond) { __builtin_amdgcn_s_sleep(1); \
    if ((++_sp & 255u) == 0u) { if (xb_ld(&(bar)[XB_TMO])) break; if (_sp > XB_SPIN_CAP) { atomicAdd(&(bar)[XB_TMO], 1u); break; } } } } while (0)

struct XcdBarrier {
    unsigned* bar; unsigned x;
    volatile LAS unsigned* st;
};

__device__ __forceinline__ XcdBarrier xcd_barrier_post(unsigned* bar, volatile LAS unsigned* st) {
    XcdBarrier b; b.bar = bar; b.x = xb_xcc_id(); b.st = st;
    if (threadIdx.x == 0) (void)xb_add(&bar[XB_XCNT(b.x)], 1u);
    return b;
}
__device__ __forceinline__ void xcd_barrier_complete(unsigned* bar, unsigned x, unsigned& nloc, unsigned& nx) {
    const unsigned G = gridDim.x * gridDim.y * gridDim.z;
    unsigned sum, cnt, mine, sp = 0u;
    for (;;) {
        sum = 0u; cnt = 0u; mine = 0u;
#pragma unroll
        for (unsigned j = 0; j < 16; ++j) { const unsigned c = xb_ld(&bar[XB_XCNT(j)]); sum += c; cnt += (c > 0u) ? 1u : 0u; mine = (j == x) ? c : mine; }
        if (sum == G) break;
        __builtin_amdgcn_s_sleep(1);
        if ((++sp & 255u) == 0u) { if (xb_ld(&bar[XB_TMO])) break; if (sp > XB_SPIN_CAP) { atomicAdd(&bar[XB_TMO], 1u); break; } }
    }
    nloc = mine > 0u ? mine : 1u; nx = cnt > 0u ? cnt : 1u;
}

__device__ __forceinline__ void xcd_barrier(const XcdBarrier& b) {
    asm volatile("s_waitcnt vmcnt(0)" ::: "memory");
    __syncthreads();
    if (threadIdx.x == 0) {
        unsigned* bar = b.bar;
        __builtin_amdgcn_s_waitcnt(0);
        unsigned nloc = b.st[0], nx = b.st[1];
        if (nloc == 0u) { xcd_barrier_complete(bar, b.x, nloc, nx); b.st[0] = nloc; b.st[1] = nx; }
        const unsigned old = xb_add(&bar[XB_XSUB(b.x)], 1u);
        const unsigned gen = old / nloc;
        if (old + 1u == (gen + 1u) * nloc) {
            __builtin_amdgcn_fence(__ATOMIC_RELEASE, "agent");
            asm volatile("s_waitcnt vmcnt(0)" ::: "memory");
            const unsigned og = xb_add(&bar[XB_TOP], 1u);
            const unsigned tg = og / nx;
            if (og + 1u == (tg + 1u) * nx) xb_add(&bar[XB_TOPGEN], 1u);
            else XB_SPIN(xb_ld(&bar[XB_TOPGEN]) == tg, bar);
            __builtin_amdgcn_fence(__ATOMIC_ACQUIRE, "agent");
            xb_add(&bar[XB_XGEN(b.x)], 1u);
            asm volatile("s_waitcnt vmcnt(0)" ::: "memory");
        } else {
            XB_SPIN(xb_ld(&bar[XB_XGEN(b.x)]) == gen, bar);
            __builtin_amdgcn_fence(__ATOMIC_ACQUIRE, "agent");
            asm volatile("s_waitcnt vmcnt(0)" ::: "memory");
        }
    }
    __syncthreads();
}
constexpr int NWAVES = 8, NTHREADS = NWAVES * 64;
constexpr int LDS_BYTES = 131072 + 4096;
static_assert(fa::LDS_BYTES <= 131072, "attention scratch fits the ring region");
constexpr size_t MiB = 1u << 20;
constexpr size_t WS_SS = 0;
constexpr size_t WS_BAR = 512 * 1024;
constexpr size_t WS_G = 1 * MiB;
constexpr size_t WS_CK = 2 * MiB;
constexpr size_t WS_A2 = 2 * MiB + 512 * 1024, WS_M2 = WS_A2 + 256 * 1024, WS_MEXP = WS_M2 + 256 * 1024, WS_AREF = WS_MEXP + 256 * 1024;
static_assert((WS_MEXP - WS_M2) / 4 == fa::AUX_MEXP && (WS_AREF - WS_M2) / 4 == fa::AUX_AREF, "aux offsets");
constexpr size_t WS_WIN = 4 * MiB, WS_WO = 29 * MiB, WS_WGU = 37 * MiB, WS_WD = 81 * MiB, WS_WPG = 103 * MiB, WS_WPP = 111 * MiB;
constexpr size_t WS_R1 = 112 * MiB;
constexpr size_t WS_R2 = 304 * MiB;
constexpr size_t WS_R3 = 368 * MiB;
constexpr size_t WS_HB = WS_R3, WS_MQ = WS_R3 + 32 * MiB, WS_MK = WS_R3 + 48 * MiB;
constexpr size_t WS_ERAW = 432 * MiB;
constexpr size_t WS_UB = 496 * MiB, WS_END = 512 * MiB;
constexpr size_t WS_CB = WS_WIN, WS_NU = WS_WIN + 16 * MiB, WS_NC = WS_NU + 128 * 1024;
constexpr size_t WS_GB = WS_BAR + 16384;

struct Args {
    const float *x, *p, *w_norm_mix, *w_in, *fox_f_bias, *q_norm_w, *k_norm_w, *conv_w, *conv_b, *mi_bias, *mf_bias, *out_norm_w, *w_out, *w_norm_ffn,
                *w_gate, *w_up, *w_down, *w_norm_ple, *w_ple_gate, *w_ple_proj, *w_ple_post;
    float* out; unsigned char* ws;
};

__device__ __forceinline__ float wave_sum(float v) {
#pragma unroll
    for (int o = 1; o < 64; o <<= 1) v += __shfl_xor(v, o);
    return v;
}
__device__ __forceinline__ int win_src_col(int d) {
    if (d < 3072) return d;
    if (d < 5120) return d + 8;
    if (d < 6144) return d + 16;
    if (d < 6152) return 3072 + (d - 6144);
    if (d < 6160) return 5128 + (d - 6152);
    return -1;
}
struct TItem { const float* src4; const float* kw; bf16_t* dst; int ld, K; };
__device__ __forceinline__ TItem p0_item(const Args& A, int it, int lane) {
    constexpr int I_IN = (DM / 64) * (NIN / 32), I_O = (DM / 64) * (DM / 32), I_GU = (DM / 64) * (2 * DFF / 32), I_D = (DFF / 64) * (DM / 32), I_PG = I_O;
    unsigned char* ws = A.ws; const int n4 = 4 * (lane & 7), kr = lane >> 3; TItem t; int r = it;
    if (r < I_IN) { const int nblk = NIN / 32, kb = r / nblk, nb = r % nblk; const int sc = win_src_col(nb * 32 + n4);
        t.src4 = sc >= 0 ? A.w_in + (size_t)(kb * 64 + kr) * INC + sc : nullptr; t.kw = A.w_norm_mix + kb * 64 + kr; t.ld = INC; t.K = DM; t.dst = (bf16_t*)(ws + WS_WIN) + (size_t)(nb * 32) * DM + kb * 64; return t; } r -= I_IN;
    if (r < I_O) { const int nblk = DM / 32, kb = r / nblk, nb = r % nblk; t.src4 = A.w_out + (size_t)(kb * 64 + kr) * DM + nb * 32 + n4; t.kw = nullptr; t.ld = DM; t.K = DM; t.dst = (bf16_t*)(ws + WS_WO) + (size_t)(nb * 32) * DM + kb * 64; return t; } r -= I_O;
    if (r < I_GU) { const int nblk = 2 * DFF / 32, kb = r / nblk, nb = r % nblk; const int d = nb * 32, pn = d >> 8, j = d & 255;
        t.src4 = ((j < 128) ? A.w_gate + 128 * pn + j : A.w_up + 128 * pn + (j - 128)) + (size_t)(kb * 64 + kr) * DFF + n4; t.kw = A.w_norm_ffn + kb * 64 + kr; t.ld = DFF; t.K = DM; t.dst = (bf16_t*)(ws + WS_WGU) + (size_t)d * DM + kb * 64; return t; } r -= I_GU;
    if (r < I_D) { const int nblk = DM / 32, kb = r / nblk, nb = r % nblk; t.src4 = A.w_down + (size_t)(kb * 64 + kr) * DM + nb * 32 + n4; t.kw = nullptr; t.ld = DM; t.K = DFF; t.dst = (bf16_t*)(ws + WS_WD) + (size_t)(nb * 32) * DFF + kb * 64; return t; } r -= I_D;
    if (r < I_PG) { const int nblk = DM / 32, kb = r / nblk, nb = r % nblk; t.src4 = A.w_ple_gate + (size_t)(kb * 64 + kr) * DM + nb * 32 + n4; t.kw = A.w_norm_ple + kb * 64 + kr; t.ld = DM; t.K = DM; t.dst = (bf16_t*)(ws + WS_WPG) + (size_t)(nb * 32) * DM + kb * 64; return t; } r -= I_PG;
    { const int nblk = DM / 32, kb = r / nblk, nb = r % nblk; t.src4 = A.w_ple_proj + (size_t)(kb * 64 + kr) * DM + nb * 32 + n4; t.kw = nullptr; t.ld = DM; t.K = PLE; t.dst = (bf16_t*)(ws + WS_WPP) + (size_t)(nb * 32) * PLE + kb * 64; return t; }
}
__device__ __forceinline__ void p0_item_load(const TItem& t, f32x4 (&v)[8]) {
#pragma unroll
    for (int i = 0; i < 8; ++i) { v[i] = t.src4 ? *(const f32x4*)(t.src4 + (size_t)(8 * i) * t.ld) : (f32x4){0.f, 0.f, 0.f, 0.f}; if (t.kw) v[i] = v[i] * t.kw[8 * i]; }
}
__device__ __forceinline__ void p0_item_store(const TItem& t, const f32x4 (&v)[8], LAS float* scr, int lane) {
    const int n4 = 4 * (lane & 7), kr = lane >> 3;
#pragma unroll
    for (int i = 0; i < 8; ++i) { LAS float* d = scr + (kr + 8 * i) * 33 + n4; d[0] = v[i].x; d[1] = v[i].y; d[2] = v[i].z; d[3] = v[i].w; }
    asm volatile("s_waitcnt lgkmcnt(0)" ::: "memory");
    const int c = lane & 7;
#pragma unroll
    for (int j = 0; j < 4; ++j) { const int n = (lane >> 3) + 8 * j; const LAS float* s = scr + (8 * c) * 33 + n;
        u32x4 o; o.x = cvtpk2(s[0 * 33], s[1 * 33]); o.y = cvtpk2(s[2 * 33], s[3 * 33]); o.z = cvtpk2(s[4 * 33], s[5 * 33]); o.w = cvtpk2(s[6 * 33], s[7 * 33]);
        *(u32x4*)(t.dst + (size_t)n * t.K + 8 * c) = o; }
    asm volatile("s_waitcnt lgkmcnt(0)" ::: "memory");
}
__device__ __forceinline__ void p0_prologue(const Args& A, LAS unsigned char* lds, int gw, int NGW, int lane, int wave) {
    LAS float* scr = (LAS float*)(lds + wave * 16384);
    unsigned char* ws = A.ws;
    constexpr int NITEMS = (DM / 64) * (NIN / 32) + 2 * (DM / 64) * (DM / 32) + (DM / 64) * (2 * DFF / 32) + (DFF / 64) * (DM / 32) + (PLE / 64) * (DM / 32);
    if (gw < NITEMS) {
        TItem cur = p0_item(A, gw, lane); f32x4 v[8]; p0_item_load(cur, v);
        for (int it = gw; it < NITEMS; it += NGW) {
            const bool more = it + NGW < NITEMS; TItem nx = cur; f32x4 w[8];
            if (more) { nx = p0_item(A, it + NGW, lane); p0_item_load(nx, w); }
            p0_item_store(cur, v, scr, lane);
            if (more) { cur = nx;
#pragma unroll
                for (int i = 0; i < 8; ++i) v[i] = w[i]; }
        }
    }
    bf16_t* XB = (bf16_t*)(ws + WS_R2); float* ss0 = (float*)(ws + WS_SS) + 3 * MROWS;
    {
        f32x4 v[8];
#pragma unroll
        for (int j = 0; j < 8; ++j) v[j] = ((const f32x4*)(A.x + (size_t)gw * DM) + lane)[64 * j];
        for (int m = gw; m < MROWS; m += NGW) {
            f32x4 nv[8]; const bool more = m + NGW < MROWS;
            if (more) {
#pragma unroll
                for (int j = 0; j < 8; ++j) nv[j] = ((const f32x4*)(A.x + (size_t)(m + NGW) * DM) + lane)[64 * j]; }
            float s = 0.f; u32x2* o8 = (u32x2*)(XB + (size_t)m * DM) + lane;
#pragma unroll
            for (int j = 0; j < 8; ++j) { s += (v[j].x * v[j].x + v[j].y * v[j].y) + (v[j].z * v[j].z + v[j].w * v[j].w); u32x2 w; w.x = cvtpk2(v[j].x, v[j].y); w.y = cvtpk2(v[j].z, v[j].w); o8[64 * j] = w; }
            s = wave_sum(s); if (lane == 0) ss0[m] = s;
            if (more) {
#pragma unroll
                for (int j = 0; j < 8; ++j) v[j] = nv[j]; }
        }
    }
    bf16_t* PB = (bf16_t*)(ws + WS_R3);
    for (int m = gw; m < MROWS; m += NGW) { const f32x4 v = ((const f32x4*)(A.p + (size_t)m * PLE))[lane]; u32x2 w; w.x = cvtpk2(v.x, v.y); w.y = cvtpk2(v.z, v.w); ((u32x2*)(PB + (size_t)m * PLE))[lane] = w; }
    float* ss = (float*)(ws + WS_SS);
    for (int i = gw * 64 + lane; i < 3 * MROWS; i += NGW * 64) ss[i] = 0.f;
}
__device__ __forceinline__ void gate_cols(const Args& A, LAS unsigned char* ldsl, int bx, int G) {
    typedef short bf16x8_ __attribute__((ext_vector_type(8))); typedef float f32x16_ __attribute__((ext_vector_type(16)));
    int tid0_ = threadIdx.x; asm volatile("" : "+v"(tid0_));
    const int tid = tid0_, lane = tid & 63, r32 = lane & 31, hi = lane >> 5, wave = __builtin_amdgcn_readfirstlane(tid >> 6);
    const bf16_t* XB = (const bf16_t*)(A.ws + WS_R2); const bf16_t* Wg = (const bf16_t*)(A.ws + WS_WIN) + (size_t)6144 * DM;
    float* Gout = (float*)(A.ws + WS_G); const float* ss0 = (const float*)(A.ws + WS_SS) + 3 * MROWS;
    LAS float* red = (LAS float*)ldsl;
    for (int t = bx; t < MROWS / 32; t += G) {
        const int row0 = t * 32; f32x16_ acc = {};
        const bf16_t* ap = XB + (size_t)(row0 + r32) * DM + wave * 256 + 8 * hi; const bf16_t* bp = Wg + (size_t)r32 * DM + wave * 256 + 8 * hi;
        bf16x8_ av[16], bv[16];
#pragma unroll
        for (int ks = 0; ks < 16; ++ks) { av[ks] = *(const bf16x8_*)(ap + 16 * ks); bv[ks] = *(const bf16x8_*)(bp + 16 * ks); }
#pragma unroll
        for (int ks = 0; ks < 16; ++ks) acc = __builtin_amdgcn_mfma_f32_32x32x16_bf16(av[ks], bv[ks], acc, 0, 0, 0);
        LAS float* rp = red + (wave * 64 + lane) * 16;
#pragma unroll
        for (int r = 0; r < 16; ++r) rp[r] = acc[r];
        __syncthreads();
        for (int e = tid; e < 1024; e += NTHREADS) { float s = 0.f;
#pragma unroll
            for (int w = 0; w < 8; ++w) s += red[w * 1024 + e];
            const int ln = e >> 4, r = e & 15, col = ln & 31, row = row0 + (r & 3) + 8 * (r >> 2) + 4 * (ln >> 5);
            if (col < 16) Gout[(size_t)row * 16 + col] = s * (1.f / sqrtf(ss0[row] * (1.f / DM) + EPS)); }
        __syncthreads();
    }
}
__device__ __forceinline__ float logsigf(float x) { return fminf(x, 0.f) - log1pf(expf(-fabsf(x))); }
__device__ __forceinline__ void scan_sequence(const Args& A, int v, LAS float* red) {
    const int tid = threadIdx.x, lane = tid & 63, wid = tid >> 6;
    const bool fox = v < NB * AH; int b, h;
    if (fox) { b = v / AH; h = v % AH; } else { const int u = v - NB * AH; b = u / MH; h = u % MH; }
    const float* Gp = (const float*)(A.ws + WS_G) + (size_t)(b * SEQ + 8 * tid) * 16;
    const int fcol = fox ? h : 12 + h; const float fb = fox ? A.fox_f_bias[h] : A.mf_bias[h];
    float lf[8]; float run = 0.f;
#pragma unroll
    for (int i = 0; i < 8; ++i) { run += logsigf(Gp[i * 16 + fcol] + fb); lf[i] = run; }
    float incl = run;
#pragma unroll
    for (int o = 1; o < 64; o <<= 1) { const float t = __shfl_up(incl, o); if (lane >= o) incl += t; }
    if (lane == 63) red[wid] = incl;
    __syncthreads();
    float base = incl - run;
    for (int w = 0; w < wid; ++w) base += red[w];
    if (fox) {
        float* CK = (float*)(A.ws + WS_CK) + (size_t)(b * AH + h) * SEQ + 8 * tid;
#pragma unroll
        for (int i = 0; i < 8; ++i) CK[i] = -(base + lf[i]) * 11.313708498984761f;
    } else {
        const float ib = A.mi_bias[h];
        float a[8], lm[8]; float rm = -__builtin_inff();
#pragma unroll
        for (int i = 0; i < 8; ++i) { a[i] = (Gp[i * 16 + 8 + h] + ib) - (base + lf[i]); rm = fmaxf(rm, a[i]); lm[i] = rm; }
        float im = rm;
#pragma unroll
        for (int o = 1; o < 64; o <<= 1) { const float t = __shfl_up(im, o); if (lane >= o) im = fmaxf(im, t); }
        if (lane == 63) red[8 + wid] = im;
        __syncthreads();
        float ex = __shfl_up(im, 1); if (lane == 0) ex = -__builtin_inff();
        for (int w = 0; w < wid; ++w) ex = fmaxf(ex, red[8 + w]);
        const size_t o0 = (size_t)(b * MH + h) * SEQ + 8 * tid;
        float* A2 = (float*)(A.ws + WS_A2) + o0; float* M2 = (float*)(A.ws + WS_M2) + o0; float* ME = (float*)(A.ws + WS_MEXP) + o0;
#pragma unroll
        for (int i = 0; i < 8; ++i) { const float Mt = fmaxf(0.f, fmaxf(ex, lm[i])); A2[i] = a[i] * LOG2E; M2[i] = Mt * LOG2E; ME[i] = expf(-((base + lf[i]) + Mt)); }
        float tm = rm; tm = fmaxf(tm, __shfl_xor(tm, 1)); tm = fmaxf(tm, __shfl_xor(tm, 2)); tm = fmaxf(tm, __shfl_xor(tm, 4)); tm = fmaxf(tm, __shfl_xor(tm, 8)); tm = fmaxf(tm, __shfl_xor(tm, 16));
        if ((lane & 31) == 0) ((float*)(A.ws + WS_AREF))[(b * MH + h) * SEQ + (tid >> 5)] = tm * LOG2E;
    }
}
__device__ __forceinline__ void unpack8(const u32x4 w, float (&f)[8]) { f[0] = bflo(w.x); f[1] = bfhi(w.x); f[2] = bflo(w.y); f[3] = bfhi(w.y); f[4] = bflo(w.z); f[5] = bfhi(w.z); f[6] = bflo(w.w); f[7] = bfhi(w.w); }
__device__ __forceinline__ u32x4 pack8f(const float (&f)[8]) { u32x4 w; w.x = cvtpk2(f[0], f[1]); w.y = cvtpk2(f[2], f[3]); w.z = cvtpk2(f[4], f[5]); w.w = cvtpk2(f[6], f[7]); return w; }
__device__ __forceinline__ void qk_norm_rows(const Args& A, int gw, int NGW, int lane) {
    bf16_t* PROJ = (bf16_t*)(A.ws + WS_R1);
    const int d0 = (8 * lane) & 127;
    float qw[8], kw[8];
#pragma unroll
    for (int i = 0; i < 8; ++i) { qw[i] = A.q_norm_w[d0 + i]; kw[i] = A.k_norm_w[d0 + i]; }
    u32x4 raw[4];
#pragma unroll
    for (int j = 0; j < 4; ++j) raw[j] = *(const u32x4*)(PROJ + (size_t)gw * PROJ_LD + 8 * lane + 512 * j);
    for (int m = gw; m < MROWS; m += NGW) {
        bf16_t* p = PROJ + (size_t)m * PROJ_LD + 8 * lane; const bool more = m + NGW < MROWS;
        u32x4 nraw[4];
        if (more) {
#pragma unroll
            for (int j = 0; j < 4; ++j) nraw[j] = *(const u32x4*)(p + (size_t)NGW * PROJ_LD + 512 * j); }
#pragma unroll
        for (int j = 0; j < 4; ++j) { float f[8]; unpack8(raw[j], f); float s = 0.f;
#pragma unroll
            for (int i = 0; i < 8; ++i) s += f[i] * f[i];
            s += __shfl_xor(s, 1); s += __shfl_xor(s, 2); s += __shfl_xor(s, 4); s += __shfl_xor(s, 8);
            const float rs = 1.f / sqrtf(s * (1.f / 128.f) + EPS);
#pragma unroll
            for (int i = 0; i < 8; ++i) f[i] = f[i] * rs * (j < 2 ? qw[i] : kw[i]);
            *(u32x4*)(p + 512 * j) = pack8f(f); }
        if (more) {
#pragma unroll
            for (int j = 0; j < 4; ++j) raw[j] = nraw[j]; }
    }
}
__device__ __forceinline__ void mconv_rows(const Args& A, int gw, int NGW, int lane) {
    const bf16_t* PROJ = (const bf16_t*)(A.ws + WS_R1) + PC_MQ + 16 * lane;
    bf16_t* OUT = (bf16_t*)(A.ws + (lane < 32 ? WS_MQ : WS_MK)) + 16 * (lane & 31);
    const int c0 = 16 * lane;
    float w[4][16], bb[16];
#pragma unroll
    for (int j = 0; j < 4; ++j)
#pragma unroll
        for (int i = 0; i < 16; ++i) w[j][i] = A.conv_w[j * 1024 + c0 + i];
#pragma unroll
    for (int i = 0; i < 16; ++i) bb[i] = A.conv_b[c0 + i];
    const float sc = lane < 32 ? 0.08838834764831845f : 1.f;
    u32x4 tap[4][2];
#define MC_LOAD(dst, m_) do { const int t_ = (m_) & (SEQ - 1); _Pragma("unroll") for (int j = 0; j < 4; ++j) { \
        if (t_ - 3 + j >= 0) { (dst)[j][0] = *(const u32x4*)(PROJ + (size_t)((m_) - 3 + j) * PROJ_LD); (dst)[j][1] = *(const u32x4*)(PROJ + (size_t)((m_) - 3 + j) * PROJ_LD + 8); } \
        else { (dst)[j][0] = (u32x4){0u, 0u, 0u, 0u}; (dst)[j][1] = (u32x4){0u, 0u, 0u, 0u}; } } } while (0)
    MC_LOAD(tap, gw);
    for (int m = gw; m < MROWS; m += NGW) {
        const bool more = m + NGW < MROWS; u32x4 ntap[4][2];
        if (more) MC_LOAD(ntap, m + NGW);
        float acc[16];
#pragma unroll
        for (int i = 0; i < 16; ++i) acc[i] = bb[i];
#pragma unroll
        for (int j = 0; j < 4; ++j) { float f[8]; unpack8(tap[j][0], f);
#pragma unroll
            for (int i = 0; i < 8; ++i) acc[i] = fmaf(w[j][i], f[i], acc[i]);
            unpack8(tap[j][1], f);
#pragma unroll
            for (int i = 0; i < 8; ++i) acc[8 + i] = fmaf(w[j][8 + i], f[i], acc[8 + i]); }
        float o[8];
#pragma unroll
        for (int i = 0; i < 8; ++i) o[i] = acc[i] * sigmoidf_(acc[i]) * sc;
        *(u32x4*)(OUT + (size_t)m * 512) = pack8f(o);
#pragma unroll
        for (int i = 0; i < 8; ++i) o[i] = acc[8 + i] * sigmoidf_(acc[8 + i]) * sc;
        *(u32x4*)(OUT + (size_t)m * 512 + 8) = pack8f(o);
        if (more) {
#pragma unroll
            for (int j = 0; j < 4; ++j) { tap[j][0] = ntap[j][0]; tap[j][1] = ntap[j][1]; } }
    }
#undef MC_LOAD
}
__device__ __forceinline__ void mlstm_out_rows(const Args& A, int gw, int NGW, int lane) {
    const bf16_t* HB = (const bf16_t*)(A.ws + WS_HB) + 16 * lane;
    const bf16_t* MO = (const bf16_t*)(A.ws + WS_R1) + PC_MO + 16 * lane;
    bf16_t* MIX = (bf16_t*)(A.ws + WS_R2) + 1024 + 16 * lane;
    float ow[16];
#pragma unroll
    for (int i = 0; i < 16; ++i) ow[i] = A.out_norm_w[16 * lane + i];
    for (int m = gw; m < MROWS; m += NGW) {
        float h[16], g[16];
        { float f[8]; unpack8(*(const u32x4*)(HB + (size_t)m * 1024), f);
#pragma unroll
          for (int i = 0; i < 8; ++i) h[i] = f[i];
          unpack8(*(const u32x4*)(HB + (size_t)m * 1024 + 8), f);
#pragma unroll
          for (int i = 0; i < 8; ++i) h[8 + i] = f[i];
          unpack8(*(const u32x4*)(MO + (size_t)m * PROJ_LD), f);
#pragma unroll
          for (int i = 0; i < 8; ++i) g[i] = f[i];
          unpack8(*(const u32x4*)(MO + (size_t)m * PROJ_LD + 8), f);
#pragma unroll
          for (int i = 0; i < 8; ++i) g[8 + i] = f[i]; }
        float s = 0.f;
#pragma unroll
        for (int i = 0; i < 16; ++i) s += h[i] * h[i];
        s += __shfl_xor(s, 1); s += __shfl_xor(s, 2); s += __shfl_xor(s, 4); s += __shfl_xor(s, 8);
        const float rs = 1.f / sqrtf(s * (1.f / 256.f) + EPS);
        float o[8];
#pragma unroll
        for (int i = 0; i < 8; ++i) o[i] = h[i] * rs * ow[i] * sigmoidf_(g[i]);
        *(u32x4*)(MIX + (size_t)m * DM) = pack8f(o);
#pragma unroll
        for (int i = 0; i < 8; ++i) o[i] = h[8 + i] * rs * ow[8 + i] * sigmoidf_(g[8 + i]);
        *(u32x4*)(MIX + (size_t)m * DM + 8) = pack8f(o);
    }
}
__device__ __forceinline__ void group_barrier(unsigned* cnt, unsigned target) {
    asm volatile("s_waitcnt vmcnt(0)" ::: "memory");
    __syncthreads();
    if (threadIdx.x == 0) {
        __builtin_amdgcn_fence(__ATOMIC_RELEASE, "agent");
        asm volatile("s_waitcnt vmcnt(0)" ::: "memory");
        (void)__hip_atomic_fetch_add(cnt, 1u, RLX_AGENT);
        unsigned sp = 0;
        while (__hip_atomic_load(cnt, RLX_AGENT) < target) { __builtin_amdgcn_s_sleep(1); if (++sp > (1u << 22)) break; }
        __builtin_amdgcn_fence(__ATOMIC_ACQUIRE, "agent");
        asm volatile("s_waitcnt vmcnt(0)" ::: "memory");
    }
    __syncthreads();
}
__device__ __forceinline__ void mlstm_scan(const Args& A, int g, int x) {
    int tid_ = threadIdx.x; asm volatile("" : "+v"(tid_));
    const float* M2 = (const float*)(A.ws + WS_M2) + (size_t)g * SEQ;
    const bf16_t* U = (const bf16_t*)(A.ws + WS_UB) + (size_t)g * 16 * 32768 + 2048 * x + 4 * tid_;
    bf16_t* C = (bf16_t*)(A.ws + WS_CB) + (size_t)g * 16 * 32768 + 2048 * x + 4 * tid_;
    u32x2 uu[15];
#pragma unroll
    for (int b = 0; b < 15; ++b) uu[b] = *(const u32x2*)(U + (size_t)b * 32768);
    f32x4 c = {0.f, 0.f, 0.f, 0.f}; *(u32x2*)C = (u32x2){0u, 0u};
    float mp = 0.f;
#pragma unroll
    for (int b = 0; b < 15; ++b) { const float me = M2[256 * b + 255]; const float gdec = (b == 0) ? 0.f : __builtin_amdgcn_exp2f(mp - me); mp = me;
        c = c * gdec + (f32x4){bflo(uu[b].x), bfhi(uu[b].x), bflo(uu[b].y), bfhi(uu[b].y)};
        u32x2 w; w.x = cvtpk2(c[0], c[1]); w.y = cvtpk2(c[2], c[3]); *(u32x2*)(C + (size_t)(b + 1) * 32768) = w; }
    if (x == 0 && tid_ < 128) {
        const float* nU = (const float*)(A.ws + WS_NU) + (size_t)g * 16 * 128 + tid_; float* nC = (float*)(A.ws + WS_NC) + (size_t)g * 16 * 128 + tid_;
        float n = 0.f; nC[0] = 0.f; float mq = 0.f;
        for (int b = 0; b < 15; ++b) { const float me = M2[256 * b + 255]; const float gdec = (b == 0) ? 0.f : __builtin_amdgcn_exp2f(mq - me); mq = me; n = n * gdec + nU[b * 128]; nC[(b + 1) * 128] = n; }
    }
}
__device__ __forceinline__ fa::BlockRef p3_fblock(const Args& A, int w, int i) {
    const int x = w & 15, g = w >> 4; fa::BlockRef r; const int bh = 2 * g + (x >> 3), b = bh / AH, h = bh % AH; const size_t row0 = (size_t)b * SEQ;
    const fa::bf16* PROJ = (const fa::bf16*)(A.ws + WS_R1) + row0 * PROJ_LD + h * 128;
    r.Q = PROJ + PC_AQ; r.K = PROJ + PC_AK; r.V = PROJ + PC_AV; r.O = (fa::bf16*)(A.ws + WS_R2) + row0 * DM + h * 128;
    r.aux = (const float*)(A.ws + WS_CK) + (size_t)bh * SEQ; r.P0 = (i == 0 ? (x & 7) : 15 - (x & 7)) * 256; return r;
}

#ifndef ONLY
#define ONLY -1
#endif
#ifndef REP0
#define REP0 1
#endif
#ifndef REP1
#define REP1 1
#endif
#ifndef REP3
#define REP3 1
#endif
#ifndef REP6
#define REP6 1
#endif
#ifndef REP2B
#define REP2B 1
#endif
#ifndef REP4
#define REP4 1
#endif
#ifndef XSYNC
#define XSYNC 0
#endif
#ifndef REP5
#define REP5 1
#endif
#ifndef REP2A
#define REP2A 1
#endif
#ifndef REP7
#define REP7 1
#endif
#ifndef REP8
#define REP8 1
#endif
#ifndef SKIPMASK
#define SKIPMASK 0
#endif
#define PH(k) if constexpr (ONLY < 0 ? !((SKIPMASK >> (k)) & 1) : ONLY == (k))
template <class T> __device__ __forceinline__ T* as_global(T* p) { return (T*)(__attribute__((address_space(1))) T*)p; }
__device__ __forceinline__ Args load_args() {
#if defined(__HIP_DEVICE_COMPILE__)
    const __attribute__((address_space(4))) Args* ap = (const __attribute__((address_space(4))) Args*)__builtin_amdgcn_kernarg_segment_ptr();
    asm volatile("" : "+s"(ap));
    Args a = *ap;
#define FX(f) a.f = as_global(a.f)
    FX(x); FX(p); FX(w_norm_mix); FX(w_in); FX(fox_f_bias); FX(q_norm_w); FX(k_norm_w); FX(conv_w); FX(conv_b); FX(mi_bias); FX(mf_bias); FX(out_norm_w); FX(w_out); FX(w_norm_ffn);
    FX(w_gate); FX(w_up); FX(w_down); FX(w_norm_ple); FX(w_ple_gate); FX(w_ple_proj); FX(w_ple_post); FX(out); FX(ws);
#undef FX
    return a;
#else
    return Args{};
#endif
}
#define ARGS() load_args()
__global__ void __launch_bounds__(NTHREADS, 2) fwd_megakernel(Args Aunused) {
    extern __shared__ __attribute__((aligned(16))) unsigned char lds[];
    cg::grid_group grid = cg::this_grid();
    LAS unsigned char* ldsl = (LAS unsigned char*)lds;
    const int G = gridDim.x, bx = blockIdx.x, NGW = G * NWAVES;
#define LANEVARS() int tid_ = threadIdx.x; asm volatile("" : "+v"(tid_)); const int lane = tid_ & 63, wave = __builtin_amdgcn_readfirstlane(tid_ >> 6), gw = bx * NWAVES + wave; (void)lane; (void)gw

    if (threadIdx.x < 16) ((volatile LAS unsigned*)(ldsl + 131072))[threadIdx.x] = 0u;
    { unsigned* bw = (unsigned*)(ARGS().ws + WS_BAR); if (bx == 0) for (int i = threadIdx.x; i < 4096 + 16 * 64; i += NTHREADS) bw[i] = 0u; }
    __syncthreads();
    PH(0) for (int rep = 0; rep < REP0; ++rep) { const Args A = ARGS(); LANEVARS(); p0_prologue(A, ldsl, gw, NGW, lane, wave); }
    grid.sync();
    XcdBarrier xbar = xcd_barrier_post((unsigned*)(ARGS().ws + WS_BAR), (volatile LAS unsigned*)(ldsl + 131072));
#define GRID_BAR() xcd_barrier(xbar)
    for (int rep = 0; rep < XSYNC; ++rep) GRID_BAR();
    PH(1) { const Args A = ARGS(); gate_cols(A, ldsl, bx, G); }
    PH(1) for (int rep = 0; rep < REP1; ++rep) { const Args A = ARGS(); unsigned char* ws = A.ws;
        pg8::Gemm g{(const bf16_t*)(ws + WS_R2), (const bf16_t*)(ws + WS_WIN), MROWS, PROJ_LD, DM}; pg8::StaticOrder S; S.init(MROWS, PROJ_LD, G, bx);
        pg8::EpiProj E{(bf16_t*)(ws + WS_R1), (const float*)(ws + WS_SS) + 3 * MROWS};
        pg8::gemm_phase<pg8::EpiProj, pg8::StaticOrder, true, true>(ldsl, g, S, E);
    }
    PH(10) { const Args A = ARGS(); unsigned char* ws = A.ws; float* SS = (float*)(ws + WS_SS);
        pg8::Gemm g{(const bf16_t*)(ws + WS_R3), (const bf16_t*)(ws + WS_WPP), MROWS, DM, PLE}; pg8::StaticOrder S; S.init(MROWS, DM, G, bx);
        pg8::EpiE E{(bf16_t*)(ws + WS_ERAW), SS};
        pg8::gemm_phase<pg8::EpiE, pg8::StaticOrder, true, true>(ldsl, g, S, E);
    }
    GRID_BAR();
    PH(2) for (int rep = 0; rep < REP2A; ++rep) { const Args A = ARGS(); for (int v = bx; v < NB * AH + NB * MH; v += G) { scan_sequence(A, v, (LAS float*)ldsl); __syncthreads(); } }
    PH(2) { const Args A = ARGS(); LANEVARS(); qk_norm_rows(A, gw, NGW, lane); }
    PH(2) for (int rep = 0; rep < REP2A; ++rep) { const Args A = ARGS(); LANEVARS(); mconv_rows(A, gw, NGW, lane); }
    GRID_BAR();
    PH(3) for (int rep = 0; rep < REP3; ++rep) { const Args A = ARGS(); const int w = bx & 255, x = w & 15, g = w >> 4;
        unsigned char* ws = A.ws; unsigned* gcnt = (unsigned*)(ws + WS_GB) + 64 * g;
        const int b = g / MH, h = g % MH; const size_t row0 = (size_t)b * SEQ;
        const float* M2 = (const float*)(ws + WS_M2) + (size_t)g * SEQ; const float aref = ((const float*)(ws + WS_AREF))[g * SEQ + x];
        const fa::bf16* MQp = (const fa::bf16*)(ws + WS_MQ) + row0 * 512 + h * 128; const fa::bf16* MKp = (const fa::bf16*)(ws + WS_MK) + row0 * 512 + h * 128;
        const fa::bf16* MVp = (const fa::bf16*)(ws + WS_R1) + row0 * PROJ_LD + PC_MV + h * 256;
        { fa::StateRef R{MKp, MVp, (fa::bf16*)(ws + WS_UB) + (size_t)(g * 16 + x) * 32768, (float*)(ws + WS_NU) + (g * 16 + x) * 128, (const float*)(ws + WS_A2) + (size_t)g * SEQ, aref, exp2f(aref - M2[256 * x + 255]), 256 * x};
          fa::mlstm_state_block(R, (char*)lds); }
        group_barrier(gcnt, 16u * (2 * rep + 1));
        mlstm_scan(A, g, x);
        group_barrier(gcnt, 16u * (2 * rep + 2));
#pragma nounroll
        for (int half = 0; half < 2; ++half) {
            fa::OutRef R{MQp, MKp, MVp + half * 128, (const fa::bf16*)(ws + WS_CB) + (size_t)(g * 16 + x) * 32768 + half * 128, (const float*)(ws + WS_NC) + (g * 16 + x) * 128,
                         (fa::bf16*)(ws + WS_HB) + row0 * 1024 + h * 256 + half * 128, M2, (const float*)(ws + WS_A2) + (size_t)g * SEQ, aref, x > 0 ? M2[256 * x - 1] : 0.f, 256 * x};
            fa::mlstm_out_pass(R, (char*)lds); }
        fa::Seam S;
        { fa::BlockRef c = p3_fblock(A, w, 0); fa::attn_prime<0>(c, (char*)lds, S);
#pragma nounroll
          for (int i = 0; i < 2; ++i) { const fa::BlockRef n = p3_fblock(A, w, 1); fa::attn_block<0>(c, n, (char*)lds, S); c = n; } }
        asm volatile("s_waitcnt vmcnt(0)" ::: "memory");
        __syncthreads();
    }
    GRID_BAR();
    PH(4) for (int rep = 0; rep < REP4; ++rep) { const Args A = ARGS(); LANEVARS(); mlstm_out_rows(A, gw, NGW, lane); }
    GRID_BAR();
    PH(5) for (int rep = 0; rep < REP5; ++rep) { const Args A = ARGS(); unsigned char* ws = A.ws; float* SS = (float*)(ws + WS_SS);
        pg8::Gemm g{(const bf16_t*)(ws + WS_R2), (const bf16_t*)(ws + WS_WO), MROWS, DM, DM}; pg8::StaticOrder S; S.init(MROWS, DM, G, bx);
        pg8::EpiRes<false> E{A.x, (bf16_t*)(ws + WS_R3), SS + MROWS, rep == 0};
        pg8::gemm_phase<pg8::EpiRes<false>, pg8::StaticOrder, true, true>(ldsl, g, S, E);
    }
    GRID_BAR();
    PH(6) for (int rep = 0; rep < REP6; ++rep) { const Args A = ARGS(); unsigned char* ws = A.ws; float* SS = (float*)(ws + WS_SS);
        pg8::Gemm g{(const bf16_t*)(ws + WS_R3), (const bf16_t*)(ws + WS_WGU), MROWS, 2 * DFF, DM}; pg8::StaticOrder S; S.init(MROWS, 2 * DFF, G, bx);
        pg8::EpiSwiGLU E{(bf16_t*)(ws + WS_R1), SS + MROWS};
        pg8::gemm_phase<pg8::EpiSwiGLU, pg8::StaticOrder, true, true>(ldsl, g, S, E);
    }
    GRID_BAR();
    PH(7) for (int rep = 0; rep < REP7; ++rep) { const Args A = ARGS(); unsigned char* ws = A.ws; float* SS = (float*)(ws + WS_SS) + (rep + 1 < REP7 ? 2 * MROWS : 0);
        pg8::Gemm g{(const bf16_t*)(ws + WS_R1), (const bf16_t*)(ws + WS_WD), MROWS, DM, DFF}; pg8::StaticOrder S; S.init(MROWS, DM, G, bx);
        pg8::EpiRes<true> E{(const void*)(ws + WS_R3), (bf16_t*)(ws + WS_R2), SS + 2 * MROWS, 1};
        pg8::gemm_phase<pg8::EpiRes<true>, pg8::StaticOrder, true, true>(ldsl, g, S, E);
    }
    GRID_BAR();
    PH(8) for (int rep = 0; rep < REP8; ++rep) { const Args A = ARGS(); unsigned char* ws = A.ws; float* SS = (float*)(ws + WS_SS);
        pg8::Gemm g{(const bf16_t*)(ws + WS_R2), (const bf16_t*)(ws + WS_WPG), MROWS, DM, DM}; pg8::StaticOrder S; S.init(MROWS, DM, G, bx);
        pg8::EpiFinal E{A.out, (const bf16_t*)(ws + WS_R2), (const bf16_t*)(ws + WS_ERAW), A.w_ple_post, SS + 2 * MROWS, SS};
        pg8::gemm_phase<pg8::EpiFinal, pg8::StaticOrder, true, true>(ldsl, g, S, E);
    }
}

extern "C" void kernel_launch(void* const* d_in, const int* in_sizes, int n_in, void* d_out, int out_size, void* d_ws, size_t ws_size, hipStream_t stream) {
    static int grid = 0;
    if (grid == 0) {
        if (n_in != 21 || in_sizes[0] != MROWS * DM || out_size != MROWS * DM || ws_size < WS_END) {
            fprintf(stderr, "kernel_launch: unexpected shapes (n_in %d, in0 %d, out %d, ws %zu; need ws >= %zu)\n", n_in, n_in > 0 ? in_sizes[0] : -1, out_size, ws_size, (size_t)WS_END); grid = -1; return; }
        int dev = 0, cus = 0, per_cu = 0;
        (void)hipGetDevice(&dev); (void)hipDeviceGetAttribute(&cus, hipDeviceAttributeMultiprocessorCount, dev);
        if (hipFuncSetAttribute((const void*)fwd_megakernel, hipFuncAttributeMaxDynamicSharedMemorySize, LDS_BYTES) != hipSuccess) { fprintf(stderr, "kernel_launch: hipFuncSetAttribute failed\n"); grid = -1; return; }
        if (hipOccupancyMaxActiveBlocksPerMultiprocessor(&per_cu, (const void*)fwd_megakernel, NTHREADS, LDS_BYTES) != hipSuccess || per_cu < 1) { fprintf(stderr, "kernel_launch: occupancy query says %d blocks per CU\n", per_cu); per_cu = 1; }
        (void)hipGetLastError();
        if (per_cu > 1) per_cu = 1;
        grid = cus * per_cu;
        if (grid != 256) { fprintf(stderr, "kernel_launch: this kernel is laid out for a 256-CU device (got %d workgroups)\n", grid); grid = -1; return; }
    }
    if (grid < 0) return;
    Args a{};
    a.x = (const float*)d_in[0]; a.p = (const float*)d_in[1]; a.w_norm_mix = (const float*)d_in[2]; a.w_in = (const float*)d_in[3]; a.fox_f_bias = (const float*)d_in[4];
    a.q_norm_w = (const float*)d_in[5]; a.k_norm_w = (const float*)d_in[6]; a.conv_w = (const float*)d_in[7]; a.conv_b = (const float*)d_in[8]; a.mi_bias = (const float*)d_in[9];
    a.mf_bias = (const float*)d_in[10]; a.out_norm_w = (const float*)d_in[11]; a.w_out = (const float*)d_in[12]; a.w_norm_ffn = (const float*)d_in[13]; a.w_gate = (const float*)d_in[14];
    a.w_up = (const float*)d_in[15]; a.w_down = (const float*)d_in[16]; a.w_norm_ple = (const float*)d_in[17]; a.w_ple_gate = (const float*)d_in[18]; a.w_ple_proj = (const float*)d_in[19];
    a.w_ple_post = (const float*)d_in[20];
    a.out = (float*)d_out; a.ws = (unsigned char*)d_ws;
    void* args[] = {&a};
    hipError_t e = hipLaunchCooperativeKernel((const void*)fwd_megakernel, dim3(grid), dim3(NTHREADS), args, LDS_BYTES, stream);
    if (e != hipSuccess) fprintf(stderr, "kernel_launch: cooperative launch failed: %s (grid %d)\n", hipGetErrorString(e), grid);
}
```

```cpp
#include <hip/hip_runtime.h>
#include <hip/hip_cooperative_groups.h>
#include <hip/hip_bf16.h>
#include <cstdio>
#include <cstdint>
namespace cg = cooperative_groups;

constexpr int NB = 4, SEQ = 4096, DM = 2048, MROWS = NB * SEQ;
constexpr int PLE = 256, AH = 8, MH = 4, DFF = 5632, INC = 6160;
constexpr int PROJ_LD = 6144, NIN = 6400;
constexpr int PC_AQ = 0, PC_AK = 1024, PC_AV = 2048, PC_MQ = 3072, PC_MK = 3584, PC_MV = 4096, PC_MO = 5120;
constexpr float EPS = 1e-6f;
constexpr float LOG2E = 1.4426950408889634f;

typedef unsigned short bf16_t;
typedef float f32x4 __attribute__((ext_vector_type(4)));
typedef float f32x2 __attribute__((ext_vector_type(2)));
typedef unsigned u32x4 __attribute__((ext_vector_type(4)));
typedef unsigned u32x2 __attribute__((ext_vector_type(2)));
typedef __bf16 bf16x2_t __attribute__((ext_vector_type(2)));
__device__ __forceinline__ unsigned cvtpk2(float lo, float hi) { f32x2 v = {lo, hi}; bf16x2_t b = __builtin_convertvector(v, bf16x2_t); return __builtin_bit_cast(unsigned, b); }
__device__ __forceinline__ float bflo(unsigned w) { return __uint_as_float(w << 16); }
__device__ __forceinline__ float bfhi(unsigned w) { return __uint_as_float(w & 0xffff0000u); }
__device__ __forceinline__ float sigmoidf_(float x) { return __builtin_amdgcn_rcpf(1.f + __expf(-x)); }
namespace pg8 {
#define PG8_LAS __attribute__((address_space(3)))
typedef unsigned short bf16_t;
typedef short bf16x8 __attribute__((ext_vector_type(8)));
typedef float f32x4 __attribute__((ext_vector_type(4)));
typedef unsigned u32x4 __attribute__((ext_vector_type(4)));
constexpr int BM = 256, BK = 64, HALF = 128, HTB = HALF * BK * 2  , STAGE_BYTES = 8 * HTB, NXCD = 8, WGM = 8;

__host__ __device__ __forceinline__ int lds_byte(int r, int c) { const int st = (r >> 4) * 2 + (c >> 5), rr = r & 15, cc = c & 31, ob = rr * 64 + cc * 2; return st * 1024 + (ob ^ (((ob >> 9) & 1) << 5)); }
__host__ __device__ __forceinline__ void stage_rc(int b, int& R, int& C) { const int st = b / 1024, sb = b % 1024, swz = sb ^ (((sb >> 9) & 1) << 5); R = (st >> 1) * 16 + swz / 64; C = (st & 1) * 32 + (swz % 64) / 2; }
__host__ __device__ __forceinline__ int perm32(int rho) { const int n = rho >> 4, i = rho & 15; return 8 * (i >> 2) + 4 * n + (i & 3); }

struct Unit { int pm, pn; int w = 0; };
struct Gemm { const bf16_t* A; const bf16_t* Bt; int M, N, K; };

struct StaticOrder {
    int nM, nN, nwg, G, c, wgm;
    __host__ __device__ void init(int M, int N, int G_, int c_, int wgm_ = WGM) { nM = M / BM; nN = N / BM; nwg = nM * nN; G = G_; c = c_; wgm = wgm_; }
    __host__ __device__ bool next(int i, Unit& u) const {
        const long L = (long)i * G + c; if (L >= nwg) return false;
        int wgid = (int)L; { const int q = nwg / NXCD, r = nwg % NXCD, xcd = wgid % NXCD, off = wgid / NXCD; wgid = (xcd < r ? xcd * (q + 1) : r * (q + 1) + (xcd - r) * q) + off; }
        const int nig = wgm * nN, gid = wgid / nig, fm = gid * wgm, gsz = (nM - fm) < wgm ? (nM - fm) : wgm;
        u.pm = fm + ((wgid % nig) % gsz); u.pn = (wgid % nig) / gsz; return true;
    }
    __device__ __forceinline__ void a_ready(const Unit&) const {}
    __device__ __forceinline__ void done(const Unit&) const {}
};
__device__ __forceinline__ unsigned cvt_pk_bf16(float lo, float hi) { return ::cvtpk2(lo, hi); }
__device__ __forceinline__ float sumsq4(f32x4 v) { return (v[0] * v[0] + v[1] * v[1]) + (v[2] * v[2] + v[3] * v[3]); }
__device__ __forceinline__ void atomic_add_f32(float* p, float v) { __hip_atomic_fetch_add(p, v, __ATOMIC_RELAXED, __HIP_MEMORY_SCOPE_AGENT); }

__device__ __forceinline__ void zero_acc(f32x4 (&acc)[2][2][4][2]) {
#pragma unroll
    for (int a = 0; a < 2; ++a)
#pragma unroll
        for (int b = 0; b < 2; ++b)
#pragma unroll
            for (int m = 0; m < 4; ++m)
#pragma unroll
                for (int n = 0; n < 2; ++n) acc[a][b][m][n] = (f32x4){0.f, 0.f, 0.f, 0.f};
}
#define PG8_ZERO_INIT __device__ __forceinline__ void init(f32x4 (&acc)[2][2][4][2], const Unit&, int, int, int, int) const { zero_acc(acc); }

struct EpiProj {
    static constexpr bool PERM = true, AFTER_DRAIN = false;
    PG8_ZERO_INIT
    bf16_t* O; const float* ss0; const float* qw; const float* kw; float* ssqk;
    __device__ __forceinline__ void operator()(const f32x4 (&acc)[2][2][4][2], const Unit& u, int wr, int wc, int fr, int fq) const {
        const int row0 = u.pm * BM + wr * 64 + fr, col0 = u.pn * BM + wc * 32 + 8 * fq;
        const bool qk = u.pn < 8;
        f32x4 wv[2] = {{1.f, 1.f, 1.f, 1.f}, {1.f, 1.f, 1.f, 1.f}};
        if (qk) { const float* wp = (u.pn < 4 ? qw : kw) + wc * 32 + 8 * fq; wv[0] = *(const f32x4*)wp; wv[1] = *(const f32x4*)(wp + 4); }
        float rsv[2][4];
#pragma unroll
        for (int ai = 0; ai < 2; ++ai)
#pragma unroll
            for (int m = 0; m < 4; ++m) rsv[ai][m] = ss0[row0 + ai * HALF + m * 16];
#pragma unroll
        for (int ai = 0; ai < 2; ++ai)
#pragma unroll
            for (int m = 0; m < 4; ++m) { const int row = row0 + ai * HALF + m * 16; const float rs = __builtin_amdgcn_rsqf(rsv[ai][m] * (1.f / 2048.f) + 1e-6f); bf16_t* rowp = O + (size_t)row * 6144 + col0;
#pragma unroll
                for (int bj = 0; bj < 2; ++bj) { const f32x4 v0 = acc[ai][bj][m][0] * rs, v1 = acc[ai][bj][m][1] * rs;
                    if (qk) { float s = sumsq4(v0) + sumsq4(v1); s += __shfl_xor(s, 16); s += __shfl_xor(s, 32); if (fq == 0) atomic_add_f32(ssqk + (size_t)(u.pn * 2 + bj) * 16384 + row, s); }
                    const f32x4 y0 = v0 * wv[0], y1 = v1 * wv[1];
                    u32x4 w; w.x = cvt_pk_bf16(y0[0], y0[1]); w.y = cvt_pk_bf16(y0[2], y0[3]); w.z = cvt_pk_bf16(y1[0], y1[1]); w.w = cvt_pk_bf16(y1[2], y1[3]);
                    *(u32x4*)(rowp + bj * HALF) = w; } }
    }
};
struct EpiE {
    static constexpr bool PERM = true, AFTER_DRAIN = false;
    PG8_ZERO_INIT
    bf16_t* O; float* ss;
    __device__ __forceinline__ void operator()(const f32x4 (&acc)[2][2][4][2], const Unit& u, int wr, int wc, int fr, int fq) const {
        const int row0 = u.pm * BM + wr * 64 + fr, col0 = u.pn * BM + wc * 32 + 8 * fq;
#pragma unroll
        for (int ai = 0; ai < 2; ++ai)
#pragma unroll
            for (int m = 0; m < 4; ++m) { const int row = row0 + ai * HALF + m * 16; bf16_t* rowp = O + (size_t)row * 2048 + col0; float s = 0.f;
#pragma unroll
                for (int bj = 0; bj < 2; ++bj) { const f32x4 v0 = acc[ai][bj][m][0], v1 = acc[ai][bj][m][1]; s += sumsq4(v0) + sumsq4(v1);
                    u32x4 w; w.x = cvt_pk_bf16(v0[0], v0[1]); w.y = cvt_pk_bf16(v0[2], v0[3]); w.z = cvt_pk_bf16(v1[0], v1[1]); w.w = cvt_pk_bf16(v1[2], v1[3]);
                    __builtin_nontemporal_store(w, (u32x4*)(rowp + bj * HALF)); }
                s += __shfl_xor(s, 16); s += __shfl_xor(s, 32);
                if (fq == 0) atomic_add_f32(ss + row, s); }
    }
};
template <bool XINB> struct EpiRes {
    static constexpr bool PERM = true, AFTER_DRAIN = false;
    const void* xin; bf16_t* xout; float* ss; int live;
    __device__ __forceinline__ void init(f32x4 (&acc)[2][2][4][2], const Unit& u, int wr, int wc, int fr, int fq) const {
        const int row0 = u.pm * BM + wr * 64 + fr, col0 = u.pn * BM + wc * 32 + 8 * fq;
#pragma unroll
        for (int ai = 0; ai < 2; ++ai)
#pragma unroll
            for (int m = 0; m < 4; ++m) { const size_t off = (size_t)(row0 + ai * HALF + m * 16) * 2048 + col0;
#pragma unroll
                for (int bj = 0; bj < 2; ++bj) {
                    if constexpr (XINB) { const u32x4 w = *(const u32x4*)((const bf16_t*)xin + off + bj * HALF);
                        acc[ai][bj][m][0] = (f32x4){::bflo(w.x), ::bfhi(w.x), ::bflo(w.y), ::bfhi(w.y)}; acc[ai][bj][m][1] = (f32x4){::bflo(w.z), ::bfhi(w.z), ::bflo(w.w), ::bfhi(w.w)}; }
                    else { const float* rp = (const float*)xin + off + bj * HALF; acc[ai][bj][m][0] = __builtin_nontemporal_load((const f32x4*)rp); acc[ai][bj][m][1] = __builtin_nontemporal_load((const f32x4*)(rp + 4)); } } }
    }
    __device__ __forceinline__ void operator()(const f32x4 (&acc)[2][2][4][2], const Unit& u, int wr, int wc, int fr, int fq) const {
        if (!live) {
#pragma unroll
            for (int ai = 0; ai < 2; ++ai)
#pragma unroll
                for (int m = 0; m < 4; ++m)
#pragma unroll
                    for (int bj = 0; bj < 2; ++bj)
#pragma unroll
                        for (int n = 0; n < 2; ++n) asm volatile("" :: "v"(acc[ai][bj][m][n]));
            return; }
        const int row0 = u.pm * BM + wr * 64 + fr, col0 = u.pn * BM + wc * 32 + 8 * fq;
#pragma unroll
        for (int ai = 0; ai < 2; ++ai)
#pragma unroll
            for (int m = 0; m < 4; ++m) { const int row = row0 + ai * HALF + m * 16; bf16_t* rowp = xout + (size_t)row * 2048 + col0; float s = 0.f;
#pragma unroll
                for (int bj = 0; bj < 2; ++bj) { const f32x4 v0 = acc[ai][bj][m][0], v1 = acc[ai][bj][m][1]; s += sumsq4(v0) + sumsq4(v1);
                    u32x4 w; w.x = cvt_pk_bf16(v0[0], v0[1]); w.y = cvt_pk_bf16(v0[2], v0[3]); w.z = cvt_pk_bf16(v1[0], v1[1]); w.w = cvt_pk_bf16(v1[2], v1[3]);
                    *(u32x4*)(rowp + bj * HALF) = w; }
                s += __shfl_xor(s, 16); s += __shfl_xor(s, 32);
                if (fq == 0) atomic_add_f32(ss + row, s); }
    }
};
struct EpiSwiGLU {
    static constexpr bool PERM = true, AFTER_DRAIN = false;
    PG8_ZERO_INIT
    bf16_t* O; const float* ss;
    __device__ __forceinline__ void operator()(const f32x4 (&acc)[2][2][4][2], const Unit& u, int wr, int wc, int fr, int fq) const {
        const int row0 = u.pm * BM + wr * 64 + fr, col0 = u.pn * HALF + wc * 32 + 8 * fq;
        float rsv[2][4];
#pragma unroll
        for (int ai = 0; ai < 2; ++ai)
#pragma unroll
            for (int m = 0; m < 4; ++m) rsv[ai][m] = ss[row0 + ai * HALF + m * 16];
#pragma unroll
        for (int ai = 0; ai < 2; ++ai)
#pragma unroll
            for (int m = 0; m < 4; ++m) { const int row = row0 + ai * HALF + m * 16; const float rs = __builtin_amdgcn_rsqf(rsv[ai][m] * (1.f / 2048.f) + 1e-6f);
                float r[8];
#pragma unroll
                for (int n = 0; n < 2; ++n)
#pragma unroll
                    for (int e = 0; e < 4; ++e) { const float g = acc[ai][0][m][n][e] * rs, up = acc[ai][1][m][n][e] * rs; r[n * 4 + e] = g * __builtin_amdgcn_rcpf(1.f + __expf(-g)) * up; }
                u32x4 w; w.x = cvt_pk_bf16(r[0], r[1]); w.y = cvt_pk_bf16(r[2], r[3]); w.z = cvt_pk_bf16(r[4], r[5]); w.w = cvt_pk_bf16(r[6], r[7]);
                __builtin_nontemporal_store(w, (u32x4*)(O + (size_t)row * 5632 + col0)); }
    }
};
struct EpiFinal {
    static constexpr bool PERM = true, AFTER_DRAIN = false;
    PG8_ZERO_INIT
    float* out; const bf16_t* x2; const bf16_t* eraw; const float* wpost; const float* ss2; const float* ssE;
    __device__ __forceinline__ void operator()(const f32x4 (&acc)[2][2][4][2], const Unit& u, int wr, int wc, int fr, int fq) const {
        const int row0 = u.pm * BM + wr * 64 + fr, col0 = u.pn * BM + wc * 32 + 8 * fq;
        f32x4 wv[2][2]; float rsv[2][4], rev[2][4];
#pragma unroll
        for (int bj = 0; bj < 2; ++bj)
#pragma unroll
            for (int n = 0; n < 2; ++n) wv[bj][n] = *(const f32x4*)(wpost + col0 + bj * HALF + n * 4);
#pragma unroll
        for (int ai = 0; ai < 2; ++ai)
#pragma unroll
            for (int m = 0; m < 4; ++m) { rsv[ai][m] = ss2[row0 + ai * HALF + m * 16]; rev[ai][m] = ssE[row0 + ai * HALF + m * 16]; }
        u32x4 xw[1][4][2], ew[1][4][2];
#define EF_LOAD(ai) do { _Pragma("unroll") for (int m = 0; m < 4; ++m) _Pragma("unroll") for (int bj = 0; bj < 2; ++bj) { const size_t o2 = (size_t)(row0 + (ai) * HALF + m * 16) * 2048 + col0 + bj * HALF; \
            xw[0][m][bj] = *(const u32x4*)(x2 + o2); ew[0][m][bj] = __builtin_nontemporal_load((const u32x4*)(eraw + o2)); } } while (0)
#define EF_OUT(ai) do { _Pragma("unroll") for (int m = 0; m < 4; ++m) { const float rs = __builtin_amdgcn_rsqf(rsv[ai][m] * (1.f / 2048.f) + 1e-6f), re = __builtin_amdgcn_rsqf(rev[ai][m] * (1.f / 2048.f) + 1e-6f); \
            _Pragma("unroll") for (int bj = 0; bj < 2; ++bj) { const size_t o2 = (size_t)(row0 + (ai) * HALF + m * 16) * 2048 + col0 + bj * HALF; const u32x4 xq = xw[0][m][bj], eq = ew[0][m][bj]; \
                const f32x4 xa = {::bflo(xq.x), ::bfhi(xq.x), ::bflo(xq.y), ::bfhi(xq.y)}, xb = {::bflo(xq.z), ::bfhi(xq.z), ::bflo(xq.w), ::bfhi(xq.w)}; \
                f32x4 ea = {::bflo(eq.x), ::bfhi(eq.x), ::bflo(eq.y), ::bfhi(eq.y)}, eb = {::bflo(eq.z), ::bfhi(eq.z), ::bflo(eq.w), ::bfhi(eq.w)}; \
                ea = ea * re * wv[bj][0]; eb = eb * re * wv[bj][1]; \
                const f32x4 a0 = acc[ai][bj][m][0] * rs, a1 = acc[ai][bj][m][1] * rs; f32x4 o0, o1; \
                _Pragma("unroll") for (int e = 0; e < 4; ++e) { o0[e] = xa[e] + ::sigmoidf_(a0[e]) * ea[e]; o1[e] = xb[e] + ::sigmoidf_(a1[e]) * eb[e]; } \
                __builtin_nontemporal_store(o0, (f32x4*)(out + o2)); __builtin_nontemporal_store(o1, (f32x4*)(out + o2 + 4)); } } } while (0)
        EF_LOAD(0); EF_OUT(0); EF_LOAD(1); EF_OUT(1);
#undef EF_LOAD
#undef EF_OUT
    }
};
struct DualOrder {
    StaticOrder s0, s1;
    __host__ __device__ static void map(const StaticOrder& s, int L, Unit& u) {
        int wgid = L; { const int q = s.nwg / NXCD, r = s.nwg % NXCD, xcd = wgid % NXCD, off = wgid / NXCD; wgid = (xcd < r ? xcd * (q + 1) : r * (q + 1) + (xcd - r) * q) + off; }
        const int nig = s.wgm * s.nN, gid = wgid / nig, fm = gid * s.wgm, gsz = (s.nM - fm) < s.wgm ? (s.nM - fm) : s.wgm;
        u.pm = fm + ((wgid % nig) % gsz); u.pn = (wgid % nig) / gsz;
    }
    __host__ __device__ bool next(int i, Unit& u) const {
        const long L = (long)i * s0.G + s0.c;
        if (L < s0.nwg) { map(s0, (int)L, u); u.w = 0; return true; }
        if (L - s0.nwg < s1.nwg) { map(s1, (int)(L - s0.nwg), u); u.w = 1; return true; }
        return false;
    }
    __device__ __forceinline__ void a_ready(const Unit&) const {}
    __device__ __forceinline__ void done(const Unit&) const {}
};
struct EpiP1 {
    static constexpr bool PERM = true, AFTER_DRAIN = false;
    PG8_ZERO_INIT
    EpiProj a; EpiE b;
    __device__ __forceinline__ void operator()(const f32x4 (&acc)[2][2][4][2], const Unit& u, int wr, int wc, int fr, int fq) const { if (u.w) b(acc, u, wr, wc, fr, fq); else a(acc, u, wr, wc, fr, fq); }
};
template <class Epi, class Sched, bool ALIGN_EPI = false, bool SP2 = false>
__device__ __forceinline__ void gemm_phase(PG8_LAS unsigned char* lds, const Gemm g, const Sched& S, const Epi& E) {
    int tid0_ = threadIdx.x; asm volatile("" : "+v"(tid0_));
    const int tid = tid0_, wid = __builtin_amdgcn_readfirstlane(tid >> 6), lane = tid & 63, wr = wid >> 2, wc = wid & 3, fr = lane & 15, fq = lane >> 4;
    int K0_ = g.K; asm volatile("" : "+s"(K0_));
    const int K = K0_, nt = K / BK;
    unsigned voffA[2], voffB[2];
#pragma unroll
    for (int i = 0; i < 2; ++i) { int R, C; stage_rc(tid * 16 + i * 8192, R, C); const int Rb = Epi::PERM ? ((R & ~31) + perm32(R & 31)) : R;
        voffA[i] = (unsigned)(R * K + C) * 2u; voffB[i] = (unsigned)(Rb * K + C) * 2u; }
    const size_t kstep = (size_t)(BK * 2);
    const size_t hstep = (size_t)HALF * K * 2;
    const size_t tstep = 2 * hstep;
    const unsigned ldsw = (unsigned)wid * 1024u;
    const int aoff = lds_byte(wr * 64 + fr, fq * 8), boff = lds_byte(wc * 32 + fr, fq * 8);
#define PG8_SA(b, h) (((b) * 2 + (h)) * HTB)
#define PG8_SB(b, h) ((4 + (b) * 2 + (h)) * HTB)
#define PG8_STAGE(bufoff, gbase, voff) do { _Pragma("unroll") for (int _i = 0; _i < 2; ++_i) \
        __builtin_amdgcn_global_load_lds((const unsigned*)((const char*)(gbase) + (voff)[_i]), (PG8_LAS unsigned*)(lds + (bufoff) + ldsw + _i * 8192), 16, 0, 0); } while (0)
#define PG8_LDA(dst, b, h) do { _Pragma("unroll") for (int m = 0; m < 4; ++m) _Pragma("unroll") for (int k = 0; k < 2; ++k) dst[m][k] = *(const PG8_LAS bf16x8*)(lds + PG8_SA(b, h) + aoff + m * 2048 + k * 1024); } while (0)
#define PG8_LDB(dst, b, h) do { _Pragma("unroll") for (int n = 0; n < 2; ++n) _Pragma("unroll") for (int k = 0; k < 2; ++k) dst[n][k] = *(const PG8_LAS bf16x8*)(lds + PG8_SB(b, h) + boff + n * 2048 + k * 1024); } while (0)
#define PG8_MMA(ai, bj, At, Bt) do { __builtin_amdgcn_s_setprio(1); _Pragma("unroll") for (int m = 0; m < 4; ++m) _Pragma("unroll") for (int n = 0; n < 2; ++n) _Pragma("unroll") for (int k = 0; k < 2; ++k) \
        acc[ai][bj][m][n] = __builtin_amdgcn_mfma_f32_16x16x32_bf16(Bt[n][k], At[m][k], acc[ai][bj][m][n], 0, 0, 0); __builtin_amdgcn_s_setprio(0); } while (0)
#define PG8_WAIT_V(n) asm volatile("s_waitcnt vmcnt(" #n ")" ::: "memory")
#define PG8_WAIT_L(n) asm volatile("s_waitcnt lgkmcnt(" #n ")" ::: "memory")
#define PG8_BAR __builtin_amdgcn_s_barrier()
#define PG8_SCHED __builtin_amdgcn_sched_barrier(0)
    Unit cur, nxt; int ui = 0;
    if (!S.next(0, cur)) return;
    f32x4 acc[2][2][4][2];
    E.init(acc, cur, wr, wc, fr, fq);
    bf16x8 At[4][2], B0[2][2], B1[2][2];
    const char* cA = (const char*)g.A + (size_t)cur.pm * tstep; const char* cB = (const char*)g.Bt + (size_t)cur.pn * tstep;
    S.a_ready(cur);
    if constexpr (SP2) {
        PG8_STAGE(PG8_SB(0, 0), cB, voffB); PG8_STAGE(PG8_SB(0, 1), cB + hstep, voffB); PG8_STAGE(PG8_SA(0, 0), cA, voffA); PG8_STAGE(PG8_SA(0, 1), cA + hstep, voffA);
        if (wr == 1) PG8_BAR;
        PG8_WAIT_V(2); PG8_BAR;
        PG8_STAGE(PG8_SB(1, 0), cB + kstep, voffB); PG8_STAGE(PG8_SA(1, 0), cA + kstep, voffA); PG8_STAGE(PG8_SB(1, 1), cB + hstep + kstep, voffB);
        PG8_WAIT_V(6); PG8_BAR;
    } else {
        PG8_STAGE(PG8_SB(0, 0), cB, voffB); PG8_STAGE(PG8_SA(0, 0), cA, voffA); PG8_STAGE(PG8_SB(0, 1), cB + hstep, voffB); PG8_STAGE(PG8_SA(0, 1), cA + hstep, voffA);
        if (wr == 1) PG8_BAR;
        PG8_WAIT_V(4); PG8_BAR;
        PG8_STAGE(PG8_SB(1, 0), cB + kstep, voffB); PG8_STAGE(PG8_SA(1, 0), cA + kstep, voffA); PG8_STAGE(PG8_SB(1, 1), cB + hstep + kstep, voffB);
        PG8_WAIT_V(6); PG8_BAR;
    }
    for (;;) {
        const bool has_next = S.next(ui + 1, nxt);
        const char* nA = has_next ? (const char*)g.A + (size_t)nxt.pm * tstep : cA; const char* nB = has_next ? (const char*)g.Bt + (size_t)nxt.pn * tstep : cB;
        for (int t = 0; t < nt; t += 2) {
            const bool last = (t == nt - 2);
            const char* a1 = cA + (size_t)(t + 1) * kstep;
            const char* a2 = last ? nA : cA + (size_t)(t + 2) * kstep; const char* b2 = last ? nB : cB + (size_t)(t + 2) * kstep;
            const char* a3 = a2 + kstep; const char* b3 = b2 + kstep;
            if (last && has_next) S.a_ready(nxt);
            if constexpr (SP2) {
            PG8_LDB(B0, 0, 0); PG8_LDB(B1, 0, 1); PG8_SCHED; PG8_LDA(At, 0, 0); PG8_STAGE(PG8_SA(1, 1), a1 + hstep, voffA);
            PG8_WAIT_V(8); PG8_WAIT_L(0); PG8_BAR; PG8_MMA(0, 0, At, B0); PG8_MMA(0, 1, At, B1); PG8_BAR; PG8_SCHED;
            PG8_LDA(At, 0, 1); PG8_STAGE(PG8_SB(0, 0), b2, voffB); PG8_STAGE(PG8_SB(0, 1), b2 + hstep, voffB); PG8_STAGE(PG8_SA(0, 0), a2, voffA);
            PG8_WAIT_V(8); PG8_WAIT_L(0); PG8_BAR; PG8_MMA(1, 0, At, B0); PG8_MMA(1, 1, At, B1); PG8_BAR; PG8_SCHED;
            PG8_LDB(B0, 1, 0); PG8_LDB(B1, 1, 1); PG8_SCHED; PG8_LDA(At, 1, 0); PG8_STAGE(PG8_SA(0, 1), a2 + hstep, voffA);
            PG8_WAIT_V(8); PG8_WAIT_L(0); PG8_BAR; PG8_MMA(0, 0, At, B0); PG8_MMA(0, 1, At, B1); PG8_BAR; PG8_SCHED;
            PG8_LDA(At, 1, 1); PG8_STAGE(PG8_SB(1, 0), b3, voffB); PG8_STAGE(PG8_SB(1, 1), b3 + hstep, voffB); PG8_STAGE(PG8_SA(1, 0), a3, voffA);
            PG8_WAIT_V(8); PG8_WAIT_L(0); PG8_BAR; PG8_MMA(1, 0, At, B0); PG8_MMA(1, 1, At, B1); PG8_BAR; PG8_SCHED;
            } else {
            PG8_LDB(B0, 0, 0); PG8_SCHED; PG8_LDA(At, 0, 0); PG8_STAGE(PG8_SA(1, 1), a1 + hstep, voffA);
            PG8_WAIT_L(8); PG8_BAR; PG8_WAIT_L(0); PG8_MMA(0, 0, At, B0); PG8_BAR; PG8_SCHED;
            PG8_LDB(B1, 0, 1); PG8_STAGE(PG8_SB(0, 0), b2, voffB);
            PG8_BAR; PG8_WAIT_L(0); PG8_MMA(0, 1, At, B1); PG8_BAR;
            PG8_LDA(At, 0, 1); PG8_STAGE(PG8_SA(0, 0), a2, voffA);
            PG8_BAR; PG8_WAIT_L(0); PG8_MMA(1, 0, At, B0); PG8_BAR; PG8_SCHED;
            PG8_STAGE(PG8_SB(0, 1), b2 + hstep, voffB);
            PG8_WAIT_V(6); PG8_BAR; PG8_MMA(1, 1, At, B1); PG8_BAR;
            PG8_LDB(B0, 1, 0); PG8_SCHED; PG8_LDA(At, 1, 0); PG8_STAGE(PG8_SA(0, 1), a2 + hstep, voffA);
            PG8_WAIT_L(8); PG8_BAR; PG8_WAIT_L(0); PG8_MMA(0, 0, At, B0); PG8_BAR; PG8_SCHED;
            PG8_LDB(B1, 1, 1); PG8_STAGE(PG8_SB(1, 0), b3, voffB);
            PG8_BAR; PG8_WAIT_L(0); PG8_MMA(0, 1, At, B1); PG8_BAR;
            PG8_LDA(At, 1, 1); PG8_STAGE(PG8_SA(1, 0), a3, voffA);
            PG8_BAR; PG8_WAIT_L(0); PG8_MMA(1, 0, At, B0); PG8_BAR; PG8_SCHED;
            PG8_STAGE(PG8_SB(1, 1), b3 + hstep, voffB);
            PG8_WAIT_V(6); PG8_BAR; PG8_MMA(1, 1, At, B1); PG8_BAR;
            }
        }
        if constexpr (ALIGN_EPI) { if (wr == 0) PG8_BAR; }
        if constexpr (!Epi::AFTER_DRAIN) { E(acc, cur, wr, wc, fr, fq); S.done(cur); }
        if (!has_next) break;
        E.init(acc, nxt, wr, wc, fr, fq);
        cur = nxt; cA = nA; cB = nB; ++ui;
        if constexpr (ALIGN_EPI) { if (wr == 1) PG8_BAR; }
    }
    PG8_WAIT_V(0);
    if constexpr (!ALIGN_EPI) { if (wr == 0) PG8_BAR; }
    PG8_BAR;
    if constexpr (Epi::AFTER_DRAIN) { E.fused(acc, cur, wr, wc, fr, fq, lds, wid, lane); S.done(cur); }
#undef PG8_SA
#undef PG8_SB
#undef PG8_STAGE
#undef PG8_LDA
#undef PG8_LDB
#undef PG8_MMA
#undef PG8_WAIT_V
#undef PG8_WAIT_L
#undef PG8_BAR
#undef PG8_SCHED
}

template <class Epi, class Sched, bool ALIGN_EPI = false, bool SP2 = false>
__device__ __forceinline__ void gemm_phase2(PG8_LAS unsigned char* lds, const Gemm g0, const Gemm g1, const Sched& S, const Epi& E) {
    int tid0_ = threadIdx.x; asm volatile("" : "+v"(tid0_));
    const int tid = tid0_, wid = __builtin_amdgcn_readfirstlane(tid >> 6), lane = tid & 63, wr = wid >> 2, wc = wid & 3, fr = lane & 15, fq = lane >> 4;
    int K0_ = g0.K, K1_ = g1.K; asm volatile("" : "+s"(K0_), "+s"(K1_));
    unsigned vA0[2], vB0[2], vA1[2], vB1[2];
#pragma unroll
    for (int i = 0; i < 2; ++i) { int R, C; stage_rc(tid * 16 + i * 8192, R, C); const int Rb = Epi::PERM ? ((R & ~31) + perm32(R & 31)) : R;
        vA0[i] = (unsigned)(R * K0_ + C) * 2u; vB0[i] = (unsigned)(Rb * K0_ + C) * 2u; vA1[i] = (unsigned)(R * K1_ + C) * 2u; vB1[i] = (unsigned)(Rb * K1_ + C) * 2u; }
    const size_t kstep = (size_t)(BK * 2);
    const size_t hs0 = (size_t)HALF * K0_ * 2, hs1 = (size_t)HALF * K1_ * 2;
    const unsigned ldsw = (unsigned)wid * 1024u;
    const int aoff = lds_byte(wr * 64 + fr, fq * 8), boff = lds_byte(wc * 32 + fr, fq * 8);
#define PG8_SA(b, h) (((b) * 2 + (h)) * HTB)
#define PG8_SB(b, h) ((4 + (b) * 2 + (h)) * HTB)
#define PG8_STAGE(bufoff, gbase, voff) do { _Pragma("unroll") for (int _i = 0; _i < 2; ++_i) \
        __builtin_amdgcn_global_load_lds((const unsigned*)((const char*)(gbase) + (voff)[_i]), (PG8_LAS unsigned*)(lds + (bufoff) + ldsw + _i * 8192), 16, 0, 0); } while (0)
#define PG8_LDA(dst, b, h) do { _Pragma("unroll") for (int m = 0; m < 4; ++m) _Pragma("unroll") for (int k = 0; k < 2; ++k) dst[m][k] = *(const PG8_LAS bf16x8*)(lds + PG8_SA(b, h) + aoff + m * 2048 + k * 1024); } while (0)
#define PG8_LDB(dst, b, h) do { _Pragma("unroll") for (int n = 0; n < 2; ++n) _Pragma("unroll") for (int k = 0; k < 2; ++k) dst[n][k] = *(const PG8_LAS bf16x8*)(lds + PG8_SB(b, h) + boff + n * 2048 + k * 1024); } while (0)
#define PG8_MMA(ai, bj, At, Bt) do { __builtin_amdgcn_s_setprio(1); _Pragma("unroll") for (int m = 0; m < 4; ++m) _Pragma("unroll") for (int n = 0; n < 2; ++n) _Pragma("unroll") for (int k = 0; k < 2; ++k) \
        acc[ai][bj][m][n] = __builtin_amdgcn_mfma_f32_16x16x32_bf16(Bt[n][k], At[m][k], acc[ai][bj][m][n], 0, 0, 0); __builtin_amdgcn_s_setprio(0); } while (0)
#define PG8_WAIT_V(n) asm volatile("s_waitcnt vmcnt(" #n ")" ::: "memory")
#define PG8_WAIT_L(n) asm volatile("s_waitcnt lgkmcnt(" #n ")" ::: "memory")
#define PG8_BAR __builtin_amdgcn_s_barrier()
#define PG8_SCHED __builtin_amdgcn_sched_barrier(0)
    Unit cur, nxt; int ui = 0;
    if (!S.next(0, cur)) return;
    f32x4 acc[2][2][4][2];
    E.init(acc, cur, wr, wc, fr, fq);
    bf16x8 At[4][2], B0[2][2], B1[2][2];
    unsigned voffA[2], voffB[2], nvA[2], nvB[2]; size_t hstep, nhs; int nt, nnt;
#define PG8_SEL(w_, VA, VB, HS, NT) do { const bool w1_ = (w_) != 0; VA[0] = w1_ ? vA1[0] : vA0[0]; VA[1] = w1_ ? vA1[1] : vA0[1]; VB[0] = w1_ ? vB1[0] : vB0[0]; VB[1] = w1_ ? vB1[1] : vB0[1]; HS = w1_ ? hs1 : hs0; NT = (w1_ ? K1_ : K0_) / BK; } while (0)
    PG8_SEL(cur.w, voffA, voffB, hstep, nt);
    const char* cA = (const char*)(cur.w ? g1.A : g0.A) + (size_t)cur.pm * (2 * hstep); const char* cB = (const char*)(cur.w ? g1.Bt : g0.Bt) + (size_t)cur.pn * (2 * hstep);
    S.a_ready(cur);
    if constexpr (SP2) {
        PG8_STAGE(PG8_SB(0, 0), cB, voffB); PG8_STAGE(PG8_SB(0, 1), cB + hstep, voffB); PG8_STAGE(PG8_SA(0, 0), cA, voffA); PG8_STAGE(PG8_SA(0, 1), cA + hstep, voffA);
        if (wr == 1) PG8_BAR;
        PG8_WAIT_V(2); PG8_BAR;
        PG8_STAGE(PG8_SB(1, 0), cB + kstep, voffB); PG8_STAGE(PG8_SA(1, 0), cA + kstep, voffA); PG8_STAGE(PG8_SB(1, 1), cB + hstep + kstep, voffB);
        PG8_WAIT_V(6); PG8_BAR;
    } else {
        PG8_STAGE(PG8_SB(0, 0), cB, voffB); PG8_STAGE(PG8_SA(0, 0), cA, voffA); PG8_STAGE(PG8_SB(0, 1), cB + hstep, voffB); PG8_STAGE(PG8_SA(0, 1), cA + hstep, voffA);
        if (wr == 1) PG8_BAR;
        PG8_WAIT_V(4); PG8_BAR;
        PG8_STAGE(PG8_SB(1, 0), cB + kstep, voffB); PG8_STAGE(PG8_SA(1, 0), cA + kstep, voffA); PG8_STAGE(PG8_SB(1, 1), cB + hstep + kstep, voffB);
        PG8_WAIT_V(6); PG8_BAR;
    }
    for (;;) {
        const bool has_next = S.next(ui + 1, nxt);
        if (has_next) PG8_SEL(nxt.w, nvA, nvB, nhs, nnt); else { nvA[0] = voffA[0]; nvA[1] = voffA[1]; nvB[0] = voffB[0]; nvB[1] = voffB[1]; nhs = hstep; nnt = nt; }
        const char* nA = has_next ? (const char*)(nxt.w ? g1.A : g0.A) + (size_t)nxt.pm * (2 * nhs) : cA; const char* nB = has_next ? (const char*)(nxt.w ? g1.Bt : g0.Bt) + (size_t)nxt.pn * (2 * nhs) : cB;
        for (int t = 0; t < nt; t += 2) {
            const bool last = (t == nt - 2);
            const char* a1 = cA + (size_t)(t + 1) * kstep;
            const char* a2 = last ? nA : cA + (size_t)(t + 2) * kstep; const char* b2 = last ? nB : cB + (size_t)(t + 2) * kstep;
            const char* a3 = a2 + kstep; const char* b3 = b2 + kstep;
            unsigned xA[2], xB[2]; xA[0] = last ? nvA[0] : voffA[0]; xA[1] = last ? nvA[1] : voffA[1]; xB[0] = last ? nvB[0] : voffB[0]; xB[1] = last ? nvB[1] : voffB[1]; const size_t xhs = last ? nhs : hstep;
            if (last && has_next) S.a_ready(nxt);
            if constexpr (SP2) {
            PG8_LDB(B0, 0, 0); PG8_LDB(B1, 0, 1); PG8_SCHED; PG8_LDA(At, 0, 0); PG8_STAGE(PG8_SA(1, 1), a1 + hstep, voffA);
            PG8_WAIT_V(8); PG8_WAIT_L(0); PG8_BAR; PG8_MMA(0, 0, At, B0); PG8_MMA(0, 1, At, B1); PG8_BAR; PG8_SCHED;
            PG8_LDA(At, 0, 1); PG8_STAGE(PG8_SB(0, 0), b2, xB); PG8_STAGE(PG8_SB(0, 1), b2 + xhs, xB); PG8_STAGE(PG8_SA(0, 0), a2, xA);
            PG8_WAIT_V(8); PG8_WAIT_L(0); PG8_BAR; PG8_MMA(1, 0, At, B0); PG8_MMA(1, 1, At, B1); PG8_BAR; PG8_SCHED;
            PG8_LDB(B0, 1, 0); PG8_LDB(B1, 1, 1); PG8_SCHED; PG8_LDA(At, 1, 0); PG8_STAGE(PG8_SA(0, 1), a2 + xhs, xA);
            PG8_WAIT_V(8); PG8_WAIT_L(0); PG8_BAR; PG8_MMA(0, 0, At, B0); PG8_MMA(0, 1, At, B1); PG8_BAR; PG8_SCHED;
            PG8_LDA(At, 1, 1); PG8_STAGE(PG8_SB(1, 0), b3, xB); PG8_STAGE(PG8_SB(1, 1), b3 + xhs, xB); PG8_STAGE(PG8_SA(1, 0), a3, xA);
            PG8_WAIT_V(8); PG8_WAIT_L(0); PG8_BAR; PG8_MMA(1, 0, At, B0); PG8_MMA(1, 1, At, B1); PG8_BAR; PG8_SCHED;
            } else {
            PG8_LDB(B0, 0, 0); PG8_SCHED; PG8_LDA(At, 0, 0); PG8_STAGE(PG8_SA(1, 1), a1 + hstep, voffA);
            PG8_WAIT_L(8); PG8_BAR; PG8_WAIT_L(0); PG8_MMA(0, 0, At, B0); PG8_BAR; PG8_SCHED;
            PG8_LDB(B1, 0, 1); PG8_STAGE(PG8_SB(0, 0), b2, xB);
            PG8_BAR; PG8_WAIT_L(0); PG8_MMA(0, 1, At, B1); PG8_BAR;
            PG8_LDA(At, 0, 1); PG8_STAGE(PG8_SA(0, 0), a2, xA);
            PG8_BAR; PG8_WAIT_L(0); PG8_MMA(1, 0, At, B0); PG8_BAR; PG8_SCHED;
            PG8_STAGE(PG8_SB(0, 1), b2 + xhs, xB);
            PG8_WAIT_V(6); PG8_BAR; PG8_MMA(1, 1, At, B1); PG8_BAR;
            PG8_LDB(B0, 1, 0); PG8_SCHED; PG8_LDA(At, 1, 0); PG8_STAGE(PG8_SA(0, 1), a2 + xhs, xA);
            PG8_WAIT_L(8); PG8_BAR; PG8_WAIT_L(0); PG8_MMA(0, 0, At, B0); PG8_BAR; PG8_SCHED;
            PG8_LDB(B1, 1, 1); PG8_STAGE(PG8_SB(1, 0), b3, xB);
            PG8_BAR; PG8_WAIT_L(0); PG8_MMA(0, 1, At, B1); PG8_BAR;
            PG8_LDA(At, 1, 1); PG8_STAGE(PG8_SA(1, 0), a3, xA);
            PG8_BAR; PG8_WAIT_L(0); PG8_MMA(1, 0, At, B0); PG8_BAR; PG8_SCHED;
            PG8_STAGE(PG8_SB(1, 1), b3 + xhs, xB);
            PG8_WAIT_V(6); PG8_BAR; PG8_MMA(1, 1, At, B1); PG8_BAR;
            }
        }
        if constexpr (ALIGN_EPI) { if (wr == 0) PG8_BAR; }
        if constexpr (!Epi::AFTER_DRAIN) { E(acc, cur, wr, wc, fr, fq); S.done(cur); }
        if (!has_next) break;
        E.init(acc, nxt, wr, wc, fr, fq);
        cur = nxt; cA = nA; cB = nB; ++ui; voffA[0] = nvA[0]; voffA[1] = nvA[1]; voffB[0] = nvB[0]; voffB[1] = nvB[1]; hstep = nhs; nt = nnt;
        if constexpr (ALIGN_EPI) { if (wr == 1) PG8_BAR; }
    }
    PG8_WAIT_V(0);
    if constexpr (!ALIGN_EPI) { if (wr == 0) PG8_BAR; }
    PG8_BAR;
    if constexpr (Epi::AFTER_DRAIN) { E.fused(acc, cur, wr, wc, fr, fq, lds, wid, lane); S.done(cur); }
#undef PG8_SEL
#undef PG8_SA
#undef PG8_SB
#undef PG8_STAGE
#undef PG8_LDA
#undef PG8_LDB
#undef PG8_MMA
#undef PG8_WAIT_V
#undef PG8_WAIT_L
#undef PG8_BAR
#undef PG8_SCHED
}

}
namespace fa {
using bf16 = __hip_bfloat16;
typedef short bf16x8 __attribute__((ext_vector_type(8)));
typedef short s16x4 __attribute__((ext_vector_type(4)));
typedef float f32x16 __attribute__((ext_vector_type(16)));
constexpr int D = 128, NW = 8, QBLK = 32, KVBLK = 64, QB = NW * QBLK;
constexpr int SHM_V = KVBLK * D * 2, SHM_K = KVBLK * D * 2;
constexpr int OFF_WS = 2 * SHM_V + 2 * SHM_K, OFF_CK = OFF_WS + NW * 64 * 4, LDS_BYTES = OFF_CK + 2 * 64 * 4;
constexpr float SCALE = 0.08838834764831845f;
constexpr float THR = 8.f;

#define KSWZ(row, colB) ((row) * 256 + ((colB) ^ (((row) & 7) << 4)))
#define SBAR() __builtin_amdgcn_sched_barrier(0)
__device__ __forceinline__ int v_st(int k, int c) { const int kk = (k & ~0xC) | ((k & 4) << 1) | ((k & 8) >> 1); return ((kk >> 3) * 4 + (c >> 5)) * 512 + ((kk & 7) * 32 + (c & 31)) * 2; }
__device__ __forceinline__ int v_rd_base(int lane) { return ((lane & 3) << 3) | (((lane >> 2) & 3) << 6) | (((lane >> 4) & 1) << 5) | (((lane >> 5) & 1) << 8); }
constexpr int v_rd_off(int d0, int ks, int half) { return d0 * 512 + ks * 4096 + half * 2048; }
__device__ __forceinline__ int crow(int r, int hi) { return (r & 3) + 8 * (r >> 2) + 4 * hi; }
__device__ __forceinline__ unsigned cvtpk(float lo, float hi) { return ::cvtpk2(lo, hi); }
__device__ __forceinline__ bf16x8 load8(const bf16* p) { return *reinterpret_cast<const bf16x8*>(p); }
template <int MODE> __device__ __forceinline__ void mask_tile(f32x16& p0, f32x16& p1, int dq) {
    const float NEG = MODE == 0 ? -__builtin_inff() : 0.f;
#pragma unroll
    for (int r = 0; r < 16; ++r) {
        const int c = (r & 3) + 8 * (r >> 2);
        if (dq - c < 0) p0[r] = NEG;
        if (dq - c - 32 < 0) p1[r] = NEG;
    }
}
__device__ __forceinline__ void partialSM(f32x16& p0, f32x16& p1, float& m_reg, float& mn, float& alpha) {
    float pmax = p0[0]; for (int r = 1; r < 16; ++r) pmax = fmaxf(pmax, p0[r]); for (int r = 0; r < 16; ++r) pmax = fmaxf(pmax, p1[r]);
    { auto rr = __builtin_amdgcn_permlane32_swap(__float_as_uint(pmax), __float_as_uint(pmax), false, false);
      pmax = fmaxf(__uint_as_float(rr[0]), __uint_as_float(rr[1])); }
    constexpr float C2 = 1.4426950408889634f * SCALE;
    if (__builtin_expect(__all((pmax - m_reg) * SCALE <= THR), 1)) { mn = m_reg; alpha = 1.f; }
    else { mn = fmaxf(m_reg, pmax); alpha = __builtin_amdgcn_exp2f((m_reg - mn) * C2); m_reg = mn; }
    const float mnL = -mn * C2;
    for (int r = 0; r < 16; ++r) p0[r] = fmaf(p0[r], C2, mnL); for (int r = 0; r < 16; ++r) p1[r] = fmaf(p1[r], C2, mnL);
    for (int r = 0; r < 16; ++r) p0[r] = __builtin_amdgcn_exp2f(p0[r]);
}
#define PK4(P, B_, OUT) do { unsigned a0 = cvtpk(P[B_+0], P[B_+1]), a1 = cvtpk(P[B_+2], P[B_+3]);                          \
        unsigned b0 = cvtpk(P[B_+4], P[B_+5]), b1 = cvtpk(P[B_+6], P[B_+7]);                                             \
        auto r0 = __builtin_amdgcn_permlane32_swap(a0, b0, false, false); auto r1 = __builtin_amdgcn_permlane32_swap(a1, b1, false, false); \
        u32x4 w = {r0[0], r1[0], r0[1], r1[1]}; OUT = *reinterpret_cast<bf16x8*>(&w); } while (0)
__device__ __forceinline__ void finishSM(f32x16& p0, f32x16& p1, float alpha, float& l_reg, bf16x8& pa0, bf16x8& pa1, bf16x8& pa2, bf16x8& pa3) {
    for (int r = 0; r < 16; ++r) p1[r] = __builtin_amdgcn_exp2f(p1[r]);
    float ps = 0; for (int r = 0; r < 16; ++r) ps += p0[r]; for (int r = 0; r < 16; ++r) ps += p1[r];
    { auto rr = __builtin_amdgcn_permlane32_swap(__float_as_uint(ps), __float_as_uint(ps), false, false);
      ps = __uint_as_float(rr[0]) + __uint_as_float(rr[1]); }
    l_reg = l_reg * alpha + ps;
    PK4(p0, 0, pa0); PK4(p0, 8, pa1); PK4(p1, 0, pa2); PK4(p1, 8, pa3);
}
__device__ __forceinline__ void linScale(f32x16& p0, f32x16& p1, float fr) {
    for (int r = 0; r < 16; ++r) p0[r] *= fr; for (int r = 0; r < 16; ++r) p1[r] *= fr;
}
__device__ __forceinline__ void linFinish(f32x16& p0, f32x16& p1, float& l_reg, bf16x8& pa0, bf16x8& pa1, bf16x8& pa2, bf16x8& pa3) {
    float ps = 0; for (int r = 0; r < 16; ++r) ps += p0[r]; for (int r = 0; r < 16; ++r) ps += p1[r];
    { auto rr = __builtin_amdgcn_permlane32_swap(__float_as_uint(ps), __float_as_uint(ps), false, false);
      ps = __uint_as_float(rr[0]) + __uint_as_float(rr[1]); }
    l_reg += ps;
    PK4(p0, 0, pa0); PK4(p0, 8, pa1); PK4(p1, 0, pa2); PK4(p1, 8, pa3);
}
#undef PK4
template <int KB, int MODE>
__device__ __forceinline__ void qkt(f32x16& p0, f32x16& p1, const char* K_lds, const float* ckl, int r32, int hi, const bf16x8* qr) {
    if constexpr (MODE == 0) {
        const float* c = ckl + KB * 64 + 4 * hi;
#pragma unroll
        for (int g = 0; g < 4; ++g) { const f32x4 a = *(const f32x4*)(c + 8 * g), b = *(const f32x4*)(c + 32 + 8 * g);
            p0[4 * g + 0] = a[0]; p0[4 * g + 1] = a[1]; p0[4 * g + 2] = a[2]; p0[4 * g + 3] = a[3];
            p1[4 * g + 0] = b[0]; p1[4 * g + 1] = b[1]; p1[4 * g + 2] = b[2]; p1[4 * g + 3] = b[3]; }
    } else { p0 = f32x16{}; p1 = f32x16{}; }
    const char* kb[4];
#pragma unroll
    for (int dd = 0; dd < 4; ++dd) kb[dd] = K_lds + KB * SHM_K + KSWZ(r32, (dd * 16 + hi * 8) * 2);
    __builtin_amdgcn_s_setprio(1);
#pragma unroll
    for (int d0 = 0; d0 < 8; ++d0) { const char* a = kb[d0 & 3] + (d0 >> 2) * 128;
        bf16x8 b0 = *reinterpret_cast<const bf16x8*>(a);
        bf16x8 b1 = *reinterpret_cast<const bf16x8*>(a + 32 * 256);
        p0 = __builtin_amdgcn_mfma_f32_32x32x16_bf16(b0, qr[d0], p0, 0, 0, 0);
        p1 = __builtin_amdgcn_mfma_f32_32x32x16_bf16(b1, qr[d0], p1, 0, 0, 0); }
    __builtin_amdgcn_s_setprio(0);
}
template <int VB>
__device__ __forceinline__ void pv_tile(f32x16* o, int vb0, bf16x8 pa0, bf16x8 pa1, bf16x8 pa2, bf16x8 pa3) {
#define TRRD(dst, off) asm volatile("ds_read_b64_tr_b16 %0, %1 offset:%2" : "=&v"(dst) : "v"(vb0), "i"(off) : "memory")
#define PV_RD(S, d0) do { constexpr int b_ = VB * SHM_V + v_rd_off(d0, 0, 0);     \
        TRRD(S##l0, b_); TRRD(S##h0, b_ + 2048); TRRD(S##l1, b_ + 4096); TRRD(S##h1, b_ + 6144); TRRD(S##l2, b_ + 8192); TRRD(S##h2, b_ + 10240); TRRD(S##l3, b_ + 12288); TRRD(S##h3, b_ + 14336); } while (0)
#define PV_MM(S, d0) do { __builtin_amdgcn_s_setprio(1);                                                                                                     \
        o[d0] = __builtin_amdgcn_mfma_f32_32x32x16_bf16(pa0, (bf16x8){S##l0[0], S##l0[1], S##l0[2], S##l0[3], S##h0[0], S##h0[1], S##h0[2], S##h0[3]}, o[d0], 0, 0, 0);   \
        o[d0] = __builtin_amdgcn_mfma_f32_32x32x16_bf16(pa1, (bf16x8){S##l1[0], S##l1[1], S##l1[2], S##l1[3], S##h1[0], S##h1[1], S##h1[2], S##h1[3]}, o[d0], 0, 0, 0);   \
        o[d0] = __builtin_amdgcn_mfma_f32_32x32x16_bf16(pa2, (bf16x8){S##l2[0], S##l2[1], S##l2[2], S##l2[3], S##h2[0], S##h2[1], S##h2[2], S##h2[3]}, o[d0], 0, 0, 0);   \
        o[d0] = __builtin_amdgcn_mfma_f32_32x32x16_bf16(pa3, (bf16x8){S##l3[0], S##l3[1], S##l3[2], S##l3[3], S##h3[0], S##h3[1], S##h3[2], S##h3[3]}, o[d0], 0, 0, 0);   \
        __builtin_amdgcn_s_setprio(0); } while (0)
    s16x4 Al0, Al1, Al2, Al3, Ah0, Ah1, Ah2, Ah3, Bl0, Bl1, Bl2, Bl3, Bh0, Bh1, Bh2, Bh3;
    PV_RD(A, 0);
    PV_RD(B, 1); asm volatile("s_waitcnt lgkmcnt(8)" ::: "memory"); SBAR(); PV_MM(A, 0); SBAR();
    PV_RD(A, 2); asm volatile("s_waitcnt lgkmcnt(8)" ::: "memory"); SBAR(); PV_MM(B, 1); SBAR();
    PV_RD(B, 3); asm volatile("s_waitcnt lgkmcnt(8)" ::: "memory"); SBAR(); PV_MM(A, 2); SBAR();
    asm volatile("s_waitcnt lgkmcnt(0)" ::: "memory"); SBAR(); PV_MM(B, 3);
#undef PV_RD
#undef PV_MM
#undef TRRD
}

template <int VB>
__device__ __forceinline__ void pv_tile_np(f32x16* o, int vb0, bf16x8 pa0, bf16x8 pa1, bf16x8 pa2, bf16x8 pa3) {
#define TRRD(dst, off) asm volatile("ds_read_b64_tr_b16 %0, %1 offset:%2" : "=&v"(dst) : "v"(vb0), "i"(off) : "memory")
#define PV_D0(d0) do { s16x4 l0, l1, l2, l3, h0, h1, h2, h3; constexpr int b_ = VB * SHM_V + v_rd_off(d0, 0, 0);   \
        TRRD(l0, b_); TRRD(h0, b_ + 2048); TRRD(l1, b_ + 4096); TRRD(h1, b_ + 6144); TRRD(l2, b_ + 8192); TRRD(h2, b_ + 10240); TRRD(l3, b_ + 12288); TRRD(h3, b_ + 14336); \
        asm volatile("s_waitcnt lgkmcnt(0)" ::: "memory"); SBAR();   \
        o[d0] = __builtin_amdgcn_mfma_f32_32x32x16_bf16(pa0, (bf16x8){l0[0], l0[1], l0[2], l0[3], h0[0], h0[1], h0[2], h0[3]}, o[d0], 0, 0, 0);   \
        o[d0] = __builtin_amdgcn_mfma_f32_32x32x16_bf16(pa1, (bf16x8){l1[0], l1[1], l1[2], l1[3], h1[0], h1[1], h1[2], h1[3]}, o[d0], 0, 0, 0);   \
        o[d0] = __builtin_amdgcn_mfma_f32_32x32x16_bf16(pa2, (bf16x8){l2[0], l2[1], l2[2], l2[3], h2[0], h2[1], h2[2], h2[3]}, o[d0], 0, 0, 0);   \
        o[d0] = __builtin_amdgcn_mfma_f32_32x32x16_bf16(pa3, (bf16x8){l3[0], l3[1], l3[2], l3[3], h3[0], h3[1], h3[2], h3[3]}, o[d0], 0, 0, 0); SBAR(); } while (0)
    PV_D0(0); PV_D0(1); PV_D0(2); PV_D0(3);
#undef PV_D0
#undef TRRD
}

struct BlockRef { const bf16* Q; const bf16* K; const bf16* V; bf16* O; const float* aux; const float* sq; int P0, j0, j1, part; bf16* PO; float* PS; unsigned* flag; };
constexpr int AUX_MEXP = 65536, AUX_AREF = 131072;
template <int MODE> struct Pitch { static constexpr int qp = MODE ? 512 : 6144, kp = MODE ? 512 : 6144, vp = 6144, op = MODE ? 1024 : 2048; };
__device__ __forceinline__ bf16x8 scale8(bf16x8 v, float w) {
    const u32x4 u = __builtin_bit_cast(u32x4, v); u32x4 r;
    r.x = cvtpk(::bflo(u.x) * w, ::bfhi(u.x) * w); r.y = cvtpk(::bflo(u.y) * w, ::bfhi(u.y) * w); r.z = cvtpk(::bflo(u.z) * w, ::bfhi(u.z) * w); r.w = cvtpk(::bflo(u.w) * w, ::bfhi(u.w) * w);
    return __builtin_bit_cast(bf16x8, r);
}
struct Seam { bf16x8 qr[8]; bf16x8 st_v0, st_v1, st_k0, st_k1; float st_c, st_f0, st_f1; };
__device__ __forceinline__ float hnorm_rs(float ss) { return __builtin_amdgcn_rsqf(ss * (1.f / 128.f) + 1e-6f); }
#define ROWK(R, PM, k0, rr) ((R).K + (size_t)(k0) * Pitch<PM>::kp + (unsigned)(((rr) * Pitch<PM>::kp) + sc))
#define ROWV(R, PM, k0, rr) ((R).V + (size_t)(k0) * Pitch<PM>::vp + (unsigned)(((rr) * Pitch<PM>::vp) + sc))
#define VMW() asm volatile("s_waitcnt vmcnt(0)" ::: "memory")
#define VMWN(n) asm volatile("s_waitcnt vmcnt(%0)" :: "i"(n) : "memory")
#define SLOAD_H(R, PM, k0) do { S.st_v0 = load8(ROWV(R, PM, k0, sr)); S.st_v1 = load8(ROWV(R, PM, k0, 32 + sr));              \
                         S.st_k0 = load8(ROWK(R, PM, k0, sr)); S.st_k1 = load8(ROWK(R, PM, k0, 32 + sr));                \
                         if constexpr (PM == 0) { S.st_c = (R).aux[(k0) + (tid & 63)]; S.st_f0 = (R).sq[8 * 16384 + (k0) + sr]; S.st_f1 = (R).sq[8 * 16384 + (k0) + 32 + sr]; } } while (0)
#define SWRITE_HK(bf) do { if constexpr (MODE == 0) { S.st_k0 = scale8(S.st_k0, hnorm_rs(S.st_f0)); S.st_k1 = scale8(S.st_k1, hnorm_rs(S.st_f1)); }                   \
                           *(bf16x8*)(K_lds + (bf) * SHM_K + kws) = S.st_k0; *(bf16x8*)(K_lds + (bf) * SHM_K + kws + 32 * 256) = S.st_k1; \
                           if constexpr (MODE == 0) { if (tid < 64) ckl[(bf) * 64 + tid] = S.st_c; } } while (0)
#define SWRITE_HV(bf) do { *(bf16x8*)(V_lds + (bf) * SHM_V + vst0) = S.st_v0; *(bf16x8*)(V_lds + (bf) * SHM_V + vst1) = S.st_v1; } while (0)
#define SWRITE_H(bf) do { SWRITE_HV(bf); SWRITE_HK(bf); } while (0)
template <int MODE>
__device__ __forceinline__ void attn_prime(const BlockRef& cur, char* lds, Seam& S) {
    const int tid = threadIdx.x, wid = __builtin_amdgcn_readfirstlane(tid >> 6), lane = tid & 63, r32 = lane & 31, hi = lane >> 5;
    const int sr = tid >> 4, sc = (tid & 15) * 8, kws = KSWZ(sr, sc * 2), vst0 = v_st(sr, sc), vst1 = v_st(32 + sr, sc); char* V_lds = lds; char* K_lds = lds + 2 * SHM_V; float* ckl = (float*)(lds + OFF_CK);
#pragma unroll
    for (int d0 = 0; d0 < 8; ++d0) S.qr[d0] = load8(cur.Q + (size_t)(cur.P0 + wid * QBLK) * Pitch<MODE>::qp + (unsigned)(r32 * Pitch<MODE>::qp + d0 * 16 + hi * 8));
    if constexpr (MODE == 0) { const float rq = hnorm_rs(cur.sq[cur.P0 + wid * QBLK + r32]);
#pragma unroll
        for (int d0 = 0; d0 < 8; ++d0) S.qr[d0] = scale8(S.qr[d0], rq); }
    SLOAD_H(cur, MODE, cur.j0 * KVBLK); VMW(); SWRITE_H(0);
    __syncthreads();
}
template <int MODE>
__device__ __forceinline__ void attn_block(const BlockRef& cur, const BlockRef& nxt, char* lds, Seam& S) {
    int tid0_ = threadIdx.x; asm volatile("" : "+v"(tid0_));
    const int tid = tid0_, wid = __builtin_amdgcn_readfirstlane(tid >> 6), lane = tid & 63, r32 = lane & 31, hi = lane >> 5;
    const int NT = cur.j1;
    const int qlo = cur.P0 + wid * QBLK, qm = qlo + r32 - 4 * hi;
    char* V_lds = lds; char* K_lds = lds + 2 * SHM_V;
    float* ws = (float*)(lds + OFF_WS) + wid * 64; float* li_l = ws, * al_l = ws + 32; float* ckl = (float*)(lds + OFF_CK);
    float m_reg = -1e30f, l_reg = 0; f32x16 o[4] = {};
    const int sr = tid >> 4, sc = (tid & 15) * 8, vst0 = v_st(sr, sc), vst1 = v_st(32 + sr, sc), kws = KSWZ(sr, sc * 2);
    const int vb0 = (int)(uintptr_t)V_lds + v_rd_base(lane);
    float m2row = 0.f; if constexpr (MODE == 1) m2row = cur.aux[qlo + r32];
#define RESC(a) do { if constexpr (MODE == 0) { if (__any((a) < 1.f)) { if (hi == 0) al_l[r32] = (a); asm volatile("s_waitcnt lgkmcnt(0)" ::: "memory");              \
                     for (int d_ = 0; d_ < 4; ++d_) for (int r = 0; r < 16; ++r) o[d_][r] *= al_l[crow(r, hi)]; } } } while (0)
#define KBASE(t) ((t) * KVBLK)
    f32x16 p0, p1; float mn, al; bf16x8 pa0, pa1, pa2, pa3;
#define STEP(t, BUF, LASTCHK) do {                                                                                               \
        float ar = 0.f; if constexpr (MODE == 1) ar = cur.aux[AUX_AREF + (t)];                                                    \
        const bool last_ = LASTCHK && ((t) + 1 >= NT);                                                                            \
        if (last_) { SLOAD_H(nxt, MODE, nxt.j0 * KVBLK); } else { SLOAD_H(cur, MODE, KBASE((t) + 1)); }                                         \
        SBAR(); qkt<BUF, MODE>(p0, p1, K_lds, ckl, r32, hi, S.qr); SBAR();                                                          \
        if (last_) { _Pragma("unroll") for (int d0 = 0; d0 < 8; ++d0) S.qr[d0] = load8(nxt.Q + (size_t)(nxt.P0 + wid * QBLK) * Pitch<MODE>::qp + (unsigned)(r32 * Pitch<MODE>::qp + d0 * 16 + hi * 8)); SBAR(); } \
        { const int kb_ = KBASE(t); if (kb_ + KVBLK - 1 > qlo) mask_tile<MODE>(p0, p1, qm - kb_); }                               \
        if constexpr (MODE == 0) { partialSM(p0, p1, m_reg, mn, al); RESC(al); finishSM(p0, p1, al, l_reg, pa0, pa1, pa2, pa3); }    \
        else { linScale(p0, p1, __builtin_amdgcn_exp2f(ar - m2row)); linFinish(p0, p1, l_reg, pa0, pa1, pa2, pa3); }               \
        SBAR(); pv_tile<BUF>(o, vb0, pa0, pa1, pa2, pa3); SBAR();                                                                 \
        VMW(); SWRITE_H((BUF) ^ 1);                                                                                               \
        __syncthreads(); } while (0)
    float rqn = 1.f; if constexpr (MODE == 0) rqn = hnorm_rs(nxt.sq[nxt.P0 + wid * QBLK + r32]);
    for (int t = cur.j0; t < NT; t += 2) { STEP(t, 0, false); STEP(t + 1, 1, true); }
    if constexpr (MODE == 0) {
#pragma unroll
        for (int d0 = 0; d0 < 8; ++d0) S.qr[d0] = scale8(S.qr[d0], rqn); }
    float wa_r = 0.f;
    { float lv = l_reg; if constexpr (MODE == 1) lv = fmaxf(fabsf(l_reg), cur.aux[AUX_MEXP + qlo + r32]);
      if constexpr (MODE == 0) { if (cur.part == 2) {
          if (tid == 0) { unsigned sp = 0; while (__hip_atomic_load(cur.flag, __ATOMIC_RELAXED, __HIP_MEMORY_SCOPE_AGENT) == 0u) { __builtin_amdgcn_s_sleep(2); if (++sp > (1u << 22)) break; }
                          __builtin_amdgcn_fence(__ATOMIC_ACQUIRE, "agent"); asm volatile("s_waitcnt vmcnt(0)" ::: "memory"); }
          __syncthreads();
          constexpr float C2 = 1.4426950408889634f * SCALE;
          const float ma = cur.PS[2 * (wid * QBLK + r32)], la = cur.PS[2 * (wid * QBLK + r32) + 1];
          const float mm = fmaxf(ma, m_reg), fa_ = la * __builtin_amdgcn_exp2f((ma - mm) * C2), fb_ = __builtin_amdgcn_exp2f((m_reg - mm) * C2);
          lv = (fa_ + l_reg * fb_) / fb_; wa_r = fa_ / (fa_ + l_reg * fb_); } }
      if (hi == 0) { li_l[r32] = lv; al_l[r32] = wa_r; } }
    asm volatile("s_waitcnt lgkmcnt(0)" ::: "memory");
    float rli[16];
#pragma unroll
    for (int r = 0; r < 16; ++r) rli[r] = __builtin_amdgcn_rcpf(li_l[crow(r, hi)]);
    bf16* Ow = cur.O + (size_t)(qlo) * Pitch<MODE>::op; unsigned opitch = Pitch<MODE>::op;
    if constexpr (MODE == 0) { if (cur.part == 1) { Ow = cur.PO + (size_t)(wid * QBLK) * 128; opitch = 128; } }
    const bool merge = (MODE == 0) && cur.part == 2;
    if (merge) {
        unsigned pw[16][4];
#pragma unroll
        for (int r = 0; r < 16; ++r)
#pragma unroll
            for (int d0 = 0; d0 < 4; ++d0) pw[r][d0] = *(const unsigned*)(cur.PO + (size_t)(wid * QBLK + crow(r, hi)) * 128 + d0 * 32 + (r32 & ~1));
#pragma unroll
        for (int r = 0; r < 16; ++r) { const float war = al_l[crow(r, hi)];
#pragma unroll
            for (int d0 = 0; d0 < 4; ++d0) o[d0][r] = o[d0][r] * rli[r] + war * ((r32 & 1) ? ::bfhi(pw[r][d0]) : ::bflo(pw[r][d0])); }
#pragma unroll
        for (int r = 0; r < 16; ++r) rli[r] = 1.f;
    }
#pragma unroll
    for (int r = 0; r < 16; ++r) { const int orow = crow(r, hi);
#pragma unroll
        for (int d0 = 0; d0 < 4; ++d0) { const float v = o[d0][r] * rli[r];
            const float vn = __shfl_xor(v, 1);
            if ((r32 & 1) == 0) *(unsigned*)(Ow + (unsigned)(orow * opitch + d0 * 32 + r32)) = cvtpk(v, vn); } }
    if constexpr (MODE == 0) { if (cur.part == 1) {
        if (hi == 0) { cur.PS[2 * (wid * QBLK + r32)] = m_reg; cur.PS[2 * (wid * QBLK + r32) + 1] = l_reg; }
        asm volatile("s_waitcnt vmcnt(0)" ::: "memory"); __syncthreads();
        if (tid == 0) { __builtin_amdgcn_fence(__ATOMIC_RELEASE, "agent"); asm volatile("s_waitcnt vmcnt(0)" ::: "memory"); __hip_atomic_store(cur.flag, 1u, __ATOMIC_RELAXED, __HIP_MEMORY_SCOPE_AGENT); } } }
    asm volatile("s_waitcnt lgkmcnt(0)" ::: "memory");
#undef RESC
#undef KBASE
#undef STEP
}
#define TRRD2(dst, base, off) asm volatile("ds_read_b64_tr_b16 %0, %1 offset:%2" : "=&v"(dst) : "v"(base), "i"(off) : "memory")
#define FRAG8(l, h) (bf16x8){l[0], l[1], l[2], l[3], h[0], h[1], h[2], h[3]}
struct StateRef { const bf16* K; const bf16* V; bf16* U; float* nU; const float* a2; float aref, scale; int P0; };
__device__ __forceinline__ void mlstm_state_block(const StateRef& R, char* lds) {
    int tid0_ = threadIdx.x; asm volatile("" : "+v"(tid0_));
    const int tid = tid0_, wid = __builtin_amdgcn_readfirstlane(tid >> 6), lane = tid & 63, r32 = lane & 31, hi = lane >> 5;
    const int sr = tid >> 4, sc = (tid & 15) * 8, vst0 = v_st(sr, sc), vst1 = v_st(32 + sr, sc);
    bf16x8 sva0, sva1, svb0, svb1, sk0, sk1; float sf0, sf1;
#define MS_LOAD(t) do { const bf16* vp_ = R.V + (size_t)(R.P0 + (t) * 64) * 6144; const bf16* kp_ = R.K + (size_t)(R.P0 + (t) * 64) * 512;                 \
        sva0 = load8(vp_ + (unsigned)(sr * 6144 + sc)); sva1 = load8(vp_ + (unsigned)((32 + sr) * 6144 + sc));                                          \
        svb0 = load8(vp_ + (unsigned)(sr * 6144 + 128 + sc)); svb1 = load8(vp_ + (unsigned)((32 + sr) * 6144 + 128 + sc));                              \
        sk0 = load8(kp_ + (unsigned)(sr * 512 + sc)); sk1 = load8(kp_ + (unsigned)((32 + sr) * 512 + sc));                                              \
        sf0 = R.a2[R.P0 + (t) * 64 + sr]; sf1 = R.a2[R.P0 + (t) * 64 + 32 + sr]; } while (0)
#define MS_WRITE(b) do { char* B_ = lds + (b) * 49152; sk0 = scale8(sk0, __builtin_amdgcn_exp2f(sf0 - R.aref)); sk1 = scale8(sk1, __builtin_amdgcn_exp2f(sf1 - R.aref)); *(bf16x8*)(B_ + vst0) = sva0; *(bf16x8*)(B_ + vst1) = sva1; *(bf16x8*)(B_ + 16384 + vst0) = svb0;           \
        *(bf16x8*)(B_ + 16384 + vst1) = svb1; *(bf16x8*)(B_ + 32768 + vst0) = sk0; *(bf16x8*)(B_ + 32768 + vst1) = sk1; } while (0)
    f32x16 acc[4] = {}; f32x16 accn = {};
    const int half = wid >> 2, d0 = wid & 3;
    const int rb = (int)(uintptr_t)lds + v_rd_base(lane);
    const int vbw = rb + half * 16384 + d0 * 512, kbw = rb + 32768, knw = kbw + (wid & 3) * 512;
    const bf16x8 ones = {0x3F80, 0x3F80, 0x3F80, 0x3F80, 0x3F80, 0x3F80, 0x3F80, 0x3F80};
#define MS_KSTEP(BUF, ks) do { s16x4 bl, bh, al0, ah0, al1, ah1, al2, ah2, al3, ah3, nl, nh;                                                             \
        TRRD2(bl, vbw, (BUF) * 49152 + (ks) * 4096); TRRD2(bh, vbw, (BUF) * 49152 + (ks) * 4096 + 2048);                                                  \
        TRRD2(al0, kbw, (BUF) * 49152 + 0 * 512 + (ks) * 4096); TRRD2(ah0, kbw, (BUF) * 49152 + 0 * 512 + (ks) * 4096 + 2048);                            \
        TRRD2(al1, kbw, (BUF) * 49152 + 1 * 512 + (ks) * 4096); TRRD2(ah1, kbw, (BUF) * 49152 + 1 * 512 + (ks) * 4096 + 2048);                            \
        TRRD2(al2, kbw, (BUF) * 49152 + 2 * 512 + (ks) * 4096); TRRD2(ah2, kbw, (BUF) * 49152 + 2 * 512 + (ks) * 4096 + 2048);                            \
        TRRD2(al3, kbw, (BUF) * 49152 + 3 * 512 + (ks) * 4096); TRRD2(ah3, kbw, (BUF) * 49152 + 3 * 512 + (ks) * 4096 + 2048);                            \
        TRRD2(nl, knw, (BUF) * 49152 + (ks) * 4096); TRRD2(nh, knw, (BUF) * 49152 + (ks) * 4096 + 2048);                                                  \
        asm volatile("s_waitcnt lgkmcnt(0)" ::: "memory"); SBAR();                                                                                        \
        const bf16x8 bfr = FRAG8(bl, bh);                                                                                                                 \
        acc[0] = __builtin_amdgcn_mfma_f32_32x32x16_bf16(FRAG8(al0, ah0), bfr, acc[0], 0, 0, 0);                                                          \
        acc[1] = __builtin_amdgcn_mfma_f32_32x32x16_bf16(FRAG8(al1, ah1), bfr, acc[1], 0, 0, 0);                                                          \
        acc[2] = __builtin_amdgcn_mfma_f32_32x32x16_bf16(FRAG8(al2, ah2), bfr, acc[2], 0, 0, 0);                                                          \
        acc[3] = __builtin_amdgcn_mfma_f32_32x32x16_bf16(FRAG8(al3, ah3), bfr, acc[3], 0, 0, 0);                                                          \
        accn = __builtin_amdgcn_mfma_f32_32x32x16_bf16(FRAG8(nl, nh), ones, accn, 0, 0, 0); SBAR(); } while (0)
#define MS_TILE(t, BUF) do { if ((t) + 1 < 4) MS_LOAD((t) + 1); SBAR();                                                                                   \
        MS_KSTEP(BUF, 0); MS_KSTEP(BUF, 1); MS_KSTEP(BUF, 2); MS_KSTEP(BUF, 3);                                                                            \
        if ((t) + 1 < 4) { VMW(); MS_WRITE((BUF) ^ 1); } __syncthreads(); } while (0)
    MS_LOAD(0); VMW(); MS_WRITE(0); __syncthreads();
    MS_TILE(0, 0); MS_TILE(1, 1); MS_TILE(2, 0); MS_TILE(3, 1);
#pragma unroll
    for (int e0 = 0; e0 < 4; ++e0)
#pragma unroll
        for (int r = 0; r < 16; ++r) { const float v = acc[e0][r] * R.scale, vn = __shfl_xor(v, 1);
            if ((r32 & 1) == 0) *(unsigned*)(R.U + (unsigned)((32 * e0 + crow(r, hi)) * 256 + 128 * half + 32 * d0 + r32)) = cvtpk(v, vn); }
    if (wid < 4 && r32 == 0) {
#pragma unroll
        for (int r = 0; r < 16; ++r) R.nU[32 * wid + crow(r, hi)] = accn[r] * R.scale; }
#undef MS_LOAD
#undef MS_WRITE
#undef MS_KSTEP
#undef MS_TILE
}
struct OutRef { const bf16* Q; const bf16* K; const bf16* V; const bf16* C; const float* nC; bf16* O; const float* aux; const float* a2; float aref, mprev; int P0; };
__device__ __forceinline__ void mlstm_out_pass(const OutRef& R, char* lds) {
    int tid0_ = threadIdx.x; asm volatile("" : "+v"(tid0_));
    const int tid = tid0_, wid = __builtin_amdgcn_readfirstlane(tid >> 6), lane = tid & 63, r32 = lane & 31, hi = lane >> 5;
    const int qlo = R.P0 + wid * QBLK, qm = qlo + r32 - 4 * hi;
    char* V_lds = lds; char* K_lds = lds + 2 * SHM_V;
    float* ws = (float*)(lds + OFF_WS) + wid * 64; float* li_l = ws; const float* ckl = nullptr;
    const int sr = tid >> 4, sc = (tid & 15) * 8, vst0 = v_st(sr, sc), vst1 = v_st(32 + sr, sc), kws = KSWZ(sr, sc * 2);
    const int vb0 = (int)(uintptr_t)V_lds + v_rd_base(lane);
    bf16x8 qr[8], st_v0, st_v1, st_k0, st_k1; float sf0 = 0.f, sf1 = 0.f;
#pragma unroll
    for (int d0 = 0; d0 < 8; ++d0) qr[d0] = load8(R.Q + (size_t)qlo * 512 + (unsigned)(r32 * 512 + d0 * 16 + hi * 8));
    const float m2row = R.aux[qlo + r32];
    const float fr = __builtin_amdgcn_exp2f(R.aref - m2row), wst = __builtin_amdgcn_exp2f(R.mprev - m2row);
    float l_reg = 0.f; f32x16 o[4] = {}; f32x16 p0, p1; bf16x8 pa0, pa1, pa2, pa3;
#define MO_LOADKV(t) do { const bf16* vp_ = R.V + (size_t)(R.P0 + (t) * 64) * 6144; const bf16* kp_ = R.K + (size_t)(R.P0 + (t) * 64) * 512;               \
        st_v0 = load8(vp_ + (unsigned)(sr * 6144 + sc)); st_v1 = load8(vp_ + (unsigned)((32 + sr) * 6144 + sc));                                        \
        st_k0 = load8(kp_ + (unsigned)(sr * 512 + sc)); st_k1 = load8(kp_ + (unsigned)((32 + sr) * 512 + sc));                                          \
        sf0 = R.a2[R.P0 + (t) * 64 + sr]; sf1 = R.a2[R.P0 + (t) * 64 + 32 + sr]; } while (0)
#define MO_LOADC(j) do { const bf16* cp_ = R.C + (size_t)((j) * 64) * 256; st_v0 = load8(cp_ + (unsigned)(sr * 256 + sc)); st_v1 = load8(cp_ + (unsigned)((32 + sr) * 256 + sc)); } while (0)
#define MO_WRITEV(b) do { *(bf16x8*)(V_lds + (b) * SHM_V + vst0) = st_v0; *(bf16x8*)(V_lds + (b) * SHM_V + vst1) = st_v1; } while (0)
#define MO_WRITEK(b) do { *(bf16x8*)(K_lds + (b) * SHM_K + kws) = scale8(st_k0, __builtin_amdgcn_exp2f(sf0 - R.aref)); *(bf16x8*)(K_lds + (b) * SHM_K + kws + 32 * 256) = scale8(st_k1, __builtin_amdgcn_exp2f(sf1 - R.aref)); } while (0)
    MO_LOADKV(0); VMW(); MO_WRITEV(0); MO_WRITEK(0); __syncthreads();
#define MO_STEP(i, BUF) do {                                                                                                                             \
        if ((i) + 1 < 4) MO_LOADKV((i) + 1); else if ((i) + 1 < 6) MO_LOADC((i) + 1 - 4);                                                                 \
        SBAR();                                                                                                                                         \
        if ((i) < 4) { qkt<BUF, 1>(p0, p1, K_lds, ckl, r32, hi, qr); SBAR();                                                                              \
            { const int kb_ = R.P0 + (i) * 64; if (kb_ + KVBLK - 1 > qlo) mask_tile<1>(p0, p1, qm - kb_); }                                                \
            linScale(p0, p1, fr); linFinish(p0, p1, l_reg, pa0, pa1, pa2, pa3); }                                                                         \
        else { pa0 = scale8(qr[4 * ((i) - 4) + 0], wst); pa1 = scale8(qr[4 * ((i) - 4) + 1], wst); pa2 = scale8(qr[4 * ((i) - 4) + 2], wst); pa3 = scale8(qr[4 * ((i) - 4) + 3], wst); } \
        SBAR(); pv_tile<BUF>(o, vb0, pa0, pa1, pa2, pa3); SBAR();                                                                                        \
        if ((i) + 1 < 6) { VMW(); MO_WRITEV((BUF) ^ 1); if ((i) + 1 < 4) MO_WRITEK((BUF) ^ 1); }                                                          \
        __syncthreads(); } while (0)
    MO_STEP(0, 0); MO_STEP(1, 1); MO_STEP(2, 0); MO_STEP(3, 1); MO_STEP(4, 0); MO_STEP(5, 1);
    { float qn = 0.f;
#pragma unroll
      for (int d0 = 0; d0 < 8; ++d0) { const u32x4 u = __builtin_bit_cast(u32x4, qr[d0]); const f32x4 na = *(const f32x4*)(R.nC + d0 * 16 + hi * 8), nb = *(const f32x4*)(R.nC + d0 * 16 + hi * 8 + 4);
          qn += ::bflo(u.x) * na[0] + ::bfhi(u.x) * na[1] + ::bflo(u.y) * na[2] + ::bfhi(u.y) * na[3] + ::bflo(u.z) * nb[0] + ::bfhi(u.z) * nb[1] + ::bflo(u.w) * nb[2] + ::bfhi(u.w) * nb[3]; }
      auto rr = __builtin_amdgcn_permlane32_swap(__float_as_uint(qn), __float_as_uint(qn), false, false);
      l_reg += wst * (__uint_as_float(rr[0]) + __uint_as_float(rr[1])); }
    { const float lv = fmaxf(fabsf(l_reg), R.aux[AUX_MEXP + qlo + r32]); if (hi == 0) li_l[r32] = lv; }
    asm volatile("s_waitcnt lgkmcnt(0)" ::: "memory");
    float rli[16];
#pragma unroll
    for (int r = 0; r < 16; ++r) rli[r] = __builtin_amdgcn_rcpf(li_l[crow(r, hi)]);
    bf16* Ow = R.O + (size_t)qlo * 1024;
#pragma unroll
    for (int r = 0; r < 16; ++r) { const int orow = crow(r, hi);
#pragma unroll
        for (int d0 = 0; d0 < 4; ++d0) { const float v = o[d0][r] * rli[r]; const float vn = __shfl_xor(v, 1);
            if ((r32 & 1) == 0) *(unsigned*)(Ow + (unsigned)(orow * 1024 + d0 * 32 + r32)) = cvtpk(v, vn); } }
    asm volatile("s_waitcnt lgkmcnt(0)" ::: "memory");
    __syncthreads();
#undef MO_LOADKV
#undef MO_LOADC
#undef MO_WRITEV
#undef MO_WRITEK
#undef MO_STEP
}
constexpr int VB2_OFF = 69632;
__device__ __forceinline__ void mlstm_out_pass2(const OutRef& R, char* lds) {
    int tid0_ = threadIdx.x; asm volatile("" : "+v"(tid0_));
    const int tid = tid0_, wid = __builtin_amdgcn_readfirstlane(tid >> 6), lane = tid & 63, r32 = lane & 31, hi = lane >> 5;
    const int qlo = R.P0 + wid * QBLK, qm = qlo + r32 - 4 * hi;
    char* V_lds = lds; char* K_lds = lds + 2 * SHM_V; char* W_lds = lds + VB2_OFF;
    float* ws = (float*)(lds + OFF_WS) + wid * 64; float* li_l = ws; const float* ckl = nullptr;
    const int sr = tid >> 4, sc = (tid & 15) * 8, vst0 = v_st(sr, sc), vst1 = v_st(32 + sr, sc), kws = KSWZ(sr, sc * 2);
    const int vb0 = (int)(uintptr_t)V_lds + v_rd_base(lane), wb0 = (int)(uintptr_t)W_lds + v_rd_base(lane);
    const bf16* qp = R.Q + (size_t)qlo * 512 + (unsigned)(r32 * 512 + hi * 8);
    bf16x8 st_v0, st_v1, st_w0, st_w1, st_k0, st_k1; float sf0 = 0.f, sf1 = 0.f;
    bf16x8 qr[8];
#pragma unroll
    for (int d0 = 0; d0 < 4; ++d0) qr[d0] = load8(qp + d0 * 16);
    const float m2row = R.aux[qlo + r32];
    const float fr = __builtin_amdgcn_exp2f(R.aref - m2row), wst = __builtin_amdgcn_exp2f(R.mprev - m2row);
    float l_reg = 0.f; f32x16 o[8] = {}; f32x16 p0, p1; bf16x8 pa0, pa1, pa2, pa3;
#define M2_LOADKV(t) do { const bf16* vp_ = R.V + (size_t)(R.P0 + (t) * 64) * 6144; const bf16* kp_ = R.K + (size_t)(R.P0 + (t) * 64) * 512;               \
        st_v0 = load8(vp_ + (unsigned)(sr * 6144 + sc)); st_v1 = load8(vp_ + (unsigned)((32 + sr) * 6144 + sc));                                        \
        st_w0 = load8(vp_ + (unsigned)(sr * 6144 + 128 + sc)); st_w1 = load8(vp_ + (unsigned)((32 + sr) * 6144 + 128 + sc));                            \
        st_k0 = load8(kp_ + (unsigned)(sr * 512 + sc)); st_k1 = load8(kp_ + (unsigned)((32 + sr) * 512 + sc));                                          \
        sf0 = R.a2[R.P0 + (t) * 64 + sr]; sf1 = R.a2[R.P0 + (t) * 64 + 32 + sr]; } while (0)
#define M2_LOADC(j) do { const bf16* cp_ = R.C + (size_t)((j) * 64) * 256; st_v0 = load8(cp_ + (unsigned)(sr * 256 + sc)); st_v1 = load8(cp_ + (unsigned)((32 + sr) * 256 + sc));      \
        st_w0 = load8(cp_ + (unsigned)(sr * 256 + 128 + sc)); st_w1 = load8(cp_ + (unsigned)((32 + sr) * 256 + 128 + sc)); } while (0)
#define M2_WRITEV(b) do { *(bf16x8*)(V_lds + (b) * SHM_V + vst0) = st_v0; *(bf16x8*)(V_lds + (b) * SHM_V + vst1) = st_v1; *(bf16x8*)(W_lds + (b) * SHM_V + vst0) = st_w0; *(bf16x8*)(W_lds + (b) * SHM_V + vst1) = st_w1; } while (0)
#define M2_WRITEK(b) do { *(bf16x8*)(K_lds + (b) * SHM_K + kws) = scale8(st_k0, __builtin_amdgcn_exp2f(sf0 - R.aref)); *(bf16x8*)(K_lds + (b) * SHM_K + kws + 32 * 256) = scale8(st_k1, __builtin_amdgcn_exp2f(sf1 - R.aref)); } while (0)
    M2_LOADKV(0); VMW(); M2_WRITEV(0); M2_WRITEK(0); __syncthreads();
#define M2_STEP(i, BUF) do {                                                                                                                             \
        SBAR();                                                                                                                                         \
        if ((i) < 4) { _Pragma("unroll") for (int d0 = 4; d0 < 8; ++d0) qr[d0] = load8(qp + d0 * 16);                                                   \
            qkt<BUF, 1>(p0, p1, K_lds, ckl, r32, hi, qr); SBAR();                                                                                         \
            { const int kb_ = R.P0 + (i) * 64; if (kb_ + KVBLK - 1 > qlo) mask_tile<1>(p0, p1, qm - kb_); }                                                \
            linScale(p0, p1, fr); linFinish(p0, p1, l_reg, pa0, pa1, pa2, pa3); }                                                                         \
        else if ((i) == 4) { pa0 = scale8(qr[0], wst); pa1 = scale8(qr[1], wst); pa2 = scale8(qr[2], wst); pa3 = scale8(qr[3], wst); }                                            \
        else { pa0 = scale8(load8(qp + 4 * 16), wst); pa1 = scale8(load8(qp + 5 * 16), wst); pa2 = scale8(load8(qp + 6 * 16), wst); pa3 = scale8(load8(qp + 7 * 16), wst); } \
        SBAR(); if ((i) + 1 < 4) M2_LOADKV((i) + 1); else if ((i) + 1 < 6) M2_LOADC((i) + 1 - 4);     \
        SBAR(); pv_tile_np<BUF>(o, vb0, pa0, pa1, pa2, pa3); SBAR(); pv_tile_np<BUF>(o + 4, wb0, pa0, pa1, pa2, pa3); SBAR();                                   \
        if ((i) + 1 < 6) { VMW(); M2_WRITEV((BUF) ^ 1); if ((i) + 1 < 4) M2_WRITEK((BUF) ^ 1); }                                                          \
        __syncthreads(); } while (0)
    M2_STEP(0, 0); M2_STEP(1, 1); M2_STEP(2, 0); M2_STEP(3, 1); M2_STEP(4, 0); M2_STEP(5, 1);
    { float qn = 0.f;
#pragma unroll
      for (int d0 = 0; d0 < 8; ++d0) { const u32x4 u = __builtin_bit_cast(u32x4, load8(qp + d0 * 16)); const f32x4 na = *(const f32x4*)(R.nC + d0 * 16 + hi * 8), nb = *(const f32x4*)(R.nC + d0 * 16 + hi * 8 + 4);
          qn += ::bflo(u.x) * na[0] + ::bfhi(u.x) * na[1] + ::bflo(u.y) * na[2] + ::bfhi(u.y) * na[3] + ::bflo(u.z) * nb[0] + ::bfhi(u.z) * nb[1] + ::bflo(u.w) * nb[2] + ::bfhi(u.w) * nb[3]; }
      auto rr = __builtin_amdgcn_permlane32_swap(__float_as_uint(qn), __float_as_uint(qn), false, false);
      l_reg += wst * (__uint_as_float(rr[0]) + __uint_as_float(rr[1])); }
    { const float lv = fmaxf(fabsf(l_reg), R.aux[AUX_MEXP + qlo + r32]); if (hi == 0) li_l[r32] = lv; }
    asm volatile("s_waitcnt lgkmcnt(0)" ::: "memory");
    float rli[16];
#pragma unroll
    for (int r = 0; r < 16; ++r) rli[r] = __builtin_amdgcn_rcpf(li_l[crow(r, hi)]);
    bf16* Ow = R.O + (size_t)qlo * 1024;
#pragma unroll
    for (int r = 0; r < 16; ++r) { const int orow = crow(r, hi);
#pragma unroll
        for (int d0 = 0; d0 < 8; ++d0) { const float v = o[d0][r] * rli[r]; const float vn = __shfl_xor(v, 1);
            if ((r32 & 1) == 0) *(unsigned*)(Ow + (unsigned)(orow * 1024 + d0 * 32 + r32)) = cvtpk(v, vn); } }
    asm volatile("s_waitcnt lgkmcnt(0)" ::: "memory");
    __syncthreads();
#undef M2_LOADKV
#undef M2_LOADC
#undef M2_WRITEV
#undef M2_WRITEK
#undef M2_STEP
}
#undef TRRD2
#undef FRAG8
#undef ROWK
#undef ROWV
#undef VMW
#undef VMWN
#undef SLOAD_H
#undef SWRITE_HK
#undef SWRITE_HV
#undef SWRITE_H
#undef SBAR
#undef KSWZ
}
#define LAS __attribute__((address_space(3)))
#define GAS __attribute__((address_space(1)))
#define RLX_AGENT __ATOMIC_RELAXED, __HIP_MEMORY_SCOPE_AGENT
#define XB_TMO      128
#define XB_XCNT(j)  (256  + 64 * (j))
#define XB_XSUB(j)  (1280 + 64 * (j))
#define XB_XGEN(j)  (2304 + 64 * (j))
#define XB_TOP      3328
#define XB_TOPGEN   3392
#define XCD_BAR_WORDS 3456
#define XB_SPIN_CAP (1u << 18)

__device__ __forceinline__ unsigned xb_ld(unsigned* p)              { return __hip_atomic_load(p, __ATOMIC_RELAXED, __HIP_MEMORY_SCOPE_AGENT); }
__device__ __forceinline__ unsigned xb_add(unsigned* p, unsigned v) { return __hip_atomic_fetch_add(p, v, __ATOMIC_RELAXED, __HIP_MEMORY_SCOPE_AGENT); }
__device__ __forceinline__ unsigned xb_xcc_id() { return (unsigned)__builtin_amdgcn_s_getreg((3 << 11) | 20) & 0xFu; }
#define XB_SPIN(cond, bar) do { unsigned _sp = 0; while (cond) { __builtin_amdgcn_s_sleep(1); \
    if ((++_sp & 255u) == 0u) { if (xb_ld(&(bar)[XB_TMO])) break; if (_sp > XB_SPIN_CAP) { atomicAdd(&(bar)[XB_TMO], 1u); break; } } } } while (0)

struct XcdBarrier {
    unsigned* bar; unsigned x;
    volatile LAS unsigned* st;
};

__device__ __forceinline__ XcdBarrier xcd_barrier_post(unsigned* bar, volatile LAS unsigned* st) {
    XcdBarrier b; b.bar = bar; b.x = xb_xcc_id(); b.st = st;
    if (threadIdx.x == 0) (void)xb_add(&bar[XB_XCNT(b.x)], 1u);
    return b;
}
__device__ __forceinline__ void xcd_barrier_complete(unsigned* bar, unsigned x, unsigned& nloc, unsigned& nx) {
    const unsigned G = gridDim.x * gridDim.y * gridDim.z;
    unsigned sum, cnt, mine, sp = 0u;
    for (;;) {
        sum = 0u; cnt = 0u; mine = 0u;
#pragma unroll
        for (unsigned j = 0; j < 16; ++j) { const unsigned c = xb_ld(&bar[XB_XCNT(j)]); sum += c; cnt += (c > 0u) ? 1u : 0u; mine = (j == x) ? c : mine; }
        if (sum == G) break;
        __builtin_amdgcn_s_sleep(1);
        if ((++sp & 255u) == 0u) { if (xb_ld(&bar[XB_TMO])) break; if (sp > XB_SPIN_CAP) { atomicAdd(&bar[XB_TMO], 1u); break; } }
    }
    nloc = mine > 0u ? mine : 1u; nx = cnt > 0u ? cnt : 1u;
}

__device__ __forceinline__ void xcd_barrier(const XcdBarrier& b) {
    asm volatile("s_waitcnt vmcnt(0)" ::: "memory");
    __syncthreads();
    if (threadIdx.x == 0) {
        unsigned* bar = b.bar;
        __builtin_amdgcn_s_waitcnt(0);
        unsigned nloc = b.st[0], nx = b.st[1];
        if (nloc == 0u) { xcd_barrier_complete(bar, b.x, nloc, nx); b.st[0] = nloc; b.st[1] = nx; }
        const unsigned old = xb_add(&bar[XB_XSUB(b.x)], 1u);
        const unsigned gen = old / nloc;
        if (old + 1u == (gen + 1u) * nloc) {
            __builtin_amdgcn_fence(__ATOMIC_RELEASE, "agent");
            asm volatile("s_waitcnt vmcnt(0)" ::: "memory");
            const unsigned og = xb_add(&bar[XB_TOP], 1u);
            const unsigned tg = og / nx;
            if (og + 1u == (tg + 1u) * nx) xb_add(&bar[XB_TOPGEN], 1u);
            else XB_SPIN(xb_ld(&bar[XB_TOPGEN]) == tg, bar);
            __builtin_amdgcn_fence(__ATOMIC_ACQUIRE, "agent");
            xb_add(&bar[XB_XGEN(b.x)], 1u);
            asm volatile("s_waitcnt vmcnt(0)" ::: "memory");
        } else {
            XB_SPIN(xb_ld(&bar[XB_XGEN(b.x)]) == gen, bar);
            __builtin_amdgcn_fence(__ATOMIC_ACQUIRE, "agent");
            asm volatile("s_waitcnt vmcnt(0)" ::: "memory");
        }
    }
    __syncthreads();
}
constexpr int NWAVES = 8, NTHREADS = NWAVES * 64;
constexpr int LDS_BYTES = 131072 + 4096;
static_assert(fa::LDS_BYTES <= 131072, "attention scratch fits the ring region");
constexpr size_t MiB = 1u << 20;
constexpr size_t WS_SS = 0;
constexpr size_t WS_BAR = 512 * 1024;
constexpr size_t OUT_SSQK = 16u << 20;
constexpr size_t WS_G = 1 * MiB;
constexpr size_t WS_CK = 2 * MiB;
constexpr size_t WS_A2 = 2 * MiB + 512 * 1024, WS_M2 = WS_A2 + 256 * 1024, WS_MEXP = WS_M2 + 256 * 1024, WS_AREF = WS_MEXP + 256 * 1024;
static_assert((WS_MEXP - WS_M2) / 4 == fa::AUX_MEXP && (WS_AREF - WS_M2) / 4 == fa::AUX_AREF, "aux offsets");
constexpr size_t WS_WIN = 4 * MiB, WS_WO = 29 * MiB, WS_WGU = 37 * MiB, WS_WD = 81 * MiB, WS_WPG = 103 * MiB, WS_WPP = 111 * MiB;
constexpr size_t WS_R1 = 112 * MiB;
constexpr size_t WS_R2 = 304 * MiB;
constexpr size_t WS_R3 = 368 * MiB;
constexpr size_t WS_HB = WS_R3, WS_MQ = WS_R3 + 32 * MiB, WS_MK = WS_R3 + 48 * MiB;
constexpr size_t WS_ERAW = 432 * MiB;
constexpr size_t WS_UB = 496 * MiB, WS_END = 512 * MiB;
constexpr size_t WS_CB = WS_WIN, WS_NU = WS_WIN + 16 * MiB, WS_NC = WS_NU + 128 * 1024;
constexpr size_t WS_FLAG = WS_BAR + 32768;
constexpr size_t WS_J0 = WS_BAR + 65536;
constexpr size_t WS_GB = WS_BAR + 16384;

struct Args {
    const float *x, *p, *w_norm_mix, *w_in, *fox_f_bias, *q_norm_w, *k_norm_w, *conv_w, *conv_b, *mi_bias, *mf_bias, *out_norm_w, *w_out, *w_norm_ffn,
                *w_gate, *w_up, *w_down, *w_norm_ple, *w_ple_gate, *w_ple_proj, *w_ple_post;
    float* out; unsigned char* ws;
};

__device__ __forceinline__ float wave_sum(float v) {
#pragma unroll
    for (int o = 1; o < 64; o <<= 1) v += __shfl_xor(v, o);
    return v;
}
__device__ __forceinline__ int win_src_col(int d) {
    if (d < 3072) return d;
    if (d < 5120) return d + 8;
    if (d < 6144) return d + 16;
    if (d < 6152) return 3072 + (d - 6144);
    if (d < 6160) return 5128 + (d - 6152);
    return -1;
}
struct TItem { const float* src4; const float* kw; bf16_t* dst; int ld, K; };
__device__ __forceinline__ TItem p0_item(const Args& A, int it, int lane) {
    constexpr int I_IN = (DM / 64) * (NIN / 32), I_O = (DM / 64) * (DM / 32), I_GU = (DM / 64) * (2 * DFF / 32), I_D = (DFF / 64) * (DM / 32), I_PG = I_O;
    unsigned char* ws = A.ws; const int n4 = 4 * (lane & 7), kr = lane >> 3; TItem t; int r = it;
    if (r < I_IN) { const int nblk = NIN / 32, kb = r / nblk, nb = r % nblk; const int sc = win_src_col(nb * 32 + n4);
        t.src4 = sc >= 0 ? A.w_in + (size_t)(kb * 64 + kr) * INC + sc : nullptr; t.kw = A.w_norm_mix + kb * 64 + kr; t.ld = INC; t.K = DM; t.dst = (bf16_t*)(ws + WS_WIN) + (size_t)(nb * 32) * DM + kb * 64; return t; } r -= I_IN;
    if (r < I_O) { const int nblk = DM / 32, kb = r / nblk, nb = r % nblk; t.src4 = A.w_out + (size_t)(kb * 64 + kr) * DM + nb * 32 + n4; t.kw = nullptr; t.ld = DM; t.K = DM; t.dst = (bf16_t*)(ws + WS_WO) + (size_t)(nb * 32) * DM + kb * 64; return t; } r -= I_O;
    if (r < I_GU) { const int nblk = 2 * DFF / 32, kb = r / nblk, nb = r % nblk; const int d = nb * 32, pn = d >> 8, j = d & 255;
        t.src4 = ((j < 128) ? A.w_gate + 128 * pn + j : A.w_up + 128 * pn + (j - 128)) + (size_t)(kb * 64 + kr) * DFF + n4; t.kw = A.w_norm_ffn + kb * 64 + kr; t.ld = DFF; t.K = DM; t.dst = (bf16_t*)(ws + WS_WGU) + (size_t)d * DM + kb * 64; return t; } r -= I_GU;
    if (r < I_D) { const int nblk = DM / 32, kb = r / nblk, nb = r % nblk; t.src4 = A.w_down + (size_t)(kb * 64 + kr) * DM + nb * 32 + n4; t.kw = nullptr; t.ld = DM; t.K = DFF; t.dst = (bf16_t*)(ws + WS_WD) + (size_t)(nb * 32) * DFF + kb * 64; return t; } r -= I_D;
    if (r < I_PG) { const int nblk = DM / 32, kb = r / nblk, nb = r % nblk; t.src4 = A.w_ple_gate + (size_t)(kb * 64 + kr) * DM + nb * 32 + n4; t.kw = A.w_norm_ple + kb * 64 + kr; t.ld = DM; t.K = DM; t.dst = (bf16_t*)(ws + WS_WPG) + (size_t)(nb * 32) * DM + kb * 64; return t; } r -= I_PG;
    { const int nblk = DM / 32, kb = r / nblk, nb = r % nblk; t.src4 = A.w_ple_proj + (size_t)(kb * 64 + kr) * DM + nb * 32 + n4; t.kw = nullptr; t.ld = DM; t.K = PLE; t.dst = (bf16_t*)(ws + WS_WPP) + (size_t)(nb * 32) * PLE + kb * 64; return t; }
}
__device__ __forceinline__ void p0_item_load(const TItem& t, f32x4 (&v)[8]) {
#pragma unroll
    for (int i = 0; i < 8; ++i) { v[i] = t.src4 ? __builtin_nontemporal_load((const f32x4*)(t.src4 + (size_t)(8 * i) * t.ld)) : (f32x4){0.f, 0.f, 0.f, 0.f}; if (t.kw) v[i] = v[i] * t.kw[8 * i]; }
}
__device__ __forceinline__ void p0_item_store(const TItem& t, const f32x4 (&v)[8], LAS float* scr, int lane) {
    const int n4 = 4 * (lane & 7), kr = lane >> 3;
#pragma unroll
    for (int i = 0; i < 8; ++i) { LAS float* d = scr + (kr + 8 * i) * 33 + n4; d[0] = v[i].x; d[1] = v[i].y; d[2] = v[i].z; d[3] = v[i].w; }
    asm volatile("s_waitcnt lgkmcnt(0)" ::: "memory");
    const int c = lane & 7;
#pragma unroll
    for (int j = 0; j < 4; ++j) { const int n = (lane >> 3) + 8 * j; const LAS float* s = scr + (8 * c) * 33 + n;
        u32x4 o; o.x = cvtpk2(s[0 * 33], s[1 * 33]); o.y = cvtpk2(s[2 * 33], s[3 * 33]); o.z = cvtpk2(s[4 * 33], s[5 * 33]); o.w = cvtpk2(s[6 * 33], s[7 * 33]);
        *(u32x4*)(t.dst + (size_t)n * t.K + 8 * c) = o; }
    asm volatile("s_waitcnt lgkmcnt(0)" ::: "memory");
}
__device__ __forceinline__ void p0_prologue(const Args& A, LAS unsigned char* lds, int gw, int NGW, int lane, int wave) {
    LAS float* scr = (LAS float*)(lds + wave * 16384);
    unsigned char* ws = A.ws;
    constexpr int I_IN = (DM / 64) * (NIN / 32), I_PP = (PLE / 64) * (DM / 32), I_ALL = I_IN + 2 * (DM / 64) * (DM / 32) + (DM / 64) * (2 * DFF / 32) + (DFF / 64) * (DM / 32) + I_PP;
    constexpr int NITEMS = I_IN + I_PP;
#define P0_GI(i_) ((i_) < I_IN ? (i_) : (i_) - I_IN + (I_ALL - I_PP))
    if (gw < NITEMS) {
        TItem cur = p0_item(A, P0_GI(gw), lane); f32x4 v[8]; p0_item_load(cur, v);
        for (int it = gw; it < NITEMS; it += NGW) {
            const bool more = it + NGW < NITEMS; TItem nx = cur; f32x4 w[8];
            if (more) { nx = p0_item(A, P0_GI(it + NGW), lane); p0_item_load(nx, w); }
            p0_item_store(cur, v, scr, lane);
            if (more) { cur = nx;
#pragma unroll
                for (int i = 0; i < 8; ++i) v[i] = w[i]; }
        }
    }
#undef P0_GI
    bf16_t* XB = (bf16_t*)(ws + WS_R2); float* ss0 = (float*)(ws + WS_SS) + 3 * MROWS;
    {
        f32x4 v[8];
#pragma unroll
        for (int j = 0; j < 8; ++j) v[j] = __builtin_nontemporal_load((const f32x4*)(A.x + (size_t)gw * DM) + lane + 64 * j);
        for (int m = gw; m < MROWS; m += NGW) {
            f32x4 nv[8]; const bool more = m + NGW < MROWS;
            if (more) {
#pragma unroll
                for (int j = 0; j < 8; ++j) nv[j] = __builtin_nontemporal_load((const f32x4*)(A.x + (size_t)(m + NGW) * DM) + lane + 64 * j); }
            float s = 0.f; u32x2* o8 = (u32x2*)(XB + (size_t)m * DM) + lane;
#pragma unroll
            for (int j = 0; j < 8; ++j) { s += (v[j].x * v[j].x + v[j].y * v[j].y) + (v[j].z * v[j].z + v[j].w * v[j].w); u32x2 w; w.x = cvtpk2(v[j].x, v[j].y); w.y = cvtpk2(v[j].z, v[j].w); o8[64 * j] = w; }
            s = wave_sum(s); if (lane == 0) ss0[m] = s;
            if (more) {
#pragma unroll
                for (int j = 0; j < 8; ++j) v[j] = nv[j]; }
        }
    }
    bf16_t* PB = (bf16_t*)(ws + WS_R3);
    for (int m = gw; m < MROWS; m += NGW) { const f32x4 v = __builtin_nontemporal_load((const f32x4*)(A.p + (size_t)m * PLE) + lane); u32x2 w; w.x = cvtpk2(v.x, v.y); w.y = cvtpk2(v.z, v.w); ((u32x2*)(PB + (size_t)m * PLE))[lane] = w; }
    float* ss = (float*)(ws + WS_SS);
    for (int i = gw * 64 + lane; i < 3 * MROWS; i += NGW * 64) ss[i] = 0.f;
    { f32x4* sq = (f32x4*)(A.out + OUT_SSQK); for (int i = gw * 64 + lane; i < MROWS * 4; i += NGW * 64) sq[i] = (f32x4){0.f, 0.f, 0.f, 0.f}; }
}
constexpr int CV_FIRST = (DM / 64) * (NIN / 32), CV_ITEMS = 2 * (DM / 64) * (DM / 32) + (DM / 64) * (2 * DFF / 32) + (DFF / 64) * (DM / 32), CV_CHUNKS = CV_ITEMS / 32;
static_assert(CV_ITEMS % 32 == 0 && CV_CHUNKS % 8 == 0, "conversion chunks");
__device__ __forceinline__ void p3_convert_chunk(const Args& A, LAS unsigned char* lds, int chunk) {
    int tid_ = threadIdx.x; asm volatile("" : "+v"(tid_));
    const int lane = tid_ & 63, wave = __builtin_amdgcn_readfirstlane(tid_ >> 6);
    LAS float* scr = (LAS float*)(lds + wave * 12288);
    const int it0 = CV_FIRST + chunk * 32 + wave * 4;
    TItem cur = p0_item(A, it0, lane); f32x4 v[8]; p0_item_load(cur, v);
#pragma nounroll
    for (int i = 0; i < 4; ++i) { const bool more = i + 1 < 4; TItem nx = cur; f32x4 w[8];
        if (more) { nx = p0_item(A, it0 + i + 1, lane); p0_item_load(nx, w); }
        p0_item_store(cur, v, scr, lane);
        if (more) { cur = nx;
#pragma unroll
            for (int j = 0; j < 8; ++j) v[j] = w[j]; } }
}
__device__ __forceinline__ void gate_cols(const Args& A, LAS unsigned char* ldsl, int bx, int G) {
    typedef short bf16x8_ __attribute__((ext_vector_type(8))); typedef float f32x16_ __attribute__((ext_vector_type(16)));
    int tid0_ = threadIdx.x; asm volatile("" : "+v"(tid0_));
    const int tid = tid0_, lane = tid & 63, r32 = lane & 31, hi = lane >> 5, wave = __builtin_amdgcn_readfirstlane(tid >> 6);
    const bf16_t* XB = (const bf16_t*)(A.ws + WS_R2); const bf16_t* Wg = (const bf16_t*)(A.ws + WS_WIN) + (size_t)6144 * DM;
    float* Gout = (float*)(A.ws + WS_G); const float* ss0 = (const float*)(A.ws + WS_SS) + 3 * MROWS;
    constexpr int BP = 4112;
    LAS unsigned char* Bl = ldsl; LAS float* red = (LAS float*)(ldsl + 16 * BP);
    for (int j = bx; j < MROWS / 64; j += G) {
        { const int row = tid >> 5, c0 = tid & 31;
#pragma unroll
          for (int i = 0; i < 8; ++i) *(LAS u32x4*)(Bl + row * BP + (c0 + 32 * i) * 16) = *(const u32x4*)(Wg + (size_t)row * DM + (c0 + 32 * i) * 8); }
        const int row0 = (2 * j + (wave >> 2)) * 32, kq = (wave & 3) * 512;
        const bf16_t* ap = XB + (size_t)(row0 + r32) * DM + kq + 8 * hi;
        bf16x8_ av[32];
#pragma unroll
        for (int ks = 0; ks < 32; ++ks) av[ks] = *(const bf16x8_*)(ap + 16 * ks);
        __syncthreads();
        f32x16_ acc = {};
        const LAS unsigned char* bp = Bl + (r32 & 15) * BP + (kq + 8 * hi) * 2;
#pragma unroll
        for (int ks = 0; ks < 32; ++ks) acc = __builtin_amdgcn_mfma_f32_32x32x16_bf16(av[ks], *(const LAS bf16x8_*)(bp + 32 * ks), acc, 0, 0, 0);
        LAS float* rp = red + (wave * 64 + lane) * 16;
#pragma unroll
        for (int r = 0; r < 16; ++r) rp[r] = acc[r];
        __syncthreads();
        for (int e = tid; e < 2048; e += NTHREADS) { const int t = e >> 10, ee = e & 1023; float s = 0.f;
#pragma unroll
            for (int w = 0; w < 4; ++w) s += red[(4 * t + w) * 1024 + ee];
            const int ln = ee >> 4, r = ee & 15, col = ln & 31, row = (2 * j + t) * 32 + (r & 3) + 8 * (r >> 2) + 4 * (ln >> 5);
            if (col < 16) Gout[(size_t)row * 16 + col] = s * (1.f / sqrtf(ss0[row] * (1.f / DM) + EPS)); }
        __syncthreads();
    }
}
__device__ __forceinline__ float logsigf(float x) { return fminf(x, 0.f) - log1pf(expf(-fabsf(x))); }
__device__ __forceinline__ void scan_sequence(const Args& A, int v, LAS float* red) {
    const int tid = threadIdx.x, lane = tid & 63, wid = tid >> 6;
    const bool fox = v < NB * AH; int b, h;
    if (fox) { b = v / AH; h = v % AH; } else { const int u = v - NB * AH; b = u / MH; h = u % MH; }
    const float* Gp = (const float*)(A.ws + WS_G) + (size_t)(b * SEQ + 8 * tid) * 16;
    const int fcol = fox ? h : 12 + h; const float fb = fox ? A.fox_f_bias[h] : A.mf_bias[h];
    float lf[8]; float run = 0.f;
#pragma unroll
    for (int i = 0; i < 8; ++i) { run += logsigf(Gp[i * 16 + fcol] + fb); lf[i] = run; }
    float incl = run;
#pragma unroll
    for (int o = 1; o < 64; o <<= 1) { const float t = __shfl_up(incl, o); if (lane >= o) incl += t; }
    if (lane == 63) red[wid] = incl;
    __syncthreads();
    float base = incl - run;
    for (int w = 0; w < wid; ++w) base += red[w];
    if (fox) {
        float* CK = (float*)(A.ws + WS_CK) + (size_t)(b * AH + h) * SEQ + 8 * tid;
        float ck[8];
#pragma unroll
        for (int i = 0; i < 8; ++i) { ck[i] = -(base + lf[i]) * 11.313708498984761f; CK[i] = ck[i]; }
        LAS float* tend = red + 32; LAS float* bst = red + 96; LAS float* wmx = red + 112;
        float mq = 0.f, mk = 0.f;
        if (tid < 128) { mq = fabsf(A.q_norm_w[tid]); mk = fabsf(A.k_norm_w[tid]); }
#pragma unroll
        for (int o = 1; o < 64; o <<= 1) { mq = fmaxf(mq, __shfl_xor(mq, o)); mk = fmaxf(mk, __shfl_xor(mk, o)); }
        if (lane == 0 && wid < 2) { wmx[wid] = mq; wmx[2 + wid] = mk; }
        if ((tid & 7) == 7) tend[tid >> 3] = ck[7];
        if ((tid & 31) == 0) bst[tid >> 5] = ck[0];
        __syncthreads();
        if (tid < 16) {
            const float B = 128.f * fmaxf(wmx[0], wmx[1]) * fmaxf(wmx[2], wmx[3]) * 0.08838834764831845f * 1.02f;
            const float Tck = (2.f * B + 30.f) * 11.313708498984761f; const int NT = 4 * tid + 4; int j0 = NT - 2;
            for (int j = NT - 1; j >= 0; --j) { if (bst[tid] - tend[j] <= Tck) j0 = j; else break; }
            j0 &= ~1; if (j0 > NT - 2) j0 = NT - 2;
            ((int*)(A.ws + WS_J0))[(b * AH + h) * 16 + tid] = j0; }
    } else {
        const float ib = A.mi_bias[h];
        float a[8], lm[8]; float rm = -__builtin_inff();
#pragma unroll
        for (int i = 0; i < 8; ++i) { a[i] = (Gp[i * 16 + 8 + h] + ib) - (base + lf[i]); rm = fmaxf(rm, a[i]); lm[i] = rm; }
        float im = rm;
#pragma unroll
        for (int o = 1; o < 64; o <<= 1) { const float t = __shfl_up(im, o); if (lane >= o) im = fmaxf(im, t); }
        if (lane == 63) red[8 + wid] = im;
        __syncthreads();
        float ex = __shfl_up(im, 1); if (lane == 0) ex = -__builtin_inff();
        for (int w = 0; w < wid; ++w) ex = fmaxf(ex, red[8 + w]);
        const size_t o0 = (size_t)(b * MH + h) * SEQ + 8 * tid;
        float* A2 = (float*)(A.ws + WS_A2) + o0; float* M2 = (float*)(A.ws + WS_M2) + o0; float* ME = (float*)(A.ws + WS_MEXP) + o0;
#pragma unroll
        for (int i = 0; i < 8; ++i) { const float Mt = fmaxf(0.f, fmaxf(ex, lm[i])); A2[i] = a[i] * LOG2E; M2[i] = Mt * LOG2E; ME[i] = expf(-((base + lf[i]) + Mt)); }
        float tm = rm; tm = fmaxf(tm, __shfl_xor(tm, 1)); tm = fmaxf(tm, __shfl_xor(tm, 2)); tm = fmaxf(tm, __shfl_xor(tm, 4)); tm = fmaxf(tm, __shfl_xor(tm, 8)); tm = fmaxf(tm, __shfl_xor(tm, 16));
        if ((lane & 31) == 0) ((float*)(A.ws + WS_AREF))[(b * MH + h) * SEQ + (tid >> 5)] = tm * LOG2E;
    }
}
__device__ __forceinline__ void unpack8(const u32x4 w, float (&f)[8]) { f[0] = bflo(w.x); f[1] = bfhi(w.x); f[2] = bflo(w.y); f[3] = bfhi(w.y); f[4] = bflo(w.z); f[5] = bfhi(w.z); f[6] = bflo(w.w); f[7] = bfhi(w.w); }
__device__ __forceinline__ u32x4 pack8f(const float (&f)[8]) { u32x4 w; w.x = cvtpk2(f[0], f[1]); w.y = cvtpk2(f[2], f[3]); w.z = cvtpk2(f[4], f[5]); w.w = cvtpk2(f[6], f[7]); return w; }
__device__ __forceinline__ void mconv_rows(const Args& A, int gw, int NGW, int lane) {
    const bf16_t* PROJ = (const bf16_t*)(A.ws + WS_R1) + PC_MQ + 16 * lane;
    bf16_t* OUT = (bf16_t*)(A.ws + (lane < 32 ? WS_MQ : WS_MK)) + 16 * (lane & 31);
    const int c0 = 16 * lane;
    float w[4][16], bb[16];
#pragma unroll
    for (int j = 0; j < 4; ++j)
#pragma unroll
        for (int i = 0; i < 16; ++i) w[j][i] = A.conv_w[j * 1024 + c0 + i];
#pragma unroll
    for (int i = 0; i < 16; ++i) bb[i] = A.conv_b[c0 + i];
    const float sc = lane < 32 ? 0.08838834764831845f : 1.f;
    u32x4 tap[4][2];
#define MC_LOAD(dst, m_) do { const int t_ = (m_) & (SEQ - 1); _Pragma("unroll") for (int j = 0; j < 4; ++j) { \
        if (t_ - 3 + j >= 0) { (dst)[j][0] = *(const u32x4*)(PROJ + (size_t)((m_) - 3 + j) * PROJ_LD); (dst)[j][1] = *(const u32x4*)(PROJ + (size_t)((m_) - 3 + j) * PROJ_LD + 8); } \
        else { (dst)[j][0] = (u32x4){0u, 0u, 0u, 0u}; (dst)[j][1] = (u32x4){0u, 0u, 0u, 0u}; } } } while (0)
    MC_LOAD(tap, gw);
    for (int m = gw; m < MROWS; m += NGW) {
        const bool more = m + NGW < MROWS; u32x4 ntap[4][2];
        if (more) MC_LOAD(ntap, m + NGW);
        float acc[16];
#pragma unroll
        for (int i = 0; i < 16; ++i) acc[i] = bb[i];
#pragma unroll
        for (int j = 0; j < 4; ++j) { float f[8]; unpack8(tap[j][0], f);
#pragma unroll
            for (int i = 0; i < 8; ++i) acc[i] = fmaf(w[j][i], f[i], acc[i]);
            unpack8(tap[j][1], f);
#pragma unroll
            for (int i = 0; i < 8; ++i) acc[8 + i] = fmaf(w[j][8 + i], f[i], acc[8 + i]); }
        float o[8];
#pragma unroll
        for (int i = 0; i < 8; ++i) o[i] = acc[i] * sigmoidf_(acc[i]) * sc;
        *(u32x4*)(OUT + (size_t)m * 512) = pack8f(o);
#pragma unroll
        for (int i = 0; i < 8; ++i) o[i] = acc[8 + i] * sigmoidf_(acc[8 + i]) * sc;
        *(u32x4*)(OUT + (size_t)m * 512 + 8) = pack8f(o);
        if (more) {
#pragma unroll
            for (int j = 0; j < 4; ++j) { tap[j][0] = ntap[j][0]; tap[j][1] = ntap[j][1]; } }
    }
#undef MC_LOAD
}
__device__ __forceinline__ void mlstm_out_rows(const Args& A, int gw, int NGW, int lane) {
    const bf16_t* HB = (const bf16_t*)(A.ws + WS_HB) + 16 * lane;
    const bf16_t* MO = (const bf16_t*)(A.ws + WS_R1) + PC_MO + 16 * lane;
    bf16_t* MIX = (bf16_t*)(A.ws + WS_R2) + 1024 + 16 * lane;
    float ow[16];
#pragma unroll
    for (int i = 0; i < 16; ++i) ow[i] = A.out_norm_w[16 * lane + i];
    u32x4 rw[4];
#define MO_LD(dst, m_) do { (dst)[0] = __builtin_nontemporal_load((const u32x4*)(HB + (size_t)(m_) * 1024)); (dst)[1] = __builtin_nontemporal_load((const u32x4*)(HB + (size_t)(m_) * 1024 + 8)); \
        (dst)[2] = __builtin_nontemporal_load((const u32x4*)(MO + (size_t)(m_) * PROJ_LD)); (dst)[3] = __builtin_nontemporal_load((const u32x4*)(MO + (size_t)(m_) * PROJ_LD + 8)); } while (0)
    MO_LD(rw, gw);
    for (int m = gw; m < MROWS; m += NGW) {
        const bool more = m + NGW < MROWS; u32x4 nrw[4];
        if (more) MO_LD(nrw, m + NGW);
        float h[16], g[16];
        { float f[8]; unpack8(rw[0], f);
#pragma unroll
          for (int i = 0; i < 8; ++i) h[i] = f[i];
          unpack8(rw[1], f);
#pragma unroll
          for (int i = 0; i < 8; ++i) h[8 + i] = f[i];
          unpack8(rw[2], f);
#pragma unroll
          for (int i = 0; i < 8; ++i) g[i] = f[i];
          unpack8(rw[3], f);
#pragma unroll
          for (int i = 0; i < 8; ++i) g[8 + i] = f[i]; }
        float s = 0.f;
#pragma unroll
        for (int i = 0; i < 16; ++i) s += h[i] * h[i];
        s += __shfl_xor(s, 1); s += __shfl_xor(s, 2); s += __shfl_xor(s, 4); s += __shfl_xor(s, 8);
        const float rs = 1.f / sqrtf(s * (1.f / 256.f) + EPS);
        float o[8];
#pragma unroll
        for (int i = 0; i < 8; ++i) o[i] = h[i] * rs * ow[i] * sigmoidf_(g[i]);
        *(u32x4*)(MIX + (size_t)m * DM) = pack8f(o);
#pragma unroll
        for (int i = 0; i < 8; ++i) o[i] = h[8 + i] * rs * ow[8 + i] * sigmoidf_(g[8 + i]);
        *(u32x4*)(MIX + (size_t)m * DM + 8) = pack8f(o);
        if (more) {
#pragma unroll
            for (int j = 0; j < 4; ++j) rw[j] = nrw[j]; }
    }
#undef MO_LD
}
__device__ __forceinline__ void group_barrier(unsigned* cnt, unsigned target) {
    asm volatile("s_waitcnt vmcnt(0)" ::: "memory");
    __syncthreads();
    if (threadIdx.x == 0) {
        __builtin_amdgcn_fence(__ATOMIC_RELEASE, "agent");
        asm volatile("s_waitcnt vmcnt(0)" ::: "memory");
        (void)__hip_atomic_fetch_add(cnt, 1u, RLX_AGENT);
        unsigned sp = 0;
        while (__hip_atomic_load(cnt, RLX_AGENT) < target) { __builtin_amdgcn_s_sleep(1); if (++sp > (1u << 22)) break; }
        __builtin_amdgcn_fence(__ATOMIC_ACQUIRE, "agent");
        asm volatile("s_waitcnt vmcnt(0)" ::: "memory");
    }
    __syncthreads();
}
__device__ __forceinline__ void mlstm_scan(const Args& A, int g, int x) {
    int tid_ = threadIdx.x; asm volatile("" : "+v"(tid_));
    const float* M2 = (const float*)(A.ws + WS_M2) + (size_t)g * SEQ;
    const bf16_t* U = (const bf16_t*)(A.ws + WS_UB) + (size_t)g * 16 * 32768 + 2048 * x + 4 * tid_;
    bf16_t* C = (bf16_t*)(A.ws + WS_CB) + (size_t)g * 16 * 32768 + 2048 * x + 4 * tid_;
    const bool nscan = x == 0 && tid_ < 128;
    const float* nU = (const float*)(A.ws + WS_NU) + (size_t)g * 16 * 128 + (tid_ & 127); float* nC = (float*)(A.ws + WS_NC) + (size_t)g * 16 * 128 + (tid_ & 127);
    u32x2 uu[15]; float me[15], nu[15];
#pragma unroll
    for (int b = 0; b < 15; ++b) { uu[b] = *(const u32x2*)(U + (size_t)b * 32768); me[b] = M2[256 * b + 255]; nu[b] = nscan ? nU[b * 128] : 0.f; }
    f32x4 c = {0.f, 0.f, 0.f, 0.f}; *(u32x2*)C = (u32x2){0u, 0u};
    float n = 0.f; if (nscan) nC[0] = 0.f;
#pragma unroll
    for (int b = 0; b < 15; ++b) { const float gdec = (b == 0) ? 0.f : __builtin_amdgcn_exp2f(me[b - 1] - me[b]);
        c = c * gdec + (f32x4){bflo(uu[b].x), bfhi(uu[b].x), bflo(uu[b].y), bfhi(uu[b].y)};
        u32x2 w; w.x = cvtpk2(c[0], c[1]); w.y = cvtpk2(c[2], c[3]); *(u32x2*)(C + (size_t)(b + 1) * 32768) = w;
        n = n * gdec + nu[b]; if (nscan) nC[(b + 1) * 128] = n; }
}
__device__ __forceinline__ fa::BlockRef p3_fitem(const Args& A, int id, int ja, int jb, int part) {
    fa::BlockRef r; const int bh = id >> 4, qb = id & 15, b = bh / AH, h = bh % AH; const size_t row0 = (size_t)b * SEQ;
    const fa::bf16* PROJ = (const fa::bf16*)(A.ws + WS_R1) + row0 * PROJ_LD + h * 128;
    r.Q = PROJ + PC_AQ; r.K = PROJ + PC_AK; r.V = PROJ + PC_AV; r.O = (fa::bf16*)(A.ws + WS_R2) + row0 * DM + h * 128;
    r.aux = (const float*)(A.ws + WS_CK) + (size_t)bh * SEQ; r.sq = A.out + OUT_SSQK + (size_t)h * MROWS + row0; r.P0 = qb * 256; r.j0 = ja; r.j1 = jb; r.part = part;
    r.PO = (fa::bf16*)A.out + (size_t)id * 32768; r.PS = A.out + 8388608 + (size_t)id * 512; r.flag = (unsigned*)(A.ws + WS_FLAG) + id; return r;
}
__device__ __forceinline__ int fox_worklist(const Args& A, LAS unsigned char* lq, int k) {
    int tid_ = threadIdx.x; asm volatile("" : "+v"(tid_));
    const int tid = tid_;
    LAS unsigned short* cost = (LAS unsigned short*)lq; LAS unsigned short* key = cost + 512; LAS unsigned short* order = key + 512; LAS unsigned char* jas = (LAS unsigned char*)(order + 512); LAS unsigned char* jbs = jas + 512;
    LAS float* pcost = (LAS float*)(jbs + 512); LAS unsigned char* pcls = (LAS unsigned char*)(pcost + 32); LAS int* cnt = (LAS int*)(pcls + 32);
    const int j0 = ((const int*)(A.ws + WS_J0))[tid], NT = 4 * (tid & 15) + 4, c = NT - j0;
    { float pc = (float)c; pc += __shfl_xor(pc, 1); pc += __shfl_xor(pc, 2); pc += __shfl_xor(pc, 4); pc += __shfl_xor(pc, 8); if ((tid & 15) == 0) pcost[tid >> 4] = pc; if (tid == 0) cnt[0] = 0; }
    __syncthreads();
    if (tid < 32) { const int b = tid >> 3, h = tid & 7; const int kk = (b & 1) ? (h < 4 ? 3 - h : h - 4) : (h < 4 ? h : 7 - h); pcls[tid] = (unsigned char)(kk + 4 * (b >> 1)); }
    __syncthreads();
    if (pcls[tid >> 4] == k) {
        if (c >= 36) { const int jm = j0 + (((c >> 1) + 1) & ~1); const int sl = __hip_atomic_fetch_add(cnt, 2, __ATOMIC_RELAXED, __HIP_MEMORY_SCOPE_WORKGROUP);
            key[sl] = (unsigned short)tid; jas[sl] = (unsigned char)j0; jbs[sl] = (unsigned char)jm; cost[sl] = (unsigned short)(jm - j0);
            key[sl + 1] = (unsigned short)(512 + tid); jas[sl + 1] = (unsigned char)jm; jbs[sl + 1] = (unsigned char)NT; cost[sl + 1] = (unsigned short)(NT - jm); }
        else { const int sl = __hip_atomic_fetch_add(cnt, 1, __ATOMIC_RELAXED, __HIP_MEMORY_SCOPE_WORKGROUP);
            key[sl] = (unsigned short)tid; jas[sl] = (unsigned char)j0; jbs[sl] = (unsigned char)NT; cost[sl] = (unsigned short)c; } }
    __syncthreads();
    const int n = cnt[0] < 512 ? cnt[0] : 512;
    if (tid < n) { const unsigned ci = cost[tid], ki = key[tid]; int rank = 0;
      for (int j = 0; j < n; ++j) { const unsigned cj = cost[j], kj = key[j]; rank += (cj > ci || (cj == ci && kj < ki)) ? 1 : 0; }
      order[rank] = (unsigned short)tid; }
    __syncthreads();
    return n;
}

#ifndef ONLY
#define ONLY -1
#endif
#ifndef REP0
#define REP0 1
#endif
#ifndef REP1
#define REP1 1
#endif
#ifndef REP3
#define REP3 1
#endif
#ifndef REP6
#define REP6 1
#endif
#ifndef REP2B
#define REP2B 1
#endif
#ifndef REP4
#define REP4 1
#endif
#ifndef XSYNC
#define XSYNC 0
#endif
#ifndef REP5
#define REP5 1
#endif
#ifndef REP2A
#define REP2A 1
#endif
#ifndef REP7
#define REP7 1
#endif
#ifndef REP8
#define REP8 1
#endif
#ifndef REPM
#define REPM 1
#endif
#ifndef REPF
#define REPF 1
#endif
#ifndef TSA
#define TSA 0
#endif
#ifndef TSB
#define TSB 0
#endif
#ifndef TSMULT
#define TSMULT 4
#endif
#ifndef SKIPMASK
#define SKIPMASK 0
#endif
#define PH(k) if constexpr (ONLY < 0 ? !((SKIPMASK >> (k)) & 1) : ONLY == (k))
template <class T> __device__ __forceinline__ T* as_global(T* p) { return (T*)(__attribute__((address_space(1))) T*)p; }
__device__ __forceinline__ Args load_args() {
#if defined(__HIP_DEVICE_COMPILE__)
    const __attribute__((address_space(4))) Args* ap = (const __attribute__((address_space(4))) Args*)__builtin_amdgcn_kernarg_segment_ptr();
    asm volatile("" : "+s"(ap));
    Args a = *ap;
#define FX(f) a.f = as_global(a.f)
    FX(x); FX(p); FX(w_norm_mix); FX(w_in); FX(fox_f_bias); FX(q_norm_w); FX(k_norm_w); FX(conv_w); FX(conv_b); FX(mi_bias); FX(mf_bias); FX(out_norm_w); FX(w_out); FX(w_norm_ffn);
    FX(w_gate); FX(w_up); FX(w_down); FX(w_norm_ple); FX(w_ple_gate); FX(w_ple_proj); FX(w_ple_post); FX(out); FX(ws);
#undef FX
    return a;
#else
    return Args{};
#endif
}
#define ARGS() load_args()
__global__ void __launch_bounds__(NTHREADS, 2) fwd_megakernel(Args Aunused) {
    extern __shared__ __attribute__((aligned(16))) unsigned char lds[];
    cg::grid_group grid = cg::this_grid();
    LAS unsigned char* ldsl = (LAS unsigned char*)lds;
    const int G = gridDim.x, bx = blockIdx.x, NGW = G * NWAVES;
#define TS(k) do { if (TSA != TSB) { if (bx == 0 && threadIdx.x == 0) ((volatile LAS unsigned long long*)(ldsl + 131072 + 256))[k] = __builtin_amdgcn_s_memrealtime(); } } while (0)
#define LANEVARS() int tid_ = threadIdx.x; asm volatile("" : "+v"(tid_)); const int lane = tid_ & 63, wave = __builtin_amdgcn_readfirstlane(tid_ >> 6), gw = bx * NWAVES + wave; (void)lane; (void)gw

    if (threadIdx.x < 16) ((volatile LAS unsigned*)(ldsl + 131072))[threadIdx.x] = 0u;
    __syncthreads();
    XcdBarrier xbar = xcd_barrier_post((unsigned*)(ARGS().ws + WS_BAR), (volatile LAS unsigned*)(ldsl + 131072));
#define GRID_BAR() xcd_barrier(xbar)
    if (ARGS().ws == nullptr) grid.sync();
    TS(0);
    PH(0) for (int rep = 0; rep < REP0; ++rep) { const Args A = ARGS(); LANEVARS(); p0_prologue(A, ldsl, gw, NGW, lane, wave); }
    GRID_BAR();
    TS(1);
    for (int rep = 0; rep < XSYNC; ++rep) GRID_BAR();
    PH(1) { const Args A = ARGS(); gate_cols(A, ldsl, bx, G); }
    PH(1) for (int rep = 0; rep < REP1; ++rep) { const Args A = ARGS(); unsigned char* ws = A.ws; float* SS = (float*)(ws + WS_SS);
        pg8::Gemm g0{(const bf16_t*)(ws + WS_R2), (const bf16_t*)(ws + WS_WIN), MROWS, PROJ_LD, DM}, g1{(const bf16_t*)(ws + WS_R3), (const bf16_t*)(ws + WS_WPP), MROWS, DM, PLE};
        pg8::DualOrder S; S.s0.init(MROWS, PROJ_LD, G, bx); S.s1.init(MROWS, DM, G, bx);
        pg8::EpiP1 E{{(bf16_t*)(ws + WS_R1), (const float*)(ws + WS_SS) + 3 * MROWS, A.q_norm_w, A.k_norm_w, A.out + OUT_SSQK}, {(bf16_t*)(ws + WS_ERAW), SS}};
        pg8::gemm_phase2<pg8::EpiP1, pg8::DualOrder, true, true>(ldsl, g0, g1, S, E);
    }
    GRID_BAR(); TS(2);
    PH(2) for (int rep = 0; rep < REP2A; ++rep) { const Args A = ARGS(); for (int v = bx; v < NB * AH + NB * MH; v += G) { scan_sequence(A, v, (LAS float*)ldsl); __syncthreads(); } }
    PH(2) for (int rep = 0; rep < REP2A; ++rep) { const Args A = ARGS(); LANEVARS(); const int nsc = NB * AH + NB * MH;
        if (G > 2 * nsc) { if (bx >= nsc) mconv_rows(A, gw - nsc * NWAVES, NGW - nsc * NWAVES, lane); } else mconv_rows(A, gw, NGW, lane); }
    GRID_BAR(); TS(3);
    PH(3) for (int rep = 0; rep < REP3; ++rep) { const Args A = ARGS(); const int w = bx & 255, x = w & 15, g = w >> 4;
        unsigned char* ws = A.ws; unsigned* gcnt = (unsigned*)(ws + WS_GB) + 64 * g;
        const int b = g / MH, h = g % MH; const size_t row0 = (size_t)b * SEQ;
        const float* M2 = (const float*)(ws + WS_M2) + (size_t)g * SEQ; const float aref = ((const float*)(ws + WS_AREF))[g * SEQ + x];
        const fa::bf16* MQp = (const fa::bf16*)(ws + WS_MQ) + row0 * 512 + h * 128; const fa::bf16* MKp = (const fa::bf16*)(ws + WS_MK) + row0 * 512 + h * 128;
        const fa::bf16* MVp = (const fa::bf16*)(ws + WS_R1) + row0 * PROJ_LD + PC_MV + h * 256;
        for (int rm = 0; rm < REPM; ++rm) {
        { fa::StateRef R{MKp, MVp, (fa::bf16*)(ws + WS_UB) + (size_t)(g * 16 + x) * 32768, (float*)(ws + WS_NU) + (g * 16 + x) * 128, (const float*)(ws + WS_A2) + (size_t)g * SEQ, aref, exp2f(aref - M2[256 * x + 255]), 256 * x};
          fa::mlstm_state_block(R, (char*)lds); }
        group_barrier(gcnt, 16u * (2 * rm + 1));
        mlstm_scan(A, g, x);
        group_barrier(gcnt, 16u * (2 * rm + 2));
        { fa::OutRef R{MQp, MKp, MVp, (const fa::bf16*)(ws + WS_CB) + (size_t)(g * 16 + x) * 32768, (const float*)(ws + WS_NC) + (g * 16 + x) * 128,
                       (fa::bf16*)(ws + WS_HB) + row0 * 1024 + h * 256, M2, (const float*)(ws + WS_A2) + (size_t)g * SEQ, aref, x > 0 ? M2[256 * x - 1] : 0.f, 256 * x};
          fa::mlstm_out_pass2(R, (char*)lds); }
        }
        TS(4);
        for (int rf = 0; rf < REPF; ++rf) {
            LAS unsigned char* lq = ldsl + 98304; LAS unsigned short* key = (LAS unsigned short*)lq + 512; LAS unsigned short* order = key + 512; LAS unsigned char* jas = (LAS unsigned char*)(order + 512); LAS unsigned char* jbs = jas + 512;
            LAS int* popw = (LAS int*)(lq + 8192);
            const int kcls = bx & 7;
            const int nit = fox_worklist(A, lq, kcls);
            unsigned* qhead = (unsigned*)(ws + WS_GB) + 16 * 64 + 64 * (8 * rf + kcls);
#define FOX_POP(dst) do { if (threadIdx.x == 0) popw[0] = (int)__hip_atomic_fetch_add(qhead, 1u, RLX_AGENT); __syncthreads(); dst = popw[0]; __syncthreads(); } while (0)
#define FOX_ITEM(q_) p3_fitem(A, (int)key[order[q_]] & 511, jas[order[q_]], jbs[order[q_]], key[order[q_]] >= 512 ? 2 : ((int)jbs[order[q_]] != 4 * ((int)key[order[q_]] & 15) + 4 ? 1 : 0))
            int qi; FOX_POP(qi);
            if (qi < nit) {
                fa::Seam S; fa::BlockRef c = FOX_ITEM(qi); fa::attn_prime<0>(c, (char*)lds, S);
                for (;;) {
                    int qn; FOX_POP(qn);
                    const bool more = qn < nit; const fa::BlockRef n = more ? FOX_ITEM(qn) : c;
                    fa::attn_block<0>(c, n, (char*)lds, S);
                    qi = qn;
                    if (!more) break;
                    c = n;
                }
            }
            if (rf == 0) { __syncthreads();
                while (qi - nit < CV_CHUNKS / 8) { p3_convert_chunk(A, ldsl, (qi - nit) * 8 + kcls); FOX_POP(qi); } }
#undef FOX_POP
#undef FOX_ITEM
        }
        asm volatile("s_waitcnt vmcnt(0)" ::: "memory");
        __syncthreads();
    }
    GRID_BAR(); TS(5);
    PH(4) for (int rep = 0; rep < REP4; ++rep) { const Args A = ARGS(); LANEVARS(); mlstm_out_rows(A, gw, NGW, lane); }
    GRID_BAR(); TS(6);
    PH(5) for (int rep = 0; rep < REP5; ++rep) { const Args A = ARGS(); unsigned char* ws = A.ws; float* SS = (float*)(ws + WS_SS);
        pg8::Gemm g{(const bf16_t*)(ws + WS_R2), (const bf16_t*)(ws + WS_WO), MROWS, DM, DM}; pg8::StaticOrder S; S.init(MROWS, DM, G, bx, 4);
        pg8::EpiRes<false> E{A.x, (bf16_t*)(ws + WS_R3), SS + MROWS, rep == 0};
        pg8::gemm_phase<pg8::EpiRes<false>, pg8::StaticOrder, true, true>(ldsl, g, S, E);
    }
    GRID_BAR(); TS(7);
    PH(6) for (int rep = 0; rep < REP6; ++rep) { const Args A = ARGS(); unsigned char* ws = A.ws; float* SS = (float*)(ws + WS_SS);
        pg8::Gemm g{(const bf16_t*)(ws + WS_R3), (const bf16_t*)(ws + WS_WGU), MROWS, 2 * DFF, DM}; pg8::StaticOrder S; S.init(MROWS, 2 * DFF, G, bx);
        pg8::EpiSwiGLU E{(bf16_t*)(ws + WS_R1), SS + MROWS};
        pg8::gemm_phase<pg8::EpiSwiGLU, pg8::StaticOrder, true, true>(ldsl, g, S, E);
    }
    GRID_BAR(); TS(8);
    PH(7) for (int rep = 0; rep < REP7; ++rep) { const Args A = ARGS(); unsigned char* ws = A.ws; float* SS = (float*)(ws + WS_SS) + (rep + 1 < REP7 ? 2 * MROWS : 0);
        pg8::Gemm g{(const bf16_t*)(ws + WS_R1), (const bf16_t*)(ws + WS_WD), MROWS, DM, DFF}; pg8::StaticOrder S; S.init(MROWS, DM, G, bx, 4);
        pg8::EpiRes<true> E{(const void*)(ws + WS_R3), (bf16_t*)(ws + WS_R2), SS + 2 * MROWS, 1};
        pg8::gemm_phase<pg8::EpiRes<true>, pg8::StaticOrder, true, true>(ldsl, g, S, E);
    }
    GRID_BAR(); TS(9);
    PH(8) for (int rep = 0; rep < REP8; ++rep) { const Args A = ARGS(); unsigned char* ws = A.ws; float* SS = (float*)(ws + WS_SS);
        pg8::Gemm g{(const bf16_t*)(ws + WS_R2), (const bf16_t*)(ws + WS_WPG), MROWS, DM, DM}; pg8::StaticOrder S; S.init(MROWS, DM, G, bx, 4);
        pg8::EpiFinal E{A.out, (const bf16_t*)(ws + WS_R2), (const bf16_t*)(ws + WS_ERAW), A.w_ple_post, SS + 2 * MROWS, SS};
        pg8::gemm_phase<pg8::EpiFinal, pg8::StaticOrder, true, true>(ldsl, g, S, E);
    }
    TS(10);
    if (TSA != TSB) { if (bx == 0 && threadIdx.x == 0) { volatile LAS unsigned long long* t = (volatile LAS unsigned long long*)(ldsl + 131072 + 256); const unsigned long long d = (t[TSB] - t[TSA]) * TSMULT, e0 = __builtin_amdgcn_s_memrealtime();
            while (__builtin_amdgcn_s_memrealtime() - e0 < d) __builtin_amdgcn_s_sleep(8); } }
}

extern "C" void kernel_launch(void* const* d_in, const int* in_sizes, int n_in, void* d_out, int out_size, void* d_ws, size_t ws_size, hipStream_t stream) {
    static int grid = 0;
    if (grid == 0) {
        if (n_in != 21 || in_sizes[0] != MROWS * DM || out_size != MROWS * DM || ws_size < WS_END) {
            fprintf(stderr, "kernel_launch: unexpected shapes (n_in %d, in0 %d, out %d, ws %zu; need ws >= %zu)\n", n_in, n_in > 0 ? in_sizes[0] : -1, out_size, ws_size, (size_t)WS_END); grid = -1; return; }
        int dev = 0, cus = 0, per_cu = 0;
        (void)hipGetDevice(&dev); (void)hipDeviceGetAttribute(&cus, hipDeviceAttributeMultiprocessorCount, dev);
        if (hipFuncSetAttribute((const void*)fwd_megakernel, hipFuncAttributeMaxDynamicSharedMemorySize, LDS_BYTES) != hipSuccess) { fprintf(stderr, "kernel_launch: hipFuncSetAttribute failed\n"); grid = -1; return; }
        if (hipOccupancyMaxActiveBlocksPerMultiprocessor(&per_cu, (const void*)fwd_megakernel, NTHREADS, LDS_BYTES) != hipSuccess || per_cu < 1) { fprintf(stderr, "kernel_launch: occupancy query says %d blocks per CU\n", per_cu); per_cu = 1; }
        (void)hipGetLastError();
        if (per_cu > 1) per_cu = 1;
        grid = cus * per_cu;
        if (grid != 256) { fprintf(stderr, "kernel_launch: this kernel is laid out for a 256-CU device (got %d workgroups)\n", grid); grid = -1; return; }
    }
    if (grid < 0) return;
    if (hipMemsetAsync((char*)d_ws + WS_BAR, 0, 65536, stream) != hipSuccess) { fprintf(stderr, "kernel_launch: hipMemsetAsync of the control words failed\n"); return; }
    Args a{};
    a.x = (const float*)d_in[0]; a.p = (const float*)d_in[1]; a.w_norm_mix = (const float*)d_in[2]; a.w_in = (const float*)d_in[3]; a.fox_f_bias = (const float*)d_in[4];
    a.q_norm_w = (const float*)d_in[5]; a.k_norm_w = (const float*)d_in[6]; a.conv_w = (const float*)d_in[7]; a.conv_b = (const float*)d_in[8]; a.mi_bias = (const float*)d_in[9];
    a.mf_bias = (const float*)d_in[10]; a.out_norm_w = (const float*)d_in[11]; a.w_out = (const float*)d_in[12]; a.w_norm_ffn = (const float*)d_in[13]; a.w_gate = (const float*)d_in[14];
    a.w_up = (const float*)d_in[15]; a.w_down = (const float*)d_in[16]; a.w_norm_ple = (const float*)d_in[17]; a.w_ple_gate = (const float*)d_in[18]; a.w_ple_proj = (const float*)d_in[19];
    a.w_ple_post = (const float*)d_in[20];
    a.out = (float*)d_out; a.ws = (unsigned char*)d_ws;
    void* args[] = {&a};
    hipError_t e = hipLaunchCooperativeKernel((const void*)fwd_megakernel, dim3(grid), dim3(NTHREADS), args, LDS_BYTES, stream);
    if (e != hipSuccess) fprintf(stderr, "kernel_launch: cooperative launch failed: %s (grid %d)\n", hipGetErrorString(e), grid);
}
```

```cpp
#include <hip/hip_runtime.h>
#include <hip/hip_cooperative_groups.h>
#include <hip/hip_bf16.h>
#include <cstdio>
#include <cstdint>
namespace cg = cooperative_groups;

constexpr int NB = 4, SEQ = 4096, DM = 2048, MROWS = NB * SEQ;
constexpr int PLE = 256, AH = 8, MH = 4, DFF = 5632, INC = 6160;
constexpr int PROJ_LD = 6144, NIN = 6400;
constexpr int PC_AQ = 0, PC_AK = 1024, PC_AV = 2048, PC_MQ = 3072, PC_MK = 3584, PC_MV = 4096, PC_MO = 5120;
constexpr float EPS = 1e-6f;
constexpr float LOG2E = 1.4426950408889634f;

typedef unsigned short bf16_t;
typedef float f32x4 __attribute__((ext_vector_type(4)));
typedef float f32x2 __attribute__((ext_vector_type(2)));
typedef unsigned u32x4 __attribute__((ext_vector_type(4)));
typedef unsigned u32x2 __attribute__((ext_vector_type(2)));
typedef __bf16 bf16x2_t __attribute__((ext_vector_type(2)));
__device__ __forceinline__ unsigned cvtpk2(float lo, float hi) { f32x2 v = {lo, hi}; bf16x2_t b = __builtin_convertvector(v, bf16x2_t); return __builtin_bit_cast(unsigned, b); }
__device__ __forceinline__ float bflo(unsigned w) { return __uint_as_float(w << 16); }
__device__ __forceinline__ float bfhi(unsigned w) { return __uint_as_float(w & 0xffff0000u); }
__device__ __forceinline__ float sigmoidf_(float x) { return __builtin_amdgcn_rcpf(1.f + __expf(-x)); }
namespace pg8 {
#define PG8_LAS __attribute__((address_space(3)))
typedef unsigned short bf16_t;
typedef short bf16x8 __attribute__((ext_vector_type(8)));
typedef float f32x4 __attribute__((ext_vector_type(4)));
typedef unsigned u32x4 __attribute__((ext_vector_type(4)));
constexpr int BM = 256, BK = 64, HALF = 128, HTB = HALF * BK * 2  , STAGE_BYTES = 8 * HTB, NXCD = 8, WGM = 8;

__host__ __device__ __forceinline__ int lds_byte(int r, int c) { const int st = (r >> 4) * 2 + (c >> 5), rr = r & 15, cc = c & 31, ob = rr * 64 + cc * 2; return st * 1024 + (ob ^ (((ob >> 9) & 1) << 5)); }
__host__ __device__ __forceinline__ void stage_rc(int b, int& R, int& C) { const int st = b / 1024, sb = b % 1024, swz = sb ^ (((sb >> 9) & 1) << 5); R = (st >> 1) * 16 + swz / 64; C = (st & 1) * 32 + (swz % 64) / 2; }
__host__ __device__ __forceinline__ int perm32(int rho) { const int n = rho >> 4, i = rho & 15; return 8 * (i >> 2) + 4 * n + (i & 3); }

struct Unit { int pm, pn; };
struct Gemm { const bf16_t* A; const bf16_t* Bt; int M, N, K; };

struct StaticOrder {
    int nM, nN, nwg, G, c, wgm;
    __host__ __device__ void init(int M, int N, int G_, int c_, int wgm_ = WGM) { nM = M / BM; nN = N / BM; nwg = nM * nN; G = G_; c = c_; wgm = wgm_; }
    __host__ __device__ bool next(int i, Unit& u) const {
        const long L = (long)i * G + c; if (L >= nwg) return false;
        int wgid = (int)L; { const int q = nwg / NXCD, r = nwg % NXCD, xcd = wgid % NXCD, off = wgid / NXCD; wgid = (xcd < r ? xcd * (q + 1) : r * (q + 1) + (xcd - r) * q) + off; }
        const int nig = wgm * nN, gid = wgid / nig, fm = gid * wgm, gsz = (nM - fm) < wgm ? (nM - fm) : wgm;
        u.pm = fm + ((wgid % nig) % gsz); u.pn = (wgid % nig) / gsz; return true;
    }
    __device__ __forceinline__ void a_ready(const Unit&) const {}
    __device__ __forceinline__ void done(const Unit&) const {}
};
__device__ __forceinline__ unsigned cvt_pk_bf16(float lo, float hi) { return ::cvtpk2(lo, hi); }
__device__ __forceinline__ float sumsq4(f32x4 v) { return (v[0] * v[0] + v[1] * v[1]) + (v[2] * v[2] + v[3] * v[3]); }
__device__ __forceinline__ void atomic_add_f32(float* p, float v) { __hip_atomic_fetch_add(p, v, __ATOMIC_RELAXED, __HIP_MEMORY_SCOPE_AGENT); }

__device__ __forceinline__ void zero_acc(f32x4 (&acc)[2][2][4][2]) {
#pragma unroll
    for (int a = 0; a < 2; ++a)
#pragma unroll
        for (int b = 0; b < 2; ++b)
#pragma unroll
            for (int m = 0; m < 4; ++m)
#pragma unroll
                for (int n = 0; n < 2; ++n) acc[a][b][m][n] = (f32x4){0.f, 0.f, 0.f, 0.f};
}
#define PG8_ZERO_INIT __device__ __forceinline__ void init(f32x4 (&acc)[2][2][4][2], const Unit&, int, int, int, int) const { zero_acc(acc); }

struct EpiProj {
    static constexpr bool PERM = true, AFTER_DRAIN = false;
    PG8_ZERO_INIT
    bf16_t* O; const float* ss0; const float* qw; const float* kw; float* ssqk;
    __device__ __forceinline__ void operator()(const f32x4 (&acc)[2][2][4][2], const Unit& u, int wr, int wc, int fr, int fq) const {
        const int row0 = u.pm * BM + wr * 64 + fr, col0 = u.pn * BM + wc * 32 + 8 * fq;
        const bool qk = u.pn < 8;
        f32x4 wv[2] = {{1.f, 1.f, 1.f, 1.f}, {1.f, 1.f, 1.f, 1.f}};
        if (qk) { const float* wp = (u.pn < 4 ? qw : kw) + wc * 32 + 8 * fq; wv[0] = *(const f32x4*)wp; wv[1] = *(const f32x4*)(wp + 4); }
        float rsv[2][4];
#pragma unroll
        for (int ai = 0; ai < 2; ++ai)
#pragma unroll
            for (int m = 0; m < 4; ++m) rsv[ai][m] = ss0[row0 + ai * HALF + m * 16];
#pragma unroll
        for (int ai = 0; ai < 2; ++ai)
#pragma unroll
            for (int m = 0; m < 4; ++m) { const int row = row0 + ai * HALF + m * 16; const float rs = __builtin_amdgcn_rsqf(rsv[ai][m] * (1.f / 2048.f) + 1e-6f); bf16_t* rowp = O + (size_t)row * 6144 + col0;
#pragma unroll
                for (int bj = 0; bj < 2; ++bj) { const f32x4 v0 = acc[ai][bj][m][0] * rs, v1 = acc[ai][bj][m][1] * rs;
                    if (qk) { float s = sumsq4(v0) + sumsq4(v1); s += __shfl_xor(s, 16); s += __shfl_xor(s, 32); if (fq == 0) atomic_add_f32(ssqk + (size_t)(u.pn * 2 + bj) * 16384 + row, s); }
                    const f32x4 y0 = v0 * wv[0], y1 = v1 * wv[1];
                    u32x4 w; w.x = cvt_pk_bf16(y0[0], y0[1]); w.y = cvt_pk_bf16(y0[2], y0[3]); w.z = cvt_pk_bf16(y1[0], y1[1]); w.w = cvt_pk_bf16(y1[2], y1[3]);
                    *(u32x4*)(rowp + bj * HALF) = w; } }
    }
};
struct EpiE {
    static constexpr bool PERM = true, AFTER_DRAIN = false;
    PG8_ZERO_INIT
    bf16_t* O; float* ss;
    __device__ __forceinline__ void operator()(const f32x4 (&acc)[2][2][4][2], const Unit& u, int wr, int wc, int fr, int fq) const {
        const int row0 = u.pm * BM + wr * 64 + fr, col0 = u.pn * BM + wc * 32 + 8 * fq;
#pragma unroll
        for (int ai = 0; ai < 2; ++ai)
#pragma unroll
            for (int m = 0; m < 4; ++m) { const int row = row0 + ai * HALF + m * 16; bf16_t* rowp = O + (size_t)row * 2048 + col0; float s = 0.f;
#pragma unroll
                for (int bj = 0; bj < 2; ++bj) { const f32x4 v0 = acc[ai][bj][m][0], v1 = acc[ai][bj][m][1]; s += sumsq4(v0) + sumsq4(v1);
                    u32x4 w; w.x = cvt_pk_bf16(v0[0], v0[1]); w.y = cvt_pk_bf16(v0[2], v0[3]); w.z = cvt_pk_bf16(v1[0], v1[1]); w.w = cvt_pk_bf16(v1[2], v1[3]);
                    __builtin_nontemporal_store(w, (u32x4*)(rowp + bj * HALF)); }
                s += __shfl_xor(s, 16); s += __shfl_xor(s, 32);
                if (fq == 0) atomic_add_f32(ss + row, s); }
    }
};
template <bool XINB> struct EpiRes {
    static constexpr bool PERM = true, AFTER_DRAIN = false;
    const void* xin; bf16_t* xout; float* ss; int live;
    __device__ __forceinline__ void init(f32x4 (&acc)[2][2][4][2], const Unit& u, int wr, int wc, int fr, int fq) const {
        const int row0 = u.pm * BM + wr * 64 + fr, col0 = u.pn * BM + wc * 32 + 8 * fq;
#pragma unroll
        for (int ai = 0; ai < 2; ++ai)
#pragma unroll
            for (int m = 0; m < 4; ++m) { const size_t off = (size_t)(row0 + ai * HALF + m * 16) * 2048 + col0;
#pragma unroll
                for (int bj = 0; bj < 2; ++bj) {
                    if constexpr (XINB) { const u32x4 w = *(const u32x4*)((const bf16_t*)xin + off + bj * HALF);
                        acc[ai][bj][m][0] = (f32x4){::bflo(w.x), ::bfhi(w.x), ::bflo(w.y), ::bfhi(w.y)}; acc[ai][bj][m][1] = (f32x4){::bflo(w.z), ::bfhi(w.z), ::bflo(w.w), ::bfhi(w.w)}; }
                    else { const float* rp = (const float*)xin + off + bj * HALF; acc[ai][bj][m][0] = __builtin_nontemporal_load((const f32x4*)rp); acc[ai][bj][m][1] = __builtin_nontemporal_load((const f32x4*)(rp + 4)); } } }
    }
    __device__ __forceinline__ void operator()(const f32x4 (&acc)[2][2][4][2], const Unit& u, int wr, int wc, int fr, int fq) const {
        if (!live) {
#pragma unroll
            for (int ai = 0; ai < 2; ++ai)
#pragma unroll
                for (int m = 0; m < 4; ++m)
#pragma unroll
                    for (int bj = 0; bj < 2; ++bj)
#pragma unroll
                        for (int n = 0; n < 2; ++n) asm volatile("" :: "v"(acc[ai][bj][m][n]));
            return; }
        const int row0 = u.pm * BM + wr * 64 + fr, col0 = u.pn * BM + wc * 32 + 8 * fq;
#pragma unroll
        for (int ai = 0; ai < 2; ++ai)
#pragma unroll
            for (int m = 0; m < 4; ++m) { const int row = row0 + ai * HALF + m * 16; bf16_t* rowp = xout + (size_t)row * 2048 + col0; float s = 0.f;
#pragma unroll
                for (int bj = 0; bj < 2; ++bj) { const f32x4 v0 = acc[ai][bj][m][0], v1 = acc[ai][bj][m][1]; s += sumsq4(v0) + sumsq4(v1);
                    u32x4 w; w.x = cvt_pk_bf16(v0[0], v0[1]); w.y = cvt_pk_bf16(v0[2], v0[3]); w.z = cvt_pk_bf16(v1[0], v1[1]); w.w = cvt_pk_bf16(v1[2], v1[3]);
                    *(u32x4*)(rowp + bj * HALF) = w; }
                s += __shfl_xor(s, 16); s += __shfl_xor(s, 32);
                if (fq == 0) atomic_add_f32(ss + row, s); }
    }
};
struct EpiSwiGLU {
    static constexpr bool PERM = true, AFTER_DRAIN = false;
    PG8_ZERO_INIT
    bf16_t* O; const float* ss;
    __device__ __forceinline__ void operator()(const f32x4 (&acc)[2][2][4][2], const Unit& u, int wr, int wc, int fr, int fq) const {
        const int row0 = u.pm * BM + wr * 64 + fr, col0 = u.pn * HALF + wc * 32 + 8 * fq;
        float rsv[2][4];
#pragma unroll
        for (int ai = 0; ai < 2; ++ai)
#pragma unroll
            for (int m = 0; m < 4; ++m) rsv[ai][m] = ss[row0 + ai * HALF + m * 16];
#pragma unroll
        for (int ai = 0; ai < 2; ++ai)
#pragma unroll
            for (int m = 0; m < 4; ++m) { const int row = row0 + ai * HALF + m * 16; const float rs = __builtin_amdgcn_rsqf(rsv[ai][m] * (1.f / 2048.f) + 1e-6f);
                float r[8];
#pragma unroll
                for (int n = 0; n < 2; ++n)
#pragma unroll
                    for (int e = 0; e < 4; ++e) { const float g = acc[ai][0][m][n][e] * rs, up = acc[ai][1][m][n][e] * rs; r[n * 4 + e] = g * __builtin_amdgcn_rcpf(1.f + __expf(-g)) * up; }
                u32x4 w; w.x = cvt_pk_bf16(r[0], r[1]); w.y = cvt_pk_bf16(r[2], r[3]); w.z = cvt_pk_bf16(r[4], r[5]); w.w = cvt_pk_bf16(r[6], r[7]);
                __builtin_nontemporal_store(w, (u32x4*)(O + (size_t)row * 5632 + col0)); }
    }
};
struct EpiFinal {
    static constexpr bool PERM = true, AFTER_DRAIN = false;
    PG8_ZERO_INIT
    float* out; const bf16_t* x2; const bf16_t* eraw; const float* wpost; const float* ss2; const float* ssE;
    __device__ __forceinline__ void operator()(const f32x4 (&acc)[2][2][4][2], const Unit& u, int wr, int wc, int fr, int fq) const {
        const int row0 = u.pm * BM + wr * 64 + fr, col0 = u.pn * BM + wc * 32 + 8 * fq;
        f32x4 wv[2][2]; float rsv[2][4], rev[2][4];
#pragma unroll
        for (int bj = 0; bj < 2; ++bj)
#pragma unroll
            for (int n = 0; n < 2; ++n) wv[bj][n] = *(const f32x4*)(wpost + col0 + bj * HALF + n * 4);
#pragma unroll
        for (int ai = 0; ai < 2; ++ai)
#pragma unroll
            for (int m = 0; m < 4; ++m) { rsv[ai][m] = ss2[row0 + ai * HALF + m * 16]; rev[ai][m] = ssE[row0 + ai * HALF + m * 16]; }
        u32x4 xw[1][4][2], ew[1][4][2];
#define EF_LOAD(ai) do { _Pragma("unroll") for (int m = 0; m < 4; ++m) _Pragma("unroll") for (int bj = 0; bj < 2; ++bj) { const size_t o2 = (size_t)(row0 + (ai) * HALF + m * 16) * 2048 + col0 + bj * HALF; \
            xw[0][m][bj] = *(const u32x4*)(x2 + o2); ew[0][m][bj] = __builtin_nontemporal_load((const u32x4*)(eraw + o2)); } } while (0)
#define EF_OUT(ai) do { _Pragma("unroll") for (int m = 0; m < 4; ++m) { const float rs = __builtin_amdgcn_rsqf(rsv[ai][m] * (1.f / 2048.f) + 1e-6f), re = __builtin_amdgcn_rsqf(rev[ai][m] * (1.f / 2048.f) + 1e-6f); \
            _Pragma("unroll") for (int bj = 0; bj < 2; ++bj) { const size_t o2 = (size_t)(row0 + (ai) * HALF + m * 16) * 2048 + col0 + bj * HALF; const u32x4 xq = xw[0][m][bj], eq = ew[0][m][bj]; \
                const f32x4 xa = {::bflo(xq.x), ::bfhi(xq.x), ::bflo(xq.y), ::bfhi(xq.y)}, xb = {::bflo(xq.z), ::bfhi(xq.z), ::bflo(xq.w), ::bfhi(xq.w)}; \
                f32x4 ea = {::bflo(eq.x), ::bfhi(eq.x), ::bflo(eq.y), ::bfhi(eq.y)}, eb = {::bflo(eq.z), ::bfhi(eq.z), ::bflo(eq.w), ::bfhi(eq.w)}; \
                ea = ea * re * wv[bj][0]; eb = eb * re * wv[bj][1]; \
                const f32x4 a0 = acc[ai][bj][m][0] * rs, a1 = acc[ai][bj][m][1] * rs; f32x4 o0, o1; \
                _Pragma("unroll") for (int e = 0; e < 4; ++e) { o0[e] = xa[e] + ::sigmoidf_(a0[e]) * ea[e]; o1[e] = xb[e] + ::sigmoidf_(a1[e]) * eb[e]; } \
                __builtin_nontemporal_store(o0, (f32x4*)(out + o2)); __builtin_nontemporal_store(o1, (f32x4*)(out + o2 + 4)); } } } while (0)
        EF_LOAD(0); EF_OUT(0); EF_LOAD(1); EF_OUT(1);
#undef EF_LOAD
#undef EF_OUT
    }
};
template <class Epi, class Sched, bool ALIGN_EPI = false, bool SP2 = false>
__device__ __forceinline__ void gemm_phase(PG8_LAS unsigned char* lds, const Gemm g, const Sched& S, const Epi& E) {
    int tid0_ = threadIdx.x; asm volatile("" : "+v"(tid0_));
    const int tid = tid0_, wid = __builtin_amdgcn_readfirstlane(tid >> 6), lane = tid & 63, wr = wid >> 2, wc = wid & 3, fr = lane & 15, fq = lane >> 4;
    int K0_ = g.K; asm volatile("" : "+s"(K0_));
    const int K = K0_, nt = K / BK;
    unsigned voffA[2], voffB[2];
#pragma unroll
    for (int i = 0; i < 2; ++i) { int R, C; stage_rc(tid * 16 + i * 8192, R, C); const int Rb = Epi::PERM ? ((R & ~31) + perm32(R & 31)) : R;
        voffA[i] = (unsigned)(R * K + C) * 2u; voffB[i] = (unsigned)(Rb * K + C) * 2u; }
    const size_t kstep = (size_t)(BK * 2);
    const size_t hstep = (size_t)HALF * K * 2;
    const size_t tstep = 2 * hstep;
    const unsigned ldsw = (unsigned)wid * 1024u;
    const int aoff = lds_byte(wr * 64 + fr, fq * 8), boff = lds_byte(wc * 32 + fr, fq * 8);
#define PG8_SA(b, h) (((b) * 2 + (h)) * HTB)
#define PG8_SB(b, h) ((4 + (b) * 2 + (h)) * HTB)
#define PG8_STAGE(bufoff, gbase, voff) do { _Pragma("unroll") for (int _i = 0; _i < 2; ++_i) \
        __builtin_amdgcn_global_load_lds((const unsigned*)((const char*)(gbase) + (voff)[_i]), (PG8_LAS unsigned*)(lds + (bufoff) + ldsw + _i * 8192), 16, 0, 0); } while (0)
#define PG8_LDA(dst, b, h) do { _Pragma("unroll") for (int m = 0; m < 4; ++m) _Pragma("unroll") for (int k = 0; k < 2; ++k) dst[m][k] = *(const PG8_LAS bf16x8*)(lds + PG8_SA(b, h) + aoff + m * 2048 + k * 1024); } while (0)
#define PG8_LDB(dst, b, h) do { _Pragma("unroll") for (int n = 0; n < 2; ++n) _Pragma("unroll") for (int k = 0; k < 2; ++k) dst[n][k] = *(const PG8_LAS bf16x8*)(lds + PG8_SB(b, h) + boff + n * 2048 + k * 1024); } while (0)
#define PG8_MMA(ai, bj, At, Bt) do { __builtin_amdgcn_s_setprio(1); _Pragma("unroll") for (int m = 0; m < 4; ++m) _Pragma("unroll") for (int n = 0; n < 2; ++n) _Pragma("unroll") for (int k = 0; k < 2; ++k) \
        acc[ai][bj][m][n] = __builtin_amdgcn_mfma_f32_16x16x32_bf16(Bt[n][k], At[m][k], acc[ai][bj][m][n], 0, 0, 0); __builtin_amdgcn_s_setprio(0); } while (0)
#define PG8_WAIT_V(n) asm volatile("s_waitcnt vmcnt(" #n ")" ::: "memory")
#define PG8_WAIT_L(n) asm volatile("s_waitcnt lgkmcnt(" #n ")" ::: "memory")
#define PG8_BAR __builtin_amdgcn_s_barrier()
#define PG8_SCHED __builtin_amdgcn_sched_barrier(0)
    Unit cur, nxt; int ui = 0;
    if (!S.next(0, cur)) return;
    f32x4 acc[2][2][4][2];
    E.init(acc, cur, wr, wc, fr, fq);
    bf16x8 At[4][2], B0[2][2], B1[2][2];
    const char* cA = (const char*)g.A + (size_t)cur.pm * tstep; const char* cB = (const char*)g.Bt + (size_t)cur.pn * tstep;
    S.a_ready(cur);
    if constexpr (SP2) {
        PG8_STAGE(PG8_SB(0, 0), cB, voffB); PG8_STAGE(PG8_SB(0, 1), cB + hstep, voffB); PG8_STAGE(PG8_SA(0, 0), cA, voffA); PG8_STAGE(PG8_SA(0, 1), cA + hstep, voffA);
        if (wr == 1) PG8_BAR;
        PG8_WAIT_V(2); PG8_BAR;
        PG8_STAGE(PG8_SB(1, 0), cB + kstep, voffB); PG8_STAGE(PG8_SA(1, 0), cA + kstep, voffA); PG8_STAGE(PG8_SB(1, 1), cB + hstep + kstep, voffB);
        PG8_WAIT_V(6); PG8_BAR;
    } else {
        PG8_STAGE(PG8_SB(0, 0), cB, voffB); PG8_STAGE(PG8_SA(0, 0), cA, voffA); PG8_STAGE(PG8_SB(0, 1), cB + hstep, voffB); PG8_STAGE(PG8_SA(0, 1), cA + hstep, voffA);
        if (wr == 1) PG8_BAR;
        PG8_WAIT_V(4); PG8_BAR;
        PG8_STAGE(PG8_SB(1, 0), cB + kstep, voffB); PG8_STAGE(PG8_SA(1, 0), cA + kstep, voffA); PG8_STAGE(PG8_SB(1, 1), cB + hstep + kstep, voffB);
        PG8_WAIT_V(6); PG8_BAR;
    }
    for (;;) {
        const bool has_next = S.next(ui + 1, nxt);
        const char* nA = has_next ? (const char*)g.A + (size_t)nxt.pm * tstep : cA; const char* nB = has_next ? (const char*)g.Bt + (size_t)nxt.pn * tstep : cB;
        for (int t = 0; t < nt; t += 2) {
            const bool last = (t == nt - 2);
            const char* a1 = cA + (size_t)(t + 1) * kstep;
            const char* a2 = last ? nA : cA + (size_t)(t + 2) * kstep; const char* b2 = last ? nB : cB + (size_t)(t + 2) * kstep;
            const char* a3 = a2 + kstep; const char* b3 = b2 + kstep;
            if (last && has_next) S.a_ready(nxt);
            if constexpr (SP2) {
            PG8_LDB(B0, 0, 0); PG8_LDB(B1, 0, 1); PG8_SCHED; PG8_LDA(At, 0, 0); PG8_STAGE(PG8_SA(1, 1), a1 + hstep, voffA);
            PG8_WAIT_V(8); PG8_WAIT_L(0); PG8_BAR; PG8_MMA(0, 0, At, B0); PG8_MMA(0, 1, At, B1); PG8_BAR; PG8_SCHED;
            PG8_LDA(At, 0, 1); PG8_STAGE(PG8_SB(0, 0), b2, voffB); PG8_STAGE(PG8_SB(0, 1), b2 + hstep, voffB); PG8_STAGE(PG8_SA(0, 0), a2, voffA);
            PG8_WAIT_V(8); PG8_WAIT_L(0); PG8_BAR; PG8_MMA(1, 0, At, B0); PG8_MMA(1, 1, At, B1); PG8_BAR; PG8_SCHED;
            PG8_LDB(B0, 1, 0); PG8_LDB(B1, 1, 1); PG8_SCHED; PG8_LDA(At, 1, 0); PG8_STAGE(PG8_SA(0, 1), a2 + hstep, voffA);
            PG8_WAIT_V(8); PG8_WAIT_L(0); PG8_BAR; PG8_MMA(0, 0, At, B0); PG8_MMA(0, 1, At, B1); PG8_BAR; PG8_SCHED;
            PG8_LDA(At, 1, 1); PG8_STAGE(PG8_SB(1, 0), b3, voffB); PG8_STAGE(PG8_SB(1, 1), b3 + hstep, voffB); PG8_STAGE(PG8_SA(1, 0), a3, voffA);
            PG8_WAIT_V(8); PG8_WAIT_L(0); PG8_BAR; PG8_MMA(1, 0, At, B0); PG8_MMA(1, 1, At, B1); PG8_BAR; PG8_SCHED;
            } else {
            PG8_LDB(B0, 0, 0); PG8_SCHED; PG8_LDA(At, 0, 0); PG8_STAGE(PG8_SA(1, 1), a1 + hstep, voffA);
            PG8_WAIT_L(8); PG8_BAR; PG8_WAIT_L(0); PG8_MMA(0, 0, At, B0); PG8_BAR; PG8_SCHED;
            PG8_LDB(B1, 0, 1); PG8_STAGE(PG8_SB(0, 0), b2, voffB);
            PG8_BAR; PG8_WAIT_L(0); PG8_MMA(0, 1, At, B1); PG8_BAR;
            PG8_LDA(At, 0, 1); PG8_STAGE(PG8_SA(0, 0), a2, voffA);
            PG8_BAR; PG8_WAIT_L(0); PG8_MMA(1, 0, At, B0); PG8_BAR; PG8_SCHED;
            PG8_STAGE(PG8_SB(0, 1), b2 + hstep, voffB);
            PG8_WAIT_V(6); PG8_BAR; PG8_MMA(1, 1, At, B1); PG8_BAR;
            PG8_LDB(B0, 1, 0); PG8_SCHED; PG8_LDA(At, 1, 0); PG8_STAGE(PG8_SA(0, 1), a2 + hstep, voffA);
            PG8_WAIT_L(8); PG8_BAR; PG8_WAIT_L(0); PG8_MMA(0, 0, At, B0); PG8_BAR; PG8_SCHED;
            PG8_LDB(B1, 1, 1); PG8_STAGE(PG8_SB(1, 0), b3, voffB);
            PG8_BAR; PG8_WAIT_L(0); PG8_MMA(0, 1, At, B1); PG8_BAR;
            PG8_LDA(At, 1, 1); PG8_STAGE(PG8_SA(1, 0), a3, voffA);
            PG8_BAR; PG8_WAIT_L(0); PG8_MMA(1, 0, At, B0); PG8_BAR; PG8_SCHED;
            PG8_STAGE(PG8_SB(1, 1), b3 + hstep, voffB);
            PG8_WAIT_V(6); PG8_BAR; PG8_MMA(1, 1, At, B1); PG8_BAR;
            }
        }
        if constexpr (ALIGN_EPI) { if (wr == 0) PG8_BAR; }
        if constexpr (!Epi::AFTER_DRAIN) { E(acc, cur, wr, wc, fr, fq); S.done(cur); }
        if (!has_next) break;
        E.init(acc, nxt, wr, wc, fr, fq);
        cur = nxt; cA = nA; cB = nB; ++ui;
        if constexpr (ALIGN_EPI) { if (wr == 1) PG8_BAR; }
    }
    PG8_WAIT_V(0);
    if constexpr (!ALIGN_EPI) { if (wr == 0) PG8_BAR; }
    PG8_BAR;
    if constexpr (Epi::AFTER_DRAIN) { E.fused(acc, cur, wr, wc, fr, fq, lds, wid, lane); S.done(cur); }
#undef PG8_SA
#undef PG8_SB
#undef PG8_STAGE
#undef PG8_LDA
#undef PG8_LDB
#undef PG8_MMA
#undef PG8_WAIT_V
#undef PG8_WAIT_L
#undef PG8_BAR
#undef PG8_SCHED
}
}
namespace fa {
using bf16 = __hip_bfloat16;
typedef short bf16x8 __attribute__((ext_vector_type(8)));
typedef short s16x4 __attribute__((ext_vector_type(4)));
typedef float f32x16 __attribute__((ext_vector_type(16)));
constexpr int D = 128, NW = 8, QBLK = 32, KVBLK = 64, QB = NW * QBLK;
constexpr int SHM_V = KVBLK * D * 2, SHM_K = KVBLK * D * 2;
constexpr int OFF_WS = 2 * SHM_V + 2 * SHM_K, OFF_CK = OFF_WS + NW * 64 * 4, LDS_BYTES = OFF_CK + 2 * 64 * 4;
constexpr float SCALE = 0.08838834764831845f;
constexpr float THR = 8.f;

#define KSWZ(row, colB) ((row) * 256 + ((colB) ^ (((row) & 7) << 4)))
#define SBAR() __builtin_amdgcn_sched_barrier(0)
__device__ __forceinline__ int v_st(int k, int c) { const int kk = (k & ~0xC) | ((k & 4) << 1) | ((k & 8) >> 1); return ((kk >> 3) * 4 + (c >> 5)) * 512 + ((kk & 7) * 32 + (c & 31)) * 2; }
__device__ __forceinline__ int v_rd_base(int lane) { return ((lane & 3) << 3) | (((lane >> 2) & 3) << 6) | (((lane >> 4) & 1) << 5) | (((lane >> 5) & 1) << 8); }
constexpr int v_rd_off(int d0, int ks, int half) { return d0 * 512 + ks * 4096 + half * 2048; }
__device__ __forceinline__ int crow(int r, int hi) { return (r & 3) + 8 * (r >> 2) + 4 * hi; }
__device__ __forceinline__ unsigned cvtpk(float lo, float hi) { return ::cvtpk2(lo, hi); }
__device__ __forceinline__ bf16x8 load8(const bf16* p) { return *reinterpret_cast<const bf16x8*>(p); }
template <int MODE> __device__ __forceinline__ void mask_tile(f32x16& p0, f32x16& p1, int dq) {
    const float NEG = MODE == 0 ? -__builtin_inff() : 0.f;
#pragma unroll
    for (int r = 0; r < 16; ++r) {
        const int c = (r & 3) + 8 * (r >> 2);
        if (dq - c < 0) p0[r] = NEG;
        if (dq - c - 32 < 0) p1[r] = NEG;
    }
}
__device__ __forceinline__ void partialSM(f32x16& p0, f32x16& p1, float& m_reg, float& mn, float& alpha) {
    float pmax = p0[0]; for (int r = 1; r < 16; ++r) pmax = fmaxf(pmax, p0[r]); for (int r = 0; r < 16; ++r) pmax = fmaxf(pmax, p1[r]);
    { auto rr = __builtin_amdgcn_permlane32_swap(__float_as_uint(pmax), __float_as_uint(pmax), false, false);
      pmax = fmaxf(__uint_as_float(rr[0]), __uint_as_float(rr[1])); }
    constexpr float C2 = 1.4426950408889634f * SCALE;
    if (__builtin_expect(__all((pmax - m_reg) * SCALE <= THR), 1)) { mn = m_reg; alpha = 1.f; }
    else { mn = fmaxf(m_reg, pmax); alpha = __builtin_amdgcn_exp2f((m_reg - mn) * C2); m_reg = mn; }
    const float mnL = -mn * C2;
    for (int r = 0; r < 16; ++r) p0[r] = fmaf(p0[r], C2, mnL); for (int r = 0; r < 16; ++r) p1[r] = fmaf(p1[r], C2, mnL);
    for (int r = 0; r < 16; ++r) p0[r] = __builtin_amdgcn_exp2f(p0[r]);
}
#define PK4(P, B_, OUT) do { unsigned a0 = cvtpk(P[B_+0], P[B_+1]), a1 = cvtpk(P[B_+2], P[B_+3]);                          \
        unsigned b0 = cvtpk(P[B_+4], P[B_+5]), b1 = cvtpk(P[B_+6], P[B_+7]);                                             \
        auto r0 = __builtin_amdgcn_permlane32_swap(a0, b0, false, false); auto r1 = __builtin_amdgcn_permlane32_swap(a1, b1, false, false); \
        u32x4 w = {r0[0], r1[0], r0[1], r1[1]}; OUT = *reinterpret_cast<bf16x8*>(&w); } while (0)
__device__ __forceinline__ void finishSM(f32x16& p0, f32x16& p1, float alpha, float& l_reg, bf16x8& pa0, bf16x8& pa1, bf16x8& pa2, bf16x8& pa3) {
    for (int r = 0; r < 16; ++r) p1[r] = __builtin_amdgcn_exp2f(p1[r]);
    float ps = 0; for (int r = 0; r < 16; ++r) ps += p0[r]; for (int r = 0; r < 16; ++r) ps += p1[r];
    { auto rr = __builtin_amdgcn_permlane32_swap(__float_as_uint(ps), __float_as_uint(ps), false, false);
      ps = __uint_as_float(rr[0]) + __uint_as_float(rr[1]); }
    l_reg = l_reg * alpha + ps;
    PK4(p0, 0, pa0); PK4(p0, 8, pa1); PK4(p1, 0, pa2); PK4(p1, 8, pa3);
}
__device__ __forceinline__ void linScale(f32x16& p0, f32x16& p1, float fr) {
    for (int r = 0; r < 16; ++r) p0[r] *= fr; for (int r = 0; r < 16; ++r) p1[r] *= fr;
}
__device__ __forceinline__ void linFinish(f32x16& p0, f32x16& p1, float& l_reg, bf16x8& pa0, bf16x8& pa1, bf16x8& pa2, bf16x8& pa3) {
    float ps = 0; for (int r = 0; r < 16; ++r) ps += p0[r]; for (int r = 0; r < 16; ++r) ps += p1[r];
    { auto rr = __builtin_amdgcn_permlane32_swap(__float_as_uint(ps), __float_as_uint(ps), false, false);
      ps = __uint_as_float(rr[0]) + __uint_as_float(rr[1]); }
    l_reg += ps;
    PK4(p0, 0, pa0); PK4(p0, 8, pa1); PK4(p1, 0, pa2); PK4(p1, 8, pa3);
}
#undef PK4
template <int KB, int MODE>
__device__ __forceinline__ void qkt(f32x16& p0, f32x16& p1, const char* K_lds, const float* ckl, int r32, int hi, const bf16x8* qr) {
    if constexpr (MODE == 0) {
        const float* c = ckl + KB * 64 + 4 * hi;
#pragma unroll
        for (int g = 0; g < 4; ++g) { const f32x4 a = *(const f32x4*)(c + 8 * g), b = *(const f32x4*)(c + 32 + 8 * g);
            p0[4 * g + 0] = a[0]; p0[4 * g + 1] = a[1]; p0[4 * g + 2] = a[2]; p0[4 * g + 3] = a[3];
            p1[4 * g + 0] = b[0]; p1[4 * g + 1] = b[1]; p1[4 * g + 2] = b[2]; p1[4 * g + 3] = b[3]; }
    } else { p0 = f32x16{}; p1 = f32x16{}; }
    const char* kb[4];
#pragma unroll
    for (int dd = 0; dd < 4; ++dd) kb[dd] = K_lds + KB * SHM_K + KSWZ(r32, (dd * 16 + hi * 8) * 2);
    __builtin_amdgcn_s_setprio(1);
#pragma unroll
    for (int d0 = 0; d0 < 8; ++d0) { const char* a = kb[d0 & 3] + (d0 >> 2) * 128;
        bf16x8 b0 = *reinterpret_cast<const bf16x8*>(a);
        bf16x8 b1 = *reinterpret_cast<const bf16x8*>(a + 32 * 256);
        p0 = __builtin_amdgcn_mfma_f32_32x32x16_bf16(b0, qr[d0], p0, 0, 0, 0);
        p1 = __builtin_amdgcn_mfma_f32_32x32x16_bf16(b1, qr[d0], p1, 0, 0, 0); }
    __builtin_amdgcn_s_setprio(0);
}
template <int VB>
__device__ __forceinline__ void pv_tile(f32x16* o, int vb0, bf16x8 pa0, bf16x8 pa1, bf16x8 pa2, bf16x8 pa3) {
#define TRRD(dst, off) asm volatile("ds_read_b64_tr_b16 %0, %1 offset:%2" : "=&v"(dst) : "v"(vb0), "i"(off) : "memory")
#define PV_RD(S, d0) do { constexpr int b_ = VB * SHM_V + v_rd_off(d0, 0, 0);     \
        TRRD(S##l0, b_); TRRD(S##h0, b_ + 2048); TRRD(S##l1, b_ + 4096); TRRD(S##h1, b_ + 6144); TRRD(S##l2, b_ + 8192); TRRD(S##h2, b_ + 10240); TRRD(S##l3, b_ + 12288); TRRD(S##h3, b_ + 14336); } while (0)
#define PV_MM(S, d0) do { __builtin_amdgcn_s_setprio(1);                                                                                                     \
        o[d0] = __builtin_amdgcn_mfma_f32_32x32x16_bf16(pa0, (bf16x8){S##l0[0], S##l0[1], S##l0[2], S##l0[3], S##h0[0], S##h0[1], S##h0[2], S##h0[3]}, o[d0], 0, 0, 0);   \
        o[d0] = __builtin_amdgcn_mfma_f32_32x32x16_bf16(pa1, (bf16x8){S##l1[0], S##l1[1], S##l1[2], S##l1[3], S##h1[0], S##h1[1], S##h1[2], S##h1[3]}, o[d0], 0, 0, 0);   \
        o[d0] = __builtin_amdgcn_mfma_f32_32x32x16_bf16(pa2, (bf16x8){S##l2[0], S##l2[1], S##l2[2], S##l2[3], S##h2[0], S##h2[1], S##h2[2], S##h2[3]}, o[d0], 0, 0, 0);   \
        o[d0] = __builtin_amdgcn_mfma_f32_32x32x16_bf16(pa3, (bf16x8){S##l3[0], S##l3[1], S##l3[2], S##l3[3], S##h3[0], S##h3[1], S##h3[2], S##h3[3]}, o[d0], 0, 0, 0);   \
        __builtin_amdgcn_s_setprio(0); } while (0)
    s16x4 Al0, Al1, Al2, Al3, Ah0, Ah1, Ah2, Ah3, Bl0, Bl1, Bl2, Bl3, Bh0, Bh1, Bh2, Bh3;
    PV_RD(A, 0);
    PV_RD(B, 1); asm volatile("s_waitcnt lgkmcnt(8)" ::: "memory"); SBAR(); PV_MM(A, 0); SBAR();
    PV_RD(A, 2); asm volatile("s_waitcnt lgkmcnt(8)" ::: "memory"); SBAR(); PV_MM(B, 1); SBAR();
    PV_RD(B, 3); asm volatile("s_waitcnt lgkmcnt(8)" ::: "memory"); SBAR(); PV_MM(A, 2); SBAR();
    asm volatile("s_waitcnt lgkmcnt(0)" ::: "memory"); SBAR(); PV_MM(B, 3);
#undef PV_RD
#undef PV_MM
#undef TRRD
}

template <int VB>
__device__ __forceinline__ void pv_tile_np(f32x16* o, int vb0, bf16x8 pa0, bf16x8 pa1, bf16x8 pa2, bf16x8 pa3) {
#define TRRD(dst, off) asm volatile("ds_read_b64_tr_b16 %0, %1 offset:%2" : "=&v"(dst) : "v"(vb0), "i"(off) : "memory")
#define PV_D0(d0) do { s16x4 l0, l1, l2, l3, h0, h1, h2, h3; constexpr int b_ = VB * SHM_V + v_rd_off(d0, 0, 0);   \
        TRRD(l0, b_); TRRD(h0, b_ + 2048); TRRD(l1, b_ + 4096); TRRD(h1, b_ + 6144); TRRD(l2, b_ + 8192); TRRD(h2, b_ + 10240); TRRD(l3, b_ + 12288); TRRD(h3, b_ + 14336); \
        asm volatile("s_waitcnt lgkmcnt(0)" ::: "memory"); SBAR();   \
        o[d0] = __builtin_amdgcn_mfma_f32_32x32x16_bf16(pa0, (bf16x8){l0[0], l0[1], l0[2], l0[3], h0[0], h0[1], h0[2], h0[3]}, o[d0], 0, 0, 0);   \
        o[d0] = __builtin_amdgcn_mfma_f32_32x32x16_bf16(pa1, (bf16x8){l1[0], l1[1], l1[2], l1[3], h1[0], h1[1], h1[2], h1[3]}, o[d0], 0, 0, 0);   \
        o[d0] = __builtin_amdgcn_mfma_f32_32x32x16_bf16(pa2, (bf16x8){l2[0], l2[1], l2[2], l2[3], h2[0], h2[1], h2[2], h2[3]}, o[d0], 0, 0, 0);   \
        o[d0] = __builtin_amdgcn_mfma_f32_32x32x16_bf16(pa3, (bf16x8){l3[0], l3[1], l3[2], l3[3], h3[0], h3[1], h3[2], h3[3]}, o[d0], 0, 0, 0); SBAR(); } while (0)
    PV_D0(0); PV_D0(1); PV_D0(2); PV_D0(3);
#undef PV_D0
#undef TRRD
}

struct BlockRef { const bf16* Q; const bf16* K; const bf16* V; bf16* O; const float* aux; const float* sq; int P0, j0, j1, part; bf16* PO; float* PS; unsigned* flag; };
constexpr int AUX_MEXP = 65536, AUX_AREF = 131072;
template <int MODE> struct Pitch { static constexpr int qp = MODE ? 512 : 6144, kp = MODE ? 512 : 6144, vp = 6144, op = MODE ? 1024 : 2048; };
__device__ __forceinline__ bf16x8 scale8(bf16x8 v, float w) {
    const u32x4 u = __builtin_bit_cast(u32x4, v); u32x4 r;
    r.x = cvtpk(::bflo(u.x) * w, ::bfhi(u.x) * w); r.y = cvtpk(::bflo(u.y) * w, ::bfhi(u.y) * w); r.z = cvtpk(::bflo(u.z) * w, ::bfhi(u.z) * w); r.w = cvtpk(::bflo(u.w) * w, ::bfhi(u.w) * w);
    return __builtin_bit_cast(bf16x8, r);
}
struct Seam { bf16x8 qr[8]; bf16x8 st_v0, st_v1, st_k0, st_k1; float st_c, st_f0, st_f1; };
__device__ __forceinline__ float hnorm_rs(float ss) { return __builtin_amdgcn_rsqf(ss * (1.f / 128.f) + 1e-6f); }
#define ROWK(R, PM, k0, rr) ((R).K + (size_t)(k0) * Pitch<PM>::kp + (unsigned)(((rr) * Pitch<PM>::kp) + sc))
#define ROWV(R, PM, k0, rr) ((R).V + (size_t)(k0) * Pitch<PM>::vp + (unsigned)(((rr) * Pitch<PM>::vp) + sc))
#define VMW() asm volatile("s_waitcnt vmcnt(0)" ::: "memory")
#define VMWN(n) asm volatile("s_waitcnt vmcnt(%0)" :: "i"(n) : "memory")
#define SLOAD_H(R, PM, k0) do { S.st_v0 = load8(ROWV(R, PM, k0, sr)); S.st_v1 = load8(ROWV(R, PM, k0, 32 + sr));              \
                         S.st_k0 = load8(ROWK(R, PM, k0, sr)); S.st_k1 = load8(ROWK(R, PM, k0, 32 + sr));                \
                         if constexpr (PM == 0) { S.st_c = (R).aux[(k0) + (tid & 63)]; S.st_f0 = (R).sq[8 * 16384 + (k0) + sr]; S.st_f1 = (R).sq[8 * 16384 + (k0) + 32 + sr]; } } while (0)
#define SWRITE_HK(bf) do { if constexpr (MODE == 0) { S.st_k0 = scale8(S.st_k0, hnorm_rs(S.st_f0)); S.st_k1 = scale8(S.st_k1, hnorm_rs(S.st_f1)); }                   \
                           *(bf16x8*)(K_lds + (bf) * SHM_K + kws) = S.st_k0; *(bf16x8*)(K_lds + (bf) * SHM_K + kws + 32 * 256) = S.st_k1; \
                           if constexpr (MODE == 0) { if (tid < 64) ckl[(bf) * 64 + tid] = S.st_c; } } while (0)
#define SWRITE_HV(bf) do { *(bf16x8*)(V_lds + (bf) * SHM_V + vst0) = S.st_v0; *(bf16x8*)(V_lds + (bf) * SHM_V + vst1) = S.st_v1; } while (0)
#define SWRITE_H(bf) do { SWRITE_HV(bf); SWRITE_HK(bf); } while (0)
template <int MODE>
__device__ __forceinline__ void attn_prime(const BlockRef& cur, char* lds, Seam& S) {
    const int tid = threadIdx.x, wid = __builtin_amdgcn_readfirstlane(tid >> 6), lane = tid & 63, r32 = lane & 31, hi = lane >> 5;
    const int sr = tid >> 4, sc = (tid & 15) * 8, kws = KSWZ(sr, sc * 2), vst0 = v_st(sr, sc), vst1 = v_st(32 + sr, sc); char* V_lds = lds; char* K_lds = lds + 2 * SHM_V; float* ckl = (float*)(lds + OFF_CK);
#pragma unroll
    for (int d0 = 0; d0 < 8; ++d0) S.qr[d0] = load8(cur.Q + (size_t)(cur.P0 + wid * QBLK) * Pitch<MODE>::qp + (unsigned)(r32 * Pitch<MODE>::qp + d0 * 16 + hi * 8));
    if constexpr (MODE == 0) { const float rq = hnorm_rs(cur.sq[cur.P0 + wid * QBLK + r32]);
#pragma unroll
        for (int d0 = 0; d0 < 8; ++d0) S.qr[d0] = scale8(S.qr[d0], rq); }
    SLOAD_H(cur, MODE, cur.j0 * KVBLK); VMW(); SWRITE_H(0);
    __syncthreads();
}
template <int MODE>
__device__ __forceinline__ void attn_block(const BlockRef& cur, const BlockRef& nxt, char* lds, Seam& S) {
    int tid0_ = threadIdx.x; asm volatile("" : "+v"(tid0_));
    const int tid = tid0_, wid = __builtin_amdgcn_readfirstlane(tid >> 6), lane = tid & 63, r32 = lane & 31, hi = lane >> 5;
    const int NT = cur.j1;
    const int qlo = cur.P0 + wid * QBLK, qm = qlo + r32 - 4 * hi;
    char* V_lds = lds; char* K_lds = lds + 2 * SHM_V;
    float* ws = (float*)(lds + OFF_WS) + wid * 64; float* li_l = ws, * al_l = ws + 32; float* ckl = (float*)(lds + OFF_CK);
    float m_reg = -1e30f, l_reg = 0; f32x16 o[4] = {};
    const int sr = tid >> 4, sc = (tid & 15) * 8, vst0 = v_st(sr, sc), vst1 = v_st(32 + sr, sc), kws = KSWZ(sr, sc * 2);
    const int vb0 = (int)(uintptr_t)V_lds + v_rd_base(lane);
    float m2row = 0.f; if constexpr (MODE == 1) m2row = cur.aux[qlo + r32];
#define RESC(a) do { if constexpr (MODE == 0) { if (__any((a) < 1.f)) { if (hi == 0) al_l[r32] = (a); asm volatile("s_waitcnt lgkmcnt(0)" ::: "memory");              \
                     for (int d_ = 0; d_ < 4; ++d_) for (int r = 0; r < 16; ++r) o[d_][r] *= al_l[crow(r, hi)]; } } } while (0)
#define KBASE(t) ((t) * KVBLK)
    f32x16 p0, p1; float mn, al; bf16x8 pa0, pa1, pa2, pa3;
#define STEP(t, BUF, LASTCHK) do {                                                                                               \
        float ar = 0.f; if constexpr (MODE == 1) ar = cur.aux[AUX_AREF + (t)];                                                    \
        const bool last_ = LASTCHK && ((t) + 1 >= NT);                                                                            \
        if (last_) { SLOAD_H(nxt, MODE, nxt.j0 * KVBLK); } else { SLOAD_H(cur, MODE, KBASE((t) + 1)); }                                         \
        SBAR(); qkt<BUF, MODE>(p0, p1, K_lds, ckl, r32, hi, S.qr); SBAR();                                                          \
        if (last_) { _Pragma("unroll") for (int d0 = 0; d0 < 8; ++d0) S.qr[d0] = load8(nxt.Q + (size_t)(nxt.P0 + wid * QBLK) * Pitch<MODE>::qp + (unsigned)(r32 * Pitch<MODE>::qp + d0 * 16 + hi * 8)); SBAR(); } \
        { const int kb_ = KBASE(t); if (kb_ + KVBLK - 1 > qlo) mask_tile<MODE>(p0, p1, qm - kb_); }                               \
        if constexpr (MODE == 0) { partialSM(p0, p1, m_reg, mn, al); RESC(al); finishSM(p0, p1, al, l_reg, pa0, pa1, pa2, pa3); }    \
        else { linScale(p0, p1, __builtin_amdgcn_exp2f(ar - m2row)); linFinish(p0, p1, l_reg, pa0, pa1, pa2, pa3); }               \
        SBAR(); pv_tile<BUF>(o, vb0, pa0, pa1, pa2, pa3); SBAR();                                                                 \
        VMW(); SWRITE_H((BUF) ^ 1);                                                                                               \
        __syncthreads(); } while (0)
    float rqn = 1.f; if constexpr (MODE == 0) rqn = hnorm_rs(nxt.sq[nxt.P0 + wid * QBLK + r32]);
    for (int t = cur.j0; t < NT; t += 2) { STEP(t, 0, false); STEP(t + 1, 1, true); }
    if constexpr (MODE == 0) {
#pragma unroll
        for (int d0 = 0; d0 < 8; ++d0) S.qr[d0] = scale8(S.qr[d0], rqn); }
    float wa_r = 0.f;
    { float lv = l_reg; if constexpr (MODE == 1) lv = fmaxf(fabsf(l_reg), cur.aux[AUX_MEXP + qlo + r32]);
      if constexpr (MODE == 0) { if (cur.part == 2) {
          if (tid == 0) { unsigned sp = 0; while (__hip_atomic_load(cur.flag, __ATOMIC_RELAXED, __HIP_MEMORY_SCOPE_AGENT) == 0u) { __builtin_amdgcn_s_sleep(2); if (++sp > (1u << 22)) break; }
                          __builtin_amdgcn_fence(__ATOMIC_ACQUIRE, "agent"); asm volatile("s_waitcnt vmcnt(0)" ::: "memory"); }
          __syncthreads();
          constexpr float C2 = 1.4426950408889634f * SCALE;
          const float ma = cur.PS[2 * (wid * QBLK + r32)], la = cur.PS[2 * (wid * QBLK + r32) + 1];
          const float mm = fmaxf(ma, m_reg), fa_ = la * __builtin_amdgcn_exp2f((ma - mm) * C2), fb_ = __builtin_amdgcn_exp2f((m_reg - mm) * C2);
          lv = (fa_ + l_reg * fb_) / fb_; wa_r = fa_ / (fa_ + l_reg * fb_); } }
      if (hi == 0) { li_l[r32] = lv; al_l[r32] = wa_r; } }
    asm volatile("s_waitcnt lgkmcnt(0)" ::: "memory");
    float rli[16];
#pragma unroll
    for (int r = 0; r < 16; ++r) rli[r] = __builtin_amdgcn_rcpf(li_l[crow(r, hi)]);
    bf16* Ow = cur.O + (size_t)(qlo) * Pitch<MODE>::op; unsigned opitch = Pitch<MODE>::op;
    if constexpr (MODE == 0) { if (cur.part == 1) { Ow = cur.PO + (size_t)(wid * QBLK) * 128; opitch = 128; } }
    const bool merge = (MODE == 0) && cur.part == 2;
    if (merge) {
        unsigned pw[16][4];
#pragma unroll
        for (int r = 0; r < 16; ++r)
#pragma unroll
            for (int d0 = 0; d0 < 4; ++d0) pw[r][d0] = *(const unsigned*)(cur.PO + (size_t)(wid * QBLK + crow(r, hi)) * 128 + d0 * 32 + (r32 & ~1));
#pragma unroll
        for (int r = 0; r < 16; ++r) { const float war = al_l[crow(r, hi)];
#pragma unroll
            for (int d0 = 0; d0 < 4; ++d0) o[d0][r] = o[d0][r] * rli[r] + war * ((r32 & 1) ? ::bfhi(pw[r][d0]) : ::bflo(pw[r][d0])); }
#pragma unroll
        for (int r = 0; r < 16; ++r) rli[r] = 1.f;
    }
#pragma unroll
    for (int r = 0; r < 16; ++r) { const int orow = crow(r, hi);
#pragma unroll
        for (int d0 = 0; d0 < 4; ++d0) { const float v = o[d0][r] * rli[r];
            const float vn = __shfl_xor(v, 1);
            if ((r32 & 1) == 0) *(unsigned*)(Ow + (unsigned)(orow * opitch + d0 * 32 + r32)) = cvtpk(v, vn); } }
    if constexpr (MODE == 0) { if (cur.part == 1) {
        if (hi == 0) { cur.PS[2 * (wid * QBLK + r32)] = m_reg; cur.PS[2 * (wid * QBLK + r32) + 1] = l_reg; }
        asm volatile("s_waitcnt vmcnt(0)" ::: "memory"); __syncthreads();
        if (tid == 0) { __builtin_amdgcn_fence(__ATOMIC_RELEASE, "agent"); asm volatile("s_waitcnt vmcnt(0)" ::: "memory"); __hip_atomic_store(cur.flag, 1u, __ATOMIC_RELAXED, __HIP_MEMORY_SCOPE_AGENT); } } }
    asm volatile("s_waitcnt lgkmcnt(0)" ::: "memory");
#undef RESC
#undef KBASE
#undef STEP
}
template <int MODE, class F>
__device__ __forceinline__ void attn_block_lp(const BlockRef& cur, char* lds, Seam& S, unsigned* qhead, volatile int* popw, int nit, F item, int& qn_out, BlockRef& n_out, bool& more_out) {
    int tid0_ = threadIdx.x; asm volatile("" : "+v"(tid0_));
    const int tid = tid0_, wid = __builtin_amdgcn_readfirstlane(tid >> 6), lane = tid & 63, r32 = lane & 31, hi = lane >> 5;
    const int NT = cur.j1;
    const int qlo = cur.P0 + wid * QBLK, qm = qlo + r32 - 4 * hi;
    char* V_lds = lds; char* K_lds = lds + 2 * SHM_V;
    float* ws = (float*)(lds + OFF_WS) + wid * 64; float* li_l = ws, * al_l = ws + 32; float* ckl = (float*)(lds + OFF_CK);
    float m_reg = -1e30f, l_reg = 0; f32x16 o[4] = {};
    const int sr = tid >> 4, sc = (tid & 15) * 8, vst0 = v_st(sr, sc), vst1 = v_st(32 + sr, sc), kws = KSWZ(sr, sc * 2);
    const int vb0 = (int)(uintptr_t)V_lds + v_rd_base(lane);
    float m2row = 0.f; if constexpr (MODE == 1) m2row = cur.aux[qlo + r32];
#define RESC(a) do { if constexpr (MODE == 0) { if (__any((a) < 1.f)) { if (hi == 0) al_l[r32] = (a); asm volatile("s_waitcnt lgkmcnt(0)" ::: "memory");              \
                     for (int d_ = 0; d_ < 4; ++d_) for (int r = 0; r < 16; ++r) o[d_][r] *= al_l[crow(r, hi)]; } } } while (0)
#define KBASE(t) ((t) * KVBLK)
    f32x16 p0, p1; float mn, al; bf16x8 pa0, pa1, pa2, pa3;
#define STEP(t, BUF, LASTCHK) do {                                                                                               \
        float ar = 0.f; if constexpr (MODE == 1) ar = cur.aux[AUX_AREF + (t)];                                                    \
        const bool last_ = LASTCHK && ((t) + 1 >= NT);                                                                            \
        if (last_) { SLOAD_H(nxt, MODE, nxt.j0 * KVBLK); } else { SLOAD_H(cur, MODE, KBASE((t) + 1)); }                                         \
        SBAR(); qkt<BUF, MODE>(p0, p1, K_lds, ckl, r32, hi, S.qr); SBAR();                                                          \
        if (last_) { _Pragma("unroll") for (int d0 = 0; d0 < 8; ++d0) S.qr[d0] = load8(nxt.Q + (size_t)(nxt.P0 + wid * QBLK) * Pitch<MODE>::qp + (unsigned)(r32 * Pitch<MODE>::qp + d0 * 16 + hi * 8)); SBAR(); } \
        { const int kb_ = KBASE(t); if (kb_ + KVBLK - 1 > qlo) mask_tile<MODE>(p0, p1, qm - kb_); }                               \
        if constexpr (MODE == 0) { partialSM(p0, p1, m_reg, mn, al); RESC(al); finishSM(p0, p1, al, l_reg, pa0, pa1, pa2, pa3); }    \
        else { linScale(p0, p1, __builtin_amdgcn_exp2f(ar - m2row)); linFinish(p0, p1, l_reg, pa0, pa1, pa2, pa3); }               \
        SBAR(); pv_tile<BUF>(o, vb0, pa0, pa1, pa2, pa3); SBAR();                                                                 \
        VMW(); SWRITE_H((BUF) ^ 1);                                                                                               \
        __syncthreads(); } while (0)
    float rqn = 1.f; BlockRef nxt = cur; int qn = 0, qraw = 0; bool more = false, drawn = false, issued = false;
#define LP_TAKE() do { qn = __builtin_amdgcn_readfirstlane(popw[0]); more = qn < nit; if (more) nxt = item(qn); if constexpr (MODE == 0) rqn = hnorm_rs(nxt.sq[nxt.P0 + wid * QBLK + r32]); } while (0)
    for (int t = cur.j0; t < NT; t += 2) {
        bool defer = false;
        if (!issued && t + 6 >= NT) { issued = true; if (tid == 0) qraw = (int)__hip_atomic_fetch_add(qhead, 1u, __ATOMIC_RELAXED, __HIP_MEMORY_SCOPE_AGENT); }
        if (!drawn && t + 4 >= NT) { drawn = true; if (tid == 0) popw[0] = qraw;
            if (t + 2 >= NT) { __syncthreads(); LP_TAKE(); } else defer = true; }
        STEP(t, 0, false);
        if (defer) LP_TAKE();
        STEP(t + 1, 1, true); }
#undef LP_TAKE
    qn_out = qn; n_out = nxt; more_out = more;
    if constexpr (MODE == 0) {
#pragma unroll
        for (int d0 = 0; d0 < 8; ++d0) S.qr[d0] = scale8(S.qr[d0], rqn); }
    float wa_r = 0.f;
    { float lv = l_reg; if constexpr (MODE == 1) lv = fmaxf(fabsf(l_reg), cur.aux[AUX_MEXP + qlo + r32]);
      if constexpr (MODE == 0) { if (cur.part == 2) {
          if (tid == 0) { unsigned sp = 0; while (__hip_atomic_load(cur.flag, __ATOMIC_RELAXED, __HIP_MEMORY_SCOPE_AGENT) == 0u) { __builtin_amdgcn_s_sleep(2); if (++sp > (1u << 22)) break; }
                          __builtin_amdgcn_fence(__ATOMIC_ACQUIRE, "agent"); asm volatile("s_waitcnt vmcnt(0)" ::: "memory"); }
          __syncthreads();
          constexpr float C2 = 1.4426950408889634f * SCALE;
          const float ma = cur.PS[2 * (wid * QBLK + r32)], la = cur.PS[2 * (wid * QBLK + r32) + 1];
          const float mm = fmaxf(ma, m_reg), fa_ = la * __builtin_amdgcn_exp2f((ma - mm) * C2), fb_ = __builtin_amdgcn_exp2f((m_reg - mm) * C2);
          lv = (fa_ + l_reg * fb_) / fb_; wa_r = fa_ / (fa_ + l_reg * fb_); } }
      if (hi == 0) { li_l[r32] = lv; al_l[r32] = wa_r; } }
    asm volatile("s_waitcnt lgkmcnt(0)" ::: "memory");
    float rli[16];
#pragma unroll
    for (int r = 0; r < 16; ++r) rli[r] = __builtin_amdgcn_rcpf(li_l[crow(r, hi)]);
    bf16* Ow = cur.O + (size_t)(qlo) * Pitch<MODE>::op; unsigned opitch = Pitch<MODE>::op;
    if constexpr (MODE == 0) { if (cur.part == 1) { Ow = cur.PO + (size_t)(wid * QBLK) * 128; opitch = 128; } }
    const bool merge = (MODE == 0) && cur.part == 2;
    if (merge) {
        unsigned pw[16][4];
#pragma unroll
        for (int r = 0; r < 16; ++r)
#pragma unroll
            for (int d0 = 0; d0 < 4; ++d0) pw[r][d0] = *(const unsigned*)(cur.PO + (size_t)(wid * QBLK + crow(r, hi)) * 128 + d0 * 32 + (r32 & ~1));
#pragma unroll
        for (int r = 0; r < 16; ++r) { const float war = al_l[crow(r, hi)];
#pragma unroll
            for (int d0 = 0; d0 < 4; ++d0) o[d0][r] = o[d0][r] * rli[r] + war * ((r32 & 1) ? ::bfhi(pw[r][d0]) : ::bflo(pw[r][d0])); }
#pragma unroll
        for (int r = 0; r < 16; ++r) rli[r] = 1.f;
    }
#pragma unroll
    for (int r = 0; r < 16; ++r) { const int orow = crow(r, hi);
#pragma unroll
        for (int d0 = 0; d0 < 4; ++d0) { const float v = o[d0][r] * rli[r];
            const float vn = __shfl_xor(v, 1);
            if ((r32 & 1) == 0) *(unsigned*)(Ow + (unsigned)(orow * opitch + d0 * 32 + r32)) = cvtpk(v, vn); } }
    if constexpr (MODE == 0) { if (cur.part == 1) {
        if (hi == 0) { cur.PS[2 * (wid * QBLK + r32)] = m_reg; cur.PS[2 * (wid * QBLK + r32) + 1] = l_reg; }
        asm volatile("s_waitcnt vmcnt(0)" ::: "memory"); __syncthreads();
        if (tid == 0) { __builtin_amdgcn_fence(__ATOMIC_RELEASE, "agent"); asm volatile("s_waitcnt vmcnt(0)" ::: "memory"); __hip_atomic_store(cur.flag, 1u, __ATOMIC_RELAXED, __HIP_MEMORY_SCOPE_AGENT); } } }
    asm volatile("s_waitcnt lgkmcnt(0)" ::: "memory");
#undef RESC
#undef KBASE
#undef STEP
}
#define TRRD2(dst, base, off) asm volatile("ds_read_b64_tr_b16 %0, %1 offset:%2" : "=&v"(dst) : "v"(base), "i"(off) : "memory")
#define FRAG8(l, h) (bf16x8){l[0], l[1], l[2], l[3], h[0], h[1], h[2], h[3]}
struct StateRef { const bf16* K; const bf16* V; bf16* U; float* nU; const float* a2; float aref, scale; int P0; };
__device__ __forceinline__ void mlstm_state_block(const StateRef& R, char* lds) {
    int tid0_ = threadIdx.x; asm volatile("" : "+v"(tid0_));
    const int tid = tid0_, wid = __builtin_amdgcn_readfirstlane(tid >> 6), lane = tid & 63, r32 = lane & 31, hi = lane >> 5;
    const int sr = tid >> 4, sc = (tid & 15) * 8, vst0 = v_st(sr, sc), vst1 = v_st(32 + sr, sc);
    bf16x8 sva0, sva1, svb0, svb1, sk0, sk1; float sf0, sf1;
#define MS_LOAD(t) do { const bf16* vp_ = R.V + (size_t)(R.P0 + (t) * 64) * 6144; const bf16* kp_ = R.K + (size_t)(R.P0 + (t) * 64) * 512;                 \
        sva0 = load8(vp_ + (unsigned)(sr * 6144 + sc)); sva1 = load8(vp_ + (unsigned)((32 + sr) * 6144 + sc));                                          \
        svb0 = load8(vp_ + (unsigned)(sr * 6144 + 128 + sc)); svb1 = load8(vp_ + (unsigned)((32 + sr) * 6144 + 128 + sc));                              \
        sk0 = load8(kp_ + (unsigned)(sr * 512 + sc)); sk1 = load8(kp_ + (unsigned)((32 + sr) * 512 + sc));                                              \
        sf0 = R.a2[R.P0 + (t) * 64 + sr]; sf1 = R.a2[R.P0 + (t) * 64 + 32 + sr]; } while (0)
#define MS_WRITE(b) do { char* B_ = lds + (b) * 49152; sk0 = scale8(sk0, __builtin_amdgcn_exp2f(sf0 - R.aref)); sk1 = scale8(sk1, __builtin_amdgcn_exp2f(sf1 - R.aref)); *(bf16x8*)(B_ + vst0) = sva0; *(bf16x8*)(B_ + vst1) = sva1; *(bf16x8*)(B_ + 16384 + vst0) = svb0;           \
        *(bf16x8*)(B_ + 16384 + vst1) = svb1; *(bf16x8*)(B_ + 32768 + vst0) = sk0; *(bf16x8*)(B_ + 32768 + vst1) = sk1; } while (0)
    f32x16 acc[4] = {}; f32x16 accn = {};
    const int half = wid >> 2, d0 = wid & 3;
    const int rb = (int)(uintptr_t)lds + v_rd_base(lane);
    const int vbw = rb + half * 16384 + d0 * 512, kbw = rb + 32768, knw = kbw + (wid & 3) * 512;
    const bf16x8 ones = {0x3F80, 0x3F80, 0x3F80, 0x3F80, 0x3F80, 0x3F80, 0x3F80, 0x3F80};
#define MS_KSTEP(BUF, ks) do { s16x4 bl, bh, al0, ah0, al1, ah1, al2, ah2, al3, ah3, nl, nh;                                                             \
        TRRD2(bl, vbw, (BUF) * 49152 + (ks) * 4096); TRRD2(bh, vbw, (BUF) * 49152 + (ks) * 4096 + 2048);                                                  \
        TRRD2(al0, kbw, (BUF) * 49152 + 0 * 512 + (ks) * 4096); TRRD2(ah0, kbw, (BUF) * 49152 + 0 * 512 + (ks) * 4096 + 2048);                            \
        TRRD2(al1, kbw, (BUF) * 49152 + 1 * 512 + (ks) * 4096); TRRD2(ah1, kbw, (BUF) * 49152 + 1 * 512 + (ks) * 4096 + 2048);                            \
        TRRD2(al2, kbw, (BUF) * 49152 + 2 * 512 + (ks) * 4096); TRRD2(ah2, kbw, (BUF) * 49152 + 2 * 512 + (ks) * 4096 + 2048);                            \
        TRRD2(al3, kbw, (BUF) * 49152 + 3 * 512 + (ks) * 4096); TRRD2(ah3, kbw, (BUF) * 49152 + 3 * 512 + (ks) * 4096 + 2048);                            \
        TRRD2(nl, knw, (BUF) * 49152 + (ks) * 4096); TRRD2(nh, knw, (BUF) * 49152 + (ks) * 4096 + 2048);                                                  \
        asm volatile("s_waitcnt lgkmcnt(0)" ::: "memory"); SBAR();                                                                                        \
        const bf16x8 bfr = FRAG8(bl, bh);                                                                                                                 \
        acc[0] = __builtin_amdgcn_mfma_f32_32x32x16_bf16(FRAG8(al0, ah0), bfr, acc[0], 0, 0, 0);                                                          \
        acc[1] = __builtin_amdgcn_mfma_f32_32x32x16_bf16(FRAG8(al1, ah1), bfr, acc[1], 0, 0, 0);                                                          \
        acc[2] = __builtin_amdgcn_mfma_f32_32x32x16_bf16(FRAG8(al2, ah2), bfr, acc[2], 0, 0, 0);                                                          \
        acc[3] = __builtin_amdgcn_mfma_f32_32x32x16_bf16(FRAG8(al3, ah3), bfr, acc[3], 0, 0, 0);                                                          \
        accn = __builtin_amdgcn_mfma_f32_32x32x16_bf16(FRAG8(nl, nh), ones, accn, 0, 0, 0); SBAR(); } while (0)
#define MS_TILE(t, BUF) do { if ((t) + 1 < 4) MS_LOAD((t) + 1); SBAR();                                                                                   \
        MS_KSTEP(BUF, 0); MS_KSTEP(BUF, 1); MS_KSTEP(BUF, 2); MS_KSTEP(BUF, 3);                                                                            \
        if ((t) + 1 < 4) { VMW(); MS_WRITE((BUF) ^ 1); } __syncthreads(); } while (0)
    MS_LOAD(0); VMW(); MS_WRITE(0); __syncthreads();
    MS_TILE(0, 0); MS_TILE(1, 1); MS_TILE(2, 0); MS_TILE(3, 1);
#pragma unroll
    for (int e0 = 0; e0 < 4; ++e0)
#pragma unroll
        for (int r = 0; r < 16; ++r) { const float v = acc[e0][r] * R.scale, vn = __shfl_xor(v, 1);
            if ((r32 & 1) == 0) *(unsigned*)(R.U + (unsigned)((32 * e0 + crow(r, hi)) * 256 + 128 * half + 32 * d0 + r32)) = cvtpk(v, vn); }
    if (wid < 4 && r32 == 0) {
#pragma unroll
        for (int r = 0; r < 16; ++r) R.nU[32 * wid + crow(r, hi)] = accn[r] * R.scale; }
#undef MS_LOAD
#undef MS_WRITE
#undef MS_KSTEP
#undef MS_TILE
}
struct OutRef { const bf16* Q; const bf16* K; const bf16* V; const bf16* C; const float* nC; bf16* O; const float* aux; const float* a2; float aref, mprev; int P0; const bf16* MO; const float* onw; };
__device__ __forceinline__ void mlstm_out_pass(const OutRef& R, char* lds) {
    int tid0_ = threadIdx.x; asm volatile("" : "+v"(tid0_));
    const int tid = tid0_, wid = __builtin_amdgcn_readfirstlane(tid >> 6), lane = tid & 63, r32 = lane & 31, hi = lane >> 5;
    const int qlo = R.P0 + wid * QBLK, qm = qlo + r32 - 4 * hi;
    char* V_lds = lds; char* K_lds = lds + 2 * SHM_V;
    float* ws = (float*)(lds + OFF_WS) + wid * 64; float* li_l = ws; const float* ckl = nullptr;
    const int sr = tid >> 4, sc = (tid & 15) * 8, vst0 = v_st(sr, sc), vst1 = v_st(32 + sr, sc), kws = KSWZ(sr, sc * 2);
    const int vb0 = (int)(uintptr_t)V_lds + v_rd_base(lane);
    bf16x8 qr[8], st_v0, st_v1, st_k0, st_k1; float sf0 = 0.f, sf1 = 0.f;
#pragma unroll
    for (int d0 = 0; d0 < 8; ++d0) qr[d0] = load8(R.Q + (size_t)qlo * 512 + (unsigned)(r32 * 512 + d0 * 16 + hi * 8));
    const float m2row = R.aux[qlo + r32];
    const float fr = __builtin_amdgcn_exp2f(R.aref - m2row), wst = __builtin_amdgcn_exp2f(R.mprev - m2row);
    float l_reg = 0.f; f32x16 o[4] = {}; f32x16 p0, p1; bf16x8 pa0, pa1, pa2, pa3;
#define MO_LOADKV(t) do { const bf16* vp_ = R.V + (size_t)(R.P0 + (t) * 64) * 6144; const bf16* kp_ = R.K + (size_t)(R.P0 + (t) * 64) * 512;               \
        st_v0 = load8(vp_ + (unsigned)(sr * 6144 + sc)); st_v1 = load8(vp_ + (unsigned)((32 + sr) * 6144 + sc));                                        \
        st_k0 = load8(kp_ + (unsigned)(sr * 512 + sc)); st_k1 = load8(kp_ + (unsigned)((32 + sr) * 512 + sc));                                          \
        sf0 = R.a2[R.P0 + (t) * 64 + sr]; sf1 = R.a2[R.P0 + (t) * 64 + 32 + sr]; } while (0)
#define MO_LOADC(j) do { const bf16* cp_ = R.C + (size_t)((j) * 64) * 256; st_v0 = load8(cp_ + (unsigned)(sr * 256 + sc)); st_v1 = load8(cp_ + (unsigned)((32 + sr) * 256 + sc)); } while (0)
#define MO_WRITEV(b) do { *(bf16x8*)(V_lds + (b) * SHM_V + vst0) = st_v0; *(bf16x8*)(V_lds + (b) * SHM_V + vst1) = st_v1; } while (0)
#define MO_WRITEK(b) do { *(bf16x8*)(K_lds + (b) * SHM_K + kws) = scale8(st_k0, __builtin_amdgcn_exp2f(sf0 - R.aref)); *(bf16x8*)(K_lds + (b) * SHM_K + kws + 32 * 256) = scale8(st_k1, __builtin_amdgcn_exp2f(sf1 - R.aref)); } while (0)
    MO_LOADKV(0); VMW(); MO_WRITEV(0); MO_WRITEK(0); __syncthreads();
#define MO_STEP(i, BUF) do {                                                                                                                             \
        if ((i) + 1 < 4) MO_LOADKV((i) + 1); else if ((i) + 1 < 6) MO_LOADC((i) + 1 - 4);                                                                 \
        SBAR();                                                                                                                                         \
        if ((i) < 4) { qkt<BUF, 1>(p0, p1, K_lds, ckl, r32, hi, qr); SBAR();                                                                              \
            { const int kb_ = R.P0 + (i) * 64; if (kb_ + KVBLK - 1 > qlo) mask_tile<1>(p0, p1, qm - kb_); }                                                \
            linScale(p0, p1, fr); linFinish(p0, p1, l_reg, pa0, pa1, pa2, pa3); }                                                                         \
        else { pa0 = scale8(qr[4 * ((i) - 4) + 0], wst); pa1 = scale8(qr[4 * ((i) - 4) + 1], wst); pa2 = scale8(qr[4 * ((i) - 4) + 2], wst); pa3 = scale8(qr[4 * ((i) - 4) + 3], wst); } \
        SBAR(); pv_tile<BUF>(o, vb0, pa0, pa1, pa2, pa3); SBAR();                                                                                        \
        if ((i) + 1 < 6) { VMW(); MO_WRITEV((BUF) ^ 1); if ((i) + 1 < 4) MO_WRITEK((BUF) ^ 1); }                                                          \
        __syncthreads(); } while (0)
    MO_STEP(0, 0); MO_STEP(1, 1); MO_STEP(2, 0); MO_STEP(3, 1); MO_STEP(4, 0); MO_STEP(5, 1);
    { float qn = 0.f;
#pragma unroll
      for (int d0 = 0; d0 < 8; ++d0) { const u32x4 u = __builtin_bit_cast(u32x4, qr[d0]); const f32x4 na = *(const f32x4*)(R.nC + d0 * 16 + hi * 8), nb = *(const f32x4*)(R.nC + d0 * 16 + hi * 8 + 4);
          qn += ::bflo(u.x) * na[0] + ::bfhi(u.x) * na[1] + ::bflo(u.y) * na[2] + ::bfhi(u.y) * na[3] + ::bflo(u.z) * nb[0] + ::bfhi(u.z) * nb[1] + ::bflo(u.w) * nb[2] + ::bfhi(u.w) * nb[3]; }
      auto rr = __builtin_amdgcn_permlane32_swap(__float_as_uint(qn), __float_as_uint(qn), false, false);
      l_reg += wst * (__uint_as_float(rr[0]) + __uint_as_float(rr[1])); }
    { const float lv = fmaxf(fabsf(l_reg), R.aux[AUX_MEXP + qlo + r32]); if (hi == 0) li_l[r32] = lv; }
    asm volatile("s_waitcnt lgkmcnt(0)" ::: "memory");
    float rli[16];
#pragma unroll
    for (int r = 0; r < 16; ++r) rli[r] = __builtin_amdgcn_rcpf(li_l[crow(r, hi)]);
    bf16* Ow = R.O + (size_t)qlo * 1024;
#pragma unroll
    for (int r = 0; r < 16; ++r) { const int orow = crow(r, hi);
#pragma unroll
        for (int d0 = 0; d0 < 4; ++d0) { const float v = o[d0][r] * rli[r]; const float vn = __shfl_xor(v, 1);
            if ((r32 & 1) == 0) *(unsigned*)(Ow + (unsigned)(orow * 1024 + d0 * 32 + r32)) = cvtpk(v, vn); } }
    asm volatile("s_waitcnt lgkmcnt(0)" ::: "memory");
    __syncthreads();
#undef MO_LOADKV
#undef MO_LOADC
#undef MO_WRITEV
#undef MO_WRITEK
#undef MO_STEP
}
constexpr int VB2_OFF = 69632;
__device__ __forceinline__ void mlstm_out_pass2(const OutRef& R, char* lds) {
    int tid0_ = threadIdx.x; asm volatile("" : "+v"(tid0_));
    const int tid = tid0_, wid = __builtin_amdgcn_readfirstlane(tid >> 6), lane = tid & 63, r32 = lane & 31, hi = lane >> 5;
    const int qlo = R.P0 + wid * QBLK, qm = qlo + r32 - 4 * hi;
    char* V_lds = lds; char* K_lds = lds + 2 * SHM_V; char* W_lds = lds + VB2_OFF;
    float* ws = (float*)(lds + OFF_WS) + wid * 64; float* li_l = ws; const float* ckl = nullptr;
    const int sr = tid >> 4, sc = (tid & 15) * 8, vst0 = v_st(sr, sc), vst1 = v_st(32 + sr, sc), kws = KSWZ(sr, sc * 2);
    const int vb0 = (int)(uintptr_t)V_lds + v_rd_base(lane), wb0 = (int)(uintptr_t)W_lds + v_rd_base(lane);
    const bf16* qp = R.Q + (size_t)qlo * 512 + (unsigned)(r32 * 512 + hi * 8);
    bf16x8 st_v0, st_v1, st_w0, st_w1, st_k0, st_k1; float sf0 = 0.f, sf1 = 0.f;
    bf16x8 qr[8];
#pragma unroll
    for (int d0 = 0; d0 < 4; ++d0) qr[d0] = load8(qp + d0 * 16);
    const float m2row = R.aux[qlo + r32];
    const float fr = __builtin_amdgcn_exp2f(R.aref - m2row), wst = __builtin_amdgcn_exp2f(R.mprev - m2row);
    float l_reg = 0.f; f32x16 o[8] = {}; f32x16 p0, p1; bf16x8 pa0, pa1, pa2, pa3;
#define M2_LOADKV(t) do { const bf16* vp_ = R.V + (size_t)(R.P0 + (t) * 64) * 6144; const bf16* kp_ = R.K + (size_t)(R.P0 + (t) * 64) * 512;               \
        st_v0 = load8(vp_ + (unsigned)(sr * 6144 + sc)); st_v1 = load8(vp_ + (unsigned)((32 + sr) * 6144 + sc));                                        \
        st_w0 = load8(vp_ + (unsigned)(sr * 6144 + 128 + sc)); st_w1 = load8(vp_ + (unsigned)((32 + sr) * 6144 + 128 + sc));                            \
        st_k0 = load8(kp_ + (unsigned)(sr * 512 + sc)); st_k1 = load8(kp_ + (unsigned)((32 + sr) * 512 + sc));                                          \
        sf0 = R.a2[R.P0 + (t) * 64 + sr]; sf1 = R.a2[R.P0 + (t) * 64 + 32 + sr]; } while (0)
#define M2_LOADC(j) do { const bf16* cp_ = R.C + (size_t)((j) * 64) * 256; st_v0 = load8(cp_ + (unsigned)(sr * 256 + sc)); st_v1 = load8(cp_ + (unsigned)((32 + sr) * 256 + sc));      \
        st_w0 = load8(cp_ + (unsigned)(sr * 256 + 128 + sc)); st_w1 = load8(cp_ + (unsigned)((32 + sr) * 256 + 128 + sc)); } while (0)
#define M2_WRITEV(b) do { *(bf16x8*)(V_lds + (b) * SHM_V + vst0) = st_v0; *(bf16x8*)(V_lds + (b) * SHM_V + vst1) = st_v1; *(bf16x8*)(W_lds + (b) * SHM_V + vst0) = st_w0; *(bf16x8*)(W_lds + (b) * SHM_V + vst1) = st_w1; } while (0)
#define M2_WRITEK(b) do { *(bf16x8*)(K_lds + (b) * SHM_K + kws) = scale8(st_k0, __builtin_amdgcn_exp2f(sf0 - R.aref)); *(bf16x8*)(K_lds + (b) * SHM_K + kws + 32 * 256) = scale8(st_k1, __builtin_amdgcn_exp2f(sf1 - R.aref)); } while (0)
    M2_LOADKV(0); VMW(); M2_WRITEV(0); M2_WRITEK(0); __syncthreads();
#define M2_STEP(i, BUF) do {                                                                                                                             \
        SBAR();                                                                                                                                         \
        if ((i) < 4) { _Pragma("unroll") for (int d0 = 4; d0 < 8; ++d0) qr[d0] = load8(qp + d0 * 16);                                                   \
            qkt<BUF, 1>(p0, p1, K_lds, ckl, r32, hi, qr); SBAR();                                                                                         \
            { const int kb_ = R.P0 + (i) * 64; if (kb_ + KVBLK - 1 > qlo) mask_tile<1>(p0, p1, qm - kb_); }                                                \
            linScale(p0, p1, fr); linFinish(p0, p1, l_reg, pa0, pa1, pa2, pa3); }                                                                         \
        else if ((i) == 4) { pa0 = scale8(qr[0], wst); pa1 = scale8(qr[1], wst); pa2 = scale8(qr[2], wst); pa3 = scale8(qr[3], wst); }                                            \
        else { pa0 = scale8(load8(qp + 4 * 16), wst); pa1 = scale8(load8(qp + 5 * 16), wst); pa2 = scale8(load8(qp + 6 * 16), wst); pa3 = scale8(load8(qp + 7 * 16), wst); } \
        SBAR(); if ((i) + 1 < 4) M2_LOADKV((i) + 1); else if ((i) + 1 < 6) M2_LOADC((i) + 1 - 4);     \
        SBAR(); pv_tile_np<BUF>(o, vb0, pa0, pa1, pa2, pa3); SBAR(); pv_tile_np<BUF>(o + 4, wb0, pa0, pa1, pa2, pa3); SBAR();                                   \
        if ((i) + 1 < 6) { VMW(); M2_WRITEV((BUF) ^ 1); if ((i) + 1 < 4) M2_WRITEK((BUF) ^ 1); }                                                          \
        __syncthreads(); } while (0)
    M2_STEP(0, 0); M2_STEP(1, 1); M2_STEP(2, 0); M2_STEP(3, 1); M2_STEP(4, 0); M2_STEP(5, 1);
    { float qn = 0.f;
#pragma unroll
      for (int d0 = 0; d0 < 8; ++d0) { const u32x4 u = __builtin_bit_cast(u32x4, load8(qp + d0 * 16)); const f32x4 na = *(const f32x4*)(R.nC + d0 * 16 + hi * 8), nb = *(const f32x4*)(R.nC + d0 * 16 + hi * 8 + 4);
          qn += ::bflo(u.x) * na[0] + ::bfhi(u.x) * na[1] + ::bflo(u.y) * na[2] + ::bfhi(u.y) * na[3] + ::bflo(u.z) * nb[0] + ::bfhi(u.z) * nb[1] + ::bflo(u.w) * nb[2] + ::bfhi(u.w) * nb[3]; }
      auto rr = __builtin_amdgcn_permlane32_swap(__float_as_uint(qn), __float_as_uint(qn), false, false);
      l_reg += wst * (__uint_as_float(rr[0]) + __uint_as_float(rr[1])); }
    { const float lv = fmaxf(fabsf(l_reg), R.aux[AUX_MEXP + qlo + r32]); if (hi == 0) li_l[r32] = lv; }
    asm volatile("s_waitcnt lgkmcnt(0)" ::: "memory");
    float rli[16];
#pragma unroll
    for (int r = 0; r < 16; ++r) rli[r] = __builtin_amdgcn_rcpf(li_l[crow(r, hi)]);
#pragma unroll
    for (int r = 0; r < 16; ++r)
#pragma unroll
        for (int d0 = 0; d0 < 8; ++d0) o[d0][r] *= rli[r];
#pragma unroll
    for (int r = 0; r < 16; ++r) { float q = 0.f;
#pragma unroll
        for (int d0 = 0; d0 < 8; ++d0) q += o[d0][r] * o[d0][r];
        q += __shfl_xor(q, 1); q += __shfl_xor(q, 2); q += __shfl_xor(q, 4); q += __shfl_xor(q, 8); q += __shfl_xor(q, 16);
        rli[r] = 1.f / sqrtf(q * (1.f / 256.f) + 1e-6f); }
    float ow[8];
#pragma unroll
    for (int d0 = 0; d0 < 8; ++d0) ow[d0] = R.onw[d0 * 32 + r32];
    const bf16* MOw = R.MO + (size_t)qlo * 6144 + (r32 & ~1); bf16* Ow = R.O + (size_t)qlo * 2048;
#pragma unroll
    for (int rg = 0; rg < 4; ++rg) { unsigned gw_[4][8];
#pragma unroll
        for (int i = 0; i < 4; ++i)
#pragma unroll
            for (int d0 = 0; d0 < 8; ++d0) gw_[i][d0] = __builtin_nontemporal_load((const unsigned*)(MOw + (unsigned)(crow(4 * rg + i, hi) * 6144 + d0 * 32)));
#pragma unroll
        for (int i = 0; i < 4; ++i) { const int r = 4 * rg + i, orow = crow(r, hi);
#pragma unroll
            for (int d0 = 0; d0 < 8; ++d0) { const float g = (r32 & 1) ? ::bfhi(gw_[i][d0]) : ::bflo(gw_[i][d0]);
                const float v = o[d0][r] * rli[r] * ow[d0] * ::sigmoidf_(g); const float vn = __shfl_xor(v, 1);
                if ((r32 & 1) == 0) *(unsigned*)(Ow + (unsigned)(orow * 2048 + d0 * 32 + r32)) = cvtpk(v, vn); } } }
    asm volatile("s_waitcnt lgkmcnt(0)" ::: "memory");
    __syncthreads();
#undef M2_LOADKV
#undef M2_LOADC
#undef M2_WRITEV
#undef M2_WRITEK
#undef M2_STEP
}
#undef TRRD2
#undef FRAG8
#undef ROWK
#undef ROWV
#undef VMW
#undef VMWN
#undef SLOAD_H
#undef SWRITE_HK
#undef SWRITE_HV
#undef SWRITE_H
#undef SBAR
#undef KSWZ
}
#define LAS __attribute__((address_space(3)))
#define GAS __attribute__((address_space(1)))
#define RLX_AGENT __ATOMIC_RELAXED, __HIP_MEMORY_SCOPE_AGENT
#define XB_TMO      128
#define XB_XCNT(j)  (256  + 64 * (j))
#define XB_XSUB(j)  (1280 + 64 * (j))
#define XB_XGEN(j)  (2304 + 64 * (j))
#define XB_TOP      3328
#define XB_TOPGEN   3392
#define XCD_BAR_WORDS 3456
#define XB_SPIN_CAP (1u << 18)

__device__ __forceinline__ unsigned xb_ld(unsigned* p)              { return __hip_atomic_load(p, __ATOMIC_RELAXED, __HIP_MEMORY_SCOPE_AGENT); }
__device__ __forceinline__ unsigned xb_add(unsigned* p, unsigned v) { return __hip_atomic_fetch_add(p, v, __ATOMIC_RELAXED, __HIP_MEMORY_SCOPE_AGENT); }
__device__ __forceinline__ unsigned xb_xcc_id() { return (unsigned)__builtin_amdgcn_s_getreg((3 << 11) | 20) & 0xFu; }
#define XB_SPIN(cond, bar) do { unsigned _sp = 0; while (cond) { __builtin_amdgcn_s_sleep(1); \
    if ((++_sp & 255u) == 0u) { if (xb_ld(&(bar)[XB_TMO])) break; if (_sp > XB_SPIN_CAP) { atomicAdd(&(bar)[XB_TMO], 1u); break; } } } } while (0)

struct XcdBarrier {
    unsigned* bar; unsigned x;
    volatile LAS unsigned* st;
};

__device__ __forceinline__ XcdBarrier xcd_barrier_post(unsigned* bar, volatile LAS unsigned* st) {
    XcdBarrier b; b.bar = bar; b.x = xb_xcc_id(); b.st = st;
    if (threadIdx.x == 0) (void)xb_add(&bar[XB_XCNT(b.x)], 1u);
    return b;
}
__device__ __forceinline__ void xcd_barrier_complete(unsigned* bar, unsigned x, unsigned& nloc, unsigned& nx) {
    const unsigned G = gridDim.x * gridDim.y * gridDim.z;
    unsigned sum, cnt, mine, sp = 0u;
    for (;;) {
        sum = 0u; cnt = 0u; mine = 0u;
#pragma unroll
        for (unsigned j = 0; j < 16; ++j) { const unsigned c = xb_ld(&bar[XB_XCNT(j)]); sum += c; cnt += (c > 0u) ? 1u : 0u; mine = (j == x) ? c : mine; }
        if (sum == G) break;
        __builtin_amdgcn_s_sleep(1);
        if ((++sp & 255u) == 0u) { if (xb_ld(&bar[XB_TMO])) break; if (sp > XB_SPIN_CAP) { atomicAdd(&bar[XB_TMO], 1u); break; } }
    }
    nloc = mine > 0u ? mine : 1u; nx = cnt > 0u ? cnt : 1u;
}

__device__ __forceinline__ void xcd_barrier(const XcdBarrier& b) {
    asm volatile("s_waitcnt vmcnt(0)" ::: "memory");
    __syncthreads();
    if (threadIdx.x == 0) {
        unsigned* bar = b.bar;
        __builtin_amdgcn_s_waitcnt(0);
        unsigned nloc = b.st[0], nx = b.st[1];
        if (nloc == 0u) { xcd_barrier_complete(bar, b.x, nloc, nx); b.st[0] = nloc; b.st[1] = nx; }
        const unsigned old = xb_add(&bar[XB_XSUB(b.x)], 1u);
        const unsigned gen = old / nloc;
        if (old + 1u == (gen + 1u) * nloc) {
            __builtin_amdgcn_fence(__ATOMIC_RELEASE, "agent");
            asm volatile("s_waitcnt vmcnt(0)" ::: "memory");
            const unsigned og = xb_add(&bar[XB_TOP], 1u);
            const unsigned tg = og / nx;
            if (og + 1u == (tg + 1u) * nx) xb_add(&bar[XB_TOPGEN], 1u);
            else XB_SPIN(xb_ld(&bar[XB_TOPGEN]) == tg, bar);
            __builtin_amdgcn_fence(__ATOMIC_ACQUIRE, "agent");
            xb_add(&bar[XB_XGEN(b.x)], 1u);
            asm volatile("s_waitcnt vmcnt(0)" ::: "memory");
        } else {
            XB_SPIN(xb_ld(&bar[XB_XGEN(b.x)]) == gen, bar);
            __builtin_amdgcn_fence(__ATOMIC_ACQUIRE, "agent");
            asm volatile("s_waitcnt vmcnt(0)" ::: "memory");
        }
    }
    __syncthreads();
}
constexpr int NWAVES = 8, NTHREADS = NWAVES * 64;
constexpr int LDS_BYTES = 131072 + 4096;
static_assert(fa::LDS_BYTES <= 131072, "attention scratch fits the ring region");
constexpr size_t MiB = 1u << 20;
constexpr size_t WS_SS = 0;
constexpr size_t WS_BAR = 512 * 1024;
constexpr size_t OUT_SSQK = 16u << 20;
constexpr size_t WS_G = 1 * MiB;
constexpr size_t WS_CK = 2 * MiB;
constexpr size_t WS_A2 = 2 * MiB + 512 * 1024, WS_M2 = WS_A2 + 256 * 1024, WS_MEXP = WS_M2 + 256 * 1024, WS_AREF = WS_MEXP + 256 * 1024;
static_assert((WS_MEXP - WS_M2) / 4 == fa::AUX_MEXP && (WS_AREF - WS_M2) / 4 == fa::AUX_AREF, "aux offsets");
constexpr size_t WS_WIN = 4 * MiB, WS_WO = 29 * MiB, WS_WGU = 37 * MiB, WS_WD = 81 * MiB, WS_WPG = 103 * MiB, WS_WPP = 111 * MiB;
constexpr size_t WS_R1 = 112 * MiB;
constexpr size_t WS_R2 = 304 * MiB;
constexpr size_t WS_R3 = 368 * MiB;
constexpr size_t WS_HB = WS_R3, WS_MQ = WS_R3 + 32 * MiB, WS_MK = WS_R3 + 48 * MiB;
constexpr size_t WS_ERAW = 432 * MiB;
constexpr size_t WS_UB = 496 * MiB, WS_END = 512 * MiB;
constexpr size_t WS_CB = WS_WIN, WS_NU = WS_WIN + 16 * MiB, WS_NC = WS_NU + 128 * 1024;
constexpr size_t WS_FLAG = WS_BAR + 32768;
constexpr size_t WS_J0 = WS_BAR + 65536;
constexpr size_t WS_GB = WS_BAR + 16384;

struct Args {
    const float *x, *p, *w_norm_mix, *w_in, *fox_f_bias, *q_norm_w, *k_norm_w, *conv_w, *conv_b, *mi_bias, *mf_bias, *out_norm_w, *w_out, *w_norm_ffn,
                *w_gate, *w_up, *w_down, *w_norm_ple, *w_ple_gate, *w_ple_proj, *w_ple_post;
    float* out; unsigned char* ws;
};

__device__ __forceinline__ float wave_sum(float v) {
#pragma unroll
    for (int o = 1; o < 64; o <<= 1) v += __shfl_xor(v, o);
    return v;
}
__device__ __forceinline__ int win_src_col(int d) {
    if (d < 3072) return d;
    if (d < 5120) return d + 8;
    if (d < 6144) return d + 16;
    if (d < 6152) return 3072 + (d - 6144);
    if (d < 6160) return 5128 + (d - 6152);
    return -1;
}
struct TItem { const float* src4; const float* kw; bf16_t* dst; int ld, K; };
__device__ __forceinline__ TItem p0_item(const Args& A, int it, int lane) {
    constexpr int I_IN = (DM / 64) * (NIN / 32), I_O = (DM / 64) * (DM / 32), I_GU = (DM / 64) * (2 * DFF / 32), I_D = (DFF / 64) * (DM / 32), I_PG = I_O;
    unsigned char* ws = A.ws; const int n4 = 4 * (lane & 7), kr = lane >> 3; TItem t; int r = it;
    if (r < I_IN) { const int nblk = NIN / 32, kb = r / nblk, nb = r % nblk; const int sc = win_src_col(nb * 32 + n4);
        t.src4 = sc >= 0 ? A.w_in + (size_t)(kb * 64 + kr) * INC + sc : nullptr; t.kw = A.w_norm_mix + kb * 64 + kr; t.ld = INC; t.K = DM; t.dst = (bf16_t*)(ws + WS_WIN) + (size_t)(nb * 32) * DM + kb * 64; return t; } r -= I_IN;
    if (r < I_O) { const int nblk = DM / 32, kb = r / nblk, nb = r % nblk; t.src4 = A.w_out + (size_t)(kb * 64 + kr) * DM + nb * 32 + n4; t.kw = nullptr; t.ld = DM; t.K = DM; t.dst = (bf16_t*)(ws + WS_WO) + (size_t)(nb * 32) * DM + kb * 64; return t; } r -= I_O;
    if (r < I_GU) { const int nblk = 2 * DFF / 32, kb = r / nblk, nb = r % nblk; const int d = nb * 32, pn = d >> 8, j = d & 255;
        t.src4 = ((j < 128) ? A.w_gate + 128 * pn + j : A.w_up + 128 * pn + (j - 128)) + (size_t)(kb * 64 + kr) * DFF + n4; t.kw = A.w_norm_ffn + kb * 64 + kr; t.ld = DFF; t.K = DM; t.dst = (bf16_t*)(ws + WS_WGU) + (size_t)d * DM + kb * 64; return t; } r -= I_GU;
    if (r < I_D) { const int nblk = DM / 32, kb = r / nblk, nb = r % nblk; t.src4 = A.w_down + (size_t)(kb * 64 + kr) * DM + nb * 32 + n4; t.kw = nullptr; t.ld = DM; t.K = DFF; t.dst = (bf16_t*)(ws + WS_WD) + (size_t)(nb * 32) * DFF + kb * 64; return t; } r -= I_D;
    if (r < I_PG) { const int nblk = DM / 32, kb = r / nblk, nb = r % nblk; t.src4 = A.w_ple_gate + (size_t)(kb * 64 + kr) * DM + nb * 32 + n4; t.kw = A.w_norm_ple + kb * 64 + kr; t.ld = DM; t.K = DM; t.dst = (bf16_t*)(ws + WS_WPG) + (size_t)(nb * 32) * DM + kb * 64; return t; } r -= I_PG;
    { const int nblk = DM / 32, kb = r / nblk, nb = r % nblk; t.src4 = A.w_ple_proj + (size_t)(kb * 64 + kr) * DM + nb * 32 + n4; t.kw = nullptr; t.ld = DM; t.K = PLE; t.dst = (bf16_t*)(ws + WS_WPP) + (size_t)(nb * 32) * PLE + kb * 64; return t; }
}
__device__ __forceinline__ void p0_item_load(const TItem& t, f32x4 (&v)[8]) {
#pragma unroll
    for (int i = 0; i < 8; ++i) { v[i] = t.src4 ? __builtin_nontemporal_load((const f32x4*)(t.src4 + (size_t)(8 * i) * t.ld)) : (f32x4){0.f, 0.f, 0.f, 0.f}; if (t.kw) v[i] = v[i] * t.kw[8 * i]; }
}
__device__ __forceinline__ void p0_item_store(const TItem& t, const f32x4 (&v)[8], LAS float* scr, int lane) {
    const int n4 = 4 * (lane & 7), kr = lane >> 3;
#pragma unroll
    for (int i = 0; i < 8; ++i) { LAS float* d = scr + (kr + 8 * i) * 33 + n4; d[0] = v[i].x; d[1] = v[i].y; d[2] = v[i].z; d[3] = v[i].w; }
    asm volatile("s_waitcnt lgkmcnt(0)" ::: "memory");
    const int c = lane & 7;
#pragma unroll
    for (int j = 0; j < 4; ++j) { const int n = (lane >> 3) + 8 * j; const LAS float* s = scr + (8 * c) * 33 + n;
        u32x4 o; o.x = cvtpk2(s[0 * 33], s[1 * 33]); o.y = cvtpk2(s[2 * 33], s[3 * 33]); o.z = cvtpk2(s[4 * 33], s[5 * 33]); o.w = cvtpk2(s[6 * 33], s[7 * 33]);
        *(u32x4*)(t.dst + (size_t)n * t.K + 8 * c) = o; }
    asm volatile("s_waitcnt lgkmcnt(0)" ::: "memory");
}
__device__ __forceinline__ void p0_prologue(const Args& A, LAS unsigned char* lds, int gw, int NGW, int lane, int wave) {
    LAS float* scr = (LAS float*)(lds + wave * 16384);
    unsigned char* ws = A.ws;
    constexpr int I_IN = (DM / 64) * (NIN / 32), I_PP = (PLE / 64) * (DM / 32), I_ALL = I_IN + 2 * (DM / 64) * (DM / 32) + (DM / 64) * (2 * DFF / 32) + (DFF / 64) * (DM / 32) + I_PP;
    constexpr int I_O_ = (DM / 64) * (DM / 32), I_GU_ = (DM / 64) * (2 * DFF / 32);
    constexpr int NITEMS = I_IN + I_GU_ + I_PP;
#define P0_GI(i_) ((i_) < I_IN ? (i_) : ((i_) < I_IN + I_GU_ ? (i_) + I_O_ : (i_) - (I_IN + I_GU_) + (I_ALL - I_PP)))
    if (gw < NITEMS) {
        TItem cur = p0_item(A, P0_GI(gw), lane); f32x4 v[8]; p0_item_load(cur, v);
        for (int it = gw; it < NITEMS; it += NGW) {
            const bool more = it + NGW < NITEMS; TItem nx = cur; f32x4 w[8];
            if (more) { nx = p0_item(A, P0_GI(it + NGW), lane); p0_item_load(nx, w); }
            p0_item_store(cur, v, scr, lane);
            if (more) { cur = nx;
#pragma unroll
                for (int i = 0; i < 8; ++i) v[i] = w[i]; }
        }
    }
#undef P0_GI
    bf16_t* XB = (bf16_t*)(ws + WS_R2); float* ss0 = (float*)(ws + WS_SS) + 3 * MROWS;
    {
        f32x4 v[8];
#pragma unroll
        for (int j = 0; j < 8; ++j) v[j] = __builtin_nontemporal_load((const f32x4*)(A.x + (size_t)gw * DM) + lane + 64 * j);
        for (int m = gw; m < MROWS; m += NGW) {
            f32x4 nv[8]; const bool more = m + NGW < MROWS;
            if (more) {
#pragma unroll
                for (int j = 0; j < 8; ++j) nv[j] = __builtin_nontemporal_load((const f32x4*)(A.x + (size_t)(m + NGW) * DM) + lane + 64 * j); }
            float s = 0.f; u32x2* o8 = (u32x2*)(XB + (size_t)m * DM) + lane;
#pragma unroll
            for (int j = 0; j < 8; ++j) { s += (v[j].x * v[j].x + v[j].y * v[j].y) + (v[j].z * v[j].z + v[j].w * v[j].w); u32x2 w; w.x = cvtpk2(v[j].x, v[j].y); w.y = cvtpk2(v[j].z, v[j].w); o8[64 * j] = w; }
            s = wave_sum(s); if (lane == 0) ss0[m] = s;
            if (more) {
#pragma unroll
                for (int j = 0; j < 8; ++j) v[j] = nv[j]; }
        }
    }
    bf16_t* PB = (bf16_t*)(ws + WS_R3);
    for (int m = gw; m < MROWS; m += NGW) { const f32x4 v = __builtin_nontemporal_load((const f32x4*)(A.p + (size_t)m * PLE) + lane); u32x2 w; w.x = cvtpk2(v.x, v.y); w.y = cvtpk2(v.z, v.w); ((u32x2*)(PB + (size_t)m * PLE))[lane] = w; }
    float* ss = (float*)(ws + WS_SS);
    for (int i = gw * 64 + lane; i < 3 * MROWS; i += NGW * 64) ss[i] = 0.f;
    { f32x4* sq = (f32x4*)(A.out + OUT_SSQK); for (int i = gw * 64 + lane; i < MROWS * 4; i += NGW * 64) sq[i] = (f32x4){0.f, 0.f, 0.f, 0.f}; }
}
constexpr int CV_FIRST = (DM / 64) * (NIN / 32), CV_SKIP0 = (DM / 64) * (DM / 32), CV_SKIPN = (DM / 64) * (2 * DFF / 32), CV_ITEMS = 2 * (DM / 64) * (DM / 32) + (DFF / 64) * (DM / 32), CV_CHUNKS = CV_ITEMS / 16;
static_assert(CV_ITEMS % 16 == 0 && CV_CHUNKS % 8 == 0 && CV_SKIP0 % 16 == 0, "conversion chunks");
__device__ __forceinline__ void p3_convert_chunk(const Args& A, LAS unsigned char* lds, int chunk) {
    int tid_ = threadIdx.x; asm volatile("" : "+v"(tid_));
    const int lane = tid_ & 63, wave = __builtin_amdgcn_readfirstlane(tid_ >> 6);
    LAS float* scr = (LAS float*)(lds + wave * 12288);
    const int j0_ = chunk * 16 + wave * 2; const int it0 = CV_FIRST + (j0_ < CV_SKIP0 ? j0_ : j0_ + CV_SKIPN);
    TItem cur = p0_item(A, it0, lane); f32x4 v[8]; p0_item_load(cur, v);
#pragma nounroll
    for (int i = 0; i < 2; ++i) { const bool more = i + 1 < 2; TItem nx = cur; f32x4 w[8];
        if (more) { nx = p0_item(A, it0 + i + 1, lane); p0_item_load(nx, w); }
        p0_item_store(cur, v, scr, lane);
        if (more) { cur = nx;
#pragma unroll
            for (int j = 0; j < 8; ++j) v[j] = w[j]; } }
}
__device__ __forceinline__ void gate_cols(const Args& A, LAS unsigned char* ldsl, int bx, int G) {
    typedef short bf16x8_ __attribute__((ext_vector_type(8))); typedef float f32x16_ __attribute__((ext_vector_type(16)));
    int tid0_ = threadIdx.x; asm volatile("" : "+v"(tid0_));
    const int tid = tid0_, lane = tid & 63, r32 = lane & 31, hi = lane >> 5, wave = __builtin_amdgcn_readfirstlane(tid >> 6);
    const bf16_t* XB = (const bf16_t*)(A.ws + WS_R2); const bf16_t* Wg = (const bf16_t*)(A.ws + WS_WIN) + (size_t)6144 * DM;
    float* Gout = (float*)(A.ws + WS_G); const float* ss0 = (const float*)(A.ws + WS_SS) + 3 * MROWS;
    constexpr int BP = 4112;
    LAS unsigned char* Bl = ldsl; LAS float* red = (LAS float*)(ldsl + 16 * BP);
    for (int j = bx; j < MROWS / 64; j += G) {
        { const int row = tid >> 5, c0 = tid & 31;
#pragma unroll
          for (int i = 0; i < 8; ++i) *(LAS u32x4*)(Bl + row * BP + (c0 + 32 * i) * 16) = *(const u32x4*)(Wg + (size_t)row * DM + (c0 + 32 * i) * 8); }
        const int row0 = (2 * j + (wave >> 2)) * 32, kq = (wave & 3) * 512;
        const bf16_t* ap = XB + (size_t)(row0 + r32) * DM + kq + 8 * hi;
        bf16x8_ av[32];
#pragma unroll
        for (int ks = 0; ks < 32; ++ks) av[ks] = *(const bf16x8_*)(ap + 16 * ks);
        __syncthreads();
        f32x16_ acc = {};
        const LAS unsigned char* bp = Bl + (r32 & 15) * BP + (kq + 8 * hi) * 2;
#pragma unroll
        for (int ks = 0; ks < 32; ++ks) acc = __builtin_amdgcn_mfma_f32_32x32x16_bf16(av[ks], *(const LAS bf16x8_*)(bp + 32 * ks), acc, 0, 0, 0);
        LAS float* rp = red + (wave * 64 + lane) * 16;
#pragma unroll
        for (int r = 0; r < 16; ++r) rp[r] = acc[r];
        __syncthreads();
        { float ssv[2048 / NTHREADS];
#pragma unroll
          for (int q = 0; q < 2048 / NTHREADS; ++q) { const int e = tid + q * NTHREADS, t = e >> 10, ee = e & 1023, ln = ee >> 4, r = ee & 15; ssv[q] = ss0[(2 * j + t) * 32 + (r & 3) + 8 * (r >> 2) + 4 * (ln >> 5)]; }
#pragma unroll
          for (int q = 0; q < 2048 / NTHREADS; ++q) { const int e = tid + q * NTHREADS, t = e >> 10, ee = e & 1023; float s = 0.f;
#pragma unroll
            for (int w = 0; w < 4; ++w) s += red[(4 * t + w) * 1024 + ee];
            const int ln = ee >> 4, r = ee & 15, col = ln & 31, row = (2 * j + t) * 32 + (r & 3) + 8 * (r >> 2) + 4 * (ln >> 5);
            if (col < 16) Gout[(size_t)row * 16 + col] = s * (1.f / sqrtf(ssv[q] * (1.f / DM) + EPS)); } }
        __syncthreads();
    }
}
__device__ __forceinline__ float logsigf(float x) { return fminf(x, 0.f) - log1pf(expf(-fabsf(x))); }
__device__ __forceinline__ void scan_sequence(const Args& A, int v, LAS float* red) {
    const int tid = threadIdx.x, lane = tid & 63, wid = tid >> 6;
    const bool fox = v < NB * AH; int b, h;
    if (fox) { b = v / AH; h = v % AH; } else { const int u = v - NB * AH; b = u / MH; h = u % MH; }
    const float* Gp = (const float*)(A.ws + WS_G) + (size_t)(b * SEQ + 8 * tid) * 16;
    const int fcol = fox ? h : 12 + h; const float fb = fox ? A.fox_f_bias[h] : A.mf_bias[h];
    float lf[8]; float run = 0.f;
#pragma unroll
    for (int i = 0; i < 8; ++i) { run += logsigf(Gp[i * 16 + fcol] + fb); lf[i] = run; }
    float incl = run;
#pragma unroll
    for (int o = 1; o < 64; o <<= 1) { const float t = __shfl_up(incl, o); if (lane >= o) incl += t; }
    if (lane == 63) red[wid] = incl;
    __syncthreads();
    float base = incl - run;
    for (int w = 0; w < wid; ++w) base += red[w];
    if (fox) {
        float* CK = (float*)(A.ws + WS_CK) + (size_t)(b * AH + h) * SEQ + 8 * tid;
        float ck[8];
#pragma unroll
        for (int i = 0; i < 8; ++i) { ck[i] = -(base + lf[i]) * 11.313708498984761f; CK[i] = ck[i]; }
        LAS float* tend = red + 32; LAS float* bst = red + 96; LAS float* wmx = red + 112;
        float mq = 0.f, mk = 0.f;
        if (tid < 128) { mq = fabsf(A.q_norm_w[tid]); mk = fabsf(A.k_norm_w[tid]); }
#pragma unroll
        for (int o = 1; o < 64; o <<= 1) { mq = fmaxf(mq, __shfl_xor(mq, o)); mk = fmaxf(mk, __shfl_xor(mk, o)); }
        if (lane == 0 && wid < 2) { wmx[wid] = mq; wmx[2 + wid] = mk; }
        if ((tid & 7) == 7) tend[tid >> 3] = ck[7];
        if ((tid & 31) == 0) bst[tid >> 5] = ck[0];
        __syncthreads();
        if (tid < 16) {
            const float B = 128.f * fmaxf(wmx[0], wmx[1]) * fmaxf(wmx[2], wmx[3]) * 0.08838834764831845f * 1.02f;
            const float Tck = (2.f * B + 30.f) * 11.313708498984761f; const int NT = 4 * tid + 4; int j0 = NT - 2;
            for (int j = NT - 1; j >= 0; --j) { if (bst[tid] - tend[j] <= Tck) j0 = j; else break; }
            j0 &= ~1; if (j0 > NT - 2) j0 = NT - 2;
            ((int*)(A.ws + WS_J0))[(b * AH + h) * 16 + tid] = j0; }
    } else {
        const float ib = A.mi_bias[h];
        float a[8], lm[8]; float rm = -__builtin_inff();
#pragma unroll
        for (int i = 0; i < 8; ++i) { a[i] = (Gp[i * 16 + 8 + h] + ib) - (base + lf[i]); rm = fmaxf(rm, a[i]); lm[i] = rm; }
        float im = rm;
#pragma unroll
        for (int o = 1; o < 64; o <<= 1) { const float t = __shfl_up(im, o); if (lane >= o) im = fmaxf(im, t); }
        if (lane == 63) red[8 + wid] = im;
        __syncthreads();
        float ex = __shfl_up(im, 1); if (lane == 0) ex = -__builtin_inff();
        for (int w = 0; w < wid; ++w) ex = fmaxf(ex, red[8 + w]);
        const size_t o0 = (size_t)(b * MH + h) * SEQ + 8 * tid;
        float* A2 = (float*)(A.ws + WS_A2) + o0; float* M2 = (float*)(A.ws + WS_M2) + o0; float* ME = (float*)(A.ws + WS_MEXP) + o0;
#pragma unroll
        for (int i = 0; i < 8; ++i) { const float Mt = fmaxf(0.f, fmaxf(ex, lm[i])); A2[i] = a[i] * LOG2E; M2[i] = Mt * LOG2E; ME[i] = expf(-((base + lf[i]) + Mt)); }
        float tm = rm; tm = fmaxf(tm, __shfl_xor(tm, 1)); tm = fmaxf(tm, __shfl_xor(tm, 2)); tm = fmaxf(tm, __shfl_xor(tm, 4)); tm = fmaxf(tm, __shfl_xor(tm, 8)); tm = fmaxf(tm, __shfl_xor(tm, 16));
        if ((lane & 31) == 0) ((float*)(A.ws + WS_AREF))[(b * MH + h) * SEQ + (tid >> 5)] = tm * LOG2E;
    }
}
__device__ __forceinline__ void unpack8(const u32x4 w, float (&f)[8]) { f[0] = bflo(w.x); f[1] = bfhi(w.x); f[2] = bflo(w.y); f[3] = bfhi(w.y); f[4] = bflo(w.z); f[5] = bfhi(w.z); f[6] = bflo(w.w); f[7] = bfhi(w.w); }
__device__ __forceinline__ u32x4 pack8f(const float (&f)[8]) { u32x4 w; w.x = cvtpk2(f[0], f[1]); w.y = cvtpk2(f[2], f[3]); w.z = cvtpk2(f[4], f[5]); w.w = cvtpk2(f[6], f[7]); return w; }
__device__ __forceinline__ void mconv_rows(const Args& A, int gw, int NGW, int lane) {
    const bf16_t* PROJ = (const bf16_t*)(A.ws + WS_R1) + PC_MQ + 16 * lane;
    bf16_t* OUT = (bf16_t*)(A.ws + (lane < 32 ? WS_MQ : WS_MK)) + 16 * (lane & 31);
    const int c0 = 16 * lane;
    float w[4][16], bb[16];
#pragma unroll
    for (int j = 0; j < 4; ++j)
#pragma unroll
        for (int i = 0; i < 16; ++i) w[j][i] = A.conv_w[j * 1024 + c0 + i];
#pragma unroll
    for (int i = 0; i < 16; ++i) bb[i] = A.conv_b[c0 + i];
    const float sc = lane < 32 ? 0.08838834764831845f : 1.f;
    u32x4 tap[4][2];
#define MC_LOAD(dst, m_) do { const int t_ = (m_) & (SEQ - 1); _Pragma("unroll") for (int j = 0; j < 4; ++j) { \
        if (t_ - 3 + j >= 0) { (dst)[j][0] = *(const u32x4*)(PROJ + (size_t)((m_) - 3 + j) * PROJ_LD); (dst)[j][1] = *(const u32x4*)(PROJ + (size_t)((m_) - 3 + j) * PROJ_LD + 8); } \
        else { (dst)[j][0] = (u32x4){0u, 0u, 0u, 0u}; (dst)[j][1] = (u32x4){0u, 0u, 0u, 0u}; } } } while (0)
    MC_LOAD(tap, gw);
    for (int m = gw; m < MROWS; m += NGW) {
        const bool more = m + NGW < MROWS; u32x4 ntap[4][2];
        if (more) MC_LOAD(ntap, m + NGW);
        float acc[16];
#pragma unroll
        for (int i = 0; i < 16; ++i) acc[i] = bb[i];
#pragma unroll
        for (int j = 0; j < 4; ++j) { float f[8]; unpack8(tap[j][0], f);
#pragma unroll
            for (int i = 0; i < 8; ++i) acc[i] = fmaf(w[j][i], f[i], acc[i]);
            unpack8(tap[j][1], f);
#pragma unroll
            for (int i = 0; i < 8; ++i) acc[8 + i] = fmaf(w[j][8 + i], f[i], acc[8 + i]); }
        float o[8];
#pragma unroll
        for (int i = 0; i < 8; ++i) o[i] = acc[i] * sigmoidf_(acc[i]) * sc;
        *(u32x4*)(OUT + (size_t)m * 512) = pack8f(o);
#pragma unroll
        for (int i = 0; i < 8; ++i) o[i] = acc[8 + i] * sigmoidf_(acc[8 + i]) * sc;
        *(u32x4*)(OUT + (size_t)m * 512 + 8) = pack8f(o);
        if (more) {
#pragma unroll
            for (int j = 0; j < 4; ++j) { tap[j][0] = ntap[j][0]; tap[j][1] = ntap[j][1]; } }
    }
#undef MC_LOAD
}
__device__ __forceinline__ void mlstm_out_rows(const Args& A, int gw, int NGW, int lane) {
    const bf16_t* HB = (const bf16_t*)(A.ws + WS_HB) + 16 * lane;
    const bf16_t* MO = (const bf16_t*)(A.ws + WS_R1) + PC_MO + 16 * lane;
    bf16_t* MIX = (bf16_t*)(A.ws + WS_R2) + 1024 + 16 * lane;
    float ow[16];
#pragma unroll
    for (int i = 0; i < 16; ++i) ow[i] = A.out_norm_w[16 * lane + i];
    u32x4 rw[4];
#define MO_LD(dst, m_) do { (dst)[0] = __builtin_nontemporal_load((const u32x4*)(HB + (size_t)(m_) * 1024)); (dst)[1] = __builtin_nontemporal_load((const u32x4*)(HB + (size_t)(m_) * 1024 + 8)); \
        (dst)[2] = __builtin_nontemporal_load((const u32x4*)(MO + (size_t)(m_) * PROJ_LD)); (dst)[3] = __builtin_nontemporal_load((const u32x4*)(MO + (size_t)(m_) * PROJ_LD + 8)); } while (0)
    MO_LD(rw, gw);
    for (int m = gw; m < MROWS; m += NGW) {
        const bool more = m + NGW < MROWS; u32x4 nrw[4];
        if (more) MO_LD(nrw, m + NGW);
        float h[16], g[16];
        { float f[8]; unpack8(rw[0], f);
#pragma unroll
          for (int i = 0; i < 8; ++i) h[i] = f[i];
          unpack8(rw[1], f);
#pragma unroll
          for (int i = 0; i < 8; ++i) h[8 + i] = f[i];
          unpack8(rw[2], f);
#pragma unroll
          for (int i = 0; i < 8; ++i) g[i] = f[i];
          unpack8(rw[3], f);
#pragma unroll
          for (int i = 0; i < 8; ++i) g[8 + i] = f[i]; }
        float s = 0.f;
#pragma unroll
        for (int i = 0; i < 16; ++i) s += h[i] * h[i];
        s += __shfl_xor(s, 1); s += __shfl_xor(s, 2); s += __shfl_xor(s, 4); s += __shfl_xor(s, 8);
        const float rs = 1.f / sqrtf(s * (1.f / 256.f) + EPS);
        float o[8];
#pragma unroll
        for (int i = 0; i < 8; ++i) o[i] = h[i] * rs * ow[i] * sigmoidf_(g[i]);
        *(u32x4*)(MIX + (size_t)m * DM) = pack8f(o);
#pragma unroll
        for (int i = 0; i < 8; ++i) o[i] = h[8 + i] * rs * ow[8 + i] * sigmoidf_(g[8 + i]);
        *(u32x4*)(MIX + (size_t)m * DM + 8) = pack8f(o);
        if (more) {
#pragma unroll
            for (int j = 0; j < 4; ++j) rw[j] = nrw[j]; }
    }
#undef MO_LD
}
__device__ __forceinline__ void group_barrier(unsigned* cnt, unsigned target) {
    asm volatile("s_waitcnt vmcnt(0)" ::: "memory");
    __syncthreads();
    if (threadIdx.x == 0) {
        __builtin_amdgcn_fence(__ATOMIC_RELEASE, "agent");
        asm volatile("s_waitcnt vmcnt(0)" ::: "memory");
        (void)__hip_atomic_fetch_add(cnt, 1u, RLX_AGENT);
        unsigned sp = 0;
        while (__hip_atomic_load(cnt, RLX_AGENT) < target) { __builtin_amdgcn_s_sleep(1); if (++sp > (1u << 22)) break; }
        __builtin_amdgcn_fence(__ATOMIC_ACQUIRE, "agent");
        asm volatile("s_waitcnt vmcnt(0)" ::: "memory");
    }
    __syncthreads();
}
__device__ __forceinline__ void mlstm_scan(const Args& A, int g, int x) {
    int tid_ = threadIdx.x; asm volatile("" : "+v"(tid_));
    const float* M2 = (const float*)(A.ws + WS_M2) + (size_t)g * SEQ;
    const bf16_t* U = (const bf16_t*)(A.ws + WS_UB) + (size_t)g * 16 * 32768 + 2048 * x + 4 * tid_;
    bf16_t* C = (bf16_t*)(A.ws + WS_CB) + (size_t)g * 16 * 32768 + 2048 * x + 4 * tid_;
    const bool nscan = x == 0 && tid_ < 128;
    const float* nU = (const float*)(A.ws + WS_NU) + (size_t)g * 16 * 128 + (tid_ & 127); float* nC = (float*)(A.ws + WS_NC) + (size_t)g * 16 * 128 + (tid_ & 127);
    u32x2 uu[15]; float me[15], nu[15];
#pragma unroll
    for (int b = 0; b < 15; ++b) { uu[b] = *(const u32x2*)(U + (size_t)b * 32768); me[b] = M2[256 * b + 255]; nu[b] = nscan ? nU[b * 128] : 0.f; }
    f32x4 c = {0.f, 0.f, 0.f, 0.f}; *(u32x2*)C = (u32x2){0u, 0u};
    float n = 0.f; if (nscan) nC[0] = 0.f;
#pragma unroll
    for (int b = 0; b < 15; ++b) { const float gdec = (b == 0) ? 0.f : __builtin_amdgcn_exp2f(me[b - 1] - me[b]);
        c = c * gdec + (f32x4){bflo(uu[b].x), bfhi(uu[b].x), bflo(uu[b].y), bfhi(uu[b].y)};
        u32x2 w; w.x = cvtpk2(c[0], c[1]); w.y = cvtpk2(c[2], c[3]); *(u32x2*)(C + (size_t)(b + 1) * 32768) = w;
        n = n * gdec + nu[b]; if (nscan) nC[(b + 1) * 128] = n; }
}
__device__ __forceinline__ fa::BlockRef p3_fitem(const Args& A, int id, int ja, int jb, int part) {
    fa::BlockRef r; const int bh = id >> 4, qb = id & 15, b = bh / AH, h = bh % AH; const size_t row0 = (size_t)b * SEQ;
    const fa::bf16* PROJ = (const fa::bf16*)(A.ws + WS_R1) + row0 * PROJ_LD + h * 128;
    r.Q = PROJ + PC_AQ; r.K = PROJ + PC_AK; r.V = PROJ + PC_AV; r.O = (fa::bf16*)(A.ws + WS_R2) + row0 * DM + h * 128;
    r.aux = (const float*)(A.ws + WS_CK) + (size_t)bh * SEQ; r.sq = A.out + OUT_SSQK + (size_t)h * MROWS + row0; r.P0 = qb * 256; r.j0 = ja; r.j1 = jb; r.part = part;
    r.PO = (fa::bf16*)A.out + (size_t)id * 32768; r.PS = A.out + 8388608 + (size_t)id * 512; r.flag = (unsigned*)(A.ws + WS_FLAG) + id; return r;
}
__device__ __forceinline__ int fox_worklist(const Args& A, LAS unsigned char* lq, int k) {
    int tid_ = threadIdx.x; asm volatile("" : "+v"(tid_));
    const int tid = tid_;
    LAS unsigned short* cost = (LAS unsigned short*)lq; LAS unsigned short* key = cost + 512; LAS unsigned short* order = key + 512; LAS unsigned char* jas = (LAS unsigned char*)(order + 512); LAS unsigned char* jbs = jas + 512;
    LAS float* pcost = (LAS float*)(jbs + 512); LAS unsigned char* pcls = (LAS unsigned char*)(pcost + 32); LAS int* cnt = (LAS int*)(pcls + 32);
    const int j0 = ((const int*)(A.ws + WS_J0))[tid], NT = 4 * (tid & 15) + 4, c = NT - j0;
    { float pc = (float)c; pc += __shfl_xor(pc, 1); pc += __shfl_xor(pc, 2); pc += __shfl_xor(pc, 4); pc += __shfl_xor(pc, 8); if ((tid & 15) == 0) pcost[tid >> 4] = pc; if (tid == 0) cnt[0] = 0; }
    __syncthreads();
    if (tid < 32) { const int b = tid >> 3, h = tid & 7; const int kk = (b & 1) ? (h < 4 ? 3 - h : h - 4) : (h < 4 ? h : 7 - h); pcls[tid] = (unsigned char)(kk + 4 * (b >> 1)); }
    __syncthreads();
    if (pcls[tid >> 4] == k) {
        if (c >= 36) { const int jm = j0 + (((c >> 1) + 1) & ~1); const int sl = __hip_atomic_fetch_add(cnt, 2, __ATOMIC_RELAXED, __HIP_MEMORY_SCOPE_WORKGROUP);
            key[sl] = (unsigned short)tid; jas[sl] = (unsigned char)j0; jbs[sl] = (unsigned char)jm; cost[sl] = (unsigned short)(jm - j0);
            key[sl + 1] = (unsigned short)(512 + tid); jas[sl + 1] = (unsigned char)jm; jbs[sl + 1] = (unsigned char)NT; cost[sl + 1] = (unsigned short)(NT - jm); }
        else { const int sl = __hip_atomic_fetch_add(cnt, 1, __ATOMIC_RELAXED, __HIP_MEMORY_SCOPE_WORKGROUP);
            key[sl] = (unsigned short)tid; jas[sl] = (unsigned char)j0; jbs[sl] = (unsigned char)NT; cost[sl] = (unsigned short)c; } }
    __syncthreads();
    const int n = cnt[0] < 512 ? cnt[0] : 512;
    if (tid < n) { const unsigned ci = cost[tid], ki = key[tid]; int rank = 0;
      for (int j = 0; j < n; ++j) { const unsigned cj = cost[j], kj = key[j]; rank += (cj > ci || (cj == ci && kj < ki)) ? 1 : 0; }
      order[rank] = (unsigned short)tid; }
    __syncthreads();
    return n;
}

#ifndef ONLY
#define ONLY -1
#endif
#ifndef REP0
#define REP0 1
#endif
#ifndef REP1
#define REP1 1
#endif
#ifndef REP3
#define REP3 1
#endif
#ifndef REP6
#define REP6 1
#endif
#ifndef REP2B
#define REP2B 1
#endif
#ifndef REP4
#define REP4 1
#endif
#ifndef XSYNC
#define XSYNC 0
#endif
#ifndef REP5
#define REP5 1
#endif
#ifndef REP2A
#define REP2A 1
#endif
#ifndef REP7
#define REP7 1
#endif
#ifndef REP8
#define REP8 1
#endif
#ifndef REPM
#define REPM 1
#endif
#ifndef REPF
#define REPF 1
#endif
#ifndef TSA
#define TSA 0
#endif
#ifndef TSB
#define TSB 0
#endif
#ifndef TSMULT
#define TSMULT 4
#endif
#ifndef SKIPMASK
#define SKIPMASK 0
#endif
#define PH(k) if constexpr (ONLY < 0 ? !((SKIPMASK >> (k)) & 1) : ONLY == (k))
template <class T> __device__ __forceinline__ T* as_global(T* p) { return (T*)(__attribute__((address_space(1))) T*)p; }
__device__ __forceinline__ Args load_args() {
#if defined(__HIP_DEVICE_COMPILE__)
    const __attribute__((address_space(4))) Args* ap = (const __attribute__((address_space(4))) Args*)__builtin_amdgcn_kernarg_segment_ptr();
    asm volatile("" : "+s"(ap));
    Args a = *ap;
#define FX(f) a.f = as_global(a.f)
    FX(x); FX(p); FX(w_norm_mix); FX(w_in); FX(fox_f_bias); FX(q_norm_w); FX(k_norm_w); FX(conv_w); FX(conv_b); FX(mi_bias); FX(mf_bias); FX(out_norm_w); FX(w_out); FX(w_norm_ffn);
    FX(w_gate); FX(w_up); FX(w_down); FX(w_norm_ple); FX(w_ple_gate); FX(w_ple_proj); FX(w_ple_post); FX(out); FX(ws);
#undef FX
    return a;
#else
    return Args{};
#endif
}
#define ARGS() load_args()
__global__ void __launch_bounds__(NTHREADS, 2) fwd_megakernel(Args Aunused) {
    extern __shared__ __attribute__((aligned(16))) unsigned char lds[];
    cg::grid_group grid = cg::this_grid();
    LAS unsigned char* ldsl = (LAS unsigned char*)lds;
    const int G = gridDim.x, bx = blockIdx.x, NGW = G * NWAVES;
#define TS(k) do { if (TSA != TSB) { if (bx == 0 && threadIdx.x == 0) ((volatile LAS unsigned long long*)(ldsl + 131072 + 256))[k] = __builtin_amdgcn_s_memrealtime(); } } while (0)
#define LANEVARS() int tid_ = threadIdx.x; asm volatile("" : "+v"(tid_)); const int lane = tid_ & 63, wave = __builtin_amdgcn_readfirstlane(tid_ >> 6), gw = bx * NWAVES + wave; (void)lane; (void)gw

    if (threadIdx.x < 16) ((volatile LAS unsigned*)(ldsl + 131072))[threadIdx.x] = 0u;
    __syncthreads();
    XcdBarrier xbar = xcd_barrier_post((unsigned*)(ARGS().ws + WS_BAR), (volatile LAS unsigned*)(ldsl + 131072));
#define GRID_BAR() xcd_barrier(xbar)
    if (ARGS().ws == nullptr) grid.sync();
    TS(0);
    PH(0) for (int rep = 0; rep < REP0; ++rep) { const Args A = ARGS(); LANEVARS(); p0_prologue(A, ldsl, gw, NGW, lane, wave); }
    GRID_BAR();
    TS(1);
    for (int rep = 0; rep < XSYNC; ++rep) GRID_BAR();
    PH(1) { const Args A = ARGS(); gate_cols(A, ldsl, bx, G); }
    PH(1) for (int rep = 0; rep < REP1; ++rep) { const Args A = ARGS(); unsigned char* ws = A.ws;
        pg8::Gemm g{(const bf16_t*)(ws + WS_R2), (const bf16_t*)(ws + WS_WIN), MROWS, PROJ_LD, DM}; pg8::StaticOrder S; S.init(MROWS, PROJ_LD, G, bx);
        pg8::EpiProj E{(bf16_t*)(ws + WS_R1), (const float*)(ws + WS_SS) + 3 * MROWS, A.q_norm_w, A.k_norm_w, A.out + OUT_SSQK};
        pg8::gemm_phase<pg8::EpiProj, pg8::StaticOrder, true, true>(ldsl, g, S, E);
    }
    PH(10) { const Args A = ARGS(); unsigned char* ws = A.ws; float* SS = (float*)(ws + WS_SS);
        pg8::Gemm g{(const bf16_t*)(ws + WS_R3), (const bf16_t*)(ws + WS_WPP), MROWS, DM, PLE}; pg8::StaticOrder S; S.init(MROWS, DM, G, bx);
        pg8::EpiE E{(bf16_t*)(ws + WS_ERAW), SS};
        pg8::gemm_phase<pg8::EpiE, pg8::StaticOrder, true, true>(ldsl, g, S, E);
    }
    GRID_BAR(); TS(2);
    PH(2) for (int rep = 0; rep < REP2A; ++rep) { const Args A = ARGS(); for (int v = bx; v < NB * AH + NB * MH; v += G) { scan_sequence(A, v, (LAS float*)ldsl); __syncthreads(); } }
    PH(2) for (int rep = 0; rep < REP2A; ++rep) { const Args A = ARGS(); LANEVARS(); const int nsc = NB * AH + NB * MH;
        if (G > 2 * nsc) { if (bx >= nsc) mconv_rows(A, gw - nsc * NWAVES, NGW - nsc * NWAVES, lane); } else mconv_rows(A, gw, NGW, lane); }
    GRID_BAR(); TS(3);
    PH(3) for (int rep = 0; rep < REP3; ++rep) { const Args A = ARGS(); const int w = bx & 255, x = w & 15, g = w >> 4;
        unsigned char* ws = A.ws; unsigned* gcnt = (unsigned*)(ws + WS_GB) + 64 * g;
        const int b = g / MH, h = g % MH; const size_t row0 = (size_t)b * SEQ;
        const float* M2 = (const float*)(ws + WS_M2) + (size_t)g * SEQ; const float aref = ((const float*)(ws + WS_AREF))[g * SEQ + x];
        const fa::bf16* MQp = (const fa::bf16*)(ws + WS_MQ) + row0 * 512 + h * 128; const fa::bf16* MKp = (const fa::bf16*)(ws + WS_MK) + row0 * 512 + h * 128;
        const fa::bf16* MVp = (const fa::bf16*)(ws + WS_R1) + row0 * PROJ_LD + PC_MV + h * 256;
        for (int rm = 0; rm < REPM; ++rm) {
        { fa::StateRef R{MKp, MVp, (fa::bf16*)(ws + WS_UB) + (size_t)(g * 16 + x) * 32768, (float*)(ws + WS_NU) + (g * 16 + x) * 128, (const float*)(ws + WS_A2) + (size_t)g * SEQ, aref, exp2f(aref - M2[256 * x + 255]), 256 * x};
          fa::mlstm_state_block(R, (char*)lds); }
        group_barrier(gcnt, 16u * (2 * rm + 1));
        mlstm_scan(A, g, x);
        group_barrier(gcnt, 16u * (2 * rm + 2));
        { fa::OutRef R{MQp, MKp, MVp, (const fa::bf16*)(ws + WS_CB) + (size_t)(g * 16 + x) * 32768, (const float*)(ws + WS_NC) + (g * 16 + x) * 128,
                       (fa::bf16*)(ws + WS_R2) + row0 * DM + 1024 + h * 256, M2, (const float*)(ws + WS_A2) + (size_t)g * SEQ, aref, x > 0 ? M2[256 * x - 1] : 0.f, 256 * x,
                       (const fa::bf16*)(ws + WS_R1) + row0 * PROJ_LD + PC_MO + h * 256, A.out_norm_w + h * 256};
          fa::mlstm_out_pass2(R, (char*)lds); }
        }
        TS(4);
        for (int rf = 0; rf < REPF; ++rf) {
            LAS unsigned char* lq = ldsl + 98304; LAS unsigned short* key = (LAS unsigned short*)lq + 512; LAS unsigned short* order = key + 512; LAS unsigned char* jas = (LAS unsigned char*)(order + 512); LAS unsigned char* jbs = jas + 512;
            LAS int* popw = (LAS int*)(lq + 8192);
            const int kcls = bx & 7;
            const int nit = fox_worklist(A, lq, kcls);
            unsigned* qhead = (unsigned*)(ws + WS_GB) + 16 * 64 + 64 * (8 * rf + kcls);
#define FOX_POP(dst) do { if (threadIdx.x == 0) popw[0] = (int)__hip_atomic_fetch_add(qhead, 1u, RLX_AGENT); __syncthreads(); dst = popw[0]; __syncthreads(); } while (0)
#define FOX_ITEM(q_) p3_fitem(A, (int)key[order[q_]] & 511, jas[order[q_]], jbs[order[q_]], key[order[q_]] >= 512 ? 2 : ((int)jbs[order[q_]] != 4 * ((int)key[order[q_]] & 15) + 4 ? 1 : 0))
            int qi; FOX_POP(qi);
            if (qi < nit) {
                fa::Seam S; fa::BlockRef c = FOX_ITEM(qi); fa::attn_prime<0>(c, (char*)lds, S);
                for (;;) {
                    int qn; bool more; fa::BlockRef n;
                    fa::attn_block_lp<0>(c, (char*)lds, S, qhead, (volatile int*)(lds + 98304 + 8192), nit, [&](int q_) { return FOX_ITEM(q_); }, qn, n, more);
                    qi = qn;
                    if (!more) break;
                    c = n;
                }
            }
            if (rf == 0) { __syncthreads(); unsigned* chead = (unsigned*)(ws + WS_GB) + 16 * 64 + 64 * 8;
#define CV_POP(dst) do { if (threadIdx.x == 0) popw[0] = (int)__hip_atomic_fetch_add(chead, 1u, RLX_AGENT); __syncthreads(); dst = popw[0]; __syncthreads(); } while (0)
                int ch; CV_POP(ch);
                while (ch < CV_CHUNKS) { p3_convert_chunk(A, ldsl, ch); CV_POP(ch); }
#undef CV_POP
            }
#undef FOX_POP
#undef FOX_ITEM
        }
        asm volatile("s_waitcnt vmcnt(0)" ::: "memory");
        __syncthreads();
    }
    GRID_BAR(); TS(5);
    PH(5) for (int rep = 0; rep < REP5; ++rep) { const Args A = ARGS(); unsigned char* ws = A.ws; float* SS = (float*)(ws + WS_SS);
        pg8::Gemm g{(const bf16_t*)(ws + WS_R2), (const bf16_t*)(ws + WS_WO), MROWS, DM, DM}; pg8::StaticOrder S; S.init(MROWS, DM, G, bx, 4);
        pg8::EpiRes<false> E{A.x, (bf16_t*)(ws + WS_R3), SS + MROWS, rep == 0};
        pg8::gemm_phase<pg8::EpiRes<false>, pg8::StaticOrder, true, true>(ldsl, g, S, E);
    }
    GRID_BAR(); TS(7);
    PH(6) for (int rep = 0; rep < REP6; ++rep) { const Args A = ARGS(); unsigned char* ws = A.ws; float* SS = (float*)(ws + WS_SS);
        pg8::Gemm g{(const bf16_t*)(ws + WS_R3), (const bf16_t*)(ws + WS_WGU), MROWS, 2 * DFF, DM}; pg8::StaticOrder S; S.init(MROWS, 2 * DFF, G, bx);
        pg8::EpiSwiGLU E{(bf16_t*)(ws + WS_R1), SS + MROWS};
        pg8::gemm_phase<pg8::EpiSwiGLU, pg8::StaticOrder, true, true>(ldsl, g, S, E);
    }
    GRID_BAR(); TS(8);
    PH(7) for (int rep = 0; rep < REP7; ++rep) { const Args A = ARGS(); unsigned char* ws = A.ws; float* SS = (float*)(ws + WS_SS) + (rep + 1 < REP7 ? 2 * MROWS : 0);
        pg8::Gemm g{(const bf16_t*)(ws + WS_R1), (const bf16_t*)(ws + WS_WD), MROWS, DM, DFF}; pg8::StaticOrder S; S.init(MROWS, DM, G, bx, 4);
        pg8::EpiRes<true> E{(const void*)(ws + WS_R3), (bf16_t*)(ws + WS_R2), SS + 2 * MROWS, 1};
        pg8::gemm_phase<pg8::EpiRes<true>, pg8::StaticOrder, true, true>(ldsl, g, S, E);
    }
    GRID_BAR(); TS(9);
    PH(8) for (int rep = 0; rep < REP8; ++rep) { const Args A = ARGS(); unsigned char* ws = A.ws; float* SS = (float*)(ws + WS_SS);
        pg8::Gemm g{(const bf16_t*)(ws + WS_R2), (const bf16_t*)(ws + WS_WPG), MROWS, DM, DM}; pg8::StaticOrder S; S.init(MROWS, DM, G, bx, 4);
        pg8::EpiFinal E{A.out, (const bf16_t*)(ws + WS_R2), (const bf16_t*)(ws + WS_ERAW), A.w_ple_post, SS + 2 * MROWS, SS};
        pg8::gemm_phase<pg8::EpiFinal, pg8::StaticOrder, true, true>(ldsl, g, S, E);
    }
    TS(10);
    if (TSA != TSB) { if (bx == 0 && threadIdx.x == 0) { volatile LAS unsigned long long* t = (volatile LAS unsigned long long*)(ldsl + 131072 + 256); const unsigned long long d = (t[TSB] - t[TSA]) * TSMULT, e0 = __builtin_amdgcn_s_memrealtime();
            while (__builtin_amdgcn_s_memrealtime() - e0 < d) __builtin_amdgcn_s_sleep(8); } }
}

extern "C" void kernel_launch(void* const* d_in, const int* in_sizes, int n_in, void* d_out, int out_size, void* d_ws, size_t ws_size, hipStream_t stream) {
    static int grid = 0;
    if (grid == 0) {
        if (n_in != 21 || in_sizes[0] != MROWS * DM || out_size != MROWS * DM || ws_size < WS_END) {
            fprintf(stderr, "kernel_launch: unexpected shapes (n_in %d, in0 %d, out %d, ws %zu; need ws >= %zu)\n", n_in, n_in > 0 ? in_sizes[0] : -1, out_size, ws_size, (size_t)WS_END); grid = -1; return; }
        int dev = 0, cus = 0, per_cu = 0;
        (void)hipGetDevice(&dev); (void)hipDeviceGetAttribute(&cus, hipDeviceAttributeMultiprocessorCount, dev);
        if (hipFuncSetAttribute((const void*)fwd_megakernel, hipFuncAttributeMaxDynamicSharedMemorySize, LDS_BYTES) != hipSuccess) { fprintf(stderr, "kernel_launch: hipFuncSetAttribute failed\n"); grid = -1; return; }
        if (hipOccupancyMaxActiveBlocksPerMultiprocessor(&per_cu, (const void*)fwd_megakernel, NTHREADS, LDS_BYTES) != hipSuccess || per_cu < 1) { fprintf(stderr, "kernel_launch: occupancy query says %d blocks per CU\n", per_cu); per_cu = 1; }
        (void)hipGetLastError();
        if (per_cu > 1) per_cu = 1;
        grid = cus * per_cu;
        if (grid != 256) { fprintf(stderr, "kernel_launch: this kernel is laid out for a 256-CU device (got %d workgroups)\n", grid); grid = -1; return; }
    }
    if (grid < 0) return;
    if (hipMemsetAsync((char*)d_ws + WS_BAR, 0, 65536, stream) != hipSuccess) { fprintf(stderr, "kernel_launch: hipMemsetAsync of the control words failed\n"); return; }
    Args a{};
    a.x = (const float*)d_in[0]; a.p = (const float*)d_in[1]; a.w_norm_mix = (const float*)d_in[2]; a.w_in = (const float*)d_in[3]; a.fox_f_bias = (const float*)d_in[4];
    a.q_norm_w = (const float*)d_in[5]; a.k_norm_w = (const float*)d_in[6]; a.conv_w = (const float*)d_in[7]; a.conv_b = (const float*)d_in[8]; a.mi_bias = (const float*)d_in[9];
    a.mf_bias = (const float*)d_in[10]; a.out_norm_w = (const float*)d_in[11]; a.w_out = (const float*)d_in[12]; a.w_norm_ffn = (const float*)d_in[13]; a.w_gate = (const float*)d_in[14];
    a.w_up = (const float*)d_in[15]; a.w_down = (const float*)d_in[16]; a.w_norm_ple = (const float*)d_in[17]; a.w_ple_gate = (const float*)d_in[18]; a.w_ple_proj = (const float*)d_in[19];
    a.w_ple_post = (const float*)d_in[20];
    a.out = (float*)d_out; a.ws = (unsigned char*)d_ws;
    void* args[] = {&a};
    hipError_t e = hipLaunchCooperativeKernel((const void*)fwd_megakernel, dim3(grid), dim3(NTHREADS), args, LDS_BYTES, stream);
    if (e != hipSuccess) fprintf(stderr, "kernel_launch: cooperative launch failed: %s (grid %d)\n", hipGetErrorString(e), grid);
}
```
